# Optimizing an MI355X kernel written in HIP

```python
import math
import jax
import jax.numpy as jnp
from jax import lax
import numpy as np

D_MODEL = 1024
BATCH = 8
SEQ = 4096
DEPTH = 1

RET_HEADS = 4
RET_HEAD_DIM = 256
RET_WIDTH = RET_HEADS * RET_HEAD_DIM
RET_CHUNK = 128
ROPE_BASE = 10000.0
ATT_HEADS = 16
ATT_HEAD_DIM = 64
ATT_WIDTH = ATT_HEADS * ATT_HEAD_DIM
DILATION_PATTERNS = ((128, 1), (512, 4), (2048, 16))
REL_BUCKETS = 32
REL_MAX_DISTANCE = 1024
N_EXPERTS = 256
TOP_K = 8
N_GROUPS = 8
TOPK_GROUPS = 4
EXPERT_HIDDEN = 256
SHARED_HIDDEN = 256
ROUTED_SCALE = 2.5
MOE_BLOCK = 128
NORM_EPS = 1e-6
PROJ_WIDTH = 4 * RET_WIDTH + 3 * ATT_WIDTH + 2 * D_MODEL

kernel_name = 'hybrid_retention_dilated_attn_moe_block'


def rms_norm(x, gain):
    xf = x.astype(jnp.float32)
    y = xf * lax.rsqrt(jnp.mean(xf * xf, axis=-1, keepdims=True) + NORM_EPS)
    return (y * gain.astype(jnp.float32)).astype(x.dtype)


def modulate(h, shift, scale):
    return h * (1.0 + scale[:, None, :]) + shift[:, None, :]


def swiglu(h, w_gate, w_up, w_down):
    return (jax.nn.silu(h @ w_gate) * (h @ w_up)) @ w_down


def rotary(t):
    seq, dh = t.shape[1], t.shape[-1]
    half = dh // 2
    inv_freq = ROPE_BASE ** (-jnp.arange(half, dtype=jnp.float32) / half)
    ang = jnp.arange(seq, dtype=jnp.float32)[:, None] * inv_freq[None, :]
    cos = jnp.cos(ang)[None, :, None, :].astype(t.dtype)
    sin = jnp.sin(ang)[None, :, None, :].astype(t.dtype)
    t1, t2 = t[..., :half], t[..., half:]
    return jnp.concatenate([t1 * cos - t2 * sin, t1 * sin + t2 * cos], axis=-1)


def retention_scan(q, k, v, log_gamma, strict):
    bsz, heads, seq, dk = q.shape
    dv = v.shape[-1]
    n_chunks = seq // RET_CHUNK
    dt = q.dtype
    pos = jnp.arange(RET_CHUNK, dtype=jnp.float32)
    diff = pos[:, None] - pos[None, :]
    allowed = (diff > 0) if strict else (diff >= 0)
    lg = log_gamma[:, None, None]
    intra = jnp.where(allowed[None], jnp.exp(lg * jnp.where(allowed, diff, 0.0)[None]), 0.0).astype(dt)
    q_scale = jnp.exp(log_gamma[:, None] * (pos[None, :] + 1.0)).astype(dt)[None, :, :, None]
    k_scale = jnp.exp(log_gamma[:, None] * (RET_CHUNK - 1.0 - pos[None, :])).astype(dt)[None, :, :, None]
    chunk_decay = jnp.exp(log_gamma * RET_CHUNK).astype(dt)[None, :, None, None]

    def chunks(t):
        return t.reshape(bsz, heads, n_chunks, RET_CHUNK, t.shape[-1]).transpose(2, 0, 1, 3, 4)

    def step(state, inp):
        qn, kn, vn = inp
        scores = jnp.einsum('bhid,bhjd->bhij', qn, kn) * intra[None]
        out = (jnp.einsum('bhij,bhje->bhie', scores, vn)
               + jnp.einsum('bhid,bhde->bhie', qn * q_scale, state))
        state = state * chunk_decay + jnp.einsum('bhjd,bhje->bhde', kn * k_scale, vn)
        return state, out

    state0 = jnp.zeros((bsz, heads, dk, dv), dt)
    _, out = lax.scan(step, state0, (chunks(q), chunks(k), chunks(v)))
    return out.transpose(1, 2, 0, 3, 4).reshape(bsz, heads, seq, dv)


def retention_mixer(q, k, v, g, ret_decay):
    bsz, seq, _ = q.shape

    def heads(t):
        return t.reshape(bsz, seq, RET_HEADS, RET_HEAD_DIM)

    q = rotary(heads(q)).transpose(0, 2, 1, 3)
    k = (rotary(heads(k)) * (RET_HEAD_DIM ** -0.5)).transpose(0, 2, 1, 3)
    v = heads(v).transpose(0, 2, 1, 3)
    log_gamma = jnp.log1p(-jnp.exp(ret_decay.astype(jnp.float32)))
    fwd = retention_scan(q, k, v, log_gamma[0], strict=False)
    bwd = jnp.flip(retention_scan(jnp.flip(q, 2), jnp.flip(k, 2), jnp.flip(v, 2), log_gamma[1], strict=True), 2)
    o = (fwd + bwd).astype(jnp.float32)
    mu = jnp.mean(o, axis=-1, keepdims=True)
    var = jnp.mean(jnp.square(o - mu), axis=-1, keepdims=True)
    o = ((o - mu) * lax.rsqrt(var + NORM_EPS)).astype(g.dtype)
    o = o.transpose(0, 2, 1, 3).reshape(bsz, seq, RET_WIDTH)
    return o * jax.nn.silu(g)


def t5_bucket(rel):
    half = REL_BUCKETS // 2
    max_exact = half // 2
    n = jnp.abs(rel)
    large = max_exact + (jnp.log(jnp.maximum(n, 1).astype(jnp.float32) / max_exact)
                         / math.log(REL_MAX_DISTANCE / max_exact) * (half - max_exact)).astype(jnp.int32)
    large = jnp.minimum(large, half - 1)
    return jnp.where(rel > 0, half, 0) + jnp.where(n < max_exact, n, large)


def dilated_band_attention(q, k, v, t5_bias, window, dilation):
    bsz, seq, heads, dh = q.shape
    radius = window // (2 * dilation)
    blk = radius
    length = seq // dilation
    n_blk = -(-length // blk)
    padded = n_blk * blk

    def to_strided(t):
        t = t.reshape(bsz, length, dilation, heads, dh).transpose(0, 2, 3, 1, 4)
        return jnp.pad(t, ((0, 0), (0, 0), (0, 0), (0, padded - length), (0, 0)))

    def band(t):
        t = jnp.pad(to_strided(t), ((0, 0), (0, 0), (0, 0), (blk, blk), (0, 0)))
        t = t.reshape(bsz, dilation, heads, n_blk + 2, blk, dh)
        return jnp.concatenate([t[:, :, :, :-2], t[:, :, :, 1:-1], t[:, :, :, 2:]], axis=4)

    qb = to_strided(q).reshape(bsz, dilation, heads, n_blk, blk, dh)
    kb, vb = band(k), band(v)
    qi = jnp.arange(blk, dtype=jnp.int32)
    kj = jnp.arange(3 * blk, dtype=jnp.int32)
    rel = kj[None, :] - blk - qi[:, None]
    key_idx = jnp.arange(n_blk, dtype=jnp.int32)[:, None] * blk - blk + kj[None, :]
    valid = (jnp.abs(rel) <= radius)[None] & ((key_idx >= 0) & (key_idx < length))[:, None, :]
    bias = t5_bias[t5_bucket(rel * dilation)].astype(jnp.float32).transpose(2, 0, 1)
    s = jnp.einsum('brhnqe,brhnke->brhnqk', qb, kb).astype(jnp.float32) * (dh ** -0.5)
    s = s + bias[None, None, :, None]
    s = jnp.where(valid[None, None, None], s, -jnp.inf)
    lse = jax.nn.logsumexp(s, axis=-1)
    p = jnp.exp(s - lse[..., None]).astype(v.dtype)
    o = jnp.einsum('brhnqk,brhnke->brhnqe', p, vb)
    o = o.reshape(bsz, dilation, heads, padded, dh)[:, :, :, :length]
    o = o.transpose(0, 3, 1, 2, 4).reshape(bsz, seq, heads, dh)
    lse = lse.reshape(bsz, dilation, heads, padded)[..., :length].transpose(0, 3, 1, 2).reshape(bsz, seq, heads)
    return o, lse


def dilated_attention(q, k, v, t5_bias):
    bsz, seq, _ = q.shape

    def heads(t):
        return t.reshape(bsz, seq, ATT_HEADS, ATT_HEAD_DIM)

    q, k, v = heads(q), heads(k), heads(v)
    outs, lses = [], []
    for window, dilation in DILATION_PATTERNS:
        o, lse = dilated_band_attention(q, k, v, t5_bias, window, dilation)
        outs.append(o)
        lses.append(lse)
    weights = jax.nn.softmax(jnp.stack(lses, axis=-1), axis=-1).astype(q.dtype)
    o = jnp.sum(jnp.stack(outs, axis=-2) * weights[..., None], axis=-2)
    return o.reshape(bsz, seq, ATT_WIDTH)


def token_mixer(h, w_in, ret_decay, t5_bias, w_ret_up, w_att_up, w_o):
    widths = [RET_WIDTH] * 4 + [ATT_WIDTH] * 3 + [D_MODEL] * 2
    splits = np.cumsum(widths)[:-1].tolist()
    proj = h @ w_in
    rq, rk, rv, rg, aq, ak, av, gate_r, gate_a = jnp.split(proj, splits, axis=-1)
    y_ret = retention_mixer(rq, rk, rv, rg, ret_decay) @ w_ret_up
    y_att = dilated_attention(aq, ak, av, t5_bias) @ w_att_up
    merged = jax.nn.sigmoid(gate_r) * y_ret + jax.nn.sigmoid(gate_a) * y_att
    return merged @ w_o


def route(h, w_router, router_bias):
    n_tok = h.shape[0]
    per_group = N_EXPERTS // N_GROUPS
    scores = jax.nn.sigmoid((h @ w_router).astype(jnp.float32))
    choice = scores + router_bias.astype(jnp.float32)
    group_score = jnp.sum(lax.top_k(choice.reshape(n_tok, N_GROUPS, per_group), 2)[0], axis=-1)
    _, top_groups = lax.top_k(group_score, TOPK_GROUPS)
    group_mask = jnp.sum(jax.nn.one_hot(top_groups, N_GROUPS, dtype=jnp.float32), axis=-2) > 0
    expert_mask = jnp.repeat(group_mask, per_group, axis=-1)
    _, expert_idx = lax.top_k(jnp.where(expert_mask, choice, -jnp.inf), TOP_K)
    gate = jnp.take_along_axis(scores, expert_idx, axis=-1)
    gate = gate / jnp.sum(gate, axis=-1, keepdims=True) * ROUTED_SCALE
    return expert_idx.astype(jnp.int32), gate


def routed_experts(h, expert_idx, gate, w_gate, w_up, w_down):
    n_tok, d = h.shape
    n_assign = n_tok * TOP_K
    n_blocks = -(-n_assign // MOE_BLOCK) + N_EXPERTS
    buf = n_blocks * MOE_BLOCK
    flat_e = expert_idx.reshape(-1)
    flat_t = jnp.repeat(jnp.arange(n_tok, dtype=jnp.int32), TOP_K)
    flat_w = gate.reshape(-1).astype(h.dtype)
    order = jnp.argsort(flat_e)
    e_s, t_s, w_s = flat_e[order], flat_t[order], flat_w[order]
    counts = jnp.bincount(flat_e, length=N_EXPERTS).astype(jnp.int32)
    padded = (counts + MOE_BLOCK - 1) // MOE_BLOCK * MOE_BLOCK
    pad_end = jnp.cumsum(padded)
    pad_start = pad_end - padded
    start = jnp.cumsum(counts) - counts
    dest = pad_start[e_s] + jnp.arange(n_assign, dtype=jnp.int32) - start[e_s]
    tok_buf = jnp.full((buf,), n_tok, jnp.int32).at[dest].set(t_s)
    w_buf = jnp.zeros((buf,), h.dtype).at[dest].set(w_s)
    block_expert = jnp.clip(jnp.searchsorted(pad_end, jnp.arange(n_blocks, dtype=jnp.int32) * MOE_BLOCK, side='right'),
                            0, N_EXPERTS - 1)
    h_pad = jnp.concatenate([h, jnp.zeros((1, d), h.dtype)], axis=0)

    def block(args):
        tok, wt, e = args
        xb = h_pad[tok]
        hid = jax.nn.silu(xb @ w_gate[e]) * (xb @ w_up[e])
        return (hid @ w_down[e]) * wt[:, None]

    y = lax.map(block, (tok_buf.reshape(n_blocks, MOE_BLOCK), w_buf.reshape(n_blocks, MOE_BLOCK), block_expert))
    return jax.ops.segment_sum(y.reshape(buf, d), tok_buf, num_segments=n_tok + 1)[:n_tok]


def setup_inputs(seed: int = 0) -> dict:
    key = jax.random.key(seed)
    ks = jax.random.split(key, 24)
    f32 = jnp.float32

    def nrm(k, shape, scale):
        return jax.random.normal(k, shape, f32) * scale

    decay_init = jnp.asarray(np.log(2.0 ** (-5.0 - np.arange(RET_HEADS))), f32)
    return {
        'x': nrm(ks[0], (BATCH, SEQ, D_MODEL), 1.0),
        'c': nrm(ks[1], (BATCH, D_MODEL), 1.0),
        'w_ada': nrm(ks[2], (DEPTH, D_MODEL, 6 * D_MODEL), 0.5 * D_MODEL ** -0.5),
        'b_ada': nrm(ks[3], (DEPTH, 6 * D_MODEL), 0.02),
        'norm_mix': 1.0 + nrm(ks[4], (DEPTH, D_MODEL), 0.02),
        'w_in': nrm(ks[5], (DEPTH, D_MODEL, PROJ_WIDTH), D_MODEL ** -0.5),
        'ret_decay': decay_init[None, None, :] + nrm(ks[6], (DEPTH, 2, RET_HEADS), 0.1),
        't5_bias': nrm(ks[7], (REL_BUCKETS, ATT_HEADS), 0.5),
        'w_ret_up': nrm(ks[8], (DEPTH, RET_WIDTH, D_MODEL), RET_WIDTH ** -0.5),
        'w_att_up': nrm(ks[9], (DEPTH, ATT_WIDTH, D_MODEL), ATT_WIDTH ** -0.5),
        'w_o': nrm(ks[10], (DEPTH, D_MODEL, D_MODEL), D_MODEL ** -0.5),
        'norm_ffn': 1.0 + nrm(ks[11], (DEPTH, D_MODEL), 0.02),
        'w_router': nrm(ks[12], (DEPTH, D_MODEL, N_EXPERTS), D_MODEL ** -0.5),
        'router_bias': nrm(ks[13], (DEPTH, N_EXPERTS), 0.01),
        'w_gate': nrm(ks[14], (DEPTH, N_EXPERTS, D_MODEL, EXPERT_HIDDEN), D_MODEL ** -0.5),
        'w_up': nrm(ks[15], (DEPTH, N_EXPERTS, D_MODEL, EXPERT_HIDDEN), D_MODEL ** -0.5),
        'w_down': nrm(ks[16], (DEPTH, N_EXPERTS, EXPERT_HIDDEN, D_MODEL), EXPERT_HIDDEN ** -0.5),
        'ws_gate': nrm(ks[17], (DEPTH, D_MODEL, SHARED_HIDDEN), D_MODEL ** -0.5),
        'ws_up': nrm(ks[18], (DEPTH, D_MODEL, SHARED_HIDDEN), D_MODEL ** -0.5),
        'ws_down': nrm(ks[19], (DEPTH, SHARED_HIDDEN, D_MODEL), SHARED_HIDDEN ** -0.5),
        'norm_final': 1.0 + nrm(ks[20], (D_MODEL,), 0.02),
    }


def reference(x, c, w_ada, b_ada, norm_mix, w_in, ret_decay, t5_bias, w_ret_up, w_att_up, w_o,
              norm_ffn, w_router, router_bias, w_gate, w_up, w_down, ws_gate, ws_up, ws_down, norm_final):
    bsz, seq, d = x.shape
    cond = jax.nn.silu(c)
    for layer in range(DEPTH):
        mod = cond @ w_ada[layer] + b_ada[layer]
        shift_m, scale_m, gate_m, shift_f, scale_f, gate_f = jnp.split(mod, 6, axis=-1)
        h = modulate(rms_norm(x, norm_mix[layer]), shift_m, scale_m)
        x = x + gate_m[:, None, :] * token_mixer(h, w_in[layer], ret_decay[layer], t5_bias,
                                                 w_ret_up[layer], w_att_up[layer], w_o[layer])
        h = modulate(rms_norm(x, norm_ffn[layer]), shift_f, scale_f).reshape(bsz * seq, d)
        expert_idx, gate = route(h, w_router[layer], router_bias[layer])
        y = (routed_experts(h, expert_idx, gate, w_gate[layer], w_up[layer], w_down[layer])
             + swiglu(h, ws_gate[layer], ws_up[layer], ws_down[layer]))
        x = x + gate_f[:, None, :] * y.reshape(bsz, seq, d)
    return rms_norm(x, norm_final)
```

```cpp
#include <hip/hip_runtime.h>
#include <cstdio>
#include <cstdint>

#ifndef MK_N_LAUNCHES
#define MK_N_LAUNCHES 1
#endif
#define PROBE_LAUNCH -1
#ifndef PROBE_PHASE
#define PROBE_PHASE -1
#endif

#define LAS __attribute__((address_space(3)))
#define GAS __attribute__((address_space(1)))
typedef unsigned short bf16_t;
typedef short bf16x8 __attribute__((ext_vector_type(8)));
typedef short s16x4 __attribute__((ext_vector_type(4)));
typedef float f32x2 __attribute__((ext_vector_type(2)));
typedef float f32x4 __attribute__((ext_vector_type(4)));
typedef float f32x16 __attribute__((ext_vector_type(16)));
typedef unsigned u32x2 __attribute__((ext_vector_type(2)));
typedef unsigned u32x4 __attribute__((ext_vector_type(4)));
typedef __bf16 bf16x2_t __attribute__((ext_vector_type(2)));

constexpr int NB = 8, SEQ = 4096, DM = 1024, NTOK = NB * SEQ;
constexpr int PROJW = 9216, NEXP = 256, TOPK = 8, EH = 256;
constexpr float NORM_EPS = 1e-6f;

constexpr size_t MiB = 1u << 20;
constexpr size_t WS_CTL = 0, CTL_ZERO_BYTES = 1 * MiB;
constexpr size_t WS_MOD = 1 * MiB;
constexpr size_t WS_BTAB = 1 * MiB + 256 * 1024;
constexpr size_t WS_ROPE_C = 2 * MiB, WS_ROPE_S = 4 * MiB;
constexpr size_t WS_SS = 6 * MiB;
constexpr size_t WS_EIDX = 8 * MiB, WS_GATE = 9 * MiB;
constexpr size_t WS_ROWL = 10 * MiB;
constexpr size_t WS_TILE_E = 12 * MiB;
constexpr size_t WS_WIN = 16 * MiB, WS_WRU = 34 * MiB, WS_WAU = 36 * MiB, WS_WO = 38 * MiB, WS_WR = 40 * MiB;
constexpr size_t WS_H = 48 * MiB;
constexpr size_t WS_PROJ = 120 * MiB;
constexpr size_t SEG = 64 * MiB;
constexpr size_t WS_RQ = WS_PROJ, WS_RK = WS_PROJ + SEG, WS_RV = WS_PROJ + 2 * SEG, WS_RG = WS_PROJ + 3 * SEG, WS_AQ = WS_PROJ + 4 * SEG,
                 WS_AK = WS_PROJ + 5 * SEG, WS_AV = WS_PROJ + 6 * SEG, WS_SGR = WS_PROJ + 7 * SEG, WS_SGA = WS_PROJ + 8 * SEG;
constexpr size_t WS_OUTF = 696 * MiB, WS_OUTB = 760 * MiB, WS_OG = 824 * MiB, WS_LSE = 1016 * MiB;
constexpr size_t WS_RETN = WS_RQ, WS_ATTC = WS_RK, WS_YR = WS_RV, WS_MERGED = WS_AQ;
constexpr size_t WS_WGU = 120 * MiB, WS_WD = 377 * MiB, WS_HID = 512 * MiB, WS_LOGIT = 696 * MiB;
constexpr size_t WS_END = 1022 * MiB;
constexpr int YD_SPLIT = 262144, YD_SHARED0 = NTOK * TOPK;
constexpr float YD_SCALE = 16.0f, YD_INV = 0.0625f;
__device__ __forceinline__ unsigned char* ydense_row(unsigned char* ws, int row) { return ws + (row < YD_SPLIT ? 120 * MiB : 696 * MiB) + (size_t)(row < YD_SPLIT ? row : row - YD_SPLIT) * DM; }
__device__ __forceinline__ unsigned pk4_fp8(float a, float b, float c, float d) {
    a = __builtin_fminf(__builtin_fmaxf(a * YD_SCALE, -448.f), 448.f); b = __builtin_fminf(__builtin_fmaxf(b * YD_SCALE, -448.f), 448.f);
    c = __builtin_fminf(__builtin_fmaxf(c * YD_SCALE, -448.f), 448.f); d = __builtin_fminf(__builtin_fmaxf(d * YD_SCALE, -448.f), 448.f);
    int w = __builtin_amdgcn_cvt_pk_fp8_f32(a, b, 0, false); w = __builtin_amdgcn_cvt_pk_fp8_f32(c, d, w, true); return (unsigned)w;
}
constexpr size_t WS_DPOS = 13 * MiB;
constexpr int CW_TMO = 0, CW_BAR = 4096, CW_CNT = 16384, CW_FILL = 16384 + 1024;
constexpr int MAX_TILES = 2048;

__device__ __forceinline__ unsigned cvtpk(float lo, float hi) { f32x2 v = {lo, hi}; bf16x2_t b = __builtin_convertvector(v, bf16x2_t); return __builtin_bit_cast(unsigned, b); }
__device__ __forceinline__ float bf2f(unsigned short u) { return __uint_as_float((unsigned)u << 16); }
__device__ __forceinline__ float bflo(unsigned u) { return __uint_as_float(u << 16); }
__device__ __forceinline__ float bfhi(unsigned u) { return __uint_as_float(u & 0xffff0000u); }
__device__ __forceinline__ float wave_sum(float v) {
#pragma unroll
    for (int o = 1; o < 64; o <<= 1) v += __shfl_xor(v, o);
    return v;
}
__device__ __forceinline__ float sigmoidf_(float x) { return __builtin_amdgcn_rcpf(1.f + __builtin_amdgcn_exp2f(x * -1.4426950408889634f)); }
__device__ __forceinline__ float siluf_(float x) { return x * __builtin_amdgcn_rcpf(1.f + __builtin_amdgcn_exp2f(x * -1.4426950408889634f)); }

namespace pg8 {
constexpr int BM = 256, BK = 64, HALF = 128, HTB = HALF * BK * 2, STAGE_BYTES = 8 * HTB, NXCD = 8, WGM = 8;
__host__ __device__ __forceinline__ int lds_byte(int r, int c) { const int st = (r >> 4) * 2 + (c >> 5), rr = r & 15, cc = c & 31, ob = rr * 64 + cc * 2; return st * 1024 + (ob ^ (((ob >> 9) & 1) << 5)); }
__host__ __device__ __forceinline__ void stage_rc(int b, int& R, int& C) { const int st = b / 1024, sb = b % 1024, swz = sb ^ (((sb >> 9) & 1) << 5); R = (st >> 1) * 16 + swz / 64; C = (st & 1) * 32 + (swz % 64) / 2; }
__host__ __device__ __forceinline__ int perm32(int rho) { const int n = rho >> 4, i = rho & 15; return 8 * (i >> 2) + 4 * n + (i & 3); }

struct Unit { int pm, pn, e; };

__device__ __forceinline__ int xcd_remap(int L, int nwg) { const int q = nwg / NXCD, r = nwg % NXCD, xcd = L % NXCD, off = L / NXCD; return (xcd < r ? xcd * (q + 1) : r * (q + 1) + (xcd - r) * q) + off; }

struct StaticOrder {
    static constexpr bool GATHER = false, DUAL = false;
    const bf16_t* A; const bf16_t* Bt; int K;
    int nM, nN, nwg, G, c, pn_off;
    __device__ void init(const bf16_t* A_, const bf16_t* Bt_, int M, int N, int K_, int G_, int c_, int pn_off_ = 0) { A = A_; Bt = Bt_; K = K_; nM = M / BM; nN = N / BM; nwg = nM * nN; G = G_; c = c_; pn_off = pn_off_; }
    __device__ bool next(int i, Unit& u) const {
        const long L = (long)i * G + c; if (L >= nwg) return false;
        const int wgid = xcd_remap((int)L, nwg);
        const int nig = WGM * nN, gid = wgid / nig, fm = gid * WGM, gsz = (nM - fm) < WGM ? (nM - fm) : WGM;
        u.pm = fm + ((wgid % nig) % gsz); u.pn = (wgid % nig) / gsz + pn_off; u.e = 0; return true;
    }
    __device__ __forceinline__ const char* a_base(const Unit& u) const { return (const char*)A + (size_t)u.pm * (size_t)(BM * 2) * K; }
    __device__ __forceinline__ const char* b_base(const Unit& u) const { return (const char*)Bt + (size_t)u.pn * (size_t)(BM * 2) * K; }
    __device__ __forceinline__ unsigned a_row(const Unit&, int) const { return 0u; }
};

struct DualOrder {
    static constexpr bool GATHER = false, DUAL = true;
    StaticOrder so; const bf16_t* A1; const bf16_t* Bt1; int K;
    __device__ bool next(int i, Unit& u) const { if (!so.next(i >> 1, u)) return false; u.e = i & 1; return true; }
    __device__ __forceinline__ const char* a_base(const Unit& u) const { return (const char*)(u.e ? A1 : so.A) + (size_t)u.pm * (size_t)(BM * 2) * K; }
    __device__ __forceinline__ const char* b_base(const Unit& u) const { return (const char*)(u.e ? Bt1 : so.Bt) + (size_t)u.pn * (size_t)(BM * 2) * K; }
    __device__ __forceinline__ unsigned a_row(const Unit&, int) const { return 0u; }
};

template <bool GATHER_>
struct MoeOrder {
    static constexpr bool GATHER = GATHER_, DUAL = false;
    const bf16_t* A; const bf16_t* Bt; int K; size_t e_stride;
    const LAS unsigned short* tile_e; const int* rowlist; int ntiles, nN, nwg, G, c;
    __device__ bool next(int i, Unit& u) const {
        const long L = (long)i * G + c; if (L >= nwg) return false;
        const int wgid = xcd_remap((int)L, nwg);
        u.pm = wgid / nN; u.pn = wgid % nN; u.e = __builtin_amdgcn_readfirstlane((int)tile_e[u.pm]); return true;
    }
    __device__ __forceinline__ const char* a_base(const Unit& u) const { return GATHER ? (const char*)A : (const char*)A + (size_t)u.pm * (size_t)(BM * 2) * K; }
    __device__ __forceinline__ const char* b_base(const Unit& u) const { return (const char*)Bt + ((size_t)u.e * e_stride + (size_t)u.pn * BM * K) * 2; }
    __device__ __forceinline__ unsigned a_row(const Unit& u, int r) const { const int ent = rowlist[(size_t)u.pm * BM + r]; return ent < 0 ? (unsigned)NTOK : (unsigned)(ent >> 4); }
};

template <class Epi, class Sched, bool ALIGN_EPI>
__device__ __forceinline__ void gemm_phase(LAS unsigned char* lds, const Sched& S, const Epi& E) {
    const int tid = threadIdx.x, wid = __builtin_amdgcn_readfirstlane(tid >> 6), lane = tid & 63, wr = wid >> 2, wc = wid & 3, fr = lane & 15, fq = lane >> 4;
    const int K = S.K, nt = K / BK;
    unsigned voffA[2], voffB[2]; int RA[2]; unsigned CA2[2];
#pragma unroll
    for (int i = 0; i < 2; ++i) { int R, C; stage_rc(tid * 16 + i * 8192, R, C); const int Rb = Epi::PERM ? ((R & ~31) + perm32(R & 31)) : R;
        voffA[i] = (unsigned)(R * K + C) * 2u; voffB[i] = (unsigned)(Rb * K + C) * 2u; RA[i] = R; CA2[i] = (unsigned)C * 2u; }
    const size_t kstep = (size_t)(BK * 2);
    const size_t hstep = (size_t)HALF * K * 2;
    const unsigned ldsw = (unsigned)wid * 1024u;
    const int aoff = lds_byte(wr * 64 + fr, fq * 8), boff = lds_byte(wc * 32 + fr, fq * 8);
    unsigned gC[2][2], gN[2][2];
#define PG8_SA(b, h) (((b) * 2 + (h)) * HTB)
#define PG8_SB(b, h) ((4 + (b) * 2 + (h)) * HTB)
#define PG8_STAGE(bufoff, gbase, voff) do { _Pragma("unroll") for (int _i = 0; _i < 2; ++_i) \
        __builtin_amdgcn_global_load_lds((const unsigned*)((const char*)(gbase) + (voff)[_i]), (LAS unsigned*)(lds + (bufoff) + ldsw + _i * 8192), 16, 0, 0); } while (0)
#define PG8_STAGE_A(bufoff, p, h, NX) do { if constexpr (Sched::GATHER) { _Pragma("unroll") for (int _i = 0; _i < 2; ++_i) { const unsigned _v = (NX) ? gN[h][_i] : gC[h][_i]; \
        __builtin_amdgcn_global_load_lds((const unsigned*)((const char*)(p) + _v), (LAS unsigned*)(lds + (bufoff) + ldsw + _i * 8192), 16, 0, 0); } } \
        else { PG8_STAGE(bufoff, (p) + (h) * hstep, voffA); } } while (0)
#define PG8_GATHER_SET(g, u) do { _Pragma("unroll") for (int _h = 0; _h < 2; ++_h) _Pragma("unroll") for (int _i = 0; _i < 2; ++_i) \
        g[_h][_i] = S.a_row(u, _h * HALF + RA[_i]) * (unsigned)(K * 2) + CA2[_i]; } while (0)
#define PG8_LDA(dst, b, h) do { _Pragma("unroll") for (int m = 0; m < 4; ++m) _Pragma("unroll") for (int k = 0; k < 2; ++k) dst[m][k] = *(const LAS bf16x8*)(lds + PG8_SA(b, h) + aoff + m * 2048 + k * 1024); } while (0)
#define PG8_LDB(dst, b, h) do { _Pragma("unroll") for (int n = 0; n < 2; ++n) _Pragma("unroll") for (int k = 0; k < 2; ++k) dst[n][k] = *(const LAS bf16x8*)(lds + PG8_SB(b, h) + boff + n * 2048 + k * 1024); } while (0)
#define PG8_MMA(ai, bj, At, Bt) do { __builtin_amdgcn_s_setprio(1); _Pragma("unroll") for (int m = 0; m < 4; ++m) _Pragma("unroll") for (int n = 0; n < 2; ++n) _Pragma("unroll") for (int k = 0; k < 2; ++k) \
        acc[ai][bj][m][n] = __builtin_amdgcn_mfma_f32_16x16x32_bf16(Bt[n][k], At[m][k], acc[ai][bj][m][n], 0, 0, 0); __builtin_amdgcn_s_setprio(0); } while (0)
#define PG8_WAIT_V(n) asm volatile("s_waitcnt vmcnt(" #n ")" ::: "memory")
#define PG8_WAIT_L(n) asm volatile("s_waitcnt lgkmcnt(" #n ")" ::: "memory")
#define PG8_BAR __builtin_amdgcn_s_barrier()
#define PG8_SCHED __builtin_amdgcn_sched_barrier(0)
    Unit cur, nxt; int ui = 0;
    if (!S.next(0, cur)) return;
    f32x4 acc[2][2][4][2];
#pragma unroll
    for (int a = 0; a < 2; ++a)
#pragma unroll
        for (int b = 0; b < 2; ++b)
#pragma unroll
            for (int m = 0; m < 4; ++m)
#pragma unroll
                for (int n = 0; n < 2; ++n) acc[a][b][m][n] = (f32x4){0.f, 0.f, 0.f, 0.f};
    bf16x8 At[4][2], B0[2][2], B1[2][2];
    const char* cA = S.a_base(cur); const char* cB = S.b_base(cur);
    if constexpr (Sched::GATHER) { PG8_GATHER_SET(gC, cur); PG8_GATHER_SET(gN, cur); }
    PG8_STAGE(PG8_SB(0, 0), cB, voffB); PG8_STAGE(PG8_SB(0, 1), cB + hstep, voffB); PG8_STAGE_A(PG8_SA(0, 0), cA, 0, false); PG8_STAGE_A(PG8_SA(0, 1), cA, 1, false);
    if (wr == 1) PG8_BAR;
    PG8_WAIT_V(2); PG8_BAR;
    PG8_STAGE(PG8_SB(1, 0), cB + kstep, voffB); PG8_STAGE_A(PG8_SA(1, 0), cA + kstep, 0, false); PG8_STAGE(PG8_SB(1, 1), cB + hstep + kstep, voffB);
    PG8_WAIT_V(6); PG8_BAR;
    for (;;) {
        const bool has_next = S.next(ui + 1, nxt);
        const char* nA = has_next ? S.a_base(nxt) : cA; const char* nB = has_next ? S.b_base(nxt) : cB;
        if constexpr (Sched::GATHER) { if (has_next) { PG8_GATHER_SET(gN, nxt); } }
        for (int t = 0; t < nt; t += 2) {
            const bool last = (t == nt - 2);
            const char* a1 = cA + (size_t)(t + 1) * kstep;
            const char* a2 = last ? nA : cA + (size_t)(t + 2) * kstep; const char* b2 = last ? nB : cB + (size_t)(t + 2) * kstep;
            const char* a3 = a2 + kstep; const char* b3 = b2 + kstep;
            PG8_LDB(B0, 0, 0); PG8_LDB(B1, 0, 1); PG8_SCHED; PG8_LDA(At, 0, 0); PG8_STAGE_A(PG8_SA(1, 1), a1, 1, false);
            PG8_WAIT_V(8); PG8_WAIT_L(0); PG8_BAR; PG8_MMA(0, 0, At, B0); PG8_MMA(0, 1, At, B1); PG8_BAR; PG8_SCHED;
            PG8_LDA(At, 0, 1); PG8_STAGE(PG8_SB(0, 0), b2, voffB); PG8_STAGE(PG8_SB(0, 1), b2 + hstep, voffB); PG8_STAGE_A(PG8_SA(0, 0), a2, 0, last);
            PG8_WAIT_V(8); PG8_WAIT_L(0); PG8_BAR; PG8_MMA(1, 0, At, B0); PG8_MMA(1, 1, At, B1); PG8_BAR; PG8_SCHED;
            PG8_LDB(B0, 1, 0); PG8_LDB(B1, 1, 1); PG8_SCHED; PG8_LDA(At, 1, 0); PG8_STAGE_A(PG8_SA(0, 1), a2, 1, last);
            PG8_WAIT_V(8); PG8_WAIT_L(0); PG8_BAR; PG8_MMA(0, 0, At, B0); PG8_MMA(0, 1, At, B1); PG8_BAR; PG8_SCHED;
            PG8_LDA(At, 1, 1); PG8_STAGE(PG8_SB(1, 0), b3, voffB); PG8_STAGE(PG8_SB(1, 1), b3 + hstep, voffB); PG8_STAGE_A(PG8_SA(1, 0), a3, 0, last);
            PG8_WAIT_V(8); PG8_WAIT_L(0); PG8_BAR; PG8_MMA(1, 0, At, B0); PG8_MMA(1, 1, At, B1); PG8_BAR; PG8_SCHED;
        }
        if constexpr (ALIGN_EPI) { if (wr == 0) PG8_BAR; }
        E(acc, cur, wr, wc, fr, fq);
        if (!has_next) break;
        if (!(Sched::DUAL && cur.e == 0))
#pragma unroll
        for (int a = 0; a < 2; ++a)
#pragma unroll
            for (int b = 0; b < 2; ++b)
#pragma unroll
                for (int m = 0; m < 4; ++m)
#pragma unroll
                    for (int n = 0; n < 2; ++n) acc[a][b][m][n] = (f32x4){0.f, 0.f, 0.f, 0.f};
        cur = nxt; cA = nA; cB = nB; ++ui;
        if constexpr (Sched::GATHER) {
#pragma unroll
            for (int h = 0; h < 2; ++h)
#pragma unroll
                for (int i = 0; i < 2; ++i) gC[h][i] = gN[h][i];
        }
        if constexpr (ALIGN_EPI) { if (wr == 1) PG8_BAR; }
    }
    PG8_WAIT_V(0);
    if constexpr (!ALIGN_EPI) { if (wr == 0) PG8_BAR; }
    PG8_BAR;
#undef PG8_SA
#undef PG8_SB
#undef PG8_STAGE
#undef PG8_STAGE_A
#undef PG8_GATHER_SET
#undef PG8_LDA
#undef PG8_LDB
#undef PG8_MMA
#undef PG8_WAIT_V
#undef PG8_WAIT_L
#undef PG8_BAR
#undef PG8_SCHED
}
}

typedef GAS unsigned gu32;
#define RLX_AGENT __ATOMIC_RELAXED, __HIP_MEMORY_SCOPE_AGENT
#define XB_TMO      128
#define XB_XCNT(j)  (256  + 64 * (j))
#define XB_XSUB(j)  (1280 + 64 * (j))
#define XB_XGEN(j)  (2304 + 64 * (j))
#define XB_TOP      3328
#define XB_TOPGEN   3392
#define XCD_BAR_WORDS 3456
#define XB_SPIN_CAP (1u << 18)
__device__ __forceinline__ unsigned xb_ld(unsigned* p)              { return __hip_atomic_load(p, __ATOMIC_RELAXED, __HIP_MEMORY_SCOPE_AGENT); }
__device__ __forceinline__ unsigned xb_add(unsigned* p, unsigned v) { return __hip_atomic_fetch_add(p, v, __ATOMIC_RELAXED, __HIP_MEMORY_SCOPE_AGENT); }
__device__ __forceinline__ unsigned xb_xcc_id() { return (unsigned)__builtin_amdgcn_s_getreg((3 << 11) | 20) & 0xFu; }
#define XB_SPIN(cond, bar) do { unsigned _sp = 0; while (cond) { __builtin_amdgcn_s_sleep(1); \
    if ((++_sp & 255u) == 0u) { if (xb_ld(&(bar)[XB_TMO])) break; if (_sp > XB_SPIN_CAP) { atomicAdd(&(bar)[XB_TMO], 1u); break; } } } } while (0)
struct XcdBarrier { unsigned* bar; unsigned x; volatile LAS unsigned* st; };
__device__ __forceinline__ XcdBarrier xcd_barrier_post(unsigned* bar, volatile LAS unsigned* st) {
    XcdBarrier b; b.bar = bar; b.x = xb_xcc_id(); b.st = st;
    if (threadIdx.x == 0) (void)xb_add(&bar[XB_XCNT(b.x)], 1u);
    return b;
}
__device__ __forceinline__ void xcd_barrier_complete(unsigned* bar, unsigned x, unsigned& nloc, unsigned& nx) {
    const unsigned G = gridDim.x * gridDim.y * gridDim.z;
    unsigned sum, cnt, mine, sp = 0u;
    for (;;) {
        sum = 0u; cnt = 0u; mine = 0u;
#pragma unroll
        for (unsigned j = 0; j < 16; ++j) { const unsigned c = xb_ld(&bar[XB_XCNT(j)]); sum += c; cnt += (c > 0u) ? 1u : 0u; mine = (j == x) ? c : mine; }
        if (sum == G) break;
        __builtin_amdgcn_s_sleep(1);
        if ((++sp & 255u) == 0u) { if (xb_ld(&bar[XB_TMO])) break; if (sp > XB_SPIN_CAP) { atomicAdd(&bar[XB_TMO], 1u); break; } }
    }
    nloc = mine > 0u ? mine : 1u; nx = cnt > 0u ? cnt : 1u;
}
__device__ __forceinline__ void xcd_barrier(const XcdBarrier& b) {
    asm volatile("s_waitcnt vmcnt(0)" ::: "memory");
    __syncthreads();
    if (threadIdx.x == 0) {
        unsigned* bar = b.bar;
        __builtin_amdgcn_s_waitcnt(0);
        unsigned nloc = b.st[0], nx = b.st[1];
        if (nloc == 0u) { xcd_barrier_complete(bar, b.x, nloc, nx); b.st[0] = nloc; b.st[1] = nx; }
        const unsigned old = xb_add(&bar[XB_XSUB(b.x)], 1u);
        const unsigned gen = old / nloc;
        if (old + 1u == (gen + 1u) * nloc) {
            __builtin_amdgcn_fence(__ATOMIC_RELEASE, "agent");
            asm volatile("s_waitcnt vmcnt(0)" ::: "memory");
            const unsigned og = xb_add(&bar[XB_TOP], 1u);
            const unsigned tg = og / nx;
            if (og + 1u == (tg + 1u) * nx) xb_add(&bar[XB_TOPGEN], 1u);
            else XB_SPIN(xb_ld(&bar[XB_TOPGEN]) == tg, bar);
            __builtin_amdgcn_fence(__ATOMIC_ACQUIRE, "agent");
            xb_add(&bar[XB_XGEN(b.x)], 1u);
            asm volatile("s_waitcnt vmcnt(0)" ::: "memory");
        } else {
            XB_SPIN(xb_ld(&bar[XB_XGEN(b.x)]) == gen, bar);
            __builtin_amdgcn_fence(__ATOMIC_ACQUIRE, "agent");
            asm volatile("s_waitcnt vmcnt(0)" ::: "memory");
        }
    }
    __syncthreads();
}

constexpr int NWAVES = 8, NTHR = 512;
constexpr int LDS_BYTES = 147456, LDSCTL_OFF = LDS_BYTES - 1024, MISC_OFF = LDSCTL_OFF + 320;

struct Args { const float* in[21]; float* out; unsigned char* ws; int ph_lo, ph_hi, li, pad; };

struct Frame {
    LAS unsigned char* lds;
    unsigned char* ws;
    int tid, lane, wave, vcu, G;
};

struct EpiInProj {
    static constexpr bool PERM = true;
    unsigned char* ws; const float* rc; const float* rs;
    __device__ __forceinline__ void operator()(const f32x4 (&acc)[2][2][4][2], const pg8::Unit& u, int wr, int wc, int fr, int fq) const {
        const int seg = u.pn >> 2;
        bf16_t* O = (bf16_t*)(ws + WS_PROJ + (size_t)seg * SEG);
        const int colt = (u.pn & 3) * 256;
        const int row0 = u.pm * 256 + wr * 64 + fr;
        const int d = wc * 32 + 8 * fq;
#pragma unroll
        for (int ai = 0; ai < 2; ++ai)
#pragma unroll
            for (int m = 0; m < 4; ++m) {
                const int row = row0 + ai * 128 + m * 16;
                f32x4 v00 = acc[ai][0][m][0], v01 = acc[ai][0][m][1], v10 = acc[ai][1][m][0], v11 = acc[ai][1][m][1];
                if (seg <= 1) {
                    const int pos = row & (SEQ - 1);
                    const f32x4 c0 = *(const f32x4*)(rc + (size_t)pos * 128 + d), c1 = *(const f32x4*)(rc + (size_t)pos * 128 + d + 4);
                    const f32x4 s0 = *(const f32x4*)(rs + (size_t)pos * 128 + d), s1 = *(const f32x4*)(rs + (size_t)pos * 128 + d + 4);
                    const float sc = seg == 1 ? 0.0625f : 1.0f;
                    const f32x4 a0 = (v00 * c0 - v10 * s0) * sc, a1 = (v01 * c1 - v11 * s1) * sc, b0 = (v00 * s0 + v10 * c0) * sc, b1 = (v01 * s1 + v11 * c1) * sc;
                    v00 = a0; v01 = a1; v10 = b0; v11 = b1;
                } else if (seg == 3) {
#pragma unroll
                    for (int i = 0; i < 4; ++i) { v00[i] = siluf_(v00[i]); v01[i] = siluf_(v01[i]); v10[i] = siluf_(v10[i]); v11[i] = siluf_(v11[i]); }
                } else if (seg == 4) { const float q = 0.18033688011112042f; v00 = v00 * q; v01 = v01 * q; v10 = v10 * q; v11 = v11 * q; }
                else if (seg >= 7) {
#pragma unroll
                    for (int i = 0; i < 4; ++i) { v00[i] = sigmoidf_(v00[i]); v01[i] = sigmoidf_(v01[i]); v10[i] = sigmoidf_(v10[i]); v11[i] = sigmoidf_(v11[i]); }
                }
                u32x4 w0, w1; w0.x = cvtpk(v00[0], v00[1]); w0.y = cvtpk(v00[2], v00[3]); w0.z = cvtpk(v01[0], v01[1]); w0.w = cvtpk(v01[2], v01[3]);
                w1.x = cvtpk(v10[0], v10[1]); w1.y = cvtpk(v10[2], v10[3]); w1.z = cvtpk(v11[0], v11[1]); w1.w = cvtpk(v11[2], v11[3]);
                if (seg == 0) {
                    const int pos = row & (SEQ - 1), il = pos & 127;
                    bf16_t* blkp = O + ((((size_t)(row >> 12) * 4 + (u.pn & 3)) * 32 + (pos >> 7)) * 4 + (il >> 5)) * 8192 + (size_t)(((d >> 3) & 1) * 32 + (il & 31)) * 8;
                    *(u32x4*)(blkp + (d >> 4) * 512) = w0; *(u32x4*)(blkp + ((d >> 4) + 8) * 512) = w1;
                } else if (seg <= 2) { bf16_t* rowp = O + (size_t)row * DM + colt + d; *(u32x4*)rowp = w0; *(u32x4*)(rowp + 128) = w1; }
                else {
                    unsigned char* rowp = (unsigned char*)O + (size_t)row * DM + colt + d;
                    u32x2 f0, f1; f0.x = pk4_fp8(v00[0], v00[1], v00[2], v00[3]); f0.y = pk4_fp8(v01[0], v01[1], v01[2], v01[3]);
                    f1.x = pk4_fp8(v10[0], v10[1], v10[2], v10[3]); f1.y = pk4_fp8(v11[0], v11[1], v11[2], v11[3]);
                    *(u32x2*)rowp = f0; *(u32x2*)(rowp + 128) = f1; }
            }
    }
};
template <bool ADD> struct EpiGateBf16 {
    static constexpr bool PERM = true;
    bf16_t* O; const bf16_t* Gt; const bf16_t* P;
    __device__ __forceinline__ void operator()(const f32x4 (&acc)[2][2][4][2], const pg8::Unit& u, int wr, int wc, int fr, int fq) const {
        const int row0 = u.pm * 256 + wr * 64 + fr, col0 = u.pn * 256 + wc * 32 + 8 * fq;
#pragma unroll
        for (int ai = 0; ai < 2; ++ai)
#pragma unroll
            for (int m = 0; m < 4; ++m) {
                const size_t ro = (size_t)(row0 + ai * 128 + m * 16) * DM + col0;
#pragma unroll
                for (int bj = 0; bj < 2; ++bj) {
                    const u32x4 g = *(const u32x4*)(Gt + ro + bj * 128);
                    f32x4 v0 = acc[ai][bj][m][0], v1 = acc[ai][bj][m][1];
                    v0[0] *= bflo(g.x); v0[1] *= bfhi(g.x); v0[2] *= bflo(g.y); v0[3] *= bfhi(g.y);
                    v1[0] *= bflo(g.z); v1[1] *= bfhi(g.z); v1[2] *= bflo(g.w); v1[3] *= bfhi(g.w);
                    if (ADD) { const u32x4 p = *(const u32x4*)(P + ro + bj * 128);
                        v0[0] += bflo(p.x); v0[1] += bfhi(p.x); v0[2] += bflo(p.y); v0[3] += bfhi(p.y);
                        v1[0] += bflo(p.z); v1[1] += bfhi(p.z); v1[2] += bflo(p.w); v1[3] += bfhi(p.w); }
                    u32x4 w; w.x = cvtpk(v0[0], v0[1]); w.y = cvtpk(v0[2], v0[3]); w.z = cvtpk(v1[0], v1[1]); w.w = cvtpk(v1[2], v1[3]);
                    *(u32x4*)(O + ro + bj * 128) = w;
                }
            }
    }
};
struct EpiMerge {
    static constexpr bool PERM = true;
    bf16_t* O; const unsigned char* Gr; const unsigned char* Ga;
    __device__ __forceinline__ void operator()(f32x4 (&acc)[2][2][4][2], const pg8::Unit& u, int wr, int wc, int fr, int fq) const {
        const int row0 = u.pm * 256 + wr * 64 + fr, col0 = u.pn * 256 + wc * 32 + 8 * fq;
#pragma unroll
        for (int ai = 0; ai < 2; ++ai)
#pragma unroll
            for (int m = 0; m < 4; ++m) {
                const size_t ro = (size_t)(row0 + ai * 128 + m * 16) * DM + col0;
#pragma unroll
                for (int bj = 0; bj < 2; ++bj) {
                    const u32x2 ga = *(const u32x2*)(Ga + ro + bj * 128);
                    const f32x2 ga0 = __builtin_amdgcn_cvt_pk_f32_fp8((int)ga.x, false), ga1 = __builtin_amdgcn_cvt_pk_f32_fp8((int)ga.x, true), ga2 = __builtin_amdgcn_cvt_pk_f32_fp8((int)ga.y, false), ga3 = __builtin_amdgcn_cvt_pk_f32_fp8((int)ga.y, true);
                    f32x4 a0 = (f32x4){ga0.x, ga0.y, ga1.x, ga1.y} * YD_INV, a1 = (f32x4){ga2.x, ga2.y, ga3.x, ga3.y} * YD_INV;
                    if (u.e == 0) {
                        const u32x2 gr = *(const u32x2*)(Gr + ro + bj * 128);
                        const f32x2 gr0 = __builtin_amdgcn_cvt_pk_f32_fp8((int)gr.x, false), gr1 = __builtin_amdgcn_cvt_pk_f32_fp8((int)gr.x, true), gr2 = __builtin_amdgcn_cvt_pk_f32_fp8((int)gr.y, false), gr3 = __builtin_amdgcn_cvt_pk_f32_fp8((int)gr.y, true);
                        const f32x4 r0 = (f32x4){gr0.x, gr0.y, gr1.x, gr1.y} * YD_INV, r1 = (f32x4){gr2.x, gr2.y, gr3.x, gr3.y} * YD_INV;
#pragma unroll
                        for (int i = 0; i < 4; ++i) { acc[ai][bj][m][0][i] *= r0[i] * __builtin_amdgcn_rcpf(fmaxf(a0[i], 1e-30f)); acc[ai][bj][m][1][i] *= r1[i] * __builtin_amdgcn_rcpf(fmaxf(a1[i], 1e-30f)); }
                    } else {
                        const f32x4 v0 = acc[ai][bj][m][0] * a0, v1 = acc[ai][bj][m][1] * a1;
                        u32x4 w; w.x = cvtpk(v0[0], v0[1]); w.y = cvtpk(v0[2], v0[3]); w.z = cvtpk(v1[0], v1[1]); w.w = cvtpk(v1[2], v1[3]);
                        *(u32x4*)(O + ro + bj * 128) = w;
                    }
                }
            }
    }
};
struct EpiOProj {
    static constexpr bool PERM = false;
    const float* x; float* x1; const float* mod; float* ss;
    __device__ __forceinline__ void operator()(const f32x4 (&acc)[2][2][4][2], const pg8::Unit& u, int wr, int wc, int fr, int fq) const {
        const int row0 = u.pm * 256 + wr * 64 + fr, col0 = u.pn * 256 + wc * 32 + 4 * fq;
        const int b = (u.pm * 256) / SEQ;
        f32x4 gm[2][2];
#pragma unroll
        for (int bj = 0; bj < 2; ++bj)
#pragma unroll
            for (int n = 0; n < 2; ++n) gm[bj][n] = *(const f32x4*)(mod + (size_t)b * 6144 + 2 * DM + col0 + bj * 128 + n * 16);
#pragma unroll
        for (int ai = 0; ai < 2; ++ai)
#pragma unroll
            for (int m = 0; m < 4; ++m) {
                const int row = row0 + ai * 128 + m * 16;
                const size_t ro = (size_t)row * DM + col0; float sq = 0.f;
#pragma unroll
                for (int bj = 0; bj < 2; ++bj)
#pragma unroll
                    for (int n = 0; n < 2; ++n) { const f32x4 xv = *(const f32x4*)(x + ro + bj * 128 + n * 16);
                        const f32x4 o = xv + gm[bj][n] * acc[ai][bj][m][n]; *(f32x4*)(x1 + ro + bj * 128 + n * 16) = o;
                        sq += (o[0] * o[0] + o[1] * o[1]) + (o[2] * o[2] + o[3] * o[3]); }
                sq += __shfl_xor(sq, 16); sq += __shfl_xor(sq, 32);
                if (fq == 0) ss[(size_t)row * 16 + u.pn * 4 + wc] = sq;
            }
    }
};
struct EpiF32 {
    static constexpr bool PERM = false;
    float* C; int ldc;
    __device__ __forceinline__ void operator()(const f32x4 (&acc)[2][2][4][2], const pg8::Unit& u, int wr, int wc, int fr, int fq) const {
        const int row0 = u.pm * 256 + wr * 64 + fr, col0 = u.pn * 256 + wc * 32 + 4 * fq;
#pragma unroll
        for (int ai = 0; ai < 2; ++ai)
#pragma unroll
            for (int m = 0; m < 4; ++m) { float* rowp = C + (size_t)(row0 + ai * 128 + m * 16) * ldc + col0;
#pragma unroll
                for (int bj = 0; bj < 2; ++bj)
#pragma unroll
                    for (int n = 0; n < 2; ++n) *(f32x4*)(rowp + bj * 128 + n * 16) = acc[ai][bj][m][n]; }
    }
};
struct EpiPlainScratch {
    static constexpr bool PERM = true;
    bf16_t* O;
    __device__ __forceinline__ void operator()(const f32x4 (&acc)[2][2][4][2], const pg8::Unit& u, int wr, int wc, int fr, int fq) const {
        const int row0 = u.pm * 256 + wr * 64 + fr, col0 = (u.pn & 3) * 256 + wc * 32 + 8 * fq;
#pragma unroll
        for (int ai = 0; ai < 2; ++ai)
#pragma unroll
            for (int m = 0; m < 4; ++m) { bf16_t* rowp = O + (size_t)(row0 + ai * 128 + m * 16) * DM + col0;
#pragma unroll
                for (int bj = 0; bj < 2; ++bj) { const f32x4 v0 = acc[ai][bj][m][0], v1 = acc[ai][bj][m][1];
                    u32x4 w; w.x = cvtpk(v0[0], v0[1]); w.y = cvtpk(v0[2], v0[3]); w.z = cvtpk(v1[0], v1[1]); w.w = cvtpk(v1[2], v1[3]); *(u32x4*)(rowp + bj * 128) = w; } }
    }
};
struct EpiNull {
    static constexpr bool PERM = false;
    __device__ __forceinline__ void operator()(const f32x4 (&acc)[2][2][4][2], const pg8::Unit&, int, int, int, int) const {
#pragma unroll
        for (int ai = 0; ai < 2; ++ai)
#pragma unroll
            for (int bj = 0; bj < 2; ++bj)
#pragma unroll
                for (int m = 0; m < 4; ++m)
#pragma unroll
                    for (int n = 0; n < 2; ++n) asm volatile("" :: "v"(acc[ai][bj][m][n]));
    }
};
struct EpiGU {
    static constexpr bool PERM = true;
    bf16_t* hid;
    __device__ __forceinline__ void operator()(const f32x4 (&acc)[2][2][4][2], const pg8::Unit& u, int wr, int wc, int fr, int fq) const {
        const int row0 = u.pm * 256 + wr * 64 + fr, col0 = u.pn * 128 + wc * 32 + 8 * fq;
#pragma unroll
        for (int ai = 0; ai < 2; ++ai)
#pragma unroll
            for (int m = 0; m < 4; ++m) { bf16_t* rowp = hid + (size_t)(row0 + ai * 128 + m * 16) * EH + col0;
                f32x4 h0, h1;
#pragma unroll
                for (int i = 0; i < 4; ++i) { h0[i] = siluf_(acc[ai][0][m][0][i]) * acc[ai][1][m][0][i]; h1[i] = siluf_(acc[ai][0][m][1][i]) * acc[ai][1][m][1][i]; }
                u32x4 w; w.x = cvtpk(h0[0], h0[1]); w.y = cvtpk(h0[2], h0[3]); w.z = cvtpk(h1[0], h1[1]); w.w = cvtpk(h1[2], h1[3]); *(u32x4*)rowp = w; }
    }
};
template <int MODE> struct EpiDownT {
    static constexpr bool PERM = true;
    unsigned char* ws; const LAS int* exp_info;
    __device__ __forceinline__ void operator()(const f32x4 (&acc)[2][2][4][2], const pg8::Unit& u, int wr, int wc, int fr, int fq) const {
        const int shift = __builtin_amdgcn_readfirstlane(exp_info[u.e]), lim = __builtin_amdgcn_readfirstlane(exp_info[512 + u.e]);
        const int row0 = u.pm * 256 + wr * 64 + fr, col0 = u.pn * 256 + wc * 32 + 8 * fq;
#pragma unroll
        for (int ai = 0; ai < 2; ++ai)
#pragma unroll
            for (int m = 0; m < 4; ++m) {
                const int pos = row0 + ai * 128 + m * 16;
                if (pos < lim) {
                    unsigned char* rowp = (MODE == 1 ? ws + WS_SS + (size_t)blockIdx.x * 2048 : ydense_row(ws, pos - shift)) + col0;
#pragma unroll
                    for (int bj = 0; bj < 2; ++bj) { const f32x4 v0 = acc[ai][bj][m][0], v1 = acc[ai][bj][m][1];
                        u32x2 w; w.x = pk4_fp8(v0[0], v0[1], v0[2], v0[3]); w.y = pk4_fp8(v1[0], v1[1], v1[2], v1[3]);
                        *(u32x2*)(rowp + bj * 128) = w; }
                }
            }
    }
};
typedef EpiDownT<0> EpiDown;

__device__ __forceinline__ void transpose_item(const float* W, int N, int K, int k0, int n0, bf16_t* WT, int drow0, LAS float* scr, int lane) {
#pragma unroll 8
    for (int i = 0; i < 32; ++i) { const int kk = 2 * i + (lane >> 5); scr[kk * 33 + (lane & 31)] = W[(size_t)(k0 + kk) * N + n0 + (lane & 31)]; }
    asm volatile("s_waitcnt lgkmcnt(0)" ::: "memory");
    const int c = lane & 7;
#pragma unroll
    for (int j = 0; j < 4; ++j) { const int n = (lane >> 3) + 8 * j; const LAS float* s = scr + (8 * c) * 33 + n;
        u32x4 o; o.x = cvtpk(s[0 * 33], s[1 * 33]); o.y = cvtpk(s[2 * 33], s[3 * 33]); o.z = cvtpk(s[4 * 33], s[5 * 33]); o.w = cvtpk(s[6 * 33], s[7 * 33]);
        *(u32x4*)(WT + (size_t)(drow0 + n) * K + k0 + 8 * c) = o; }
    asm volatile("s_waitcnt lgkmcnt(0)" ::: "memory");
}
__device__ __forceinline__ void transpose_plain(const float* W, int K, int N, bf16_t* WT, LAS float* scr, int item, int lane) {
    const int nblk = N / 32, kb = item / nblk, nb = item % nblk;
    transpose_item(W, N, K, 64 * kb, 32 * nb, WT, 32 * nb, scr, lane);
}

__device__ __forceinline__ int t5_bucket(int rel) {
    const int n = rel < 0 ? -rel : rel;
    int large = 8 + (int)(logf((float)(n > 1 ? n : 1) / 8.0f) / 4.852030263919617f * 8.0f);
    large = large < 15 ? large : 15;
    return (rel > 0 ? 16 : 0) + (n < 8 ? n : large);
}

__device__ __forceinline__ void phase0(Frame& F, const Args& a) {
    const float* c = a.in[1]; const float* w_ada = a.in[2]; const float* b_ada = a.in[3];
    {
        LAS float* cond = (LAS float*)F.lds;
        LAS float* red = (LAS float*)(F.lds + 32768);
        for (int i = F.tid; i < NB * DM; i += NTHR) cond[i] = siluf_(c[i]);
        __syncthreads();
        for (int cg = F.vcu; cg < 256; cg += F.G) {
            const int j = F.tid & 31, kg = F.tid >> 5;
            float s[NB];
#pragma unroll
            for (int b = 0; b < NB; ++b) s[b] = 0.f;
            if (j < 24) {
                for (int k = kg; k < DM; k += 16) { const float w = w_ada[(size_t)k * 6144 + cg * 24 + j];
#pragma unroll
                    for (int b = 0; b < NB; ++b) s[b] += cond[b * DM + k] * w; }
            }
#pragma unroll
            for (int b = 0; b < NB; ++b) red[(kg * NB + b) * 32 + j] = s[b];
            __syncthreads();
            if (F.tid < 192) { const int b = F.tid / 24, jj = F.tid % 24; float t = 0.f;
                for (int g = 0; g < 16; ++g) t += red[(g * NB + b) * 32 + jj];
                ((float*)(F.ws + WS_MOD))[b * 6144 + cg * 24 + jj] = t + b_ada[cg * 24 + jj]; }
            __syncthreads();
        }
    }
    const int gt = F.vcu * NTHR + F.tid, NGT = F.G * NTHR;
    {
        float* rc = (float*)(F.ws + WS_ROPE_C); float* rs = (float*)(F.ws + WS_ROPE_S);
        for (int i = gt; i < SEQ * 128; i += NGT) { const int pos = i >> 7, d = i & 127;
            const float inv = (float)pow(10000.0, -(double)d / 128.0); const float ang = (float)pos * inv;
            rc[i] = (float)cos((double)ang); rs[i] = (float)sin((double)ang); }
    }
    {
        const float* t5 = a.in[7]; float* bt = (float*)(F.ws + WS_BTAB);
        for (int i = gt; i < 3 * 16 * 160; i += NGT) { const int g = i / (16 * 160), h = (i / 160) % 16, j = i % 160;
            const int dil = g == 0 ? 1 : (g == 1 ? 4 : 16);
            bt[i] = j <= 128 ? t5[t5_bucket((j - 64) * dil) * 16 + h] * 1.4426950408889634f : 0.f; }
    }
    { unsigned* z = (unsigned*)(F.ws + WS_H + (size_t)NTOK * DM * 2); for (int i = gt; i < DM / 2; i += NGT) z[i] = 0u; }
    {
        LAS float* scr = (LAS float*)(F.lds + 49152 + F.wave * 8704);
        const int gw = F.vcu * NWAVES + F.wave, NGW = F.G * NWAVES;
        constexpr int I_IN = (DM / 64) * (PROJW / 32), I_SQ = (DM / 64) * (DM / 32), I_R = (DM / 64) * (NEXP / 32);
        constexpr int NITEMS = I_IN + 3 * I_SQ + I_R;
        for (int it = gw; it < NITEMS; it += NGW) {
            int r = it;
            if (r < I_IN) { transpose_plain(a.in[5], DM, PROJW, (bf16_t*)(F.ws + WS_WIN), scr, r, F.lane); continue; } r -= I_IN;
            if (r < I_SQ) { transpose_plain(a.in[8], DM, DM, (bf16_t*)(F.ws + WS_WRU), scr, r, F.lane); continue; } r -= I_SQ;
            if (r < I_SQ) { transpose_plain(a.in[9], DM, DM, (bf16_t*)(F.ws + WS_WAU), scr, r, F.lane); continue; } r -= I_SQ;
            if (r < I_SQ) { transpose_plain(a.in[10], DM, DM, (bf16_t*)(F.ws + WS_WO), scr, r, F.lane); continue; } r -= I_SQ;
            transpose_plain(a.in[12], DM, NEXP, (bf16_t*)(F.ws + WS_WR), scr, r, F.lane);
        }
    }
}

struct TrItem { const float* src; bf16_t* dst; int N, K; };
__device__ __forceinline__ TrItem moe_item(const Args& a, unsigned char* ws, int it) {
    constexpr int PER_E = 256;
    const int e = it / PER_E, r = it % PER_E, kind = r >> 7, q = r & 127;
    TrItem t;
    if (kind < 2) {
        const float* W = e < 256 ? a.in[kind == 0 ? 14 : 15] + (size_t)e * 1024 * 256 : a.in[kind == 0 ? 17 : 18];
        const int kb = q >> 3, n0 = 32 * (q & 7);
        t.src = W + (size_t)(64 * kb) * 256 + n0; t.N = 256; t.K = 1024;
        t.dst = (bf16_t*)(ws + WS_WGU) + (size_t)e * 512 * 1024 + (size_t)((n0 >> 7) * 256 + kind * 128 + (n0 & 127)) * 1024 + 64 * kb;
    } else {
        const float* W = e < 256 ? a.in[16] + (size_t)e * 256 * 1024 : a.in[19];
        const int kb = q >> 5, n0 = 32 * (q & 31);
        t.src = W + (size_t)(64 * kb) * 1024 + n0; t.N = 1024; t.K = 256;
        t.dst = (bf16_t*)(ws + WS_WD) + (size_t)e * 1024 * 256 + (size_t)n0 * 256 + 64 * kb;
    }
    return t;
}
__device__ __forceinline__ void tr_load(const TrItem& t, float (&v)[32], int lane) {
    const float* p = t.src + (size_t)(lane >> 5) * t.N + (lane & 31);
#pragma unroll
    for (int i = 0; i < 32; ++i) v[i] = __builtin_nontemporal_load(p + (size_t)(2 * i) * t.N);
}
__device__ __forceinline__ void tr_store(const TrItem& t, const float (&v)[32], LAS float* scr, int lane) {
#pragma unroll
    for (int i = 0; i < 32; ++i) scr[(2 * i + (lane >> 5)) * 33 + (lane & 31)] = v[i];
    asm volatile("s_waitcnt lgkmcnt(0)" ::: "memory");
    const int c = lane & 7;
#pragma unroll
    for (int j = 0; j < 4; ++j) { const int n = (lane >> 3) + 8 * j; const LAS float* s = scr + (8 * c) * 33 + n;
        u32x4 o; o.x = cvtpk(s[0 * 33], s[1 * 33]); o.y = cvtpk(s[2 * 33], s[3 * 33]); o.z = cvtpk(s[4 * 33], s[5 * 33]); o.w = cvtpk(s[6 * 33], s[7 * 33]);
        *(u32x4*)(t.dst + (size_t)n * t.K + 8 * c) = o; }
    asm volatile("s_waitcnt lgkmcnt(0)" ::: "memory");
}
constexpr int CW_CONVQ = 16384 + 2048;
__device__ __forceinline__ void moe_weight_convert(Frame& F, const Args& a) {
    LAS float* scr = (LAS float*)(F.lds + F.wave * 8704);
    const int total = 257 * 256, nchunks = total / 8;
    unsigned* q = (unsigned*)(F.ws + WS_CTL) + CW_CONVQ;
    float v0[32], v1[32];
    for (;;) {
        unsigned ck = 0;
        if (F.lane == 0) ck = __hip_atomic_fetch_add(q, 1u, __ATOMIC_RELAXED, __HIP_MEMORY_SCOPE_AGENT);
        ck = __builtin_amdgcn_readfirstlane(ck);
        if ((int)ck >= nchunks) break;
        const int it0 = (int)ck * 8;
        TrItem t0 = moe_item(a, F.ws, it0), t1 = t0;
        tr_load(t0, v0, F.lane);
#pragma unroll 1
        for (int k = 0; k < 8; k += 2) {
            t1 = moe_item(a, F.ws, it0 + k + 1); tr_load(t1, v1, F.lane);
            tr_store(t0, v0, scr, F.lane);
            if (k + 2 < 8) { t0 = moe_item(a, F.ws, it0 + k + 2); tr_load(t0, v0, F.lane); }
            tr_store(t1, v1, scr, F.lane);
        }
    }
}

__device__ __forceinline__ void norm_mod_rows(Frame& F, const float* x, const float* norm, const float* mod, int shift_off, int scale_off, const float* ssp, bf16_t* out) {
    const int gw = F.vcu * NWAVES + F.wave, NGW = F.G * NWAVES;
    f32x4 g4[4];
#pragma unroll
    for (int j = 0; j < 4; ++j) g4[j] = *(const f32x4*)(norm + 4 * F.lane + 256 * j);
    f32x4 v[4], vn[4]; float p = 0.f, pn = 0.f;
    int row = gw;
    if (row < NTOK) { const f32x4* xr = (const f32x4*)(x + (size_t)row * DM) + F.lane;
#pragma unroll
        for (int j = 0; j < 4; ++j) v[j] = xr[64 * j];
        if (ssp) p = F.lane < 16 ? ssp[(size_t)row * 16 + F.lane] : 0.f; }
#pragma unroll 1
    for (; row < NTOK; row += NGW) {
        const int nrow = row + NGW < NTOK ? row + NGW : row;
        { const f32x4* xr = (const f32x4*)(x + (size_t)nrow * DM) + F.lane;
#pragma unroll
          for (int j = 0; j < 4; ++j) vn[j] = xr[64 * j];
          if (ssp) pn = F.lane < 16 ? ssp[(size_t)nrow * 16 + F.lane] : 0.f; }
        const int b = row / SEQ;
        float s = 0.f;
#pragma unroll
        for (int j = 0; j < 4; ++j) s += (v[j][0] * v[j][0] + v[j][1] * v[j][1]) + (v[j][2] * v[j][2] + v[j][3] * v[j][3]);
        const float tot = wave_sum(ssp ? p : s);
        const float rstd = rsqrtf(tot * (1.f / DM) + NORM_EPS);
        u32x2* o8 = (u32x2*)(out + (size_t)row * DM) + F.lane;
#pragma unroll
        for (int j = 0; j < 4; ++j) {
            const int col = 4 * F.lane + 256 * j;
            const f32x4 sc = *(const f32x4*)(mod + (size_t)b * 6144 + scale_off + col), sh = *(const f32x4*)(mod + (size_t)b * 6144 + shift_off + col);
            const f32x4 y = (v[j] * rstd) * g4[j] * (sc + 1.0f) + sh;
            u32x2 w; w.x = cvtpk(y[0], y[1]); w.y = cvtpk(y[2], y[3]); o8[64 * j] = w;
        }
#pragma unroll
        for (int j = 0; j < 4; ++j) v[j] = vn[j];
        p = pn;
    }
}

__device__ __forceinline__ unsigned off_b(unsigned row, unsigned ch) { return 256u * row + 16u * (ch ^ (((row & 3) << 2) | ((row >> 2) & 3))); }
__device__ __forceinline__ int crow(int reg, int h) { return (reg & 3) + 8 * (reg >> 2) + 4 * h; }
__device__ __forceinline__ s16x4 tr_read(LAS unsigned char* p) { return __builtin_bit_cast(s16x4, __builtin_amdgcn_ds_read_tr16_b64_v4i16((LAS s16x4*)p)); }
__device__ __forceinline__ bf16x8 pack8(const f32x16& x, int s) {
    u32x4 p; p.x = cvtpk(x[8 * s], x[8 * s + 1]); p.y = cvtpk(x[8 * s + 2], x[8 * s + 3]); p.z = cvtpk(x[8 * s + 4], x[8 * s + 5]); p.w = cvtpk(x[8 * s + 6], x[8 * s + 7]);
    return __builtin_bit_cast(bf16x8, p);
}
#define MFMA32(a, b, c) __builtin_amdgcn_mfma_f32_32x32x16_bf16((a), (b), (c), 0, 0, 0)

constexpr int RK_STR = 528, RV_STR = 192;
constexpr int RL_K = 0, RL_V = 128 * RK_STR, RL_S = RL_V + 128 * RV_STR, RL_P = RL_S + 64 * RK_STR, RL_END = RL_P + 10 * 2048;
__device__ __forceinline__ void retention_chain(Frame& F, const Args& a, int chain) {
    const int b = chain >> 5, h = (chain >> 3) & 3, dir = (chain >> 2) & 1, es = chain & 3;
    const int lane = F.lane, r = lane & 31, hh = lane >> 5, w = F.wave, ib = w >> 1, eb = w & 1;
    const bf16_t* RQ = (const bf16_t*)(F.ws + WS_RQ); const bf16_t* RK = (const bf16_t*)(F.ws + WS_RK); const bf16_t* RV = (const bf16_t*)(F.ws + WS_RV);
    bf16_t* OUT = (bf16_t*)(F.ws + (dir ? WS_OUTB : WS_OUTF));
    const float lg = log1pf(-__expf(a.in[6][dir * 4 + h]));
    const float decayC = __expf(lg * 128.f);
    LAS unsigned char* lds = F.lds;
    f32x16 st0, st1;
#pragma unroll
    for (int i = 0; i < 16; ++i) { st0[i] = 0.f; st1[i] = 0.f; }
    for (int i = F.tid; i < (64 * RK_STR) / 16; i += NTHR) *(LAS u32x4*)(lds + RL_S + i * 16) = (u32x4){0u, 0u, 0u, 0u};
    const int vj = F.tid >> 2, ve0 = (F.tid & 3) * 16;
    const float vscale = __expf(lg * (dir == 0 ? (float)(127 - vj) : (float)vj));
    const int blk = (lane >> 4) & 1, q4 = (lane & 15) >> 2, p4 = lane & 3;
    LAS unsigned char* kbase = lds + RL_K + r * RK_STR + 16 * hh;
    LAS unsigned char* sbase = lds + RL_S + (eb * 32 + r) * RK_STR + 16 * hh;
    LAS unsigned char* vtr = lds + RL_V + (4 * hh + q4) * RV_STR + (eb * 32 + 16 * blk + 4 * p4) * 2;
    LAS unsigned char* ktr = lds + RL_K + (4 * hh + q4) * RK_STR + ((w >> 1) * 64 + 16 * blk + 4 * p4) * 2;
    LAS unsigned char* spub = lds + RL_S + (eb * 32 + r) * RK_STR + ((w >> 1) * 64 + 4 * hh) * 2;
    const float rsc = __expf(lg * (dir == 0 ? (float)(ib * 32 + r - 127) : (float)(-(ib * 32 + r))));
    const char* RKb = (const char*)RK + (size_t)h * 512; const char* RVb = (const char*)RV + (size_t)(h * 256 + es * 64) * 2; const char* RQb = (const char*)RQ + ((size_t)((b * 4 + h) * 32) * 4 + ib) * 16384;
    char* OUTb = (char*)OUT + (size_t)(ib * 32 * DM + h * 256 + es * 64 + eb * 32) * 2;
    const unsigned klo = (unsigned)(((F.tid >> 5) * DM + (F.tid & 31) * 8) * 2), vlo = (unsigned)((vj * DM + ve0) * 2), qlo = (unsigned)(lane * 16), olo = (unsigned)((r * DM + 4 * hh) * 2);
    u32x4 kpre[8]; u32x4 vpre[2]; bf16x8 qf[16];
    {
        const size_t t0 = (size_t)b * SEQ + (size_t)(dir == 0 ? 0 : 31) * 128;
        const char* kc = RKb + t0 * (DM * 2); const char* vc = RVb + t0 * (DM * 2); const char* qc = RQb + (size_t)(dir == 0 ? 0 : 31) * 65536;
#pragma unroll
        for (int i = 0; i < 8; ++i) kpre[i] = *(const u32x4*)(kc + (size_t)i * (16 * DM * 2) + klo);
        vpre[0] = *(const u32x4*)(vc + vlo); vpre[1] = *(const u32x4*)(vc + vlo + 16);
#pragma unroll
        for (int s = 0; s < 16; ++s) qf[s] = *(const bf16x8*)(qc + qlo + 1024 * s);
    }
#pragma unroll 1
    for (int n = 0; n < 32; ++n) {
        const int cidx = dir == 0 ? n : 31 - n;
        const size_t t0 = (size_t)b * SEQ + (size_t)cidx * 128;
        {
            LAS unsigned char* kw = lds + RL_K + (F.tid >> 5) * RK_STR + (F.tid & 31) * 16;
#pragma unroll
            for (int i = 0; i < 8; ++i) *(LAS u32x4*)(kw + i * 16 * RK_STR) = kpre[i];
#pragma unroll
            for (int i = 0; i < 2; ++i) {
                u32x4 o; o.x = cvtpk(bflo(vpre[i].x) * vscale, bfhi(vpre[i].x) * vscale); o.y = cvtpk(bflo(vpre[i].y) * vscale, bfhi(vpre[i].y) * vscale);
                o.z = cvtpk(bflo(vpre[i].z) * vscale, bfhi(vpre[i].z) * vscale); o.w = cvtpk(bflo(vpre[i].w) * vscale, bfhi(vpre[i].w) * vscale);
                *(LAS u32x4*)(lds + RL_V + vj * RV_STR + ve0 * 2 + 16 * i) = o;
            }
        }
        __syncthreads();
        {
            const int nn = n + 1 < 32 ? n + 1 : n; const int cn = dir == 0 ? nn : 31 - nn;
            const size_t t1 = (size_t)b * SEQ + (size_t)cn * 128;
            const char* kc = RKb + t1 * (DM * 2); const char* vc = RVb + t1 * (DM * 2);
#pragma unroll
            for (int i = 0; i < 8; ++i) kpre[i] = *(const u32x4*)(kc + (size_t)i * (16 * DM * 2) + klo);
            vpre[0] = *(const u32x4*)(vc + vlo); vpre[1] = *(const u32x4*)(vc + vlo + 16);
        }
        const int jb_lo = dir == 0 ? 0 : ib, jb_hi = dir == 0 ? ib : 3;
#pragma unroll 1
        for (int jb = jb_lo + ((jb_lo ^ eb) & 1); jb <= jb_hi; jb += 2) {
            LAS unsigned char* kb = kbase + jb * (32 * RK_STR);
            f32x16 sT;
#pragma unroll
            for (int i = 0; i < 16; ++i) sT[i] = 0.f;
#pragma unroll
            for (int hb = 0; hb < 2; ++hb) {
                bf16x8 kf[8];
#pragma unroll
                for (int s = 0; s < 8; ++s) kf[s] = *(const LAS bf16x8*)(kb + (hb * 8 + s) * 32);
                __builtin_amdgcn_sched_barrier(0);
#pragma unroll
                for (int s = 0; s < 8; ++s) sT = MFMA32(kf[s], qf[hb * 8 + s], sT);
                __builtin_amdgcn_sched_barrier(0);
            }
            if (jb == ib) {
#pragma unroll
                for (int i = 0; i < 16; ++i) { const int jl = crow(i, hh); const bool keep = dir == 0 ? (jl <= r) : (jl > r); sT[i] = keep ? sT[i] : 0.f; }
            }
            const int ibr = dir == 0 ? ib : 3 - ib, jbr = dir == 0 ? jb : 3 - jb;
            LAS unsigned char* pw = lds + RL_P + ((ibr * (ibr + 1)) / 2 + jbr) * 2048 + lane * 16;
            *(LAS bf16x8*)pw = pack8(sT, 0); *(LAS bf16x8*)(pw + 1024) = pack8(sT, 1);
        }
        __syncthreads();
        f32x16 acc;
#pragma unroll
        for (int i = 0; i < 16; ++i) acc[i] = 0.f;
#pragma unroll 1
        for (int jb = jb_lo; jb <= jb_hi; ++jb) {
            const int ibr = dir == 0 ? ib : 3 - ib, jbr = dir == 0 ? jb : 3 - jb;
            const LAS unsigned char* pr = lds + RL_P + ((ibr * (ibr + 1)) / 2 + jbr) * 2048 + lane * 16;
            LAS unsigned char* vb = vtr + jb * (32 * RV_STR);
#pragma unroll
            for (int s2 = 0; s2 < 2; ++s2) {
                const s16x4 lo = tr_read(vb + s2 * (16 * RV_STR)), hi = tr_read(vb + s2 * (16 * RV_STR) + 8 * RV_STR);
                acc = MFMA32(__builtin_shufflevector(lo, hi, 0, 1, 2, 3, 4, 5, 6, 7), *(const LAS bf16x8*)(pr + s2 * 1024), acc);
            }
        }
#pragma unroll
        for (int hb = 0; hb < 2; ++hb) {
            bf16x8 sf[8];
#pragma unroll
            for (int s = 0; s < 8; ++s) sf[s] = *(const LAS bf16x8*)(sbase + (hb * 8 + s) * 32);
            __builtin_amdgcn_sched_barrier(0);
#pragma unroll
            for (int s = 0; s < 8; ++s) acc = MFMA32(sf[s], qf[hb * 8 + s], acc);
            __builtin_amdgcn_sched_barrier(0);
        }
        u32x2 ow[4];
#pragma unroll
        for (int g = 0; g < 4; ++g) { ow[g].x = cvtpk(acc[4 * g] * rsc, acc[4 * g + 1] * rsc); ow[g].y = cvtpk(acc[4 * g + 2] * rsc, acc[4 * g + 3] * rsc); }
        {
            const int nn = n + 1 < 32 ? n + 1 : n; const int cn = dir == 0 ? nn : 31 - nn;
            const char* qc = RQb + (size_t)cn * 65536;
#pragma unroll
            for (int s = 0; s < 16; ++s) qf[s] = *(const bf16x8*)(qc + qlo + 1024 * s);
        }
        {
            char* oc = OUTb + t0 * (DM * 2) + olo;
#pragma unroll
            for (int g = 0; g < 4; ++g) *(u32x2*)(oc + g * 16) = ow[g];
        }
#pragma unroll
        for (int ks = 0; ks < 8; ++ks) {
            const s16x4 vlo4 = tr_read(vtr + ks * (16 * RV_STR)), vhi4 = tr_read(vtr + ks * (16 * RV_STR) + 8 * RV_STR);
            const bf16x8 vf = __builtin_shufflevector(vlo4, vhi4, 0, 1, 2, 3, 4, 5, 6, 7);
#pragma unroll
            for (int dd = 0; dd < 2; ++dd) {
                const s16x4 lo = tr_read(ktr + ks * (16 * RK_STR) + dd * 64), hi = tr_read(ktr + ks * (16 * RK_STR) + 8 * RK_STR + dd * 64);
                const bf16x8 kt = __builtin_shufflevector(lo, hi, 0, 1, 2, 3, 4, 5, 6, 7);
                if (dd == 0) st0 = MFMA32(kt, vf, st0); else st1 = MFMA32(kt, vf, st1);
            }
        }
#pragma unroll
        for (int i = 0; i < 16; ++i) { st0[i] *= decayC; st1[i] *= decayC; }
        __syncthreads();
#pragma unroll
        for (int g = 0; g < 4; ++g) {
            u32x2 w0, w1;
            w0.x = cvtpk(st0[4 * g], st0[4 * g + 1]); w0.y = cvtpk(st0[4 * g + 2], st0[4 * g + 3]);
            w1.x = cvtpk(st1[4 * g], st1[4 * g + 1]); w1.y = cvtpk(st1[4 * g + 2], st1[4 * g + 3]);
            *(LAS u32x2*)(spub + g * 16) = w0; *(LAS u32x2*)(spub + 64 + g * 16) = w1;
        }
    }
    __syncthreads();
}

__device__ __forceinline__ u32x4 fp8x8_to_bf16(unsigned w0, unsigned w1) {
    const f32x2 a = __builtin_amdgcn_cvt_pk_f32_fp8((int)w0, false), b = __builtin_amdgcn_cvt_pk_f32_fp8((int)w0, true), c = __builtin_amdgcn_cvt_pk_f32_fp8((int)w1, false), d = __builtin_amdgcn_cvt_pk_f32_fp8((int)w1, true);
    return (u32x4){cvtpk(a.x, a.y), cvtpk(b.x, b.y), cvtpk(c.x, c.y), cvtpk(d.x, d.y)};
}
constexpr int AK_STR = 144, AV_STR = 192;
constexpr int AL_K = 0, AL_V = 384 * AK_STR, AL_B = AL_V + 384 * AV_STR, AL_END = AL_B + 896;
struct AttUnit { int g, dil, length, res, run0, b, head; };
__device__ __forceinline__ AttUnit att_decode(int slot) {
    AttUnit u; const int bh = slot / 48, k = slot % 48, ru = k & 15; u.g = k >> 4;
    u.dil = u.g == 0 ? 1 : (u.g == 1 ? 4 : 16); u.length = SEQ / u.dil; u.res = ru % u.dil; u.run0 = (ru / u.dil) * 256; u.b = bh >> 4; u.head = bh & 15; return u;
}
__device__ __forceinline__ void attention_phase(Frame& F, int u0, int u1, int zero) {
    if (u0 >= u1) return;
    const int lane = F.lane, r = lane & 31, hh = lane >> 5, w = F.wave;
    const unsigned char* AQ = F.ws + WS_AQ; const unsigned char* AK = F.ws + WS_AK; const unsigned char* AV = F.ws + WS_AV;
    LAS unsigned char* lds = F.lds;
    const int blk = (lane >> 4) & 1, q4 = (lane & 15) >> 2, p4 = lane & 3;
    LAS unsigned char* kbase = lds + AL_K + (32 * w + r) * AK_STR + 16 * hh;
    LAS unsigned char* vbase = lds + AL_V + (32 * w + 4 * hh + q4) * AV_STR + (16 * blk + 4 * p4) * 2;
    const LAS float* bt = (const LAS float*)(lds + AL_B) + (4 * hh - r + 32);
    u32x4 kk[3], vv[3]; u32x2 qn[4]; float bnext = 0.f;
    u32x4 kk2[3], vv2[3]; u32x2 qn2[4]; float bnext2 = 0.f;
#define ATT_LOAD(U) do { const AttUnit un_ = att_decode(U); \
        if (F.tid < 224) { const int X_ = F.tid - 32; bnext = (X_ >= 0 && X_ <= 128) ? ((const float*)(F.ws + WS_BTAB))[(un_.g * 16 + un_.head) * 160 + X_] : 0.f; } \
        _Pragma("unroll") for (int i = 0; i < 3; ++i) { const int id = F.tid + i * NTHR, row = id >> 2, ch = id & 3; int idx = un_.run0 - 64 + row; idx = idx < 0 ? 0 : (idx >= un_.length ? un_.length - 1 : idx); \
            const size_t off = ((size_t)un_.b * SEQ + (size_t)idx * un_.dil + un_.res) * DM + un_.head * 64 + ch * 16; kk[i] = *(const u32x4*)(AK + off); vv[i] = *(const u32x4*)(AV + off); } \
        const size_t qt_ = (size_t)un_.b * SEQ + (size_t)(un_.run0 + 32 * w + r) * un_.dil + un_.res; \
        _Pragma("unroll") for (int s = 0; s < 4; ++s) qn[s] = *(const u32x2*)(AQ + qt_ * DM + un_.head * 64 + 16 * s + 8 * hh); } while (0)
#define ATT_LOAD2(U) do { const AttUnit un_ = att_decode(U); \
        if (F.tid < 224) { const int X_ = F.tid - 32; bnext2 = (X_ >= 0 && X_ <= 128) ? ((const float*)(F.ws + WS_BTAB))[(un_.g * 16 + un_.head) * 160 + X_] : 0.f; } \
        _Pragma("unroll") for (int i = 0; i < 3; ++i) { const int id = F.tid + i * NTHR, row = id >> 2, ch = id & 3; int idx = un_.run0 - 64 + row; idx = idx < 0 ? 0 : (idx >= un_.length ? un_.length - 1 : idx); \
            const size_t off = ((size_t)un_.b * SEQ + (size_t)idx * un_.dil + un_.res) * DM + un_.head * 64 + ch * 16; kk2[i] = *(const u32x4*)(AK + off); vv2[i] = *(const u32x4*)(AV + off); } \
        const size_t qt_ = (size_t)un_.b * SEQ + (size_t)(un_.run0 + 32 * w + r) * un_.dil + un_.res; \
        _Pragma("unroll") for (int s = 0; s < 4; ++s) qn2[s] = *(const u32x2*)(AQ + qt_ * DM + un_.head * 64 + 16 * s + 8 * hh); } while (0)
    const int nun = u1 - u0, nit = nun * (PROBE_PHASE == 31 ? 2 : 1);
#define ATT_SLOT(I) (u0 + ((I) >= nit ? nun - 1 : ((I) >= nun ? (I) - nun : (I))))
    ATT_LOAD(ATT_SLOT(0)); ATT_LOAD2(ATT_SLOT(1));
#pragma unroll 1
    for (int it = 0; it < nit; ++it) {
        const int unit = u0 + (it >= nun ? it - nun : it);
        const AttUnit un = att_decode(unit);
        unsigned char* OG = F.ws + WS_OG + (size_t)un.g * (SEG / 2); float* LSE = (float*)(F.ws + WS_LSE) + (size_t)un.g * NTOK * 16;
#pragma unroll
        for (int i = 0; i < 3; ++i) { const int id = F.tid + i * NTHR, row = id >> 2, ch = id & 3;
            *(LAS u32x4*)(lds + AL_K + row * AK_STR + 32 * ch) = fp8x8_to_bf16(kk[i].x, kk[i].y); *(LAS u32x4*)(lds + AL_K + row * AK_STR + 32 * ch + 16) = fp8x8_to_bf16(kk[i].z, kk[i].w);
            *(LAS u32x4*)(lds + AL_V + row * AV_STR + 32 * ch) = fp8x8_to_bf16(vv[i].x, vv[i].y); *(LAS u32x4*)(lds + AL_V + row * AV_STR + 32 * ch + 16) = fp8x8_to_bf16(vv[i].z, vv[i].w); }
        if (F.tid < 224) ((LAS float*)(lds + AL_B))[F.tid] = bnext;
        bf16x8 qf[4];
#pragma unroll
        for (int s = 0; s < 4; ++s) qf[s] = __builtin_bit_cast(bf16x8, fp8x8_to_bf16(qn[s].x, qn[s].y));
        __syncthreads();
#pragma unroll
        for (int i = 0; i < 3; ++i) { kk[i] = kk2[i]; vv[i] = vv2[i]; }
#pragma unroll
        for (int s = 0; s < 4; ++s) qn[s] = qn2[s];
        bnext = bnext2;
        ATT_LOAD2(ATT_SLOT(it + 2));
        const size_t qtok = (size_t)un.b * SEQ + (size_t)(un.run0 + 32 * w + r) * un.dil + un.res;
        const int lv = 4 * hh - r, kv = un.run0 - 64 + 32 * w + 4 * hh;
        const int clo = max(-lv, -kv), chi = min(128 - lv, un.length - 1 - kv);
        const bool edge = (un.run0 == 0) || (un.run0 + 256 == un.length);
        float m = -3.0e38f, lsum = 0.f;
        f32x16 o0, o1;
#pragma unroll 1
        for (int rc_ = 0; rc_ < (PROBE_PHASE == 33 ? 2 + zero : 1); ++rc_) {
        m = -3.0e38f; lsum = 0.f;
#pragma unroll
        for (int i = 0; i < 16; ++i) { o0[i] = 0.f; o1[i] = 0.f; }
#pragma unroll
        for (int kb = 0; kb < 5; ++kb) {
            f32x16 sT;
#pragma unroll
            for (int i = 0; i < 16; ++i) sT[i] = 0.f;
#pragma unroll
            for (int s = 0; s < 4; ++s) sT = MFMA32(*(const LAS bf16x8*)(kbase + kb * (32 * AK_STR) + s * 32), qf[s], sT);
            float bv[16];
#pragma unroll
            for (int i = 0; i < 16; ++i) bv[i] = bt[32 * kb + (i & 3) + 8 * (i >> 2)];
            const bool masked = (kb == 0) || (kb == 4) || edge;
            float bm = -3.0e38f;
            if (masked) {
#pragma unroll
                for (int i = 0; i < 16; ++i) { const int c = 32 * kb + (i & 3) + 8 * (i >> 2); const bool valid = (c >= clo) && (c <= chi);
                    const float sv = sT[i] * (1.0f / 256.0f) + bv[i]; sT[i] = valid ? sv : -3.0e38f; bm = fmaxf(bm, sT[i]); }
            } else {
#pragma unroll
                for (int i = 0; i < 16; ++i) { sT[i] = sT[i] * (1.0f / 256.0f) + bv[i]; bm = fmaxf(bm, sT[i]); }
            }
            bm = fmaxf(bm, __shfl_xor(bm, 32));
            const float mn = fmaxf(m, bm), alpha = __builtin_amdgcn_exp2f(m - mn);
            if (kb > 0 && __any(mn > m)) {
#pragma unroll
                for (int i = 0; i < 16; ++i) { o0[i] *= alpha; o1[i] *= alpha; }
            }
            m = mn; lsum *= alpha;
            if (masked) {
#pragma unroll
                for (int i = 0; i < 16; ++i) { const float p = sT[i] > -1.0e38f ? __builtin_amdgcn_exp2f(sT[i] - mn) : 0.f; sT[i] = p; lsum += p; }
            } else {
#pragma unroll
                for (int i = 0; i < 16; ++i) { const float p = __builtin_amdgcn_exp2f(sT[i] - mn); sT[i] = p; lsum += p; }
            }
#pragma unroll
            for (int s2 = 0; s2 < 2; ++s2) {
                const bf16x8 pb = pack8(sT, s2);
#pragma unroll
                for (int e2 = 0; e2 < 2; ++e2) {
                    const s16x4 lo = tr_read(vbase + kb * (32 * AV_STR) + s2 * (16 * AV_STR) + e2 * 64);
                    const s16x4 hi = tr_read(vbase + kb * (32 * AV_STR) + s2 * (16 * AV_STR) + 8 * AV_STR + e2 * 64);
                    const bf16x8 vf = __builtin_shufflevector(lo, hi, 0, 1, 2, 3, 4, 5, 6, 7);
                    if (e2 == 0) o0 = MFMA32(vf, pb, o0); else o1 = MFMA32(vf, pb, o1);
                }
            }
        }
        }
        lsum += __shfl_xor(lsum, 32);
        if (hh == 0) LSE[qtok * 16 + un.head] = (m + __log2f(lsum)) * 0.6931471805599453f;
        const float linv = YD_INV / lsum;
        __syncthreads();
#pragma unroll 1
        for (int rs_ = 0; rs_ < (PROBE_PHASE == 34 ? 2 + zero : 1); ++rs_)
        {
            LAS unsigned char* ost = lds + AL_K + w * (32 * AK_STR);
#pragma unroll
            for (int g = 0; g < 4; ++g) {
                u32x2 a0, a1; a0.x = cvtpk(o0[4 * g] * linv, o0[4 * g + 1] * linv); a0.y = cvtpk(o0[4 * g + 2] * linv, o0[4 * g + 3] * linv);
                a1.x = cvtpk(o1[4 * g] * linv, o1[4 * g + 1] * linv); a1.y = cvtpk(o1[4 * g + 2] * linv, o1[4 * g + 3] * linv);
                *(LAS u32x2*)(ost + r * AK_STR + 16 * g + 8 * hh) = a0; *(LAS u32x2*)(ost + r * AK_STR + 64 + 16 * g + 8 * hh) = a1;
            }
            asm volatile("s_waitcnt lgkmcnt(0)" ::: "memory");
#pragma unroll
            for (int it = 0; it < 4; ++it) {
                const int ql = 8 * it + (lane >> 3);
                const u32x4 v = *(const LAS u32x4*)(ost + ql * AK_STR + 16 * (lane & 7));
                const size_t tok = (size_t)un.b * SEQ + (size_t)(un.run0 + 32 * w + ql) * un.dil + un.res;
                u32x2 f8; f8.x = pk4_fp8(bflo(v.x), bfhi(v.x), bflo(v.y), bfhi(v.y)); f8.y = pk4_fp8(bflo(v.z), bfhi(v.z), bflo(v.w), bfhi(v.w));
                __builtin_nontemporal_store(f8, (u32x2*)(OG + tok * DM + un.head * 64 + 8 * (lane & 7)));
            }
        }
        __syncthreads();
    }
#undef ATT_LOAD
#undef ATT_LOAD2
#undef ATT_SLOT
}

__device__ __forceinline__ void mixer_post_rows(Frame& F) {
    const int gw = F.vcu * NWAVES + F.wave, NGW = F.G * NWAVES, lane = F.lane;
    const bf16_t* OF = (const bf16_t*)(F.ws + WS_OUTF); const bf16_t* OB = (const bf16_t*)(F.ws + WS_OUTB); const unsigned char* SG = (F.ws + WS_RG);
    const unsigned char* OG = F.ws + WS_OG; const float* LSE = (const float*)(F.ws + WS_LSE);
    bf16_t* RN = (bf16_t*)(F.ws + WS_RETN); bf16_t* AC = (bf16_t*)(F.ws + WS_ATTC);
    const int head = lane >> 2;
    u32x2 fa[4], fb[4], na[4], nb[4]; unsigned sg[4], nsg[4]; u32x4 og[3], nog[3]; float ls[3], nls[3];
#define MP_LOAD(A, B, S, O, L, ROW) do { _Pragma("unroll") for (int h = 0; h < 4; ++h) { const size_t off_ = (size_t)(ROW) * DM + h * 256 + 4 * lane; \
            A[h] = *(const u32x2*)(OF + off_); B[h] = *(const u32x2*)(OB + off_); S[h] = *(const unsigned*)(SG + off_); } \
        _Pragma("unroll") for (int g = 0; g < 3; ++g) { O[g] = *(const u32x4*)(OG + (size_t)g * NTOK * DM + (size_t)(ROW) * DM + 16 * lane); L[g] = LSE[((size_t)g * NTOK + (ROW)) * 16 + head]; } } while (0)
    if (gw >= NTOK) return;
    MP_LOAD(fa, fb, sg, og, ls, gw);
#pragma unroll 1
    for (int row = gw; row < NTOK; row += NGW) {
        const int rn = row + NGW < NTOK ? row + NGW : row;
        MP_LOAD(na, nb, nsg, nog, nls, rn);
        f32x4 v[4];
#pragma unroll
        for (int h = 0; h < 4; ++h) v[h] = (f32x4){bflo(fa[h].x) + bflo(fb[h].x), bfhi(fa[h].x) + bfhi(fb[h].x), bflo(fa[h].y) + bflo(fb[h].y), bfhi(fa[h].y) + bfhi(fb[h].y)};
#pragma unroll
        for (int h = 0; h < 4; ++h) {
            const float mu = wave_sum((v[h][0] + v[h][1]) + (v[h][2] + v[h][3])) * (1.f / 256.f);
            const f32x4 d = v[h] - mu;
            const float var = wave_sum((d[0] * d[0] + d[1] * d[1]) + (d[2] * d[2] + d[3] * d[3])) * (1.f / 256.f);
            const float rs = rsqrtf(var + NORM_EPS);
            const f32x2 g01 = __builtin_amdgcn_cvt_pk_f32_fp8((int)sg[h], false), g23 = __builtin_amdgcn_cvt_pk_f32_fp8((int)sg[h], true); const float rq = rs * YD_INV;
            u32x2 o; o.x = cvtpk(d[0] * rq * g01.x, d[1] * rq * g01.y); o.y = cvtpk(d[2] * rq * g23.x, d[3] * rq * g23.y);
            *(u32x2*)(RN + (size_t)row * DM + h * 256 + 4 * lane) = o;
        }
        const float lm = fmaxf(ls[0], fmaxf(ls[1], ls[2]));
        float wg[3]; float wsum = 0.f;
#pragma unroll
        for (int g = 0; g < 3; ++g) { wg[g] = __expf(ls[g] - lm); wsum += wg[g]; }
        const float winv = 1.f / wsum;
        unsigned res[8];
#pragma unroll
        for (int wI = 0; wI < 4; ++wI) {
            float a0 = 0.f, a1 = 0.f, a2 = 0.f, a3 = 0.f;
#pragma unroll
            for (int g = 0; g < 3; ++g) { const int wd = (int)(wI == 0 ? og[g].x : (wI == 1 ? og[g].y : (wI == 2 ? og[g].z : og[g].w)));
                const f32x2 p0 = __builtin_amdgcn_cvt_pk_f32_fp8(wd, false), p1 = __builtin_amdgcn_cvt_pk_f32_fp8(wd, true);
                a0 += wg[g] * p0.x; a1 += wg[g] * p0.y; a2 += wg[g] * p1.x; a3 += wg[g] * p1.y; }
            const float sc = winv * YD_INV;
            res[2 * wI] = cvtpk(a0 * sc, a1 * sc); res[2 * wI + 1] = cvtpk(a2 * sc, a3 * sc);
        }
        u32x4 oo[2]; oo[0] = (u32x4){res[0], res[1], res[2], res[3]}; oo[1] = (u32x4){res[4], res[5], res[6], res[7]};
        bf16_t* ap = AC + (size_t)row * DM + 16 * lane; *(u32x4*)ap = oo[0]; *(u32x4*)(ap + 8) = oo[1];
#pragma unroll
        for (int h = 0; h < 4; ++h) { fa[h] = na[h]; fb[h] = nb[h]; sg[h] = nsg[h]; }
#pragma unroll
        for (int g = 0; g < 3; ++g) { og[g] = nog[g]; ls[g] = nls[g]; }
    }
#undef MP_LOAD
}

__device__ __forceinline__ void routing_rows(Frame& F, const Args& a) {
    const int gw = F.vcu * NWAVES + F.wave, NGW = F.G * NWAVES, lane = F.lane;
    const float* LOG = (const float*)(F.ws + WS_LOGIT); const float* rb = a.in[13];
    int* EIDX = (int*)(F.ws + WS_EIDX); float* GATE = (float*)(F.ws + WS_GATE);
    LAS unsigned* hist = (LAS unsigned*)(F.lds);
    for (int i = F.tid; i < NEXP; i += NTHR) hist[i] = 0u;
    __syncthreads();
    const f32x4 bias = *(const f32x4*)(rb + 4 * lane);
    for (int row = gw; row < NTOK; row += NGW) {
        const f32x4 lg = *(const f32x4*)(LOG + (size_t)row * NEXP + 4 * lane);
        float sc[4], ch[4];
#pragma unroll
        for (int i = 0; i < 4; ++i) { sc[i] = 1.f / (1.f + expf(-lg[i])); ch[i] = sc[i] + bias[i]; }
        float m1 = fmaxf(ch[0], ch[1]), m2 = fminf(ch[0], ch[1]);
        { const float c2 = ch[2]; const float n1 = fmaxf(m1, c2); m2 = fmaxf(m2, fminf(m1, c2)); m1 = n1; }
        { const float c3 = ch[3]; const float n1 = fmaxf(m1, c3); m2 = fmaxf(m2, fminf(m1, c3)); m1 = n1; }
#pragma unroll
        for (int o = 1; o < 8; o <<= 1) { const float b1 = __shfl_xor(m1, o), b2 = __shfl_xor(m2, o);
            const float n1 = fmaxf(m1, b1); const float n2 = fmaxf(fminf(m1, b1), fmaxf(m2, b2)); m1 = n1; m2 = n2; }
        const float gs = m1 + m2; const int mygrp = lane >> 3;
        int rank = 0;
#pragma unroll
        for (int g = 0; g < 8; ++g) { const float og = __shfl(gs, g * 8); rank += (og > gs || (og == gs && g < mygrp)) ? 1 : 0; }
        const bool elig = rank < 4;
        float cv[4];
#pragma unroll
        for (int i = 0; i < 4; ++i) cv[i] = elig ? ch[i] : -3.0e38f;
        float gsel = 0.f; int esel = 0; float gsum = 0.f;
#pragma unroll
        for (int k = 0; k < TOPK; ++k) {
            float bv = cv[0]; int bi = 4 * lane;
#pragma unroll
            for (int i = 1; i < 4; ++i) if (cv[i] > bv) { bv = cv[i]; bi = 4 * lane + i; }
#pragma unroll
            for (int o = 1; o < 64; o <<= 1) { const float ov = __shfl_xor(bv, o); const int oi = __shfl_xor(bi, o); if (ov > bv || (ov == bv && oi < bi)) { bv = ov; bi = oi; } }
            const int own = bi >> 2, el = bi & 3;
            const float mine = el == 0 ? sc[0] : (el == 1 ? sc[1] : (el == 2 ? sc[2] : sc[3]));
            const float s = __shfl(mine, own);
            if (lane == own) { if (el == 0) cv[0] = -3.0e38f; else if (el == 1) cv[1] = -3.0e38f; else if (el == 2) cv[2] = -3.0e38f; else cv[3] = -3.0e38f; }
            gsum += s;
            if (lane == k) { gsel = s; esel = bi; }
        }
        if (lane < TOPK) { EIDX[row * TOPK + lane] = esel; GATE[row * TOPK + lane] = gsel / gsum * 2.5f; __hip_atomic_fetch_add(&hist[esel], 1u, __ATOMIC_RELAXED, __HIP_MEMORY_SCOPE_WORKGROUP); }
    }
    __syncthreads();
    for (int i = F.tid; i < NEXP; i += NTHR) if (hist[i]) atomicAdd((unsigned*)(F.ws + WS_CTL) + CW_CNT + i, hist[i]);
}

__device__ __forceinline__ void routing_lists(Frame& F) {
    LAS unsigned* cnt = (LAS unsigned*)(F.lds);
    LAS unsigned* pstart = cnt + 256;
    LAS unsigned* lh = pstart + 264;
    LAS unsigned* lbase = lh + 256;
    LAS unsigned* ustart = lbase + 256;
    int* DPOS = (int*)(F.ws + WS_DPOS);
    unsigned* ctl = (unsigned*)(F.ws + WS_CTL);
    const int* EIDX = (const int*)(F.ws + WS_EIDX); int* ROWL = (int*)(F.ws + WS_ROWL); int* TILE_E = (int*)(F.ws + WS_TILE_E);
    for (int i = F.tid; i < NEXP; i += NTHR) { cnt[i] = __hip_atomic_load(ctl + CW_CNT + i, RLX_AGENT); lh[i] = 0u; }
    __syncthreads();
    if (F.tid == 0) { unsigned s = 0, us = 0; for (int e = 0; e < NEXP; ++e) { pstart[e] = s; ustart[e] = us; s += (cnt[e] + 255u) & ~255u; us += cnt[e]; } pstart[NEXP] = s; }
    __syncthreads();
    const unsigned ptotal = pstart[NEXP];
    const int per = (NTOK + F.G - 1) / F.G, tk0 = F.vcu * per, tk1 = (tk0 + per) < NTOK ? (tk0 + per) : NTOK;
    for (int i = tk0 * TOPK + F.tid; i < tk1 * TOPK; i += NTHR) __hip_atomic_fetch_add(&lh[EIDX[i]], 1u, __ATOMIC_RELAXED, __HIP_MEMORY_SCOPE_WORKGROUP);
    __syncthreads();
    for (int e = F.tid; e < NEXP; e += NTHR) { const unsigned c = lh[e]; lbase[e] = c ? atomicAdd(ctl + CW_FILL + e, c) : 0u; lh[e] = 0u; }
    __syncthreads();
    for (int i = tk0 * TOPK + F.tid; i < tk1 * TOPK; i += NTHR) { const int e = EIDX[i]; const unsigned p = __hip_atomic_fetch_add(&lh[e], 1u, __ATOMIC_RELAXED, __HIP_MEMORY_SCOPE_WORKGROUP);
        ROWL[pstart[e] + lbase[e] + p] = (i >> 3) * 16 + (i & 7); DPOS[i] = (int)(ustart[e] + lbase[e] + p); }
    for (int t = tk0 + F.tid; t < tk1; t += NTHR) ROWL[ptotal + t] = t * 16 + 8;
    for (int e = F.vcu; e < NEXP; e += F.G) { const unsigned s = pstart[e] + cnt[e], en = pstart[e + 1]; for (unsigned p = s + F.tid; p < en; p += NTHR) ROWL[p] = -1; }
    if (F.vcu == 0) {
        const int nrt = (int)(ptotal >> 8);
        for (int e = F.tid; e < NEXP; e += NTHR) { for (unsigned t = pstart[e] >> 8; t < (pstart[e + 1] >> 8); ++t) TILE_E[t] = e; TILE_E[4096 + e] = (int)(pstart[e] - ustart[e]); TILE_E[8192 + e] = (int)(pstart[e] + cnt[e]); }
        for (int t = F.tid; t < NTOK / 256; t += NTHR) TILE_E[nrt + t] = NEXP;
        if (F.tid == 0) { TILE_E[4096 + NEXP] = (int)ptotal - YD_SHARED0; TILE_E[8192 + NEXP] = (int)ptotal + NTOK; }
        if (F.tid == 0) TILE_E[MAX_TILES] = nrt + NTOK / 256;
    }
}

__device__ __forceinline__ void final_rows(Frame& F, const Args& a) {
    const int gw = F.vcu * NWAVES + F.wave, NGW = F.G * NWAVES, lane = F.lane;
    const float* mod = (const float*)(F.ws + WS_MOD); const float* nf = a.in[20];
    const int* DPOS = (const int*)(F.ws + WS_DPOS); const float* GATE = (const float*)(F.ws + WS_GATE);
    f32x4 g4[4];
#pragma unroll
    for (int j = 0; j < 4; ++j) g4[j] = *(const f32x4*)(nf + 4 * lane + 256 * j);
    if (gw >= NTOK) return;
    auto clampr = [&](int r) { return r < NTOK ? r : gw; };
    int dcur = DPOS[clampr(gw) * 8 + (lane & 7)]; float gcur = GATE[clampr(gw) * 8 + (lane & 7)];
    int dnxt = DPOS[clampr(gw + NGW) * 8 + (lane & 7)]; float gnxt = GATE[clampr(gw + NGW) * 8 + (lane & 7)];
    f32x4 xw[4], xn[4]; int yw[9][4], yn[9][4];
#define FIN_LOAD(XW, YW, ROW, DV) do { const f32x4* xr_ = (const f32x4*)(a.out + (size_t)(ROW) * DM) + lane; \
        _Pragma("unroll") for (int j = 0; j < 4; ++j) XW[j] = xr_[64 * j]; \
        _Pragma("unroll") for (int k = 0; k < 9; ++k) { const unsigned char* yr_ = ydense_row(F.ws, k < 8 ? __builtin_amdgcn_readlane((DV), k) : YD_SHARED0 + (ROW)) + 4 * lane; \
            _Pragma("unroll") for (int j = 0; j < 4; ++j) YW[k][j] = *(const int*)(yr_ + 256 * j); } } while (0)
    FIN_LOAD(xw, yw, gw, dcur);
#pragma unroll 1
    for (int row = gw; row < NTOK; row += NGW) {
        const int rn = clampr(row + NGW), rn2 = clampr(row + 2 * NGW);
        FIN_LOAD(xn, yn, rn, dnxt);
        const int dn2 = DPOS[rn2 * 8 + (lane & 7)]; const float gn2 = GATE[rn2 * 8 + (lane & 7)];
        const int b = row / SEQ;
        f32x4 v[4]; float s = 0.f;
#pragma unroll
        for (int j = 0; j < 4; ++j) {
            const int col = 4 * lane + 256 * j;
            f32x4 y = (f32x4){0.f, 0.f, 0.f, 0.f};
#pragma unroll
            for (int k = 0; k < 9; ++k) { const int wv = yw[k][j]; const float gk = (k < 8 ? __uint_as_float(__builtin_amdgcn_readlane(__float_as_uint(gcur), k)) : 1.0f) * YD_INV;
                const f32x2 lo = __builtin_amdgcn_cvt_pk_f32_fp8(wv, false), hi = __builtin_amdgcn_cvt_pk_f32_fp8(wv, true);
                y[0] += gk * lo.x; y[1] += gk * lo.y; y[2] += gk * hi.x; y[3] += gk * hi.y; }
            const f32x4 gf = *(const f32x4*)(mod + (size_t)b * 6144 + 5 * DM + col);
            v[j] = xw[j] + gf * y;
            s += (v[j][0] * v[j][0] + v[j][1] * v[j][1]) + (v[j][2] * v[j][2] + v[j][3] * v[j][3]);
        }
        const float rstd = rsqrtf(wave_sum(s) * (1.f / DM) + NORM_EPS);
        f32x4* xo = (f32x4*)(a.out + (size_t)row * DM) + lane;
#pragma unroll
        for (int j = 0; j < 4; ++j) xo[64 * j] = (v[j] * rstd) * g4[j];
#pragma unroll
        for (int j = 0; j < 4; ++j) xw[j] = xn[j];
#pragma unroll
        for (int k = 0; k < 9; ++k)
#pragma unroll
            for (int j = 0; j < 4; ++j) yw[k][j] = yn[k][j];
        dcur = dnxt; gcur = gnxt; dnxt = dn2; gnxt = gn2;
    }
#undef FIN_LOAD
}

constexpr int MT_OFF = 131072, MT_INFO = MT_OFF + 4096;
__device__ __forceinline__ void moe_tables_to_lds(Frame& F, int ntiles) {
    const int* TILE_E = (const int*)(F.ws + WS_TILE_E);
    LAS unsigned short* te = (LAS unsigned short*)(F.lds + MT_OFF); LAS int* info = (LAS int*)(F.lds + MT_INFO);
    for (int t = F.tid; t < ntiles; t += NTHR) te[t] = (unsigned short)TILE_E[t];
    for (int e = F.tid; e <= NEXP; e += NTHR) { info[e] = TILE_E[4096 + e]; info[512 + e] = TILE_E[8192 + e]; }
    __syncthreads();
}
constexpr int DW_STR = 192;
constexpr int DW_BUF = 256 * DW_STR;
typedef float f32x4_t __attribute__((ext_vector_type(4)));
#define MFMA16(a, b, c) __builtin_amdgcn_mfma_f32_16x16x32_bf16((a), (b), (c), 0, 0, 0)
template <int MODE> __device__ __forceinline__ void down_phase(Frame& F, const Args& a) {
    const int* TILE_E = (const int*)(F.ws + WS_TILE_E); const int ntiles = __builtin_amdgcn_readfirstlane(TILE_E[MAX_TILES]);
    moe_tables_to_lds(F, ntiles);
    const LAS unsigned short* tile_e = (const LAS unsigned short*)(F.lds + MT_OFF); const LAS int* info = (const LAS int*)(F.lds + MT_INFO);
    const int lane = F.lane, w = F.wave, fr = lane & 15, g4 = lane >> 4;
    LAS unsigned char* lds = F.lds;
    const bf16_t* HID = (const bf16_t*)(F.ws + WS_HID);
    const int sk = F.tid >> 4, sn4 = F.tid & 15;
    const int spos = 16 * (sn4 & 3) + 4 * (sn4 >> 2);
    const int q4 = (lane & 15) >> 2, p4 = lane & 3;
    auto next_tile = [&](int i) -> int { const long L = (long)i * F.G + (int)blockIdx.x; return L < ntiles ? pg8::xcd_remap((int)L, ntiles) : -1; };
    int ui = 0, tile = next_tile(0);
    if (tile < 0) return;
    f32x4_t st[8], st2[8];
    auto wd_base = [&](int t) -> const float* { const int e = MODE == 1 ? 0 : (int)tile_e[t]; return e < NEXP ? a.in[16] + (size_t)e * (EH * DM) : a.in[19]; };
#define DW_LOAD(R, WB, C) do { const float* p_ = (WB) + (size_t)sk * DM + (C) * 64 + sn4 * 4; _Pragma("unroll") for (int i = 0; i < 8; ++i) R[i] = *(const f32x4_t*)(p_ + (size_t)i * 32 * DM); } while (0)
#define DW_WRITE(R, SLOT) do { _Pragma("unroll") for (int i = 0; i < 8; ++i) { const int k_ = sk + 32 * i; u32x2 w_; w_.x = cvtpk(R[i][0], R[i][1]); w_.y = cvtpk(R[i][2], R[i][3]); \
        *(LAS u32x2*)(lds + (SLOT) * DW_BUF + k_ * DW_STR + (((spos >> 4) ^ ((k_ >> 3) & 1)) << 5) + (spos & 15) * 2) = w_; } } while (0)
    const float* wb = wd_base(tile);
    int ntile = next_tile(1);
    const float* nwb = ntile >= 0 ? wd_base(ntile) : wb;
    DW_LOAD(st, wb, 0); DW_WRITE(st, 0);
    DW_LOAD(st, wb, 1); DW_LOAD(st2, wb, 2);
    __syncthreads();
    int cc = 0;
    for (;;) {
        const int e = (int)tile_e[tile]; const int shift = info[e], lim = info[512 + e];
        bf16x8 af[2][8];
        { const bf16_t* hp = HID + ((size_t)tile * 256 + 32 * w + fr) * EH + 8 * g4;
#pragma unroll
          for (int m = 0; m < 2; ++m)
#pragma unroll
              for (int ks = 0; ks < 8; ++ks) af[m][ks] = *(const bf16x8*)(hp + (size_t)m * 16 * EH + 32 * ks);
#pragma unroll
          for (int m = 0; m < 2; ++m)
#pragma unroll
              for (int ks = 0; ks < 8; ++ks) asm volatile("" : "+v"(af[m][ks])); }
        const int pos0 = tile * 256 + 32 * w + fr;
#pragma unroll 1
        for (int c = 0; c < 16; c += 2) {
#pragma unroll
            for (int hc = 0; hc < 2; ++hc, ++cc) {
                const int cq = c + hc;
                f32x4 acc[2][4];
                if (MODE == 3) {
#pragma unroll
                    for (int m = 0; m < 2; ++m)
#pragma unroll
                        for (int nf = 0; nf < 4; ++nf) acc[m][nf] = (f32x4){0.f, 0.f, 0.f, 0.f}; }
                LAS unsigned char* bb = lds + (cc & 1) * DW_BUF + (8 * g4 + q4) * DW_STR + 8 * p4;
#pragma unroll 1
                for (int rp_ = 0; rp_ < (MODE == 3 ? a.pad : (PROBE_PHASE == 40 ? 2 + a.pad : 1)); ++rp_) {
#pragma unroll
                for (int m = 0; m < 2; ++m)
#pragma unroll
                    for (int nf = 0; nf < 4; ++nf) acc[m][nf] = (f32x4){0.f, 0.f, 0.f, 0.f};
#pragma unroll
                for (int ks = 0; ks < 8; ++ks) {
#pragma unroll
                    for (int nf = 0; nf < 4; ++nf) {
                        LAS unsigned char* pp = bb + ks * (32 * DW_STR) + ((nf ^ (g4 & 1)) << 5);
                        const s16x4 lo = tr_read(pp), hi = tr_read(pp + 4 * DW_STR);
                        const bf16x8 bf = __builtin_shufflevector(lo, hi, 0, 1, 2, 3, 4, 5, 6, 7);
                        acc[0][nf] = MFMA16(bf, af[0][ks], acc[0][nf]); acc[1][nf] = MFMA16(bf, af[1][ks], acc[1][nf]);
                    }
                }
                }
                u32x4 ow[2];
#pragma unroll
                for (int m = 0; m < 2; ++m) { ow[m].x = pk4_fp8(acc[m][0][0], acc[m][0][1], acc[m][0][2], acc[m][0][3]); ow[m].y = pk4_fp8(acc[m][1][0], acc[m][1][1], acc[m][1][2], acc[m][1][3]);
                    ow[m].z = pk4_fp8(acc[m][2][0], acc[m][2][1], acc[m][2][2], acc[m][2][3]); ow[m].w = pk4_fp8(acc[m][3][0], acc[m][3][1], acc[m][3][2], acc[m][3][3]); }
                const int c3 = cq + 3; const float* b3 = c3 < 16 ? wb : nwb; const int k3 = c3 < 16 ? c3 : c3 - 16;
                if (hc == 0) { DW_WRITE(st, (cc + 1) & 1); DW_LOAD(st, b3, k3); } else { DW_WRITE(st2, (cc + 1) & 1); DW_LOAD(st2, b3, k3); }
#pragma unroll
                for (int m = 0; m < 2; ++m) {
                    const int pos = pos0 + 16 * m;
                    unsigned char* rowp = (pos < lim ? ydense_row(F.ws, pos - shift) : F.ws + WS_SS + (size_t)blockIdx.x * 2048) + 64 * cq + 16 * g4;
                    if (MODE >= 2) asm volatile("" :: "v"(ow[m])); else *(u32x4*)rowp = ow[m];
                }
                __syncthreads();
            }
        }
        if (ntile < 0) break;
        tile = ntile; wb = nwb; ++ui;
        ntile = next_tile(ui + 1); nwb = ntile >= 0 ? wd_base(ntile) : wb;
    }
#undef DW_LOAD
#undef DW_WRITE
}

constexpr int N_PHASES = 13;
__global__ void __launch_bounds__(NTHR, 2) fwd_kernel(Args args) {
    extern __shared__ __attribute__((aligned(16))) unsigned char lds_raw[];
    Frame F;
    F.lds = (LAS unsigned char*)lds_raw; F.ws = args.ws;
    F.tid = threadIdx.x; F.lane = F.tid & 63; F.wave = __builtin_amdgcn_readfirstlane(F.tid >> 6);
    F.G = gridDim.x; { const int bx = blockIdx.x; F.vcu = (F.G % 8 == 0) ? (bx % 8) * (F.G / 8) + bx / 8 : bx; }
    volatile LAS unsigned* MISC = (volatile LAS unsigned*)(F.lds + MISC_OFF);
    for (int u = F.tid; u < (LDS_BYTES - LDSCTL_OFF) / 4; u += NTHR) ((LAS unsigned*)(F.lds + LDSCTL_OFF))[u] = 0u;
    __syncthreads();
    unsigned* ctl = (unsigned*)(F.ws + WS_CTL);
    XcdBarrier bar; bar.bar = ctl + CW_BAR; bar.x = 0; bar.st = nullptr;
    const int lo = args.ph_lo, hi = args.ph_hi;
    if (hi - lo > 1) bar = xcd_barrier_post(ctl + CW_BAR, MISC + 8);
#ifdef ONLY_PHASE
#define IN(k) ((k) == ONLY_PHASE && lo <= (k) && (k) < hi)
#else
#define IN(k) (lo <= (k) && (k) < hi)
#endif
#define SEAM(k) do { if (IN(k) && IN((k) + 1)) xcd_barrier(bar); } while (0)
#ifndef PROBE_PHASE
#define PROBE_PHASE -1
#endif
#define REP(k) _Pragma("unroll 1") for (int rep_ = 0; rep_ < ((k) == PROBE_PHASE ? 2 + args.pad : 1); ++rep_)
    const float* mod = (const float*)(F.ws + WS_MOD);
    bf16_t* HB = (bf16_t*)(F.ws + WS_H);

    if (IN(0)) REP(0) { phase0(F, args); } SEAM(0);
    if (IN(1)) REP(1) { norm_mod_rows(F, args.in[0], args.in[4], mod, 0, DM, nullptr, HB); } SEAM(1);
    if (IN(2)) REP(2) {
        EpiInProj E{F.ws, (const float*)(F.ws + WS_ROPE_C), (const float*)(F.ws + WS_ROPE_S)};
        { pg8::StaticOrder S; S.init(HB, (const bf16_t*)(F.ws + WS_WIN), NTOK, PROJW - 3 * DM, DM, F.G, (int)blockIdx.x, 12);
          pg8::gemm_phase<EpiInProj, pg8::StaticOrder, true>(F.lds, S, E); }
        { pg8::StaticOrder S; S.init(HB, (const bf16_t*)(F.ws + WS_WIN), NTOK, 3 * DM, DM, F.G, (int)blockIdx.x, 0);
          pg8::gemm_phase<EpiInProj, pg8::StaticOrder, true>(F.lds, S, E); }
    } SEAM(2);
    if (IN(3)) {
#ifndef NO_RET
        REP(30) for (int ch = F.vcu; ch < 256; ch += F.G) retention_chain(F, args, ch);
#endif
#ifndef NO_ATT
        const int per = (6144 + F.G - 1) / F.G;
        attention_phase(F, F.vcu * per, (F.vcu + 1) * per < 6144 ? (F.vcu + 1) * per : 6144, args.pad);
#endif
    } SEAM(3);
    if (IN(4)) REP(4) { mixer_post_rows(F); } SEAM(4);
    if (IN(5)) REP(5) {
        pg8::DualOrder S; S.so.init((const bf16_t*)(F.ws + WS_RETN), (const bf16_t*)(F.ws + WS_WRU), NTOK, DM, DM, F.G, (int)blockIdx.x);
        S.A1 = (const bf16_t*)(F.ws + WS_ATTC); S.Bt1 = (const bf16_t*)(F.ws + WS_WAU); S.K = DM;
        EpiMerge E{(bf16_t*)(F.ws + WS_MERGED), F.ws + WS_SGR, F.ws + WS_SGA};
        pg8::gemm_phase<EpiMerge, pg8::DualOrder, true>(F.lds, S, E);
    } SEAM(5);
    if (IN(6)) REP(6) {
        pg8::StaticOrder S; S.init((const bf16_t*)(F.ws + WS_MERGED), (const bf16_t*)(F.ws + WS_WO), NTOK, DM, DM, F.G, (int)blockIdx.x);
        EpiOProj E{args.in[0], args.out, mod, (float*)(F.ws + WS_SS)};
        pg8::gemm_phase<EpiOProj, pg8::StaticOrder, true>(F.lds, S, E);
    } SEAM(6);
    if (IN(7)) REP(7) {
        norm_mod_rows(F, args.out, args.in[11], mod, 3 * DM, 4 * DM, (const float*)(F.ws + WS_SS), HB);
    } SEAM(7);
    if (IN(8)) {
        pg8::StaticOrder S; S.init(HB, (const bf16_t*)(F.ws + WS_WR), NTOK, NEXP, DM, F.G, (int)blockIdx.x);
        EpiF32 E{(float*)(F.ws + WS_LOGIT), NEXP};
        pg8::gemm_phase<EpiF32, pg8::StaticOrder, true>(F.lds, S, E);
        __syncthreads();
        moe_weight_convert(F, args);
    } SEAM(8);
    if (IN(9)) { routing_rows(F, args); } SEAM(9);
    if (IN(10)) { routing_lists(F); } SEAM(10);
    if (IN(11)) REP(11) {
        const int* TILE_E = (const int*)(F.ws + WS_TILE_E); const int ntiles = __builtin_amdgcn_readfirstlane(TILE_E[MAX_TILES]);
        pg8::MoeOrder<true> S; S.A = HB; S.Bt = (const bf16_t*)(F.ws + WS_WGU); S.K = DM; S.e_stride = (size_t)512 * 1024; S.tile_e = (const LAS unsigned short*)(F.lds + MT_OFF); S.rowlist = (const int*)(F.ws + WS_ROWL); moe_tables_to_lds(F, ntiles);
        S.ntiles = ntiles; S.nN = 2; S.nwg = ntiles * 2; S.G = F.G; S.c = (int)blockIdx.x;
        EpiGU E{(bf16_t*)(F.ws + WS_HID)};
        pg8::gemm_phase<EpiGU, pg8::MoeOrder<true>, true>(F.lds, S, E);
    } SEAM(11);
    if (IN(12)) REP(12) {
        down_phase<0>(F, args);
    } SEAM(12);
    if (IN(13)) { final_rows(F, args); }
#if PROBE_LAUNCH == 14
    if (lo == 14) {
        pg8::StaticOrder S; S.init(HB, (const bf16_t*)(F.ws + WS_WIN), NTOK, PROJW, DM, F.G, (int)blockIdx.x);
        EpiNull E{};
        pg8::gemm_phase<EpiNull, pg8::StaticOrder, true>(F.lds, S, E);
    }
#endif
#if PROBE_LAUNCH == 16
    if (lo == 14) {
        const int* TILE_E = (const int*)(F.ws + WS_TILE_E); const int ntiles = __builtin_amdgcn_readfirstlane(TILE_E[MAX_TILES]);
        pg8::MoeOrder<false> S; S.A = (const bf16_t*)(F.ws + WS_HID); S.Bt = (const bf16_t*)(F.ws + WS_WD); S.K = EH; S.e_stride = (size_t)1024 * 256; S.tile_e = (const LAS unsigned short*)(F.lds + MT_OFF); S.rowlist = (const int*)(F.ws + WS_ROWL); moe_tables_to_lds(F, ntiles);
        S.ntiles = ntiles; S.nN = 4; S.nwg = ntiles * 4; S.G = F.G; S.c = (int)blockIdx.x;
        EpiNull E{};
        pg8::gemm_phase<EpiNull, pg8::MoeOrder<false>, true>(F.lds, S, E);
    }
#endif
#if PROBE_LAUNCH == 18
    if (lo == 14) { down_phase<1>(F, args); }
#endif
#if PROBE_LAUNCH == 19
    if (lo == 14) { down_phase<2>(F, args); }
#endif
#if PROBE_LAUNCH == 20
    if (lo == 14) { down_phase<3>(F, args); }
#endif
#if PROBE_LAUNCH == 17
    if (lo == 14) {
        const int* TILE_E = (const int*)(F.ws + WS_TILE_E); const int ntiles = __builtin_amdgcn_readfirstlane(TILE_E[MAX_TILES]);
        pg8::MoeOrder<false> S; S.A = (const bf16_t*)(F.ws + WS_HID); S.Bt = (const bf16_t*)(F.ws + WS_WD); S.K = EH; S.e_stride = (size_t)1024 * 256; S.tile_e = (const LAS unsigned short*)(F.lds + MT_OFF); S.rowlist = (const int*)(F.ws + WS_ROWL); moe_tables_to_lds(F, ntiles);
        S.ntiles = ntiles; S.nN = 4; S.nwg = ntiles * 4; S.G = F.G; S.c = (int)blockIdx.x;
        EpiDownT<1> E{F.ws, (const LAS int*)(F.lds + MT_INFO)};
        pg8::gemm_phase<EpiDownT<1>, pg8::MoeOrder<false>, true>(F.lds, S, E);
    }
#endif
#if PROBE_LAUNCH == 15
    if (lo == 14) {
        pg8::StaticOrder S; S.init(HB, (const bf16_t*)(F.ws + WS_WIN), NTOK, PROJW, DM, F.G, (int)blockIdx.x);
        EpiPlainScratch E{(bf16_t*)(F.ws + WS_OUTF)};
        pg8::gemm_phase<EpiPlainScratch, pg8::StaticOrder, true>(F.lds, S, E);
    }
#endif
#undef IN
#undef SEAM
}

extern "C" void kernel_launch(void* const* d_in, const int* in_sizes, int n_in, void* d_out, int out_size, void* d_ws, size_t ws_size, hipStream_t stream) {
    static int grid = 0;
    if (grid == 0) {
        if (n_in != 21 || out_size != NTOK * DM || ws_size < WS_END) { fprintf(stderr, "kernel_launch: unexpected shapes (n_in %d out %d ws %zu)\n", n_in, out_size, ws_size); grid = -1; return; }
        int dev = 0, cus = 0, per_cu = 0;
        if (hipGetDevice(&dev) != hipSuccess || hipDeviceGetAttribute(&cus, hipDeviceAttributeMultiprocessorCount, dev) != hipSuccess) { grid = -1; return; }
        if (hipFuncSetAttribute((const void*)fwd_kernel, hipFuncAttributeMaxDynamicSharedMemorySize, LDS_BYTES) != hipSuccess) { fprintf(stderr, "kernel_launch: hipFuncSetAttribute failed\n"); grid = -1; return; }
        if (hipOccupancyMaxActiveBlocksPerMultiprocessor(&per_cu, (const void*)fwd_kernel, NTHR, LDS_BYTES) != hipSuccess || per_cu < 1)
            fprintf(stderr, "kernel_launch: note: occupancy query reports %d\n", per_cu);
        (void)hipGetLastError();
        grid = cus;
    }
    if (grid < 0) return;
    (void)hipMemsetAsync((char*)d_ws + WS_CTL, 0, CTL_ZERO_BYTES, stream);
    Args a{};
    for (int i = 0; i < 21; ++i) a.in[i] = (const float*)d_in[i];
    a.out = (float*)d_out; a.ws = (unsigned char*)d_ws;
#if MK_N_LAUNCHES == 1
    a.ph_lo = 0; a.ph_hi = N_PHASES + 1; a.li = 0;
    hipLaunchKernelGGL(fwd_kernel, dim3(grid), dim3(NTHR), LDS_BYTES, stream, a);
#else
    for (int p = 0; p <= N_PHASES; ++p) {
        if ((PROBE_LAUNCH == 18 || PROBE_LAUNCH == 19 || PROBE_LAUNCH == 20) && p == 12) { a.ph_lo = 14; a.ph_hi = 15; hipLaunchKernelGGL(fwd_kernel, dim3(grid), dim3(NTHR), LDS_BYTES, stream, a); }
        a.ph_lo = p; a.ph_hi = p + 1; a.li = p; hipLaunchKernelGGL(fwd_kernel, dim3(grid), dim3(NTHR), LDS_BYTES, stream, a);
        if (p == PROBE_LAUNCH) hipLaunchKernelGGL(fwd_kernel, dim3(grid), dim3(NTHR), LDS_BYTES, stream, a);
        if (((PROBE_LAUNCH == 14 || PROBE_LAUNCH == 15) && p == 2) || ((PROBE_LAUNCH == 16 || PROBE_LAUNCH == 17) && p == 12)) { a.ph_lo = 14; a.ph_hi = 15; hipLaunchKernelGGL(fwd_kernel, dim3(grid), dim3(NTHR), LDS_BYTES, stream, a); } }
#endif
}
```

```cpp
#include <hip/hip_runtime.h>
#include <cstdio>
#include <cstdint>

#ifndef MK_N_LAUNCHES
#define MK_N_LAUNCHES 1
#endif
#define PROBE_LAUNCH -1
#ifndef PROBE_PHASE
#define PROBE_PHASE -1
#endif

#define LAS __attribute__((address_space(3)))
#define GAS __attribute__((address_space(1)))
typedef unsigned short bf16_t;
typedef short bf16x8 __attribute__((ext_vector_type(8)));
typedef short s16x4 __attribute__((ext_vector_type(4)));
typedef float f32x2 __attribute__((ext_vector_type(2)));
typedef float f32x4 __attribute__((ext_vector_type(4)));
typedef float f32x16 __attribute__((ext_vector_type(16)));
typedef unsigned u32x2 __attribute__((ext_vector_type(2)));
typedef unsigned u32x4 __attribute__((ext_vector_type(4)));
typedef __bf16 bf16x2_t __attribute__((ext_vector_type(2)));

constexpr int NB = 8, SEQ = 4096, DM = 1024, NTOK = NB * SEQ;
constexpr int PROJW = 9216, NEXP = 256, TOPK = 8, EH = 256;
constexpr float NORM_EPS = 1e-6f;

constexpr size_t MiB = 1u << 20;
constexpr size_t WS_CTL = 0, CTL_ZERO_BYTES = 1 * MiB;
constexpr size_t WS_MOD = 1 * MiB;
constexpr size_t WS_BTAB = 1 * MiB + 256 * 1024;
constexpr size_t WS_ROPE_C = 2 * MiB, WS_ROPE_S = 4 * MiB;
constexpr size_t WS_SS = 6 * MiB;
constexpr size_t WS_EIDX = 8 * MiB, WS_GATE = 9 * MiB;
constexpr size_t WS_ROWL = 10 * MiB;
constexpr size_t WS_TILE_E = 12 * MiB;
constexpr size_t WS_WIN = 16 * MiB, WS_WRU = 34 * MiB, WS_WAU = 36 * MiB, WS_WO = 38 * MiB, WS_WR = 40 * MiB;
constexpr size_t WS_H = 48 * MiB;
constexpr size_t WS_PROJ = 120 * MiB;
constexpr size_t SEG = 64 * MiB;
constexpr size_t WS_RQ = WS_PROJ, WS_RK = WS_PROJ + SEG, WS_RV = WS_PROJ + 2 * SEG, WS_RG = WS_PROJ + 3 * SEG, WS_AQ = WS_PROJ + 4 * SEG,
                 WS_AK = WS_PROJ + 5 * SEG, WS_AV = WS_PROJ + 6 * SEG, WS_SGR = WS_PROJ + 7 * SEG, WS_SGA = WS_PROJ + 8 * SEG;
constexpr size_t WS_OUTF = 696 * MiB, WS_OUTB = 760 * MiB, WS_OG = 824 * MiB, WS_LSE = 1016 * MiB;
constexpr size_t WS_RETN = WS_RQ, WS_ATTC = WS_RK, WS_YR = WS_RV, WS_MERGED = WS_AQ;
constexpr size_t WS_WGU = 120 * MiB, WS_WD = 377 * MiB, WS_HID = 512 * MiB, WS_LOGIT = 696 * MiB;
constexpr size_t WS_END = 1022 * MiB;
constexpr int YD_SPLIT = 262144, YD_SHARED0 = NTOK * TOPK;
constexpr float YD_SCALE = 16.0f, YD_INV = 0.0625f;
__device__ __forceinline__ unsigned char* ydense_row(unsigned char* ws, int row) { return ws + (row < YD_SPLIT ? 120 * MiB : 696 * MiB) + (size_t)(row < YD_SPLIT ? row : row - YD_SPLIT) * DM; }
__device__ __forceinline__ unsigned pk4_fp8(float a, float b, float c, float d) {
    a = __builtin_fminf(__builtin_fmaxf(a * YD_SCALE, -448.f), 448.f); b = __builtin_fminf(__builtin_fmaxf(b * YD_SCALE, -448.f), 448.f);
    c = __builtin_fminf(__builtin_fmaxf(c * YD_SCALE, -448.f), 448.f); d = __builtin_fminf(__builtin_fmaxf(d * YD_SCALE, -448.f), 448.f);
    int w = __builtin_amdgcn_cvt_pk_fp8_f32(a, b, 0, false); w = __builtin_amdgcn_cvt_pk_fp8_f32(c, d, w, true); return (unsigned)w;
}
constexpr size_t WS_DPOS = 13 * MiB;
constexpr int CW_TMO = 0, CW_BAR = 4096, CW_CNT = 16384, CW_FILL = 16384 + 1024;
constexpr int MAX_TILES = 2048;

__device__ __forceinline__ unsigned cvtpk(float lo, float hi) { f32x2 v = {lo, hi}; bf16x2_t b = __builtin_convertvector(v, bf16x2_t); return __builtin_bit_cast(unsigned, b); }
__device__ __forceinline__ float bf2f(unsigned short u) { return __uint_as_float((unsigned)u << 16); }
__device__ __forceinline__ float bflo(unsigned u) { return __uint_as_float(u << 16); }
__device__ __forceinline__ float bfhi(unsigned u) { return __uint_as_float(u & 0xffff0000u); }
__device__ __forceinline__ float wave_sum(float v) {
#pragma unroll
    for (int o = 1; o < 64; o <<= 1) v += __shfl_xor(v, o);
    return v;
}
__device__ __forceinline__ float sigmoidf_(float x) { return __builtin_amdgcn_rcpf(1.f + __builtin_amdgcn_exp2f(x * -1.4426950408889634f)); }
__device__ __forceinline__ float siluf_(float x) { return x * __builtin_amdgcn_rcpf(1.f + __builtin_amdgcn_exp2f(x * -1.4426950408889634f)); }

namespace pg8 {
constexpr int BM = 256, BK = 64, HALF = 128, HTB = HALF * BK * 2, STAGE_BYTES = 8 * HTB, NXCD = 8, WGM = 8;
__host__ __device__ __forceinline__ int lds_byte(int r, int c) { const int st = (r >> 4) * 2 + (c >> 5), rr = r & 15, cc = c & 31, ob = rr * 64 + cc * 2; return st * 1024 + (ob ^ (((ob >> 9) & 1) << 5)); }
__host__ __device__ __forceinline__ void stage_rc(int b, int& R, int& C) { const int st = b / 1024, sb = b % 1024, swz = sb ^ (((sb >> 9) & 1) << 5); R = (st >> 1) * 16 + swz / 64; C = (st & 1) * 32 + (swz % 64) / 2; }
__host__ __device__ __forceinline__ int perm32(int rho) { const int n = rho >> 4, i = rho & 15; return 8 * (i >> 2) + 4 * n + (i & 3); }

struct Unit { int pm, pn, e; };

__device__ __forceinline__ int xcd_remap(int L, int nwg) { const int q = nwg / NXCD, r = nwg % NXCD, xcd = L % NXCD, off = L / NXCD; return (xcd < r ? xcd * (q + 1) : r * (q + 1) + (xcd - r) * q) + off; }

struct StaticOrder {
    static constexpr bool GATHER = false, DUAL = false;
    const bf16_t* A; const bf16_t* Bt; int K;
    int nM, nN, nwg, G, c, pn_off;
    __device__ void init(const bf16_t* A_, const bf16_t* Bt_, int M, int N, int K_, int G_, int c_, int pn_off_ = 0) { A = A_; Bt = Bt_; K = K_; nM = M / BM; nN = N / BM; nwg = nM * nN; G = G_; c = c_; pn_off = pn_off_; }
    __device__ bool next(int i, Unit& u) const {
        const long L = (long)i * G + c; if (L >= nwg) return false;
        const int wgid = xcd_remap((int)L, nwg);
        const int nig = WGM * nN, gid = wgid / nig, fm = gid * WGM, gsz = (nM - fm) < WGM ? (nM - fm) : WGM;
        u.pm = fm + ((wgid % nig) % gsz); u.pn = (wgid % nig) / gsz + pn_off; u.e = 0; return true;
    }
    __device__ __forceinline__ const char* a_base(const Unit& u) const { return (const char*)A + (size_t)u.pm * (size_t)(BM * 2) * K; }
    __device__ __forceinline__ const char* b_base(const Unit& u) const { return (const char*)Bt + (size_t)u.pn * (size_t)(BM * 2) * K; }
    __device__ __forceinline__ unsigned a_row(const Unit&, int) const { return 0u; }
};

struct DualOrder {
    static constexpr bool GATHER = false, DUAL = true;
    StaticOrder so; const bf16_t* A1; const bf16_t* Bt1; int K;
    __device__ bool next(int i, Unit& u) const { if (!so.next(i >> 1, u)) return false; u.e = i & 1; return true; }
    __device__ __forceinline__ const char* a_base(const Unit& u) const { return (const char*)(u.e ? A1 : so.A) + (size_t)u.pm * (size_t)(BM * 2) * K; }
    __device__ __forceinline__ const char* b_base(const Unit& u) const { return (const char*)(u.e ? Bt1 : so.Bt) + (size_t)u.pn * (size_t)(BM * 2) * K; }
    __device__ __forceinline__ unsigned a_row(const Unit&, int) const { return 0u; }
};

template <bool GATHER_>
struct MoeOrder {
    static constexpr bool GATHER = GATHER_, DUAL = false;
    const bf16_t* A; const bf16_t* Bt; int K; size_t e_stride;
    const LAS unsigned short* tile_e; const int* rowlist; int ntiles, nN, nwg, G, c;
    __device__ bool next(int i, Unit& u) const {
        const long L = (long)i * G + c; if (L >= nwg) return false;
        const int wgid = xcd_remap((int)L, nwg);
        u.pm = wgid / nN; u.pn = wgid % nN; u.e = __builtin_amdgcn_readfirstlane((int)tile_e[u.pm]); return true;
    }
    __device__ __forceinline__ const char* a_base(const Unit& u) const { return GATHER ? (const char*)A : (const char*)A + (size_t)u.pm * (size_t)(BM * 2) * K; }
    __device__ __forceinline__ const char* b_base(const Unit& u) const { return (const char*)Bt + ((size_t)u.e * e_stride + (size_t)u.pn * BM * K) * 2; }
    __device__ __forceinline__ unsigned a_row(const Unit& u, int r) const { const int ent = rowlist[(size_t)u.pm * BM + r]; return ent < 0 ? (unsigned)NTOK : (unsigned)(ent >> 4); }
};

template <class Epi, class Sched, bool ALIGN_EPI>
__device__ __forceinline__ void gemm_phase(LAS unsigned char* lds, const Sched& S, const Epi& E) {
    const int tid = threadIdx.x, wid = __builtin_amdgcn_readfirstlane(tid >> 6), lane = tid & 63, wr = wid >> 2, wc = wid & 3, fr = lane & 15, fq = lane >> 4;
    const int K = S.K, nt = K / BK;
    unsigned voffA[2], voffB[2]; int RA[2]; unsigned CA2[2];
#pragma unroll
    for (int i = 0; i < 2; ++i) { int R, C; stage_rc(tid * 16 + i * 8192, R, C); const int Rb = Epi::PERM ? ((R & ~31) + perm32(R & 31)) : R;
        voffA[i] = (unsigned)(R * K + C) * 2u; voffB[i] = (unsigned)(Rb * K + C) * 2u; RA[i] = R; CA2[i] = (unsigned)C * 2u; }
    const size_t kstep = (size_t)(BK * 2);
    const size_t hstep = (size_t)HALF * K * 2;
    const unsigned ldsw = (unsigned)wid * 1024u;
    const int aoff = lds_byte(wr * 64 + fr, fq * 8), boff = lds_byte(wc * 32 + fr, fq * 8);
    unsigned gC[2][2], gN[2][2];
#define PG8_SA(b, h) (((b) * 2 + (h)) * HTB)
#define PG8_SB(b, h) ((4 + (b) * 2 + (h)) * HTB)
#define PG8_STAGE(bufoff, gbase, voff) do { _Pragma("unroll") for (int _i = 0; _i < 2; ++_i) \
        __builtin_amdgcn_global_load_lds((const unsigned*)((const char*)(gbase) + (voff)[_i]), (LAS unsigned*)(lds + (bufoff) + ldsw + _i * 8192), 16, 0, 0); } while (0)
#define PG8_STAGE_A(bufoff, p, h, NX) do { if constexpr (Sched::GATHER) { _Pragma("unroll") for (int _i = 0; _i < 2; ++_i) { const unsigned _v = (NX) ? gN[h][_i] : gC[h][_i]; \
        __builtin_amdgcn_global_load_lds((const unsigned*)((const char*)(p) + _v), (LAS unsigned*)(lds + (bufoff) + ldsw + _i * 8192), 16, 0, 0); } } \
        else { PG8_STAGE(bufoff, (p) + (h) * hstep, voffA); } } while (0)
#define PG8_GATHER_SET(g, u) do { _Pragma("unroll") for (int _h = 0; _h < 2; ++_h) _Pragma("unroll") for (int _i = 0; _i < 2; ++_i) \
        g[_h][_i] = S.a_row(u, _h * HALF + RA[_i]) * (unsigned)(K * 2) + CA2[_i]; } while (0)
#define PG8_LDA(dst, b, h) do { _Pragma("unroll") for (int m = 0; m < 4; ++m) _Pragma("unroll") for (int k = 0; k < 2; ++k) dst[m][k] = *(const LAS bf16x8*)(lds + PG8_SA(b, h) + aoff + m * 2048 + k * 1024); } while (0)
#define PG8_LDB(dst, b, h) do { _Pragma("unroll") for (int n = 0; n < 2; ++n) _Pragma("unroll") for (int k = 0; k < 2; ++k) dst[n][k] = *(const LAS bf16x8*)(lds + PG8_SB(b, h) + boff + n * 2048 + k * 1024); } while (0)
#define PG8_MMA(ai, bj, At, Bt) do { __builtin_amdgcn_s_setprio(1); _Pragma("unroll") for (int m = 0; m < 4; ++m) _Pragma("unroll") for (int n = 0; n < 2; ++n) _Pragma("unroll") for (int k = 0; k < 2; ++k) \
        acc[ai][bj][m][n] = __builtin_amdgcn_mfma_f32_16x16x32_bf16(Bt[n][k], At[m][k], acc[ai][bj][m][n], 0, 0, 0); __builtin_amdgcn_s_setprio(0); } while (0)
#define PG8_WAIT_V(n) asm volatile("s_waitcnt vmcnt(" #n ")" ::: "memory")
#define PG8_WAIT_L(n) asm volatile("s_waitcnt lgkmcnt(" #n ")" ::: "memory")
#define PG8_BAR __builtin_amdgcn_s_barrier()
#define PG8_SCHED __builtin_amdgcn_sched_barrier(0)
    Unit cur, nxt; int ui = 0;
    if (!S.next(0, cur)) return;
    f32x4 acc[2][2][4][2];
#pragma unroll
    for (int a = 0; a < 2; ++a)
#pragma unroll
        for (int b = 0; b < 2; ++b)
#pragma unroll
            for (int m = 0; m < 4; ++m)
#pragma unroll
                for (int n = 0; n < 2; ++n) acc[a][b][m][n] = (f32x4){0.f, 0.f, 0.f, 0.f};
    bf16x8 At[4][2], B0[2][2], B1[2][2];
    const char* cA = S.a_base(cur); const char* cB = S.b_base(cur);
    if constexpr (Sched::GATHER) { PG8_GATHER_SET(gC, cur); PG8_GATHER_SET(gN, cur); }
    PG8_STAGE(PG8_SB(0, 0), cB, voffB); PG8_STAGE(PG8_SB(0, 1), cB + hstep, voffB); PG8_STAGE_A(PG8_SA(0, 0), cA, 0, false); PG8_STAGE_A(PG8_SA(0, 1), cA, 1, false);
    if (wr == 1) PG8_BAR;
    PG8_WAIT_V(2); PG8_BAR;
    PG8_STAGE(PG8_SB(1, 0), cB + kstep, voffB); PG8_STAGE_A(PG8_SA(1, 0), cA + kstep, 0, false); PG8_STAGE(PG8_SB(1, 1), cB + hstep + kstep, voffB);
    PG8_WAIT_V(6); PG8_BAR;
    for (;;) {
        const bool has_next = S.next(ui + 1, nxt);
        const char* nA = has_next ? S.a_base(nxt) : cA; const char* nB = has_next ? S.b_base(nxt) : cB;
        if constexpr (Sched::GATHER) { if (has_next) { PG8_GATHER_SET(gN, nxt); } }
        for (int t = 0; t < nt; t += 2) {
            const bool last = (t == nt - 2);
            const char* a1 = cA + (size_t)(t + 1) * kstep;
            const char* a2 = last ? nA : cA + (size_t)(t + 2) * kstep; const char* b2 = last ? nB : cB + (size_t)(t + 2) * kstep;
            const char* a3 = a2 + kstep; const char* b3 = b2 + kstep;
            PG8_LDB(B0, 0, 0); PG8_LDB(B1, 0, 1); PG8_SCHED; PG8_LDA(At, 0, 0); PG8_STAGE_A(PG8_SA(1, 1), a1, 1, false);
            PG8_WAIT_V(8); PG8_WAIT_L(0); PG8_BAR; PG8_MMA(0, 0, At, B0); PG8_MMA(0, 1, At, B1); PG8_BAR; PG8_SCHED;
            PG8_LDA(At, 0, 1); PG8_STAGE(PG8_SB(0, 0), b2, voffB); PG8_STAGE(PG8_SB(0, 1), b2 + hstep, voffB); PG8_STAGE_A(PG8_SA(0, 0), a2, 0, last);
            PG8_WAIT_V(8); PG8_WAIT_L(0); PG8_BAR; PG8_MMA(1, 0, At, B0); PG8_MMA(1, 1, At, B1); PG8_BAR; PG8_SCHED;
            PG8_LDB(B0, 1, 0); PG8_LDB(B1, 1, 1); PG8_SCHED; PG8_LDA(At, 1, 0); PG8_STAGE_A(PG8_SA(0, 1), a2, 1, last);
            PG8_WAIT_V(8); PG8_WAIT_L(0); PG8_BAR; PG8_MMA(0, 0, At, B0); PG8_MMA(0, 1, At, B1); PG8_BAR; PG8_SCHED;
            PG8_LDA(At, 1, 1); PG8_STAGE(PG8_SB(1, 0), b3, voffB); PG8_STAGE(PG8_SB(1, 1), b3 + hstep, voffB); PG8_STAGE_A(PG8_SA(1, 0), a3, 0, last);
            PG8_WAIT_V(8); PG8_WAIT_L(0); PG8_BAR; PG8_MMA(1, 0, At, B0); PG8_MMA(1, 1, At, B1); PG8_BAR; PG8_SCHED;
        }
        if constexpr (ALIGN_EPI) { if (wr == 0) PG8_BAR; }
        E(acc, cur, wr, wc, fr, fq);
        if (!has_next) break;
        if (!(Sched::DUAL && cur.e == 0))
#pragma unroll
        for (int a = 0; a < 2; ++a)
#pragma unroll
            for (int b = 0; b < 2; ++b)
#pragma unroll
                for (int m = 0; m < 4; ++m)
#pragma unroll
                    for (int n = 0; n < 2; ++n) acc[a][b][m][n] = (f32x4){0.f, 0.f, 0.f, 0.f};
        cur = nxt; cA = nA; cB = nB; ++ui;
        if constexpr (Sched::GATHER) {
#pragma unroll
            for (int h = 0; h < 2; ++h)
#pragma unroll
                for (int i = 0; i < 2; ++i) gC[h][i] = gN[h][i];
        }
        if constexpr (ALIGN_EPI) { if (wr == 1) PG8_BAR; }
    }
    PG8_WAIT_V(0);
    if constexpr (!ALIGN_EPI) { if (wr == 0) PG8_BAR; }
    PG8_BAR;
#undef PG8_SA
#undef PG8_SB
#undef PG8_STAGE
#undef PG8_STAGE_A
#undef PG8_GATHER_SET
#undef PG8_LDA
#undef PG8_LDB
#undef PG8_MMA
#undef PG8_WAIT_V
#undef PG8_WAIT_L
#undef PG8_BAR
#undef PG8_SCHED
}
}

typedef GAS unsigned gu32;
#define RLX_AGENT __ATOMIC_RELAXED, __HIP_MEMORY_SCOPE_AGENT
#define XB_TMO      128
#define XB_XCNT(j)  (256  + 64 * (j))
#define XB_XSUB(j)  (1280 + 64 * (j))
#define XB_XGEN(j)  (2304 + 64 * (j))
#define XB_TOP      3328
#define XB_TOPGEN   3392
#define XCD_BAR_WORDS 3456
#define XB_SPIN_CAP (1u << 18)
__device__ __forceinline__ unsigned xb_ld(unsigned* p)              { return __hip_atomic_load(p, __ATOMIC_RELAXED, __HIP_MEMORY_SCOPE_AGENT); }
__device__ __forceinline__ unsigned xb_add(unsigned* p, unsigned v) { return __hip_atomic_fetch_add(p, v, __ATOMIC_RELAXED, __HIP_MEMORY_SCOPE_AGENT); }
__device__ __forceinline__ unsigned xb_xcc_id() { return (unsigned)__builtin_amdgcn_s_getreg((3 << 11) | 20) & 0xFu; }
#define XB_SPIN(cond, bar) do { unsigned _sp = 0; while (cond) { __builtin_amdgcn_s_sleep(1); \
    if ((++_sp & 255u) == 0u) { if (xb_ld(&(bar)[XB_TMO])) break; if (_sp > XB_SPIN_CAP) { atomicAdd(&(bar)[XB_TMO], 1u); break; } } } } while (0)
struct XcdBarrier { unsigned* bar; unsigned x; volatile LAS unsigned* st; };
__device__ __forceinline__ XcdBarrier xcd_barrier_post(unsigned* bar, volatile LAS unsigned* st) {
    XcdBarrier b; b.bar = bar; b.x = xb_xcc_id(); b.st = st;
    if (threadIdx.x == 0) (void)xb_add(&bar[XB_XCNT(b.x)], 1u);
    return b;
}
__device__ __forceinline__ void xcd_barrier_complete(unsigned* bar, unsigned x, unsigned& nloc, unsigned& nx) {
    const unsigned G = gridDim.x * gridDim.y * gridDim.z;
    unsigned sum, cnt, mine, sp = 0u;
    for (;;) {
        sum = 0u; cnt = 0u; mine = 0u;
#pragma unroll
        for (unsigned j = 0; j < 16; ++j) { const unsigned c = xb_ld(&bar[XB_XCNT(j)]); sum += c; cnt += (c > 0u) ? 1u : 0u; mine = (j == x) ? c : mine; }
        if (sum == G) break;
        __builtin_amdgcn_s_sleep(1);
        if ((++sp & 255u) == 0u) { if (xb_ld(&bar[XB_TMO])) break; if (sp > XB_SPIN_CAP) { atomicAdd(&bar[XB_TMO], 1u); break; } }
    }
    nloc = mine > 0u ? mine : 1u; nx = cnt > 0u ? cnt : 1u;
}
__device__ __forceinline__ void xcd_barrier(const XcdBarrier& b) {
    asm volatile("s_waitcnt vmcnt(0)" ::: "memory");
    __syncthreads();
    if (threadIdx.x == 0) {
        unsigned* bar = b.bar;
        __builtin_amdgcn_s_waitcnt(0);
        unsigned nloc = b.st[0], nx = b.st[1];
        if (nloc == 0u) { xcd_barrier_complete(bar, b.x, nloc, nx); b.st[0] = nloc; b.st[1] = nx; }
        const unsigned old = xb_add(&bar[XB_XSUB(b.x)], 1u);
        const unsigned gen = old / nloc;
        if (old + 1u == (gen + 1u) * nloc) {
            __builtin_amdgcn_fence(__ATOMIC_RELEASE, "agent");
            asm volatile("s_waitcnt vmcnt(0)" ::: "memory");
            const unsigned og = xb_add(&bar[XB_TOP], 1u);
            const unsigned tg = og / nx;
            if (og + 1u == (tg + 1u) * nx) xb_add(&bar[XB_TOPGEN], 1u);
            else XB_SPIN(xb_ld(&bar[XB_TOPGEN]) == tg, bar);
            __builtin_amdgcn_fence(__ATOMIC_ACQUIRE, "agent");
            xb_add(&bar[XB_XGEN(b.x)], 1u);
            asm volatile("s_waitcnt vmcnt(0)" ::: "memory");
        } else {
            XB_SPIN(xb_ld(&bar[XB_XGEN(b.x)]) == gen, bar);
            __builtin_amdgcn_fence(__ATOMIC_ACQUIRE, "agent");
            asm volatile("s_waitcnt vmcnt(0)" ::: "memory");
        }
    }
    __syncthreads();
}

constexpr int NWAVES = 8, NTHR = 512;
constexpr int LDS_BYTES = 147456, LDSCTL_OFF = LDS_BYTES - 1024, MISC_OFF = LDSCTL_OFF + 320;

struct Args { const float* in[21]; float* out; unsigned char* ws; int ph_lo, ph_hi, li, pad; };

struct Frame {
    LAS unsigned char* lds;
    unsigned char* ws;
    int tid, lane, wave, vcu, G;
};

struct EpiInProj {
    static constexpr bool PERM = true;
    unsigned char* ws; const float* rc; const float* rs;
    __device__ __forceinline__ void operator()(const f32x4 (&acc)[2][2][4][2], const pg8::Unit& u, int wr, int wc, int fr, int fq) const {
        const int seg = u.pn >> 2;
        bf16_t* O = (bf16_t*)(ws + WS_PROJ + (size_t)seg * SEG);
        const int colt = (u.pn & 3) * 256;
        const int row0 = u.pm * 256 + wr * 64 + fr;
        const int d = wc * 32 + 8 * fq;
#pragma unroll
        for (int ai = 0; ai < 2; ++ai)
#pragma unroll
            for (int m = 0; m < 4; ++m) {
                const int row = row0 + ai * 128 + m * 16;
                f32x4 v00 = acc[ai][0][m][0], v01 = acc[ai][0][m][1], v10 = acc[ai][1][m][0], v11 = acc[ai][1][m][1];
                if (seg <= 1) {
                    const int pos = row & (SEQ - 1);
                    const f32x4 c0 = *(const f32x4*)(rc + (size_t)pos * 128 + d), c1 = *(const f32x4*)(rc + (size_t)pos * 128 + d + 4);
                    const f32x4 s0 = *(const f32x4*)(rs + (size_t)pos * 128 + d), s1 = *(const f32x4*)(rs + (size_t)pos * 128 + d + 4);
                    const float sc = seg == 1 ? 0.0625f : 1.0f;
                    const f32x4 a0 = (v00 * c0 - v10 * s0) * sc, a1 = (v01 * c1 - v11 * s1) * sc, b0 = (v00 * s0 + v10 * c0) * sc, b1 = (v01 * s1 + v11 * c1) * sc;
                    v00 = a0; v01 = a1; v10 = b0; v11 = b1;
                } else if (seg == 3) {
#pragma unroll
                    for (int i = 0; i < 4; ++i) { v00[i] = siluf_(v00[i]); v01[i] = siluf_(v01[i]); v10[i] = siluf_(v10[i]); v11[i] = siluf_(v11[i]); }
                } else if (seg == 4) { const float q = 0.18033688011112042f; v00 = v00 * q; v01 = v01 * q; v10 = v10 * q; v11 = v11 * q; }
                else if (seg >= 7) {
#pragma unroll
                    for (int i = 0; i < 4; ++i) { v00[i] = sigmoidf_(v00[i]); v01[i] = sigmoidf_(v01[i]); v10[i] = sigmoidf_(v10[i]); v11[i] = sigmoidf_(v11[i]); }
                }
                u32x4 w0, w1; w0.x = cvtpk(v00[0], v00[1]); w0.y = cvtpk(v00[2], v00[3]); w0.z = cvtpk(v01[0], v01[1]); w0.w = cvtpk(v01[2], v01[3]);
                w1.x = cvtpk(v10[0], v10[1]); w1.y = cvtpk(v10[2], v10[3]); w1.z = cvtpk(v11[0], v11[1]); w1.w = cvtpk(v11[2], v11[3]);
                if (seg == 0) {
                    const int pos = row & (SEQ - 1), il = pos & 127;
                    bf16_t* blkp = O + ((((size_t)(row >> 12) * 4 + (u.pn & 3)) * 32 + (pos >> 7)) * 4 + (il >> 5)) * 8192 + (size_t)(((d >> 3) & 1) * 32 + (il & 31)) * 8;
                    *(u32x4*)(blkp + (d >> 4) * 512) = w0; *(u32x4*)(blkp + ((d >> 4) + 8) * 512) = w1;
                } else if (seg <= 2) { bf16_t* rowp = O + (size_t)row * DM + colt + d; *(u32x4*)rowp = w0; *(u32x4*)(rowp + 128) = w1; }
                else {
                    unsigned char* rowp = (unsigned char*)O + (size_t)row * DM + colt + d;
                    u32x2 f0, f1; f0.x = pk4_fp8(v00[0], v00[1], v00[2], v00[3]); f0.y = pk4_fp8(v01[0], v01[1], v01[2], v01[3]);
                    f1.x = pk4_fp8(v10[0], v10[1], v10[2], v10[3]); f1.y = pk4_fp8(v11[0], v11[1], v11[2], v11[3]);
                    *(u32x2*)rowp = f0; *(u32x2*)(rowp + 128) = f1; }
            }
    }
};
template <bool ADD> struct EpiGateBf16 {
    static constexpr bool PERM = true;
    bf16_t* O; const bf16_t* Gt; const bf16_t* P;
    __device__ __forceinline__ void operator()(const f32x4 (&acc)[2][2][4][2], const pg8::Unit& u, int wr, int wc, int fr, int fq) const {
        const int row0 = u.pm * 256 + wr * 64 + fr, col0 = u.pn * 256 + wc * 32 + 8 * fq;
#pragma unroll
        for (int ai = 0; ai < 2; ++ai)
#pragma unroll
            for (int m = 0; m < 4; ++m) {
                const size_t ro = (size_t)(row0 + ai * 128 + m * 16) * DM + col0;
#pragma unroll
                for (int bj = 0; bj < 2; ++bj) {
                    const u32x4 g = *(const u32x4*)(Gt + ro + bj * 128);
                    f32x4 v0 = acc[ai][bj][m][0], v1 = acc[ai][bj][m][1];
                    v0[0] *= bflo(g.x); v0[1] *= bfhi(g.x); v0[2] *= bflo(g.y); v0[3] *= bfhi(g.y);
                    v1[0] *= bflo(g.z); v1[1] *= bfhi(g.z); v1[2] *= bflo(g.w); v1[3] *= bfhi(g.w);
                    if (ADD) { const u32x4 p = *(const u32x4*)(P + ro + bj * 128);
                        v0[0] += bflo(p.x); v0[1] += bfhi(p.x); v0[2] += bflo(p.y); v0[3] += bfhi(p.y);
                        v1[0] += bflo(p.z); v1[1] += bfhi(p.z); v1[2] += bflo(p.w); v1[3] += bfhi(p.w); }
                    u32x4 w; w.x = cvtpk(v0[0], v0[1]); w.y = cvtpk(v0[2], v0[3]); w.z = cvtpk(v1[0], v1[1]); w.w = cvtpk(v1[2], v1[3]);
                    *(u32x4*)(O + ro + bj * 128) = w;
                }
            }
    }
};
struct EpiMerge {
    static constexpr bool PERM = true;
    bf16_t* O; const unsigned char* Gr; const unsigned char* Ga;
    __device__ __forceinline__ void operator()(f32x4 (&acc)[2][2][4][2], const pg8::Unit& u, int wr, int wc, int fr, int fq) const {
        const int row0 = u.pm * 256 + wr * 64 + fr, col0 = u.pn * 256 + wc * 32 + 8 * fq;
#pragma unroll
        for (int ai = 0; ai < 2; ++ai)
#pragma unroll
            for (int m = 0; m < 4; ++m) {
                const size_t ro = (size_t)(row0 + ai * 128 + m * 16) * DM + col0;
#pragma unroll
                for (int bj = 0; bj < 2; ++bj) {
                    const u32x2 ga = *(const u32x2*)(Ga + ro + bj * 128);
                    const f32x2 ga0 = __builtin_amdgcn_cvt_pk_f32_fp8((int)ga.x, false), ga1 = __builtin_amdgcn_cvt_pk_f32_fp8((int)ga.x, true), ga2 = __builtin_amdgcn_cvt_pk_f32_fp8((int)ga.y, false), ga3 = __builtin_amdgcn_cvt_pk_f32_fp8((int)ga.y, true);
                    f32x4 a0 = (f32x4){ga0.x, ga0.y, ga1.x, ga1.y} * YD_INV, a1 = (f32x4){ga2.x, ga2.y, ga3.x, ga3.y} * YD_INV;
                    if (u.e == 0) {
                        const u32x2 gr = *(const u32x2*)(Gr + ro + bj * 128);
                        const f32x2 gr0 = __builtin_amdgcn_cvt_pk_f32_fp8((int)gr.x, false), gr1 = __builtin_amdgcn_cvt_pk_f32_fp8((int)gr.x, true), gr2 = __builtin_amdgcn_cvt_pk_f32_fp8((int)gr.y, false), gr3 = __builtin_amdgcn_cvt_pk_f32_fp8((int)gr.y, true);
                        const f32x4 r0 = (f32x4){gr0.x, gr0.y, gr1.x, gr1.y} * YD_INV, r1 = (f32x4){gr2.x, gr2.y, gr3.x, gr3.y} * YD_INV;
#pragma unroll
                        for (int i = 0; i < 4; ++i) { acc[ai][bj][m][0][i] *= r0[i] * __builtin_amdgcn_rcpf(fmaxf(a0[i], 1e-30f)); acc[ai][bj][m][1][i] *= r1[i] * __builtin_amdgcn_rcpf(fmaxf(a1[i], 1e-30f)); }
                    } else {
                        const f32x4 v0 = acc[ai][bj][m][0] * a0, v1 = acc[ai][bj][m][1] * a1;
                        u32x4 w; w.x = cvtpk(v0[0], v0[1]); w.y = cvtpk(v0[2], v0[3]); w.z = cvtpk(v1[0], v1[1]); w.w = cvtpk(v1[2], v1[3]);
                        *(u32x4*)(O + ro + bj * 128) = w;
                    }
                }
            }
    }
};
struct EpiOProj {
    static constexpr bool PERM = false;
    const float* x; float* x1; const float* mod; float* ss;
    __device__ __forceinline__ void operator()(const f32x4 (&acc)[2][2][4][2], const pg8::Unit& u, int wr, int wc, int fr, int fq) const {
        const int row0 = u.pm * 256 + wr * 64 + fr, col0 = u.pn * 256 + wc * 32 + 4 * fq;
        const int b = (u.pm * 256) / SEQ;
        f32x4 gm[2][2];
#pragma unroll
        for (int bj = 0; bj < 2; ++bj)
#pragma unroll
            for (int n = 0; n < 2; ++n) gm[bj][n] = *(const f32x4*)(mod + (size_t)b * 6144 + 2 * DM + col0 + bj * 128 + n * 16);
#pragma unroll
        for (int ai = 0; ai < 2; ++ai)
#pragma unroll
            for (int m = 0; m < 4; ++m) {
                const int row = row0 + ai * 128 + m * 16;
                const size_t ro = (size_t)row * DM + col0; float sq = 0.f;
#pragma unroll
                for (int bj = 0; bj < 2; ++bj)
#pragma unroll
                    for (int n = 0; n < 2; ++n) { const f32x4 xv = *(const f32x4*)(x + ro + bj * 128 + n * 16);
                        const f32x4 o = xv + gm[bj][n] * acc[ai][bj][m][n]; *(f32x4*)(x1 + ro + bj * 128 + n * 16) = o;
                        sq += (o[0] * o[0] + o[1] * o[1]) + (o[2] * o[2] + o[3] * o[3]); }
                sq += __shfl_xor(sq, 16); sq += __shfl_xor(sq, 32);
                if (fq == 0) ss[(size_t)row * 16 + u.pn * 4 + wc] = sq;
            }
    }
};
struct EpiF32 {
    static constexpr bool PERM = false;
    float* C; int ldc;
    __device__ __forceinline__ void operator()(const f32x4 (&acc)[2][2][4][2], const pg8::Unit& u, int wr, int wc, int fr, int fq) const {
        const int row0 = u.pm * 256 + wr * 64 + fr, col0 = u.pn * 256 + wc * 32 + 4 * fq;
#pragma unroll
        for (int ai = 0; ai < 2; ++ai)
#pragma unroll
            for (int m = 0; m < 4; ++m) { float* rowp = C + (size_t)(row0 + ai * 128 + m * 16) * ldc + col0;
#pragma unroll
                for (int bj = 0; bj < 2; ++bj)
#pragma unroll
                    for (int n = 0; n < 2; ++n) *(f32x4*)(rowp + bj * 128 + n * 16) = acc[ai][bj][m][n]; }
    }
};
struct EpiPlainScratch {
    static constexpr bool PERM = true;
    bf16_t* O;
    __device__ __forceinline__ void operator()(const f32x4 (&acc)[2][2][4][2], const pg8::Unit& u, int wr, int wc, int fr, int fq) const {
        const int row0 = u.pm * 256 + wr * 64 + fr, col0 = (u.pn & 3) * 256 + wc * 32 + 8 * fq;
#pragma unroll
        for (int ai = 0; ai < 2; ++ai)
#pragma unroll
            for (int m = 0; m < 4; ++m) { bf16_t* rowp = O + (size_t)(row0 + ai * 128 + m * 16) * DM + col0;
#pragma unroll
                for (int bj = 0; bj < 2; ++bj) { const f32x4 v0 = acc[ai][bj][m][0], v1 = acc[ai][bj][m][1];
                    u32x4 w; w.x = cvtpk(v0[0], v0[1]); w.y = cvtpk(v0[2], v0[3]); w.z = cvtpk(v1[0], v1[1]); w.w = cvtpk(v1[2], v1[3]); *(u32x4*)(rowp + bj * 128) = w; } }
    }
};
struct EpiNull {
    static constexpr bool PERM = false;
    __device__ __forceinline__ void operator()(const f32x4 (&acc)[2][2][4][2], const pg8::Unit&, int, int, int, int) const {
#pragma unroll
        for (int ai = 0; ai < 2; ++ai)
#pragma unroll
            for (int bj = 0; bj < 2; ++bj)
#pragma unroll
                for (int m = 0; m < 4; ++m)
#pragma unroll
                    for (int n = 0; n < 2; ++n) asm volatile("" :: "v"(acc[ai][bj][m][n]));
    }
};
struct EpiGU {
    static constexpr bool PERM = true;
    bf16_t* hid;
    __device__ __forceinline__ void operator()(const f32x4 (&acc)[2][2][4][2], const pg8::Unit& u, int wr, int wc, int fr, int fq) const {
        const int row0 = u.pm * 256 + wr * 64 + fr, col0 = u.pn * 128 + wc * 32 + 8 * fq;
#pragma unroll
        for (int ai = 0; ai < 2; ++ai)
#pragma unroll
            for (int m = 0; m < 4; ++m) { bf16_t* rowp = hid + (size_t)(row0 + ai * 128 + m * 16) * EH + col0;
                f32x4 h0, h1;
#pragma unroll
                for (int i = 0; i < 4; ++i) { h0[i] = siluf_(acc[ai][0][m][0][i]) * acc[ai][1][m][0][i]; h1[i] = siluf_(acc[ai][0][m][1][i]) * acc[ai][1][m][1][i]; }
                u32x4 w; w.x = cvtpk(h0[0], h0[1]); w.y = cvtpk(h0[2], h0[3]); w.z = cvtpk(h1[0], h1[1]); w.w = cvtpk(h1[2], h1[3]); *(u32x4*)rowp = w; }
    }
};
template <int MODE> struct EpiDownT {
    static constexpr bool PERM = true;
    unsigned char* ws; const LAS int* exp_info;
    __device__ __forceinline__ void operator()(const f32x4 (&acc)[2][2][4][2], const pg8::Unit& u, int wr, int wc, int fr, int fq) const {
        const int shift = __builtin_amdgcn_readfirstlane(exp_info[u.e]), lim = __builtin_amdgcn_readfirstlane(exp_info[512 + u.e]);
        const int row0 = u.pm * 256 + wr * 64 + fr, col0 = u.pn * 256 + wc * 32 + 8 * fq;
#pragma unroll
        for (int ai = 0; ai < 2; ++ai)
#pragma unroll
            for (int m = 0; m < 4; ++m) {
                const int pos = row0 + ai * 128 + m * 16;
                if (pos < lim) {
                    unsigned char* rowp = (MODE == 1 ? ws + WS_SS + (size_t)blockIdx.x * 2048 : ydense_row(ws, pos - shift)) + col0;
#pragma unroll
                    for (int bj = 0; bj < 2; ++bj) { const f32x4 v0 = acc[ai][bj][m][0], v1 = acc[ai][bj][m][1];
                        u32x2 w; w.x = pk4_fp8(v0[0], v0[1], v0[2], v0[3]); w.y = pk4_fp8(v1[0], v1[1], v1[2], v1[3]);
                        *(u32x2*)(rowp + bj * 128) = w; }
                }
            }
    }
};
typedef EpiDownT<0> EpiDown;

__device__ __forceinline__ void transpose_item(const float* W, int N, int K, int k0, int n0, bf16_t* WT, int drow0, LAS float* scr, int lane) {
#pragma unroll 8
    for (int i = 0; i < 32; ++i) { const int kk = 2 * i + (lane >> 5); scr[kk * 33 + (lane & 31)] = W[(size_t)(k0 + kk) * N + n0 + (lane & 31)]; }
    asm volatile("s_waitcnt lgkmcnt(0)" ::: "memory");
    const int c = lane & 7;
#pragma unroll
    for (int j = 0; j < 4; ++j) { const int n = (lane >> 3) + 8 * j; const LAS float* s = scr + (8 * c) * 33 + n;
        u32x4 o; o.x = cvtpk(s[0 * 33], s[1 * 33]); o.y = cvtpk(s[2 * 33], s[3 * 33]); o.z = cvtpk(s[4 * 33], s[5 * 33]); o.w = cvtpk(s[6 * 33], s[7 * 33]);
        *(u32x4*)(WT + (size_t)(drow0 + n) * K + k0 + 8 * c) = o; }
    asm volatile("s_waitcnt lgkmcnt(0)" ::: "memory");
}
__device__ __forceinline__ void transpose_plain(const float* W, int K, int N, bf16_t* WT, LAS float* scr, int item, int lane) {
    const int nblk = N / 32, kb = item / nblk, nb = item % nblk;
    transpose_item(W, N, K, 64 * kb, 32 * nb, WT, 32 * nb, scr, lane);
}

__device__ __forceinline__ int t5_bucket(int rel) {
    const int n = rel < 0 ? -rel : rel;
    int large = 8 + (int)(logf((float)(n > 1 ? n : 1) / 8.0f) / 4.852030263919617f * 8.0f);
    large = large < 15 ? large : 15;
    return (rel > 0 ? 16 : 0) + (n < 8 ? n : large);
}

__device__ __forceinline__ void phase0(Frame& F, const Args& a) {
    const float* c = a.in[1]; const float* w_ada = a.in[2]; const float* b_ada = a.in[3];
    {
        LAS float* cond = (LAS float*)F.lds;
        LAS float* red = (LAS float*)(F.lds + 32768);
        for (int i = F.tid; i < NB * DM; i += NTHR) cond[i] = siluf_(c[i]);
        __syncthreads();
        for (int cg = F.vcu; cg < 256; cg += F.G) {
            const int j = F.tid & 31, kg = F.tid >> 5;
            float s[NB];
#pragma unroll
            for (int b = 0; b < NB; ++b) s[b] = 0.f;
            if (j < 24) {
                for (int k = kg; k < DM; k += 16) { const float w = w_ada[(size_t)k * 6144 + cg * 24 + j];
#pragma unroll
                    for (int b = 0; b < NB; ++b) s[b] += cond[b * DM + k] * w; }
            }
#pragma unroll
            for (int b = 0; b < NB; ++b) red[(kg * NB + b) * 32 + j] = s[b];
            __syncthreads();
            if (F.tid < 192) { const int b = F.tid / 24, jj = F.tid % 24; float t = 0.f;
                for (int g = 0; g < 16; ++g) t += red[(g * NB + b) * 32 + jj];
                ((float*)(F.ws + WS_MOD))[b * 6144 + cg * 24 + jj] = t + b_ada[cg * 24 + jj]; }
            __syncthreads();
        }
    }
    const int gt = F.vcu * NTHR + F.tid, NGT = F.G * NTHR;
    {
        float* rc = (float*)(F.ws + WS_ROPE_C); float* rs = (float*)(F.ws + WS_ROPE_S);
        for (int i = gt; i < SEQ * 128; i += NGT) { const int pos = i >> 7, d = i & 127;
            const float inv = (float)pow(10000.0, -(double)d / 128.0); const float ang = (float)pos * inv;
            rc[i] = (float)cos((double)ang); rs[i] = (float)sin((double)ang); }
    }
    {
        const float* t5 = a.in[7]; float* bt = (float*)(F.ws + WS_BTAB);
        for (int i = gt; i < 3 * 16 * 160; i += NGT) { const int g = i / (16 * 160), h = (i / 160) % 16, j = i % 160;
            const int dil = g == 0 ? 1 : (g == 1 ? 4 : 16);
            bt[i] = j <= 128 ? t5[t5_bucket((j - 64) * dil) * 16 + h] * 1.4426950408889634f : 0.f; }
    }
    { unsigned* z = (unsigned*)(F.ws + WS_H + (size_t)NTOK * DM * 2); for (int i = gt; i < DM / 2; i += NGT) z[i] = 0u; }
    {
        LAS float* scr = (LAS float*)(F.lds + 49152 + F.wave * 8704);
        const int gw = F.vcu * NWAVES + F.wave, NGW = F.G * NWAVES;
        constexpr int I_IN = (DM / 64) * (PROJW / 32), I_SQ = (DM / 64) * (DM / 32), I_R = (DM / 64) * (NEXP / 32);
        constexpr int NITEMS = I_IN + 3 * I_SQ + I_R;
        for (int it = gw; it < NITEMS; it += NGW) {
            int r = it;
            if (r < I_IN) { transpose_plain(a.in[5], DM, PROJW, (bf16_t*)(F.ws + WS_WIN), scr, r, F.lane); continue; } r -= I_IN;
            if (r < I_SQ) { transpose_plain(a.in[8], DM, DM, (bf16_t*)(F.ws + WS_WRU), scr, r, F.lane); continue; } r -= I_SQ;
            if (r < I_SQ) { transpose_plain(a.in[9], DM, DM, (bf16_t*)(F.ws + WS_WAU), scr, r, F.lane); continue; } r -= I_SQ;
            if (r < I_SQ) { transpose_plain(a.in[10], DM, DM, (bf16_t*)(F.ws + WS_WO), scr, r, F.lane); continue; } r -= I_SQ;
            transpose_plain(a.in[12], DM, NEXP, (bf16_t*)(F.ws + WS_WR), scr, r, F.lane);
        }
    }
}

struct TrItem { const float* src; bf16_t* dst; int N, K; };
__device__ __forceinline__ TrItem moe_item(const Args& a, unsigned char* ws, int it) {
    constexpr int PER_E = 256;
    const int e = it / PER_E, r = it % PER_E, kind = r >> 7, q = r & 127;
    TrItem t;
    if (kind < 2) {
        const float* W = e < 256 ? a.in[kind == 0 ? 14 : 15] + (size_t)e * 1024 * 256 : a.in[kind == 0 ? 17 : 18];
        const int kb = q >> 3, n0 = 32 * (q & 7);
        t.src = W + (size_t)(64 * kb) * 256 + n0; t.N = 256; t.K = 1024;
        t.dst = (bf16_t*)(ws + WS_WGU) + (size_t)e * 512 * 1024 + (size_t)((n0 >> 7) * 256 + kind * 128 + (n0 & 127)) * 1024 + 64 * kb;
    } else {
        const float* W = e < 256 ? a.in[16] + (size_t)e * 256 * 1024 : a.in[19];
        const int kb = q >> 5, n0 = 32 * (q & 31);
        t.src = W + (size_t)(64 * kb) * 1024 + n0; t.N = 1024; t.K = 256;
        t.dst = (bf16_t*)(ws + WS_WD) + (size_t)e * 1024 * 256 + (size_t)n0 * 256 + 64 * kb;
    }
    return t;
}
__device__ __forceinline__ void tr_load(const TrItem& t, float (&v)[32], int lane) {
    const float* p = t.src + (size_t)(lane >> 5) * t.N + (lane & 31);
#pragma unroll
    for (int i = 0; i < 32; ++i) v[i] = __builtin_nontemporal_load(p + (size_t)(2 * i) * t.N);
}
__device__ __forceinline__ void tr_store(const TrItem& t, const float (&v)[32], LAS float* scr, int lane) {
#pragma unroll
    for (int i = 0; i < 32; ++i) scr[(2 * i + (lane >> 5)) * 33 + (lane & 31)] = v[i];
    asm volatile("s_waitcnt lgkmcnt(0)" ::: "memory");
    const int c = lane & 7;
#pragma unroll
    for (int j = 0; j < 4; ++j) { const int n = (lane >> 3) + 8 * j; const LAS float* s = scr + (8 * c) * 33 + n;
        u32x4 o; o.x = cvtpk(s[0 * 33], s[1 * 33]); o.y = cvtpk(s[2 * 33], s[3 * 33]); o.z = cvtpk(s[4 * 33], s[5 * 33]); o.w = cvtpk(s[6 * 33], s[7 * 33]);
        *(u32x4*)(t.dst + (size_t)n * t.K + 8 * c) = o; }
    asm volatile("s_waitcnt lgkmcnt(0)" ::: "memory");
}
constexpr int CW_CONVQ = 16384 + 2048;
__device__ __forceinline__ void moe_weight_convert(Frame& F, const Args& a) {
    LAS float* scr = (LAS float*)(F.lds + F.wave * 8704);
    const int total = 257 * 256, nchunks = total / 8;
    unsigned* q = (unsigned*)(F.ws + WS_CTL) + CW_CONVQ;
    float v0[32], v1[32];
    for (;;) {
        unsigned ck = 0;
        if (F.lane == 0) ck = __hip_atomic_fetch_add(q, 1u, __ATOMIC_RELAXED, __HIP_MEMORY_SCOPE_AGENT);
        ck = __builtin_amdgcn_readfirstlane(ck);
        if ((int)ck >= nchunks) break;
        const int it0 = (int)ck * 8;
        TrItem t0 = moe_item(a, F.ws, it0), t1 = t0;
        tr_load(t0, v0, F.lane);
#pragma unroll 1
        for (int k = 0; k < 8; k += 2) {
            t1 = moe_item(a, F.ws, it0 + k + 1); tr_load(t1, v1, F.lane);
            tr_store(t0, v0, scr, F.lane);
            if (k + 2 < 8) { t0 = moe_item(a, F.ws, it0 + k + 2); tr_load(t0, v0, F.lane); }
            tr_store(t1, v1, scr, F.lane);
        }
    }
}

__device__ __forceinline__ void norm_mod_rows(Frame& F, const float* x, const float* norm, const float* mod, int shift_off, int scale_off, const float* ssp, bf16_t* out) {
    const int gw = F.vcu * NWAVES + F.wave, NGW = F.G * NWAVES;
    f32x4 g4[4];
#pragma unroll
    for (int j = 0; j < 4; ++j) g4[j] = *(const f32x4*)(norm + 4 * F.lane + 256 * j);
    f32x4 v[4], vn[4]; float p = 0.f, pn = 0.f;
    int row = gw;
    if (row < NTOK) { const f32x4* xr = (const f32x4*)(x + (size_t)row * DM) + F.lane;
#pragma unroll
        for (int j = 0; j < 4; ++j) v[j] = xr[64 * j];
        if (ssp) p = F.lane < 16 ? ssp[(size_t)row * 16 + F.lane] : 0.f; }
#pragma unroll 1
    for (; row < NTOK; row += NGW) {
        const int nrow = row + NGW < NTOK ? row + NGW : row;
        { const f32x4* xr = (const f32x4*)(x + (size_t)nrow * DM) + F.lane;
#pragma unroll
          for (int j = 0; j < 4; ++j) vn[j] = xr[64 * j];
          if (ssp) pn = F.lane < 16 ? ssp[(size_t)nrow * 16 + F.lane] : 0.f; }
        const int b = row / SEQ;
        float s = 0.f;
#pragma unroll
        for (int j = 0; j < 4; ++j) s += (v[j][0] * v[j][0] + v[j][1] * v[j][1]) + (v[j][2] * v[j][2] + v[j][3] * v[j][3]);
        const float tot = wave_sum(ssp ? p : s);
        const float rstd = rsqrtf(tot * (1.f / DM) + NORM_EPS);
        u32x2* o8 = (u32x2*)(out + (size_t)row * DM) + F.lane;
#pragma unroll
        for (int j = 0; j < 4; ++j) {
            const int col = 4 * F.lane + 256 * j;
            const f32x4 sc = *(const f32x4*)(mod + (size_t)b * 6144 + scale_off + col), sh = *(const f32x4*)(mod + (size_t)b * 6144 + shift_off + col);
            const f32x4 y = (v[j] * rstd) * g4[j] * (sc + 1.0f) + sh;
            u32x2 w; w.x = cvtpk(y[0], y[1]); w.y = cvtpk(y[2], y[3]); o8[64 * j] = w;
        }
#pragma unroll
        for (int j = 0; j < 4; ++j) v[j] = vn[j];
        p = pn;
    }
}

__device__ __forceinline__ unsigned off_b(unsigned row, unsigned ch) { return 256u * row + 16u * (ch ^ (((row & 3) << 2) | ((row >> 2) & 3))); }
__device__ __forceinline__ int crow(int reg, int h) { return (reg & 3) + 8 * (reg >> 2) + 4 * h; }
__device__ __forceinline__ s16x4 tr_read(LAS unsigned char* p) { return __builtin_bit_cast(s16x4, __builtin_amdgcn_ds_read_tr16_b64_v4i16((LAS s16x4*)p)); }
__device__ __forceinline__ bf16x8 pack8(const f32x16& x, int s) {
    u32x4 p; p.x = cvtpk(x[8 * s], x[8 * s + 1]); p.y = cvtpk(x[8 * s + 2], x[8 * s + 3]); p.z = cvtpk(x[8 * s + 4], x[8 * s + 5]); p.w = cvtpk(x[8 * s + 6], x[8 * s + 7]);
    return __builtin_bit_cast(bf16x8, p);
}
#define MFMA32(a, b, c) __builtin_amdgcn_mfma_f32_32x32x16_bf16((a), (b), (c), 0, 0, 0)

constexpr int RK_STR = 528, RV_STR = 192;
constexpr int RL_K = 0, RL_V = 128 * RK_STR, RL_S = RL_V + 128 * RV_STR, RL_P = RL_S + 64 * RK_STR, RL_END = RL_P + 10 * 2048;
__device__ __forceinline__ void retention_chain(Frame& F, const Args& a, int chain) {
    const int b = chain >> 5, h = (chain >> 3) & 3, dir = (chain >> 2) & 1, es = chain & 3;
    const int lane = F.lane, r = lane & 31, hh = lane >> 5, w = F.wave, ib = w >> 1, eb = w & 1;
    const bf16_t* RQ = (const bf16_t*)(F.ws + WS_RQ); const bf16_t* RK = (const bf16_t*)(F.ws + WS_RK); const bf16_t* RV = (const bf16_t*)(F.ws + WS_RV);
    bf16_t* OUT = (bf16_t*)(F.ws + (dir ? WS_OUTB : WS_OUTF));
    const float lg = log1pf(-__expf(a.in[6][dir * 4 + h]));
    const float decayC = __expf(lg * 128.f);
    LAS unsigned char* lds = F.lds;
    f32x16 st0, st1;
#pragma unroll
    for (int i = 0; i < 16; ++i) { st0[i] = 0.f; st1[i] = 0.f; }
    for (int i = F.tid; i < (64 * RK_STR) / 16; i += NTHR) *(LAS u32x4*)(lds + RL_S + i * 16) = (u32x4){0u, 0u, 0u, 0u};
    const int vj = F.tid >> 2, ve0 = (F.tid & 3) * 16;
    const float vscale = __expf(lg * (dir == 0 ? (float)(127 - vj) : (float)vj));
    const int blk = (lane >> 4) & 1, q4 = (lane & 15) >> 2, p4 = lane & 3;
    LAS unsigned char* kbase = lds + RL_K + r * RK_STR + 16 * hh;
    LAS unsigned char* sbase = lds + RL_S + (eb * 32 + r) * RK_STR + 16 * hh;
    LAS unsigned char* vtr = lds + RL_V + (4 * hh + q4) * RV_STR + (eb * 32 + 16 * blk + 4 * p4) * 2;
    LAS unsigned char* ktr = lds + RL_K + (4 * hh + q4) * RK_STR + ((w >> 1) * 64 + 16 * blk + 4 * p4) * 2;
    LAS unsigned char* spub = lds + RL_S + (eb * 32 + r) * RK_STR + ((w >> 1) * 64 + 4 * hh) * 2;
    const float rsc = __expf(lg * (dir == 0 ? (float)(ib * 32 + r - 127) : (float)(-(ib * 32 + r))));
    const char* RKb = (const char*)RK + (size_t)h * 512; const char* RVb = (const char*)RV + (size_t)(h * 256 + es * 64) * 2; const char* RQb = (const char*)RQ + ((size_t)((b * 4 + h) * 32) * 4 + ib) * 16384;
    char* OUTb = (char*)OUT + (size_t)(ib * 32 * DM + h * 256 + es * 64 + eb * 32) * 2;
    const unsigned klo = (unsigned)(((F.tid >> 5) * DM + (F.tid & 31) * 8) * 2), vlo = (unsigned)((vj * DM + ve0) * 2), qlo = (unsigned)(lane * 16), olo = (unsigned)((r * DM + 4 * hh) * 2);
    u32x4 kpre[8]; u32x4 vpre[2]; bf16x8 qf[16];
    {
        const size_t t0 = (size_t)b * SEQ + (size_t)(dir == 0 ? 0 : 31) * 128;
        const char* kc = RKb + t0 * (DM * 2); const char* vc = RVb + t0 * (DM * 2); const char* qc = RQb + (size_t)(dir == 0 ? 0 : 31) * 65536;
#pragma unroll
        for (int i = 0; i < 8; ++i) kpre[i] = *(const u32x4*)(kc + (size_t)i * (16 * DM * 2) + klo);
        vpre[0] = *(const u32x4*)(vc + vlo); vpre[1] = *(const u32x4*)(vc + vlo + 16);
#pragma unroll
        for (int s = 0; s < 16; ++s) qf[s] = *(const bf16x8*)(qc + qlo + 1024 * s);
    }
#pragma unroll 1
    for (int n = 0; n < 32; ++n) {
        const int cidx = dir == 0 ? n : 31 - n;
        const size_t t0 = (size_t)b * SEQ + (size_t)cidx * 128;
        {
            LAS unsigned char* kw = lds + RL_K + (F.tid >> 5) * RK_STR + (F.tid & 31) * 16;
#pragma unroll
            for (int i = 0; i < 8; ++i) *(LAS u32x4*)(kw + i * 16 * RK_STR) = kpre[i];
#pragma unroll
            for (int i = 0; i < 2; ++i) {
                u32x4 o; o.x = cvtpk(bflo(vpre[i].x) * vscale, bfhi(vpre[i].x) * vscale); o.y = cvtpk(bflo(vpre[i].y) * vscale, bfhi(vpre[i].y) * vscale);
                o.z = cvtpk(bflo(vpre[i].z) * vscale, bfhi(vpre[i].z) * vscale); o.w = cvtpk(bflo(vpre[i].w) * vscale, bfhi(vpre[i].w) * vscale);
                *(LAS u32x4*)(lds + RL_V + vj * RV_STR + ve0 * 2 + 16 * i) = o;
            }
        }
        __syncthreads();
        {
            const int nn = n + 1 < 32 ? n + 1 : n; const int cn = dir == 0 ? nn : 31 - nn;
            const size_t t1 = (size_t)b * SEQ + (size_t)cn * 128;
            const char* kc = RKb + t1 * (DM * 2); const char* vc = RVb + t1 * (DM * 2);
#pragma unroll
            for (int i = 0; i < 8; ++i) kpre[i] = *(const u32x4*)(kc + (size_t)i * (16 * DM * 2) + klo);
            vpre[0] = *(const u32x4*)(vc + vlo); vpre[1] = *(const u32x4*)(vc + vlo + 16);
        }
        const int jb_lo = dir == 0 ? 0 : ib, jb_hi = dir == 0 ? ib : 3;
#pragma unroll 1
        for (int jb = jb_lo + ((jb_lo ^ eb) & 1); jb <= jb_hi; jb += 2) {
            LAS unsigned char* kb = kbase + jb * (32 * RK_STR);
            f32x16 sT;
#pragma unroll
            for (int i = 0; i < 16; ++i) sT[i] = 0.f;
#pragma unroll
            for (int hb = 0; hb < 2; ++hb) {
                bf16x8 kf[8];
#pragma unroll
                for (int s = 0; s < 8; ++s) kf[s] = *(const LAS bf16x8*)(kb + (hb * 8 + s) * 32);
                __builtin_amdgcn_sched_barrier(0);
#pragma unroll
                for (int s = 0; s < 8; ++s) sT = MFMA32(kf[s], qf[hb * 8 + s], sT);
                __builtin_amdgcn_sched_barrier(0);
            }
            if (jb == ib) {
#pragma unroll
                for (int i = 0; i < 16; ++i) { const int jl = crow(i, hh); const bool keep = dir == 0 ? (jl <= r) : (jl > r); sT[i] = keep ? sT[i] : 0.f; }
            }
            const int ibr = dir == 0 ? ib : 3 - ib, jbr = dir == 0 ? jb : 3 - jb;
            LAS unsigned char* pw = lds + RL_P + ((ibr * (ibr + 1)) / 2 + jbr) * 2048 + lane * 16;
            *(LAS bf16x8*)pw = pack8(sT, 0); *(LAS bf16x8*)(pw + 1024) = pack8(sT, 1);
        }
        __syncthreads();
        f32x16 acc;
#pragma unroll
        for (int i = 0; i < 16; ++i) acc[i] = 0.f;
#pragma unroll 1
        for (int jb = jb_lo; jb <= jb_hi; ++jb) {
            const int ibr = dir == 0 ? ib : 3 - ib, jbr = dir == 0 ? jb : 3 - jb;
            const LAS unsigned char* pr = lds + RL_P + ((ibr * (ibr + 1)) / 2 + jbr) * 2048 + lane * 16;
            LAS unsigned char* vb = vtr + jb * (32 * RV_STR);
#pragma unroll
            for (int s2 = 0; s2 < 2; ++s2) {
                const s16x4 lo = tr_read(vb + s2 * (16 * RV_STR)), hi = tr_read(vb + s2 * (16 * RV_STR) + 8 * RV_STR);
                acc = MFMA32(__builtin_shufflevector(lo, hi, 0, 1, 2, 3, 4, 5, 6, 7), *(const LAS bf16x8*)(pr + s2 * 1024), acc);
            }
        }
#pragma unroll
        for (int hb = 0; hb < 2; ++hb) {
            bf16x8 sf[8];
#pragma unroll
            for (int s = 0; s < 8; ++s) sf[s] = *(const LAS bf16x8*)(sbase + (hb * 8 + s) * 32);
            __builtin_amdgcn_sched_barrier(0);
#pragma unroll
            for (int s = 0; s < 8; ++s) acc = MFMA32(sf[s], qf[hb * 8 + s], acc);
            __builtin_amdgcn_sched_barrier(0);
        }
        u32x2 ow[4];
#pragma unroll
        for (int g = 0; g < 4; ++g) { ow[g].x = cvtpk(acc[4 * g] * rsc, acc[4 * g + 1] * rsc); ow[g].y = cvtpk(acc[4 * g + 2] * rsc, acc[4 * g + 3] * rsc); }
        {
            const int nn = n + 1 < 32 ? n + 1 : n; const int cn = dir == 0 ? nn : 31 - nn;
            const char* qc = RQb + (size_t)cn * 65536;
#pragma unroll
            for (int s = 0; s < 16; ++s) qf[s] = *(const bf16x8*)(qc + qlo + 1024 * s);
        }
        {
            char* oc = OUTb + t0 * (DM * 2) + olo;
#pragma unroll
            for (int g = 0; g < 4; ++g) *(u32x2*)(oc + g * 16) = ow[g];
        }
#pragma unroll
        for (int ks = 0; ks < 8; ++ks) {
            const s16x4 vlo4 = tr_read(vtr + ks * (16 * RV_STR)), vhi4 = tr_read(vtr + ks * (16 * RV_STR) + 8 * RV_STR);
            const bf16x8 vf = __builtin_shufflevector(vlo4, vhi4, 0, 1, 2, 3, 4, 5, 6, 7);
#pragma unroll
            for (int dd = 0; dd < 2; ++dd) {
                const s16x4 lo = tr_read(ktr + ks * (16 * RK_STR) + dd * 64), hi = tr_read(ktr + ks * (16 * RK_STR) + 8 * RK_STR + dd * 64);
                const bf16x8 kt = __builtin_shufflevector(lo, hi, 0, 1, 2, 3, 4, 5, 6, 7);
                if (dd == 0) st0 = MFMA32(kt, vf, st0); else st1 = MFMA32(kt, vf, st1);
            }
        }
#pragma unroll
        for (int i = 0; i < 16; ++i) { st0[i] *= decayC; st1[i] *= decayC; }
        __syncthreads();
#pragma unroll
        for (int g = 0; g < 4; ++g) {
            u32x2 w0, w1;
            w0.x = cvtpk(st0[4 * g], st0[4 * g + 1]); w0.y = cvtpk(st0[4 * g + 2], st0[4 * g + 3]);
            w1.x = cvtpk(st1[4 * g], st1[4 * g + 1]); w1.y = cvtpk(st1[4 * g + 2], st1[4 * g + 3]);
            *(LAS u32x2*)(spub + g * 16) = w0; *(LAS u32x2*)(spub + 64 + g * 16) = w1;
        }
    }
    __syncthreads();
}

__device__ __forceinline__ void retention_chain_rs(Frame& F, const Args& a, int chain) {
    const int b = chain >> 5, h = (chain >> 3) & 3, dir = (chain >> 2) & 1, es = chain & 3;
    const int lane = F.lane, r = lane & 31, hh = lane >> 5, w = F.wave;
    const bool outw = w < 4; const int ib = w & 3, sw = w & 3;
    const bf16_t* RQ = (const bf16_t*)(F.ws + WS_RQ); const bf16_t* RK = (const bf16_t*)(F.ws + WS_RK); const bf16_t* RV = (const bf16_t*)(F.ws + WS_RV);
    bf16_t* OUT = (bf16_t*)(F.ws + (dir ? WS_OUTB : WS_OUTF));
    const float lg = log1pf(-__expf(a.in[6][dir * 4 + h]));
    const float decayC = __expf(lg * 128.f);
    LAS unsigned char* lds = F.lds;
    f32x16 R[4];
#pragma unroll
    for (int k = 0; k < 4; ++k)
#pragma unroll
        for (int i = 0; i < 16; ++i) R[k][i] = 0.f;
#define QFRAG(s) __builtin_bit_cast(bf16x8, (f32x4){R[(s) >> 2][4 * ((s) & 3)], R[(s) >> 2][4 * ((s) & 3) + 1], R[(s) >> 2][4 * ((s) & 3) + 2], R[(s) >> 2][4 * ((s) & 3) + 3]})
#define QLOAD(s, P) do { const f32x4 t_ = *(const f32x4*)(P); R[(s) >> 2][4 * ((s) & 3)] = t_[0]; R[(s) >> 2][4 * ((s) & 3) + 1] = t_[1]; R[(s) >> 2][4 * ((s) & 3) + 2] = t_[2]; R[(s) >> 2][4 * ((s) & 3) + 3] = t_[3]; } while (0)
    for (int i = F.tid; i < (64 * RK_STR) / 16; i += NTHR) *(LAS u32x4*)(lds + RL_S + i * 16) = (u32x4){0u, 0u, 0u, 0u};
    const int vj = F.tid >> 2, ve0 = (F.tid & 3) * 16;
    const float vscale = __expf(lg * (dir == 0 ? (float)(127 - vj) : (float)vj));
    const int blk = (lane >> 4) & 1, q4 = (lane & 15) >> 2, p4 = lane & 3;
    LAS unsigned char* kbase = lds + RL_K + r * RK_STR + 16 * hh;
    LAS unsigned char* sbase = lds + RL_S + r * RK_STR + 16 * hh;
    LAS unsigned char* vtr = lds + RL_V + (4 * hh + q4) * RV_STR + (16 * blk + 4 * p4) * 2;
    LAS unsigned char* ktr = lds + RL_K + (4 * hh + q4) * RK_STR + (sw * 64 + 16 * blk + 4 * p4) * 2;
    LAS unsigned char* spub = lds + RL_S + r * RK_STR + (sw * 64 + 4 * hh) * 2;
    const float rsc = __expf(lg * (dir == 0 ? (float)(ib * 32 + r - 127) : (float)(-(ib * 32 + r))));
    const char* RKb = (const char*)RK + (size_t)h * 512; const char* RVb = (const char*)RV + (size_t)(h * 256 + es * 64) * 2; const char* RQb = (const char*)RQ + ((size_t)((b * 4 + h) * 32) * 4 + ib) * 16384;
    char* OUTb = (char*)OUT + (size_t)(ib * 32 * DM + h * 256 + es * 64) * 2;
    const unsigned klo = (unsigned)(((F.tid >> 5) * DM + (F.tid & 31) * 8) * 2), vlo = (unsigned)((vj * DM + ve0) * 2), qlo = (unsigned)(lane * 16), olo = (unsigned)((r * DM + 4 * hh) * 2);
    u32x4 kpre[8]; u32x4 vpre[2];
    {
        const size_t t0 = (size_t)b * SEQ + (size_t)(dir == 0 ? 0 : 31) * 128;
        const char* kc = RKb + t0 * (DM * 2); const char* vc = RVb + t0 * (DM * 2); const char* qc = RQb + (size_t)(dir == 0 ? 0 : 31) * 65536;
#pragma unroll
        for (int i = 0; i < 8; ++i) kpre[i] = *(const u32x4*)(kc + (size_t)i * (16 * DM * 2) + klo);
        vpre[0] = *(const u32x4*)(vc + vlo); vpre[1] = *(const u32x4*)(vc + vlo + 16);
        if (outw) {
#pragma unroll
            for (int s = 0; s < 16; ++s) QLOAD(s, qc + qlo + 1024 * s);
        }
    }
#pragma unroll 1
    for (int n = 0; n < 32; ++n) {
        const int cidx = dir == 0 ? n : 31 - n;
        const size_t t0 = (size_t)b * SEQ + (size_t)cidx * 128;
        {
            LAS unsigned char* kw = lds + RL_K + (F.tid >> 5) * RK_STR + (F.tid & 31) * 16;
#pragma unroll
            for (int i = 0; i < 8; ++i) *(LAS u32x4*)(kw + i * 16 * RK_STR) = kpre[i];
#pragma unroll
            for (int i = 0; i < 2; ++i) {
                u32x4 o; o.x = cvtpk(bflo(vpre[i].x) * vscale, bfhi(vpre[i].x) * vscale); o.y = cvtpk(bflo(vpre[i].y) * vscale, bfhi(vpre[i].y) * vscale);
                o.z = cvtpk(bflo(vpre[i].z) * vscale, bfhi(vpre[i].z) * vscale); o.w = cvtpk(bflo(vpre[i].w) * vscale, bfhi(vpre[i].w) * vscale);
                *(LAS u32x4*)(lds + RL_V + vj * RV_STR + ve0 * 2 + 16 * i) = o;
            }
        }
        __syncthreads();
        {
            const int nn = n + 1 < 32 ? n + 1 : n; const int cn = dir == 0 ? nn : 31 - nn;
            const size_t t1 = (size_t)b * SEQ + (size_t)cn * 128;
            const char* kc = RKb + t1 * (DM * 2); const char* vc = RVb + t1 * (DM * 2);
#pragma unroll
            for (int i = 0; i < 8; ++i) kpre[i] = *(const u32x4*)(kc + (size_t)i * (16 * DM * 2) + klo);
            vpre[0] = *(const u32x4*)(vc + vlo); vpre[1] = *(const u32x4*)(vc + vlo + 16);
        }
        if (outw) {
            f32x16 acc0, acc1;
#pragma unroll
            for (int i = 0; i < 16; ++i) { acc0[i] = 0.f; acc1[i] = 0.f; }
            const int jb_lo = dir == 0 ? 0 : ib, jb_hi = dir == 0 ? ib : 3;
#pragma unroll 1
            for (int jb = jb_lo; jb <= jb_hi; ++jb) {
                LAS unsigned char* kb = kbase + jb * (32 * RK_STR);
                f32x16 sT;
#pragma unroll
                for (int i = 0; i < 16; ++i) sT[i] = 0.f;
#pragma unroll
                for (int hb = 0; hb < 2; ++hb) {
                    bf16x8 kf[8];
#pragma unroll
                    for (int s = 0; s < 8; ++s) kf[s] = *(const LAS bf16x8*)(kb + (hb * 8 + s) * 32);
                    __builtin_amdgcn_sched_barrier(0);
#pragma unroll
                    for (int s = 0; s < 8; ++s) sT = MFMA32(kf[s], QFRAG(hb * 8 + s), sT);
                    __builtin_amdgcn_sched_barrier(0);
                }
                if (jb == ib) {
#pragma unroll
                    for (int i = 0; i < 16; ++i) { const int jl = crow(i, hh); const bool keep = dir == 0 ? (jl <= r) : (jl > r); sT[i] = keep ? sT[i] : 0.f; }
                }
                const bf16x8 p0 = pack8(sT, 0), p1 = pack8(sT, 1);
                LAS unsigned char* vb = vtr + jb * (32 * RV_STR);
#pragma unroll
                for (int s2 = 0; s2 < 2; ++s2) {
                    const s16x4 l0 = tr_read(vb + s2 * (16 * RV_STR)), h0 = tr_read(vb + s2 * (16 * RV_STR) + 8 * RV_STR);
                    const s16x4 l1 = tr_read(vb + s2 * (16 * RV_STR) + 64), h1 = tr_read(vb + s2 * (16 * RV_STR) + 8 * RV_STR + 64);
                    acc0 = MFMA32(__builtin_shufflevector(l0, h0, 0, 1, 2, 3, 4, 5, 6, 7), s2 == 0 ? p0 : p1, acc0);
                    acc1 = MFMA32(__builtin_shufflevector(l1, h1, 0, 1, 2, 3, 4, 5, 6, 7), s2 == 0 ? p0 : p1, acc1);
                }
            }
#pragma unroll
            for (int hb = 0; hb < 4; ++hb) {
                bf16x8 sf0[4], sf1[4];
#pragma unroll
                for (int s = 0; s < 4; ++s) { sf0[s] = *(const LAS bf16x8*)(sbase + (hb * 4 + s) * 32); sf1[s] = *(const LAS bf16x8*)(sbase + 32 * RK_STR + (hb * 4 + s) * 32); }
                __builtin_amdgcn_sched_barrier(0);
#pragma unroll
                for (int s = 0; s < 4; ++s) { acc0 = MFMA32(sf0[s], QFRAG(hb * 4 + s), acc0); acc1 = MFMA32(sf1[s], QFRAG(hb * 4 + s), acc1); }
                __builtin_amdgcn_sched_barrier(0);
            }
            u32x2 ow[8];
#pragma unroll
            for (int g = 0; g < 4; ++g) { ow[g].x = cvtpk(acc0[4 * g] * rsc, acc0[4 * g + 1] * rsc); ow[g].y = cvtpk(acc0[4 * g + 2] * rsc, acc0[4 * g + 3] * rsc);
                ow[4 + g].x = cvtpk(acc1[4 * g] * rsc, acc1[4 * g + 1] * rsc); ow[4 + g].y = cvtpk(acc1[4 * g + 2] * rsc, acc1[4 * g + 3] * rsc); }
            {
                const int nn = n + 1 < 32 ? n + 1 : n; const int cn = dir == 0 ? nn : 31 - nn;
                const char* qc = RQb + (size_t)cn * 65536;
#pragma unroll
                for (int s = 0; s < 16; ++s) QLOAD(s, qc + qlo + 1024 * s);
            }
            {
                char* oc = OUTb + t0 * (DM * 2) + olo;
#pragma unroll
                for (int g = 0; g < 4; ++g) { *(u32x2*)(oc + g * 16) = ow[g]; *(u32x2*)(oc + 64 + g * 16) = ow[4 + g]; }
            }
        } else {
#pragma unroll
            for (int ks = 0; ks < 8; ++ks) {
                const s16x4 vl0 = tr_read(vtr + ks * (16 * RV_STR)), vh0 = tr_read(vtr + ks * (16 * RV_STR) + 8 * RV_STR);
                const s16x4 vl1 = tr_read(vtr + ks * (16 * RV_STR) + 64), vh1 = tr_read(vtr + ks * (16 * RV_STR) + 8 * RV_STR + 64);
                const bf16x8 vf0 = __builtin_shufflevector(vl0, vh0, 0, 1, 2, 3, 4, 5, 6, 7), vf1 = __builtin_shufflevector(vl1, vh1, 0, 1, 2, 3, 4, 5, 6, 7);
#pragma unroll
                for (int dd = 0; dd < 2; ++dd) {
                    const s16x4 lo = tr_read(ktr + ks * (16 * RK_STR) + dd * 64), hi = tr_read(ktr + ks * (16 * RK_STR) + 8 * RK_STR + dd * 64);
                    const bf16x8 kt = __builtin_shufflevector(lo, hi, 0, 1, 2, 3, 4, 5, 6, 7);
                    R[2 * dd] = MFMA32(kt, vf0, R[2 * dd]); R[2 * dd + 1] = MFMA32(kt, vf1, R[2 * dd + 1]);
                }
            }
#pragma unroll
            for (int k = 0; k < 4; ++k)
#pragma unroll
                for (int i = 0; i < 16; ++i) R[k][i] *= decayC;
        }
        __syncthreads();
        if (!outw) {
#pragma unroll
            for (int dd = 0; dd < 2; ++dd)
#pragma unroll
                for (int e = 0; e < 2; ++e)
#pragma unroll
                    for (int g = 0; g < 4; ++g) { u32x2 wv; wv.x = cvtpk(R[2 * dd + e][4 * g], R[2 * dd + e][4 * g + 1]); wv.y = cvtpk(R[2 * dd + e][4 * g + 2], R[2 * dd + e][4 * g + 3]);
                        *(LAS u32x2*)(spub + e * (32 * RK_STR) + dd * 64 + g * 16) = wv; }
        }
    }
    __syncthreads();
#undef QFRAG
#undef QLOAD
}

__device__ __forceinline__ u32x4 fp8x8_to_bf16(unsigned w0, unsigned w1) {
    const f32x2 a = __builtin_amdgcn_cvt_pk_f32_fp8((int)w0, false), b = __builtin_amdgcn_cvt_pk_f32_fp8((int)w0, true), c = __builtin_amdgcn_cvt_pk_f32_fp8((int)w1, false), d = __builtin_amdgcn_cvt_pk_f32_fp8((int)w1, true);
    return (u32x4){cvtpk(a.x, a.y), cvtpk(b.x, b.y), cvtpk(c.x, c.y), cvtpk(d.x, d.y)};
}
constexpr int AK_STR = 144, AV_STR = 192;
constexpr int AL_K = 0, AL_V = 384 * AK_STR, AL_B = AL_V + 384 * AV_STR, AL_END = AL_B + 896;
struct AttUnit { int g, dil, length, res, run0, b, head; };
__device__ __forceinline__ AttUnit att_decode(int slot) {
    AttUnit u; const int bh = slot / 48, k = slot % 48, ru = k & 15; u.g = k >> 4;
    u.dil = u.g == 0 ? 1 : (u.g == 1 ? 4 : 16); u.length = SEQ / u.dil; u.res = ru % u.dil; u.run0 = (ru / u.dil) * 256; u.b = bh >> 4; u.head = bh & 15; return u;
}
__device__ __forceinline__ void attention_phase(Frame& F, int u0, int u1, int zero) {
    if (u0 >= u1) return;
    const int lane = F.lane, r = lane & 31, hh = lane >> 5, w = F.wave;
    const unsigned char* AQ = F.ws + WS_AQ; const unsigned char* AK = F.ws + WS_AK; const unsigned char* AV = F.ws + WS_AV;
    LAS unsigned char* lds = F.lds;
    const int blk = (lane >> 4) & 1, q4 = (lane & 15) >> 2, p4 = lane & 3;
    LAS unsigned char* kbase = lds + AL_K + (32 * w + r) * AK_STR + 16 * hh;
    LAS unsigned char* vbase = lds + AL_V + (32 * w + 4 * hh + q4) * AV_STR + (16 * blk + 4 * p4) * 2;
    const LAS float* bt = (const LAS float*)(lds + AL_B) + (4 * hh - r + 32);
    u32x4 kk[3], vv[3]; u32x2 qn[4]; float bnext = 0.f;
    u32x4 kk2[3], vv2[3]; u32x2 qn2[4]; float bnext2 = 0.f;
#define ATT_LOAD(U) do { const AttUnit un_ = att_decode(U); \
        if (F.tid < 224) { const int X_ = F.tid - 32; bnext = (X_ >= 0 && X_ <= 128) ? ((const float*)(F.ws + WS_BTAB))[(un_.g * 16 + un_.head) * 160 + X_] : 0.f; } \
        _Pragma("unroll") for (int i = 0; i < 3; ++i) { const int id = F.tid + i * NTHR, row = id >> 2, ch = id & 3; int idx = un_.run0 - 64 + row; idx = idx < 0 ? 0 : (idx >= un_.length ? un_.length - 1 : idx); \
            const size_t off = ((size_t)un_.b * SEQ + (size_t)idx * un_.dil + un_.res) * DM + un_.head * 64 + ch * 16; kk[i] = *(const u32x4*)(AK + off); vv[i] = *(const u32x4*)(AV + off); } \
        const size_t qt_ = (size_t)un_.b * SEQ + (size_t)(un_.run0 + 32 * w + r) * un_.dil + un_.res; \
        _Pragma("unroll") for (int s = 0; s < 4; ++s) qn[s] = *(const u32x2*)(AQ + qt_ * DM + un_.head * 64 + 16 * s + 8 * hh); } while (0)
#define ATT_LOAD2(U) do { const AttUnit un_ = att_decode(U); \
        if (F.tid < 224) { const int X_ = F.tid - 32; bnext2 = (X_ >= 0 && X_ <= 128) ? ((const float*)(F.ws + WS_BTAB))[(un_.g * 16 + un_.head) * 160 + X_] : 0.f; } \
        _Pragma("unroll") for (int i = 0; i < 3; ++i) { const int id = F.tid + i * NTHR, row = id >> 2, ch = id & 3; int idx = un_.run0 - 64 + row; idx = idx < 0 ? 0 : (idx >= un_.length ? un_.length - 1 : idx); \
            const size_t off = ((size_t)un_.b * SEQ + (size_t)idx * un_.dil + un_.res) * DM + un_.head * 64 + ch * 16; kk2[i] = *(const u32x4*)(AK + off); vv2[i] = *(const u32x4*)(AV + off); } \
        const size_t qt_ = (size_t)un_.b * SEQ + (size_t)(un_.run0 + 32 * w + r) * un_.dil + un_.res; \
        _Pragma("unroll") for (int s = 0; s < 4; ++s) qn2[s] = *(const u32x2*)(AQ + qt_ * DM + un_.head * 64 + 16 * s + 8 * hh); } while (0)
    const int nun = u1 - u0, nit = nun * (PROBE_PHASE == 31 ? 2 : 1);
#define ATT_SLOT(I) (u0 + ((I) >= nit ? nun - 1 : ((I) >= nun ? (I) - nun : (I))))
    ATT_LOAD(ATT_SLOT(0)); ATT_LOAD2(ATT_SLOT(1));
#pragma unroll 1
    for (int it = 0; it < nit; ++it) {
        const int unit = u0 + (it >= nun ? it - nun : it);
        const AttUnit un = att_decode(unit);
        unsigned char* OG = F.ws + WS_OG + (size_t)un.g * (SEG / 2); float* LSE = (float*)(F.ws + WS_LSE) + (size_t)un.g * NTOK * 16;
#pragma unroll
        for (int i = 0; i < 3; ++i) { const int id = F.tid + i * NTHR, row = id >> 2, ch = id & 3;
            *(LAS u32x4*)(lds + AL_K + row * AK_STR + 32 * ch) = fp8x8_to_bf16(kk[i].x, kk[i].y); *(LAS u32x4*)(lds + AL_K + row * AK_STR + 32 * ch + 16) = fp8x8_to_bf16(kk[i].z, kk[i].w);
            *(LAS u32x4*)(lds + AL_V + row * AV_STR + 32 * ch) = fp8x8_to_bf16(vv[i].x, vv[i].y); *(LAS u32x4*)(lds + AL_V + row * AV_STR + 32 * ch + 16) = fp8x8_to_bf16(vv[i].z, vv[i].w); }
        if (F.tid < 224) ((LAS float*)(lds + AL_B))[F.tid] = bnext;
        bf16x8 qf[4];
#pragma unroll
        for (int s = 0; s < 4; ++s) qf[s] = __builtin_bit_cast(bf16x8, fp8x8_to_bf16(qn[s].x, qn[s].y));
        __syncthreads();
#pragma unroll
        for (int i = 0; i < 3; ++i) { kk[i] = kk2[i]; vv[i] = vv2[i]; }
#pragma unroll
        for (int s = 0; s < 4; ++s) qn[s] = qn2[s];
        bnext = bnext2;
        ATT_LOAD2(ATT_SLOT(it + 2));
        const size_t qtok = (size_t)un.b * SEQ + (size_t)(un.run0 + 32 * w + r) * un.dil + un.res;
        const int lv = 4 * hh - r, kv = un.run0 - 64 + 32 * w + 4 * hh;
        const int clo = max(-lv, -kv), chi = min(128 - lv, un.length - 1 - kv);
        const bool edge = (un.run0 == 0) || (un.run0 + 256 == un.length);
        float m = -3.0e38f, lsum = 0.f;
        f32x16 o0, o1;
#pragma unroll 1
        for (int rc_ = 0; rc_ < (PROBE_PHASE == 33 ? 2 + zero : 1); ++rc_) {
        m = -3.0e38f; lsum = 0.f;
#pragma unroll
        for (int i = 0; i < 16; ++i) { o0[i] = 0.f; o1[i] = 0.f; }
#pragma unroll
        for (int kb = 0; kb < 5; ++kb) {
            f32x16 sT;
#pragma unroll
            for (int i = 0; i < 16; ++i) sT[i] = 0.f;
#pragma unroll
            for (int s = 0; s < 4; ++s) sT = MFMA32(*(const LAS bf16x8*)(kbase + kb * (32 * AK_STR) + s * 32), qf[s], sT);
            float bv[16];
#pragma unroll
            for (int i = 0; i < 16; ++i) bv[i] = bt[32 * kb + (i & 3) + 8 * (i >> 2)];
            const bool masked = (kb == 0) || (kb == 4) || edge;
            float bm = -3.0e38f;
            if (masked) {
#pragma unroll
                for (int i = 0; i < 16; ++i) { const int c = 32 * kb + (i & 3) + 8 * (i >> 2); const bool valid = (c >= clo) && (c <= chi);
                    const float sv = sT[i] * (1.0f / 256.0f) + bv[i]; sT[i] = valid ? sv : -3.0e38f; bm = fmaxf(bm, sT[i]); }
            } else {
#pragma unroll
                for (int i = 0; i < 16; ++i) { sT[i] = sT[i] * (1.0f / 256.0f) + bv[i]; bm = fmaxf(bm, sT[i]); }
            }
            bm = fmaxf(bm, __shfl_xor(bm, 32));
            const float mn = fmaxf(m, bm), alpha = __builtin_amdgcn_exp2f(m - mn);
            if (kb > 0 && __any(mn > m)) {
#pragma unroll
                for (int i = 0; i < 16; ++i) { o0[i] *= alpha; o1[i] *= alpha; }
            }
            m = mn; lsum *= alpha;
            if (masked) {
#pragma unroll
                for (int i = 0; i < 16; ++i) { const float p = sT[i] > -1.0e38f ? __builtin_amdgcn_exp2f(sT[i] - mn) : 0.f; sT[i] = p; lsum += p; }
            } else {
#pragma unroll
                for (int i = 0; i < 16; ++i) { const float p = __builtin_amdgcn_exp2f(sT[i] - mn); sT[i] = p; lsum += p; }
            }
#pragma unroll
            for (int s2 = 0; s2 < 2; ++s2) {
                const bf16x8 pb = pack8(sT, s2);
#pragma unroll
                for (int e2 = 0; e2 < 2; ++e2) {
                    const s16x4 lo = tr_read(vbase + kb * (32 * AV_STR) + s2 * (16 * AV_STR) + e2 * 64);
                    const s16x4 hi = tr_read(vbase + kb * (32 * AV_STR) + s2 * (16 * AV_STR) + 8 * AV_STR + e2 * 64);
                    const bf16x8 vf = __builtin_shufflevector(lo, hi, 0, 1, 2, 3, 4, 5, 6, 7);
                    if (e2 == 0) o0 = MFMA32(vf, pb, o0); else o1 = MFMA32(vf, pb, o1);
                }
            }
        }
        }
        lsum += __shfl_xor(lsum, 32);
        if (hh == 0) LSE[qtok * 16 + un.head] = (m + __log2f(lsum)) * 0.6931471805599453f;
        const float linv = YD_INV / lsum;
        __syncthreads();
#pragma unroll 1
        for (int rs_ = 0; rs_ < (PROBE_PHASE == 34 ? 2 + zero : 1); ++rs_)
        {
            LAS unsigned char* ost = lds + AL_K + w * (32 * AK_STR);
#pragma unroll
            for (int g = 0; g < 4; ++g) {
                u32x2 a0, a1; a0.x = cvtpk(o0[4 * g] * linv, o0[4 * g + 1] * linv); a0.y = cvtpk(o0[4 * g + 2] * linv, o0[4 * g + 3] * linv);
                a1.x = cvtpk(o1[4 * g] * linv, o1[4 * g + 1] * linv); a1.y = cvtpk(o1[4 * g + 2] * linv, o1[4 * g + 3] * linv);
                *(LAS u32x2*)(ost + r * AK_STR + 16 * g + 8 * hh) = a0; *(LAS u32x2*)(ost + r * AK_STR + 64 + 16 * g + 8 * hh) = a1;
            }
            asm volatile("s_waitcnt lgkmcnt(0)" ::: "memory");
#pragma unroll
            for (int it = 0; it < 4; ++it) {
                const int ql = 8 * it + (lane >> 3);
                const u32x4 v = *(const LAS u32x4*)(ost + ql * AK_STR + 16 * (lane & 7));
                const size_t tok = (size_t)un.b * SEQ + (size_t)(un.run0 + 32 * w + ql) * un.dil + un.res;
                u32x2 f8; f8.x = pk4_fp8(bflo(v.x), bfhi(v.x), bflo(v.y), bfhi(v.y)); f8.y = pk4_fp8(bflo(v.z), bfhi(v.z), bflo(v.w), bfhi(v.w));
                __builtin_nontemporal_store(f8, (u32x2*)(OG + tok * DM + un.head * 64 + 8 * (lane & 7)));
            }
        }
        __syncthreads();
    }
#undef ATT_LOAD
#undef ATT_LOAD2
#undef ATT_SLOT
}

__device__ __forceinline__ void mixer_post_rows(Frame& F) {
    const int gw = F.vcu * NWAVES + F.wave, NGW = F.G * NWAVES, lane = F.lane;
    const bf16_t* OF = (const bf16_t*)(F.ws + WS_OUTF); const bf16_t* OB = (const bf16_t*)(F.ws + WS_OUTB); const unsigned char* SG = (F.ws + WS_RG);
    const unsigned char* OG = F.ws + WS_OG; const float* LSE = (const float*)(F.ws + WS_LSE);
    bf16_t* RN = (bf16_t*)(F.ws + WS_RETN); bf16_t* AC = (bf16_t*)(F.ws + WS_ATTC);
    const int head = lane >> 2;
    u32x2 fa[4], fb[4], na[4], nb[4]; unsigned sg[4], nsg[4]; u32x4 og[3], nog[3]; float ls[3], nls[3];
#define MP_LOAD(A, B, S, O, L, ROW) do { _Pragma("unroll") for (int h = 0; h < 4; ++h) { const size_t off_ = (size_t)(ROW) * DM + h * 256 + 4 * lane; \
            A[h] = *(const u32x2*)(OF + off_); B[h] = *(const u32x2*)(OB + off_); S[h] = *(const unsigned*)(SG + off_); } \
        _Pragma("unroll") for (int g = 0; g < 3; ++g) { O[g] = *(const u32x4*)(OG + (size_t)g * NTOK * DM + (size_t)(ROW) * DM + 16 * lane); L[g] = LSE[((size_t)g * NTOK + (ROW)) * 16 + head]; } } while (0)
    if (gw >= NTOK) return;
    MP_LOAD(fa, fb, sg, og, ls, gw);
#pragma unroll 1
    for (int row = gw; row < NTOK; row += NGW) {
        const int rn = row + NGW < NTOK ? row + NGW : row;
        MP_LOAD(na, nb, nsg, nog, nls, rn);
        f32x4 v[4];
#pragma unroll
        for (int h = 0; h < 4; ++h) v[h] = (f32x4){bflo(fa[h].x) + bflo(fb[h].x), bfhi(fa[h].x) + bfhi(fb[h].x), bflo(fa[h].y) + bflo(fb[h].y), bfhi(fa[h].y) + bfhi(fb[h].y)};
#pragma unroll
        for (int h = 0; h < 4; ++h) {
            const float mu = wave_sum((v[h][0] + v[h][1]) + (v[h][2] + v[h][3])) * (1.f / 256.f);
            const f32x4 d = v[h] - mu;
            const float var = wave_sum((d[0] * d[0] + d[1] * d[1]) + (d[2] * d[2] + d[3] * d[3])) * (1.f / 256.f);
            const float rs = rsqrtf(var + NORM_EPS);
            const f32x2 g01 = __builtin_amdgcn_cvt_pk_f32_fp8((int)sg[h], false), g23 = __builtin_amdgcn_cvt_pk_f32_fp8((int)sg[h], true); const float rq = rs * YD_INV;
            u32x2 o; o.x = cvtpk(d[0] * rq * g01.x, d[1] * rq * g01.y); o.y = cvtpk(d[2] * rq * g23.x, d[3] * rq * g23.y);
            *(u32x2*)(RN + (size_t)row * DM + h * 256 + 4 * lane) = o;
        }
        const float lm = fmaxf(ls[0], fmaxf(ls[1], ls[2]));
        float wg[3]; float wsum = 0.f;
#pragma unroll
        for (int g = 0; g < 3; ++g) { wg[g] = __expf(ls[g] - lm); wsum += wg[g]; }
        const float winv = 1.f / wsum;
        unsigned res[8];
#pragma unroll
        for (int wI = 0; wI < 4; ++wI) {
            float a0 = 0.f, a1 = 0.f, a2 = 0.f, a3 = 0.f;
#pragma unroll
            for (int g = 0; g < 3; ++g) { const int wd = (int)(wI == 0 ? og[g].x : (wI == 1 ? og[g].y : (wI == 2 ? og[g].z : og[g].w)));
                const f32x2 p0 = __builtin_amdgcn_cvt_pk_f32_fp8(wd, false), p1 = __builtin_amdgcn_cvt_pk_f32_fp8(wd, true);
                a0 += wg[g] * p0.x; a1 += wg[g] * p0.y; a2 += wg[g] * p1.x; a3 += wg[g] * p1.y; }
            const float sc = winv * YD_INV;
            res[2 * wI] = cvtpk(a0 * sc, a1 * sc); res[2 * wI + 1] = cvtpk(a2 * sc, a3 * sc);
        }
        u32x4 oo[2]; oo[0] = (u32x4){res[0], res[1], res[2], res[3]}; oo[1] = (u32x4){res[4], res[5], res[6], res[7]};
        bf16_t* ap = AC + (size_t)row * DM + 16 * lane; *(u32x4*)ap = oo[0]; *(u32x4*)(ap + 8) = oo[1];
#pragma unroll
        for (int h = 0; h < 4; ++h) { fa[h] = na[h]; fb[h] = nb[h]; sg[h] = nsg[h]; }
#pragma unroll
        for (int g = 0; g < 3; ++g) { og[g] = nog[g]; ls[g] = nls[g]; }
    }
#undef MP_LOAD
}

__device__ __forceinline__ void routing_rows(Frame& F, const Args& a) {
    const int gw = F.vcu * NWAVES + F.wave, NGW = F.G * NWAVES, lane = F.lane;
    const float* LOG = (const float*)(F.ws + WS_LOGIT); const float* rb = a.in[13];
    int* EIDX = (int*)(F.ws + WS_EIDX); float* GATE = (float*)(F.ws + WS_GATE);
    LAS unsigned* hist = (LAS unsigned*)(F.lds);
    for (int i = F.tid; i < NEXP; i += NTHR) hist[i] = 0u;
    __syncthreads();
    const f32x4 bias = *(const f32x4*)(rb + 4 * lane);
    for (int row = gw; row < NTOK; row += NGW) {
        const f32x4 lg = *(const f32x4*)(LOG + (size_t)row * NEXP + 4 * lane);
        float sc[4], ch[4];
#pragma unroll
        for (int i = 0; i < 4; ++i) { sc[i] = 1.f / (1.f + expf(-lg[i])); ch[i] = sc[i] + bias[i]; }
        float m1 = fmaxf(ch[0], ch[1]), m2 = fminf(ch[0], ch[1]);
        { const float c2 = ch[2]; const float n1 = fmaxf(m1, c2); m2 = fmaxf(m2, fminf(m1, c2)); m1 = n1; }
        { const float c3 = ch[3]; const float n1 = fmaxf(m1, c3); m2 = fmaxf(m2, fminf(m1, c3)); m1 = n1; }
#pragma unroll
        for (int o = 1; o < 8; o <<= 1) { const float b1 = __shfl_xor(m1, o), b2 = __shfl_xor(m2, o);
            const float n1 = fmaxf(m1, b1); const float n2 = fmaxf(fminf(m1, b1), fmaxf(m2, b2)); m1 = n1; m2 = n2; }
        const float gs = m1 + m2; const int mygrp = lane >> 3;
        int rank = 0;
#pragma unroll
        for (int g = 0; g < 8; ++g) { const float og = __shfl(gs, g * 8); rank += (og > gs || (og == gs && g < mygrp)) ? 1 : 0; }
        const bool elig = rank < 4;
        float cv[4];
#pragma unroll
        for (int i = 0; i < 4; ++i) cv[i] = elig ? ch[i] : -3.0e38f;
        float gsel = 0.f; int esel = 0; float gsum = 0.f;
#pragma unroll
        for (int k = 0; k < TOPK; ++k) {
            float bv = cv[0]; int bi = 4 * lane;
#pragma unroll
            for (int i = 1; i < 4; ++i) if (cv[i] > bv) { bv = cv[i]; bi = 4 * lane + i; }
#pragma unroll
            for (int o = 1; o < 64; o <<= 1) { const float ov = __shfl_xor(bv, o); const int oi = __shfl_xor(bi, o); if (ov > bv || (ov == bv && oi < bi)) { bv = ov; bi = oi; } }
            const int own = bi >> 2, el = bi & 3;
            const float mine = el == 0 ? sc[0] : (el == 1 ? sc[1] : (el == 2 ? sc[2] : sc[3]));
            const float s = __shfl(mine, own);
            if (lane == own) { if (el == 0) cv[0] = -3.0e38f; else if (el == 1) cv[1] = -3.0e38f; else if (el == 2) cv[2] = -3.0e38f; else cv[3] = -3.0e38f; }
            gsum += s;
            if (lane == k) { gsel = s; esel = bi; }
        }
        if (lane < TOPK) { EIDX[row * TOPK + lane] = esel; GATE[row * TOPK + lane] = gsel / gsum * 2.5f; __hip_atomic_fetch_add(&hist[esel], 1u, __ATOMIC_RELAXED, __HIP_MEMORY_SCOPE_WORKGROUP); }
    }
    __syncthreads();
    for (int i = F.tid; i < NEXP; i += NTHR) if (hist[i]) atomicAdd((unsigned*)(F.ws + WS_CTL) + CW_CNT + i, hist[i]);
}

__device__ __forceinline__ void routing_lists(Frame& F) {
    LAS unsigned* cnt = (LAS unsigned*)(F.lds);
    LAS unsigned* pstart = cnt + 256;
    LAS unsigned* lh = pstart + 264;
    LAS unsigned* lbase = lh + 256;
    LAS unsigned* ustart = lbase + 256;
    int* DPOS = (int*)(F.ws + WS_DPOS);
    unsigned* ctl = (unsigned*)(F.ws + WS_CTL);
    const int* EIDX = (const int*)(F.ws + WS_EIDX); int* ROWL = (int*)(F.ws + WS_ROWL); int* TILE_E = (int*)(F.ws + WS_TILE_E);
    for (int i = F.tid; i < NEXP; i += NTHR) { cnt[i] = __hip_atomic_load(ctl + CW_CNT + i, RLX_AGENT); lh[i] = 0u; }
    __syncthreads();
    if (F.tid == 0) { unsigned s = 0, us = 0; for (int e = 0; e < NEXP; ++e) { pstart[e] = s; ustart[e] = us; s += (cnt[e] + 255u) & ~255u; us += cnt[e]; } pstart[NEXP] = s; }
    __syncthreads();
    const unsigned ptotal = pstart[NEXP];
    const int per = (NTOK + F.G - 1) / F.G, tk0 = F.vcu * per, tk1 = (tk0 + per) < NTOK ? (tk0 + per) : NTOK;
    for (int i = tk0 * TOPK + F.tid; i < tk1 * TOPK; i += NTHR) __hip_atomic_fetch_add(&lh[EIDX[i]], 1u, __ATOMIC_RELAXED, __HIP_MEMORY_SCOPE_WORKGROUP);
    __syncthreads();
    for (int e = F.tid; e < NEXP; e += NTHR) { const unsigned c = lh[e]; lbase[e] = c ? atomicAdd(ctl + CW_FILL + e, c) : 0u; lh[e] = 0u; }
    __syncthreads();
    for (int i = tk0 * TOPK + F.tid; i < tk1 * TOPK; i += NTHR) { const int e = EIDX[i]; const unsigned p = __hip_atomic_fetch_add(&lh[e], 1u, __ATOMIC_RELAXED, __HIP_MEMORY_SCOPE_WORKGROUP);
        ROWL[pstart[e] + lbase[e] + p] = (i >> 3) * 16 + (i & 7); DPOS[i] = (int)(ustart[e] + lbase[e] + p); }
    for (int t = tk0 + F.tid; t < tk1; t += NTHR) ROWL[ptotal + t] = t * 16 + 8;
    for (int e = F.vcu; e < NEXP; e += F.G) { const unsigned s = pstart[e] + cnt[e], en = pstart[e + 1]; for (unsigned p = s + F.tid; p < en; p += NTHR) ROWL[p] = -1; }
    if (F.vcu == 0) {
        const int nrt = (int)(ptotal >> 8);
        for (int e = F.tid; e < NEXP; e += NTHR) { for (unsigned t = pstart[e] >> 8; t < (pstart[e + 1] >> 8); ++t) TILE_E[t] = e; TILE_E[4096 + e] = (int)(pstart[e] - ustart[e]); TILE_E[8192 + e] = (int)(pstart[e] + cnt[e]); }
        for (int t = F.tid; t < NTOK / 256; t += NTHR) TILE_E[nrt + t] = NEXP;
        if (F.tid == 0) { TILE_E[4096 + NEXP] = (int)ptotal - YD_SHARED0; TILE_E[8192 + NEXP] = (int)ptotal + NTOK; }
        if (F.tid == 0) TILE_E[MAX_TILES] = nrt + NTOK / 256;
    }
}

__device__ __forceinline__ void final_rows(Frame& F, const Args& a) {
    const int gw = F.vcu * NWAVES + F.wave, NGW = F.G * NWAVES, lane = F.lane;
    const float* mod = (const float*)(F.ws + WS_MOD); const float* nf = a.in[20];
    const int* DPOS = (const int*)(F.ws + WS_DPOS); const float* GATE = (const float*)(F.ws + WS_GATE);
    f32x4 g4[4];
#pragma unroll
    for (int j = 0; j < 4; ++j) g4[j] = *(const f32x4*)(nf + 4 * lane + 256 * j);
    if (gw >= NTOK) return;
    auto clampr = [&](int r) { return r < NTOK ? r : gw; };
    int dcur = DPOS[clampr(gw) * 8 + (lane & 7)]; float gcur = GATE[clampr(gw) * 8 + (lane & 7)];
    int dnxt = DPOS[clampr(gw + NGW) * 8 + (lane & 7)]; float gnxt = GATE[clampr(gw + NGW) * 8 + (lane & 7)];
    f32x4 xw[4], xn[4]; int yw[9][4], yn[9][4];
#define FIN_LOAD(XW, YW, ROW, DV) do { const f32x4* xr_ = (const f32x4*)(a.out + (size_t)(ROW) * DM) + lane; \
        _Pragma("unroll") for (int j = 0; j < 4; ++j) XW[j] = xr_[64 * j]; \
        _Pragma("unroll") for (int k = 0; k < 9; ++k) { const unsigned char* yr_ = ydense_row(F.ws, k < 8 ? __builtin_amdgcn_readlane((DV), k) : YD_SHARED0 + (ROW)) + 4 * lane; \
            _Pragma("unroll") for (int j = 0; j < 4; ++j) YW[k][j] = *(const int*)(yr_ + 256 * j); } } while (0)
    FIN_LOAD(xw, yw, gw, dcur);
#pragma unroll 1
    for (int row = gw; row < NTOK; row += NGW) {
        const int rn = clampr(row + NGW), rn2 = clampr(row + 2 * NGW);
        FIN_LOAD(xn, yn, rn, dnxt);
        const int dn2 = DPOS[rn2 * 8 + (lane & 7)]; const float gn2 = GATE[rn2 * 8 + (lane & 7)];
        const int b = row / SEQ;
        f32x4 v[4]; float s = 0.f;
#pragma unroll
        for (int j = 0; j < 4; ++j) {
            const int col = 4 * lane + 256 * j;
            f32x4 y = (f32x4){0.f, 0.f, 0.f, 0.f};
#pragma unroll
            for (int k = 0; k < 9; ++k) { const int wv = yw[k][j]; const float gk = (k < 8 ? __uint_as_float(__builtin_amdgcn_readlane(__float_as_uint(gcur), k)) : 1.0f) * YD_INV;
                const f32x2 lo = __builtin_amdgcn_cvt_pk_f32_fp8(wv, false), hi = __builtin_amdgcn_cvt_pk_f32_fp8(wv, true);
                y[0] += gk * lo.x; y[1] += gk * lo.y; y[2] += gk * hi.x; y[3] += gk * hi.y; }
            const f32x4 gf = *(const f32x4*)(mod + (size_t)b * 6144 + 5 * DM + col);
            v[j] = xw[j] + gf * y;
            s += (v[j][0] * v[j][0] + v[j][1] * v[j][1]) + (v[j][2] * v[j][2] + v[j][3] * v[j][3]);
        }
        const float rstd = rsqrtf(wave_sum(s) * (1.f / DM) + NORM_EPS);
        f32x4* xo = (f32x4*)(a.out + (size_t)row * DM) + lane;
#pragma unroll
        for (int j = 0; j < 4; ++j) xo[64 * j] = (v[j] * rstd) * g4[j];
#pragma unroll
        for (int j = 0; j < 4; ++j) xw[j] = xn[j];
#pragma unroll
        for (int k = 0; k < 9; ++k)
#pragma unroll
            for (int j = 0; j < 4; ++j) yw[k][j] = yn[k][j];
        dcur = dnxt; gcur = gnxt; dnxt = dn2; gnxt = gn2;
    }
#undef FIN_LOAD
}

constexpr int MT_OFF = 131072, MT_INFO = MT_OFF + 4096;
__device__ __forceinline__ void moe_tables_to_lds(Frame& F, int ntiles) {
    const int* TILE_E = (const int*)(F.ws + WS_TILE_E);
    LAS unsigned short* te = (LAS unsigned short*)(F.lds + MT_OFF); LAS int* info = (LAS int*)(F.lds + MT_INFO);
    for (int t = F.tid; t < ntiles; t += NTHR) te[t] = (unsigned short)TILE_E[t];
    for (int e = F.tid; e <= NEXP; e += NTHR) { info[e] = TILE_E[4096 + e]; info[512 + e] = TILE_E[8192 + e]; }
    __syncthreads();
}
constexpr int DW_STR = 192;
constexpr int DW_BUF = 256 * DW_STR;
typedef float f32x4_t __attribute__((ext_vector_type(4)));
#define MFMA16(a, b, c) __builtin_amdgcn_mfma_f32_16x16x32_bf16((a), (b), (c), 0, 0, 0)
template <int MODE> __device__ __forceinline__ void down_phase(Frame& F, const Args& a) {
    const int* TILE_E = (const int*)(F.ws + WS_TILE_E); const int ntiles = __builtin_amdgcn_readfirstlane(TILE_E[MAX_TILES]);
    moe_tables_to_lds(F, ntiles);
    const LAS unsigned short* tile_e = (const LAS unsigned short*)(F.lds + MT_OFF); const LAS int* info = (const LAS int*)(F.lds + MT_INFO);
    const int lane = F.lane, w = F.wave, fr = lane & 15, g4 = lane >> 4;
    LAS unsigned char* lds = F.lds;
    const bf16_t* HID = (const bf16_t*)(F.ws + WS_HID);
    const int sk = F.tid >> 4, sn4 = F.tid & 15;
    const int spos = 16 * (sn4 & 3) + 4 * (sn4 >> 2);
    const int q4 = (lane & 15) >> 2, p4 = lane & 3;
    auto next_tile = [&](int i) -> int { const long L = (long)i * F.G + (int)blockIdx.x; return L < ntiles ? pg8::xcd_remap((int)L, ntiles) : -1; };
    int ui = 0, tile = next_tile(0);
    if (tile < 0) return;
    f32x4_t st[8], st2[8];
    auto wd_base = [&](int t) -> const float* { const int e = MODE == 1 ? 0 : (int)tile_e[t]; return e < NEXP ? a.in[16] + (size_t)e * (EH * DM) : a.in[19]; };
#define DW_LOAD(R, WB, C) do { const float* p_ = (WB) + (size_t)sk * DM + (C) * 64 + sn4 * 4; _Pragma("unroll") for (int i = 0; i < 8; ++i) R[i] = *(const f32x4_t*)(p_ + (size_t)i * 32 * DM); } while (0)
#define DW_WRITE(R, SLOT) do { _Pragma("unroll") for (int i = 0; i < 8; ++i) { const int k_ = sk + 32 * i; u32x2 w_; w_.x = cvtpk(R[i][0], R[i][1]); w_.y = cvtpk(R[i][2], R[i][3]); \
        *(LAS u32x2*)(lds + (SLOT) * DW_BUF + k_ * DW_STR + (((spos >> 4) ^ ((k_ >> 3) & 1)) << 5) + (spos & 15) * 2) = w_; } } while (0)
    const float* wb = wd_base(tile);
    int ntile = next_tile(1);
    const float* nwb = ntile >= 0 ? wd_base(ntile) : wb;
    DW_LOAD(st, wb, 0); DW_WRITE(st, 0);
    DW_LOAD(st, wb, 1); DW_LOAD(st2, wb, 2);
    __syncthreads();
    int cc = 0;
    for (;;) {
        const int e = (int)tile_e[tile]; const int shift = info[e], lim = info[512 + e];
        bf16x8 af[2][8];
        { const bf16_t* hp = HID + ((size_t)tile * 256 + 32 * w + fr) * EH + 8 * g4;
#pragma unroll
          for (int m = 0; m < 2; ++m)
#pragma unroll
              for (int ks = 0; ks < 8; ++ks) af[m][ks] = *(const bf16x8*)(hp + (size_t)m * 16 * EH + 32 * ks);
#pragma unroll
          for (int m = 0; m < 2; ++m)
#pragma unroll
              for (int ks = 0; ks < 8; ++ks) asm volatile("" : "+v"(af[m][ks])); }
        const int pos0 = tile * 256 + 32 * w + fr;
#pragma unroll 1
        for (int c = 0; c < 16; c += 2) {
#pragma unroll
            for (int hc = 0; hc < 2; ++hc, ++cc) {
                const int cq = c + hc;
                f32x4 acc[2][4];
                if (MODE == 3) {
#pragma unroll
                    for (int m = 0; m < 2; ++m)
#pragma unroll
                        for (int nf = 0; nf < 4; ++nf) acc[m][nf] = (f32x4){0.f, 0.f, 0.f, 0.f}; }
                LAS unsigned char* bb = lds + (cc & 1) * DW_BUF + (8 * g4 + q4) * DW_STR + 8 * p4;
#pragma unroll 1
                for (int rp_ = 0; rp_ < (MODE == 3 ? a.pad : (PROBE_PHASE == 40 ? 2 + a.pad : 1)); ++rp_) {
#pragma unroll
                for (int m = 0; m < 2; ++m)
#pragma unroll
                    for (int nf = 0; nf < 4; ++nf) acc[m][nf] = (f32x4){0.f, 0.f, 0.f, 0.f};
#pragma unroll
                for (int ks = 0; ks < 8; ++ks) {
#pragma unroll
                    for (int nf = 0; nf < 4; ++nf) {
                        LAS unsigned char* pp = bb + ks * (32 * DW_STR) + ((nf ^ (g4 & 1)) << 5);
                        const s16x4 lo = tr_read(pp), hi = tr_read(pp + 4 * DW_STR);
                        const bf16x8 bf = __builtin_shufflevector(lo, hi, 0, 1, 2, 3, 4, 5, 6, 7);
                        acc[0][nf] = MFMA16(bf, af[0][ks], acc[0][nf]); acc[1][nf] = MFMA16(bf, af[1][ks], acc[1][nf]);
                    }
                }
                }
                u32x4 ow[2];
#pragma unroll
                for (int m = 0; m < 2; ++m) { ow[m].x = pk4_fp8(acc[m][0][0], acc[m][0][1], acc[m][0][2], acc[m][0][3]); ow[m].y = pk4_fp8(acc[m][1][0], acc[m][1][1], acc[m][1][2], acc[m][1][3]);
                    ow[m].z = pk4_fp8(acc[m][2][0], acc[m][2][1], acc[m][2][2], acc[m][2][3]); ow[m].w = pk4_fp8(acc[m][3][0], acc[m][3][1], acc[m][3][2], acc[m][3][3]); }
                const int c3 = cq + 3; const float* b3 = c3 < 16 ? wb : nwb; const int k3 = c3 < 16 ? c3 : c3 - 16;
                if (hc == 0) { DW_WRITE(st, (cc + 1) & 1); DW_LOAD(st, b3, k3); } else { DW_WRITE(st2, (cc + 1) & 1); DW_LOAD(st2, b3, k3); }
#pragma unroll
                for (int m = 0; m < 2; ++m) {
                    const int pos = pos0 + 16 * m;
                    unsigned char* rowp = (pos < lim ? ydense_row(F.ws, pos - shift) : F.ws + WS_SS + (size_t)blockIdx.x * 2048) + 64 * cq + 16 * g4;
                    if (MODE >= 2) asm volatile("" :: "v"(ow[m])); else *(u32x4*)rowp = ow[m];
                }
                __syncthreads();
            }
        }
        if (ntile < 0) break;
        tile = ntile; wb = nwb; ++ui;
        ntile = next_tile(ui + 1); nwb = ntile >= 0 ? wd_base(ntile) : wb;
    }
#undef DW_LOAD
#undef DW_WRITE
}

constexpr int N_PHASES = 13;
__global__ void __launch_bounds__(NTHR, 2) fwd_kernel(Args args) {
    extern __shared__ __attribute__((aligned(16))) unsigned char lds_raw[];
    Frame F;
    F.lds = (LAS unsigned char*)lds_raw; F.ws = args.ws;
    F.tid = threadIdx.x; F.lane = F.tid & 63; F.wave = __builtin_amdgcn_readfirstlane(F.tid >> 6);
    F.G = gridDim.x; { const int bx = blockIdx.x; F.vcu = (F.G % 8 == 0) ? (bx % 8) * (F.G / 8) + bx / 8 : bx; }
    volatile LAS unsigned* MISC = (volatile LAS unsigned*)(F.lds + MISC_OFF);
    for (int u = F.tid; u < (LDS_BYTES - LDSCTL_OFF) / 4; u += NTHR) ((LAS unsigned*)(F.lds + LDSCTL_OFF))[u] = 0u;
    __syncthreads();
    unsigned* ctl = (unsigned*)(F.ws + WS_CTL);
    XcdBarrier bar; bar.bar = ctl + CW_BAR; bar.x = 0; bar.st = nullptr;
    const int lo = args.ph_lo, hi = args.ph_hi;
    if (hi - lo > 1) bar = xcd_barrier_post(ctl + CW_BAR, MISC + 8);
#ifdef ONLY_PHASE
#define IN(k) ((k) == ONLY_PHASE && lo <= (k) && (k) < hi)
#else
#define IN(k) (lo <= (k) && (k) < hi)
#endif
#define SEAM(k) do { if (IN(k) && IN((k) + 1)) xcd_barrier(bar); } while (0)
#ifndef PROBE_PHASE
#define PROBE_PHASE -1
#endif
#define REP(k) _Pragma("unroll 1") for (int rep_ = 0; rep_ < ((k) == PROBE_PHASE ? 2 + args.pad : 1); ++rep_)
    const float* mod = (const float*)(F.ws + WS_MOD);
    bf16_t* HB = (bf16_t*)(F.ws + WS_H);

    if (IN(0)) REP(0) { phase0(F, args); } SEAM(0);
    if (IN(1)) REP(1) { norm_mod_rows(F, args.in[0], args.in[4], mod, 0, DM, nullptr, HB); } SEAM(1);
    if (IN(2)) REP(2) {
        EpiInProj E{F.ws, (const float*)(F.ws + WS_ROPE_C), (const float*)(F.ws + WS_ROPE_S)};
        { pg8::StaticOrder S; S.init(HB, (const bf16_t*)(F.ws + WS_WIN), NTOK, PROJW - 3 * DM, DM, F.G, (int)blockIdx.x, 12);
          pg8::gemm_phase<EpiInProj, pg8::StaticOrder, true>(F.lds, S, E); }
        { pg8::StaticOrder S; S.init(HB, (const bf16_t*)(F.ws + WS_WIN), NTOK, 3 * DM, DM, F.G, (int)blockIdx.x, 0);
          pg8::gemm_phase<EpiInProj, pg8::StaticOrder, true>(F.lds, S, E); }
    } SEAM(2);
    if (IN(3)) {
#ifndef NO_RET
        REP(30) for (int ch = F.vcu; ch < 256; ch += F.G) retention_chain_rs(F, args, ch);
#endif
#ifndef NO_ATT
        const int per = (6144 + F.G - 1) / F.G;
        attention_phase(F, F.vcu * per, (F.vcu + 1) * per < 6144 ? (F.vcu + 1) * per : 6144, args.pad);
#endif
    } SEAM(3);
    if (IN(4)) REP(4) { mixer_post_rows(F); } SEAM(4);
    if (IN(5)) REP(5) {
        pg8::DualOrder S; S.so.init((const bf16_t*)(F.ws + WS_RETN), (const bf16_t*)(F.ws + WS_WRU), NTOK, DM, DM, F.G, (int)blockIdx.x);
        S.A1 = (const bf16_t*)(F.ws + WS_ATTC); S.Bt1 = (const bf16_t*)(F.ws + WS_WAU); S.K = DM;
        EpiMerge E{(bf16_t*)(F.ws + WS_MERGED), F.ws + WS_SGR, F.ws + WS_SGA};
        pg8::gemm_phase<EpiMerge, pg8::DualOrder, true>(F.lds, S, E);
    } SEAM(5);
    if (IN(6)) REP(6) {
        pg8::StaticOrder S; S.init((const bf16_t*)(F.ws + WS_MERGED), (const bf16_t*)(F.ws + WS_WO), NTOK, DM, DM, F.G, (int)blockIdx.x);
        EpiOProj E{args.in[0], args.out, mod, (float*)(F.ws + WS_SS)};
        pg8::gemm_phase<EpiOProj, pg8::StaticOrder, true>(F.lds, S, E);
    } SEAM(6);
    if (IN(7)) REP(7) {
        norm_mod_rows(F, args.out, args.in[11], mod, 3 * DM, 4 * DM, (const float*)(F.ws + WS_SS), HB);
    } SEAM(7);
    if (IN(8)) {
        pg8::StaticOrder S; S.init(HB, (const bf16_t*)(F.ws + WS_WR), NTOK, NEXP, DM, F.G, (int)blockIdx.x);
        EpiF32 E{(float*)(F.ws + WS_LOGIT), NEXP};
        pg8::gemm_phase<EpiF32, pg8::StaticOrder, true>(F.lds, S, E);
        __syncthreads();
        moe_weight_convert(F, args);
    } SEAM(8);
    if (IN(9)) { routing_rows(F, args); } SEAM(9);
    if (IN(10)) { routing_lists(F); } SEAM(10);
    if (IN(11)) REP(11) {
        const int* TILE_E = (const int*)(F.ws + WS_TILE_E); const int ntiles = __builtin_amdgcn_readfirstlane(TILE_E[MAX_TILES]);
        pg8::MoeOrder<true> S; S.A = HB; S.Bt = (const bf16_t*)(F.ws + WS_WGU); S.K = DM; S.e_stride = (size_t)512 * 1024; S.tile_e = (const LAS unsigned short*)(F.lds + MT_OFF); S.rowlist = (const int*)(F.ws + WS_ROWL); moe_tables_to_lds(F, ntiles);
        S.ntiles = ntiles; S.nN = 2; S.nwg = ntiles * 2; S.G = F.G; S.c = (int)blockIdx.x;
        EpiGU E{(bf16_t*)(F.ws + WS_HID)};
        pg8::gemm_phase<EpiGU, pg8::MoeOrder<true>, true>(F.lds, S, E);
    } SEAM(11);
    if (IN(12)) REP(12) {
        down_phase<0>(F, args);
    } SEAM(12);
    if (IN(13)) { final_rows(F, args); }
#if PROBE_LAUNCH == 14
    if (lo == 14) {
        pg8::StaticOrder S; S.init(HB, (const bf16_t*)(F.ws + WS_WIN), NTOK, PROJW, DM, F.G, (int)blockIdx.x);
        EpiNull E{};
        pg8::gemm_phase<EpiNull, pg8::StaticOrder, true>(F.lds, S, E);
    }
#endif
#if PROBE_LAUNCH == 16
    if (lo == 14) {
        const int* TILE_E = (const int*)(F.ws + WS_TILE_E); const int ntiles = __builtin_amdgcn_readfirstlane(TILE_E[MAX_TILES]);
        pg8::MoeOrder<false> S; S.A = (const bf16_t*)(F.ws + WS_HID); S.Bt = (const bf16_t*)(F.ws + WS_WD); S.K = EH; S.e_stride = (size_t)1024 * 256; S.tile_e = (const LAS unsigned short*)(F.lds + MT_OFF); S.rowlist = (const int*)(F.ws + WS_ROWL); moe_tables_to_lds(F, ntiles);
        S.ntiles = ntiles; S.nN = 4; S.nwg = ntiles * 4; S.G = F.G; S.c = (int)blockIdx.x;
        EpiNull E{};
        pg8::gemm_phase<EpiNull, pg8::MoeOrder<false>, true>(F.lds, S, E);
    }
#endif
#if PROBE_LAUNCH == 18
    if (lo == 14) { down_phase<1>(F, args); }
#endif
#if PROBE_LAUNCH == 19
    if (lo == 14) { down_phase<2>(F, args); }
#endif
#if PROBE_LAUNCH == 20
    if (lo == 14) { down_phase<3>(F, args); }
#endif
#if PROBE_LAUNCH == 17
    if (lo == 14) {
        const int* TILE_E = (const int*)(F.ws + WS_TILE_E); const int ntiles = __builtin_amdgcn_readfirstlane(TILE_E[MAX_TILES]);
        pg8::MoeOrder<false> S; S.A = (const bf16_t*)(F.ws + WS_HID); S.Bt = (const bf16_t*)(F.ws + WS_WD); S.K = EH; S.e_stride = (size_t)1024 * 256; S.tile_e = (const LAS unsigned short*)(F.lds + MT_OFF); S.rowlist = (const int*)(F.ws + WS_ROWL); moe_tables_to_lds(F, ntiles);
        S.ntiles = ntiles; S.nN = 4; S.nwg = ntiles * 4; S.G = F.G; S.c = (int)blockIdx.x;
        EpiDownT<1> E{F.ws, (const LAS int*)(F.lds + MT_INFO)};
        pg8::gemm_phase<EpiDownT<1>, pg8::MoeOrder<false>, true>(F.lds, S, E);
    }
#endif
#if PROBE_LAUNCH == 15
    if (lo == 14) {
        pg8::StaticOrder S; S.init(HB, (const bf16_t*)(F.ws + WS_WIN), NTOK, PROJW, DM, F.G, (int)blockIdx.x);
        EpiPlainScratch E{(bf16_t*)(F.ws + WS_OUTF)};
        pg8::gemm_phase<EpiPlainScratch, pg8::StaticOrder, true>(F.lds, S, E);
    }
#endif
#undef IN
#undef SEAM
}

extern "C" void kernel_launch(void* const* d_in, const int* in_sizes, int n_in, void* d_out, int out_size, void* d_ws, size_t ws_size, hipStream_t stream) {
    static int grid = 0;
    if (grid == 0) {
        if (n_in != 21 || out_size != NTOK * DM || ws_size < WS_END) { fprintf(stderr, "kernel_launch: unexpected shapes (n_in %d out %d ws %zu)\n", n_in, out_size, ws_size); grid = -1; return; }
        int dev = 0, cus = 0, per_cu = 0;
        if (hipGetDevice(&dev) != hipSuccess || hipDeviceGetAttribute(&cus, hipDeviceAttributeMultiprocessorCount, dev) != hipSuccess) { grid = -1; return; }
        if (hipFuncSetAttribute((const void*)fwd_kernel, hipFuncAttributeMaxDynamicSharedMemorySize, LDS_BYTES) != hipSuccess) { fprintf(stderr, "kernel_launch: hipFuncSetAttribute failed\n"); grid = -1; return; }
        if (hipOccupancyMaxActiveBlocksPerMultiprocessor(&per_cu, (const void*)fwd_kernel, NTHR, LDS_BYTES) != hipSuccess || per_cu < 1)
            fprintf(stderr, "kernel_launch: note: occupancy query reports %d\n", per_cu);
        (void)hipGetLastError();
        grid = cus;
    }
    if (grid < 0) return;
    (void)hipMemsetAsync((char*)d_ws + WS_CTL, 0, CTL_ZERO_BYTES, stream);
    Args a{};
    for (int i = 0; i < 21; ++i) a.in[i] = (const float*)d_in[i];
    a.out = (float*)d_out; a.ws = (unsigned char*)d_ws;
#if MK_N_LAUNCHES == 1
    a.ph_lo = 0; a.ph_hi = N_PHASES + 1; a.li = 0;
    hipLaunchKernelGGL(fwd_kernel, dim3(grid), dim3(NTHR), LDS_BYTES, stream, a);
#else
    for (int p = 0; p <= N_PHASES; ++p) {
        if ((PROBE_LAUNCH == 18 || PROBE_LAUNCH == 19 || PROBE_LAUNCH == 20) && p == 12) { a.ph_lo = 14; a.ph_hi = 15; hipLaunchKernelGGL(fwd_kernel, dim3(grid), dim3(NTHR), LDS_BYTES, stream, a); }
        a.ph_lo = p; a.ph_hi = p + 1; a.li = p; hipLaunchKernelGGL(fwd_kernel, dim3(grid), dim3(NTHR), LDS_BYTES, stream, a);
        if (p == PROBE_LAUNCH) hipLaunchKernelGGL(fwd_kernel, dim3(grid), dim3(NTHR), LDS_BYTES, stream, a);
        if (((PROBE_LAUNCH == 14 || PROBE_LAUNCH == 15) && p == 2) || ((PROBE_LAUNCH == 16 || PROBE_LAUNCH == 17) && p == 12)) { a.ph_lo = 14; a.ph_hi = 15; hipLaunchKernelGGL(fwd_kernel, dim3(grid), dim3(NTHR), LDS_BYTES, stream, a); } }
#endif
}
```

```cpp
#include <hip/hip_runtime.h>
#include <cstdio>
#include <cstdint>

#ifndef MK_N_LAUNCHES
#define MK_N_LAUNCHES 1
#endif
#define PROBE_LAUNCH -1
#ifndef PROBE_PHASE
#define PROBE_PHASE -1
#endif

#define LAS __attribute__((address_space(3)))
#define GAS __attribute__((address_space(1)))
typedef unsigned short bf16_t;
typedef short bf16x8 __attribute__((ext_vector_type(8)));
typedef short s16x4 __attribute__((ext_vector_type(4)));
typedef float f32x2 __attribute__((ext_vector_type(2)));
typedef float f32x4 __attribute__((ext_vector_type(4)));
typedef float f32x16 __attribute__((ext_vector_type(16)));
typedef unsigned u32x2 __attribute__((ext_vector_type(2)));
typedef unsigned u32x4 __attribute__((ext_vector_type(4)));
typedef __bf16 bf16x2_t __attribute__((ext_vector_type(2)));

constexpr int NB = 8, SEQ = 4096, DM = 1024, NTOK = NB * SEQ;
constexpr int PROJW = 9216, NEXP = 256, TOPK = 8, EH = 256;
constexpr float NORM_EPS = 1e-6f;

constexpr size_t MiB = 1u << 20;
constexpr size_t WS_CTL = 0, CTL_ZERO_BYTES = 1 * MiB;
constexpr size_t WS_MOD = 1 * MiB;
constexpr size_t WS_BTAB = 1 * MiB + 256 * 1024;
constexpr size_t WS_ROPE_C = 2 * MiB, WS_ROPE_S = 4 * MiB;
constexpr size_t WS_SS = 6 * MiB;
constexpr size_t WS_EIDX = 8 * MiB, WS_GATE = 9 * MiB;
constexpr size_t WS_ROWL = 10 * MiB;
constexpr size_t WS_TILE_E = 12 * MiB;
constexpr size_t WS_WIN = 16 * MiB, WS_WRU = 34 * MiB, WS_WAU = 36 * MiB, WS_WO = 38 * MiB, WS_WR = 40 * MiB;
constexpr size_t WS_H = 48 * MiB;
constexpr size_t WS_PROJ = 120 * MiB;
constexpr size_t SEG = 64 * MiB;
constexpr size_t WS_RQ = WS_PROJ, WS_RK = WS_PROJ + SEG, WS_RV = WS_PROJ + 2 * SEG, WS_RG = WS_PROJ + 3 * SEG, WS_AQ = WS_PROJ + 4 * SEG,
                 WS_AK = WS_PROJ + 5 * SEG, WS_AV = WS_PROJ + 6 * SEG, WS_SGR = WS_PROJ + 7 * SEG, WS_SGA = WS_PROJ + 8 * SEG;
constexpr size_t WS_OUTF = 696 * MiB, WS_OUTB = 760 * MiB, WS_OG = 824 * MiB, WS_LSE = 1016 * MiB;
constexpr size_t WS_RETN = WS_RQ, WS_ATTC = WS_RK, WS_YR = WS_RV, WS_MERGED = WS_AQ;
constexpr size_t WS_WGU = 120 * MiB, WS_WD = 377 * MiB, WS_HID = 512 * MiB, WS_LOGIT = 696 * MiB;
constexpr size_t WS_X1B = 448 * MiB;
constexpr size_t WS_END = 1022 * MiB;
constexpr int YD_SPLIT = 262144, YD_SHARED0 = NTOK * TOPK;
constexpr float YD_SCALE = 16.0f, YD_INV = 0.0625f;
__device__ __forceinline__ unsigned char* ydense_row(unsigned char* ws, int row) { return ws + (row < YD_SPLIT ? 120 * MiB : 696 * MiB) + (size_t)(row < YD_SPLIT ? row : row - YD_SPLIT) * DM; }
__device__ __forceinline__ unsigned pk4_fp8(float a, float b, float c, float d) {
    a = __builtin_fminf(__builtin_fmaxf(a * YD_SCALE, -448.f), 448.f); b = __builtin_fminf(__builtin_fmaxf(b * YD_SCALE, -448.f), 448.f);
    c = __builtin_fminf(__builtin_fmaxf(c * YD_SCALE, -448.f), 448.f); d = __builtin_fminf(__builtin_fmaxf(d * YD_SCALE, -448.f), 448.f);
    int w = __builtin_amdgcn_cvt_pk_fp8_f32(a, b, 0, false); w = __builtin_amdgcn_cvt_pk_fp8_f32(c, d, w, true); return (unsigned)w;
}
constexpr size_t WS_DPOS = 13 * MiB;
constexpr int CW_TMO = 0, CW_BAR = 4096, CW_CNT = 16384, CW_FILL = 16384 + 1024;
constexpr int MAX_TILES = 2048;

__device__ __forceinline__ unsigned cvtpk(float lo, float hi) { f32x2 v = {lo, hi}; bf16x2_t b = __builtin_convertvector(v, bf16x2_t); return __builtin_bit_cast(unsigned, b); }
__device__ __forceinline__ float bf2f(unsigned short u) { return __uint_as_float((unsigned)u << 16); }
__device__ __forceinline__ float bflo(unsigned u) { return __uint_as_float(u << 16); }
__device__ __forceinline__ float bfhi(unsigned u) { return __uint_as_float(u & 0xffff0000u); }
__device__ __forceinline__ float wave_sum(float v) {
#pragma unroll
    for (int o = 1; o < 64; o <<= 1) v += __shfl_xor(v, o);
    return v;
}
__device__ __forceinline__ float sigmoidf_(float x) { return __builtin_amdgcn_rcpf(1.f + __builtin_amdgcn_exp2f(x * -1.4426950408889634f)); }
__device__ __forceinline__ float siluf_(float x) { return x * __builtin_amdgcn_rcpf(1.f + __builtin_amdgcn_exp2f(x * -1.4426950408889634f)); }

namespace pg8 {
constexpr int BM = 256, BK = 64, HALF = 128, HTB = HALF * BK * 2, STAGE_BYTES = 8 * HTB, NXCD = 8, WGM = 8;
__host__ __device__ __forceinline__ int lds_byte(int r, int c) { const int st = (r >> 4) * 2 + (c >> 5), rr = r & 15, cc = c & 31, ob = rr * 64 + cc * 2; return st * 1024 + (ob ^ (((ob >> 9) & 1) << 5)); }
__host__ __device__ __forceinline__ void stage_rc(int b, int& R, int& C) { const int st = b / 1024, sb = b % 1024, swz = sb ^ (((sb >> 9) & 1) << 5); R = (st >> 1) * 16 + swz / 64; C = (st & 1) * 32 + (swz % 64) / 2; }
__host__ __device__ __forceinline__ int perm32(int rho) { const int n = rho >> 4, i = rho & 15; return 8 * (i >> 2) + 4 * n + (i & 3); }

struct Unit { int pm, pn, e; };

__device__ __forceinline__ int xcd_remap(int L, int nwg) { const int q = nwg / NXCD, r = nwg % NXCD, xcd = L % NXCD, off = L / NXCD; return (xcd < r ? xcd * (q + 1) : r * (q + 1) + (xcd - r) * q) + off; }

struct StaticOrder {
    static constexpr bool GATHER = false, DUAL = false;
    const bf16_t* A; const bf16_t* Bt; int K;
    int nM, nN, nwg, G, c, pn_off;
    __device__ void init(const bf16_t* A_, const bf16_t* Bt_, int M, int N, int K_, int G_, int c_, int pn_off_ = 0) { A = A_; Bt = Bt_; K = K_; nM = M / BM; nN = N / BM; nwg = nM * nN; G = G_; c = c_; pn_off = pn_off_; }
    __device__ bool next(int i, Unit& u) const {
        const long L = (long)i * G + c; if (L >= nwg) return false;
        const int wgid = xcd_remap((int)L, nwg);
        const int nig = WGM * nN, gid = wgid / nig, fm = gid * WGM, gsz = (nM - fm) < WGM ? (nM - fm) : WGM;
        u.pm = fm + ((wgid % nig) % gsz); u.pn = (wgid % nig) / gsz + pn_off; u.e = 0; return true;
    }
    __device__ __forceinline__ const char* a_base(const Unit& u) const { return (const char*)A + (size_t)u.pm * (size_t)(BM * 2) * K; }
    __device__ __forceinline__ const char* b_base(const Unit& u) const { return (const char*)Bt + (size_t)u.pn * (size_t)(BM * 2) * K; }
    __device__ __forceinline__ unsigned a_row(const Unit&, int) const { return 0u; }
};

struct DualOrder {
    static constexpr bool GATHER = false, DUAL = true;
    StaticOrder so; const bf16_t* A1; const bf16_t* Bt1; int K;
    __device__ bool next(int i, Unit& u) const { if (!so.next(i >> 1, u)) return false; u.e = i & 1; return true; }
    __device__ __forceinline__ const char* a_base(const Unit& u) const { return (const char*)(u.e ? A1 : so.A) + (size_t)u.pm * (size_t)(BM * 2) * K; }
    __device__ __forceinline__ const char* b_base(const Unit& u) const { return (const char*)(u.e ? Bt1 : so.Bt) + (size_t)u.pn * (size_t)(BM * 2) * K; }
    __device__ __forceinline__ unsigned a_row(const Unit&, int) const { return 0u; }
};

template <bool GATHER_>
struct MoeOrder {
    static constexpr bool GATHER = GATHER_, DUAL = false;
    const bf16_t* A; const bf16_t* Bt; int K; size_t e_stride;
    const LAS unsigned short* tile_e; const int* rowlist; int ntiles, nN, nwg, G, c;
    __device__ bool next(int i, Unit& u) const {
        const long L = (long)i * G + c; if (L >= nwg) return false;
        const int wgid = xcd_remap((int)L, nwg);
        u.pm = wgid / nN; u.pn = wgid % nN; u.e = __builtin_amdgcn_readfirstlane((int)tile_e[u.pm]); return true;
    }
    __device__ __forceinline__ const char* a_base(const Unit& u) const { return GATHER ? (const char*)A : (const char*)A + (size_t)u.pm * (size_t)(BM * 2) * K; }
    __device__ __forceinline__ const char* b_base(const Unit& u) const { return (const char*)Bt + ((size_t)u.e * e_stride + (size_t)u.pn * BM * K) * 2; }
    __device__ __forceinline__ unsigned a_row(const Unit& u, int r) const { const int ent = rowlist[(size_t)u.pm * BM + r]; return ent < 0 ? (unsigned)NTOK : (unsigned)(ent >> 4); }
};

template <class Epi, class Sched, bool ALIGN_EPI>
__device__ __forceinline__ void gemm_phase(LAS unsigned char* lds, const Sched& S, const Epi& E) {
    const int tid = threadIdx.x, wid = __builtin_amdgcn_readfirstlane(tid >> 6), lane = tid & 63, wr = wid >> 2, wc = wid & 3, fr = lane & 15, fq = lane >> 4;
    const int K = S.K, nt = K / BK;
    unsigned voffA[2], voffB[2]; int RA[2]; unsigned CA2[2];
#pragma unroll
    for (int i = 0; i < 2; ++i) { int R, C; stage_rc(tid * 16 + i * 8192, R, C); const int Rb = Epi::PERM ? ((R & ~31) + perm32(R & 31)) : R;
        voffA[i] = (unsigned)(R * K + C) * 2u; voffB[i] = (unsigned)(Rb * K + C) * 2u; RA[i] = R; CA2[i] = (unsigned)C * 2u; }
    const size_t kstep = (size_t)(BK * 2);
    const size_t hstep = (size_t)HALF * K * 2;
    const unsigned ldsw = (unsigned)wid * 1024u;
    const int aoff = lds_byte(wr * 64 + fr, fq * 8), boff = lds_byte(wc * 32 + fr, fq * 8);
    unsigned gC[2][2], gN[2][2];
#define PG8_SA(b, h) (((b) * 2 + (h)) * HTB)
#define PG8_SB(b, h) ((4 + (b) * 2 + (h)) * HTB)
#define PG8_STAGE(bufoff, gbase, voff) do { _Pragma("unroll") for (int _i = 0; _i < 2; ++_i) \
        __builtin_amdgcn_global_load_lds((const unsigned*)((const char*)(gbase) + (voff)[_i]), (LAS unsigned*)(lds + (bufoff) + ldsw + _i * 8192), 16, 0, 0); } while (0)
#define PG8_STAGE_A(bufoff, p, h, NX) do { if constexpr (Sched::GATHER) { _Pragma("unroll") for (int _i = 0; _i < 2; ++_i) { const unsigned _v = (NX) ? gN[h][_i] : gC[h][_i]; \
        __builtin_amdgcn_global_load_lds((const unsigned*)((const char*)(p) + _v), (LAS unsigned*)(lds + (bufoff) + ldsw + _i * 8192), 16, 0, 0); } } \
        else { PG8_STAGE(bufoff, (p) + (h) * hstep, voffA); } } while (0)
#define PG8_GATHER_SET(g, u) do { _Pragma("unroll") for (int _h = 0; _h < 2; ++_h) _Pragma("unroll") for (int _i = 0; _i < 2; ++_i) \
        g[_h][_i] = S.a_row(u, _h * HALF + RA[_i]) * (unsigned)(K * 2) + CA2[_i]; } while (0)
#define PG8_LDA(dst, b, h) do { _Pragma("unroll") for (int m = 0; m < 4; ++m) _Pragma("unroll") for (int k = 0; k < 2; ++k) dst[m][k] = *(const LAS bf16x8*)(lds + PG8_SA(b, h) + aoff + m * 2048 + k * 1024); } while (0)
#define PG8_LDB(dst, b, h) do { _Pragma("unroll") for (int n = 0; n < 2; ++n) _Pragma("unroll") for (int k = 0; k < 2; ++k) dst[n][k] = *(const LAS bf16x8*)(lds + PG8_SB(b, h) + boff + n * 2048 + k * 1024); } while (0)
#define PG8_MMA(ai, bj, At, Bt) do { __builtin_amdgcn_s_setprio(1); _Pragma("unroll") for (int m = 0; m < 4; ++m) _Pragma("unroll") for (int n = 0; n < 2; ++n) _Pragma("unroll") for (int k = 0; k < 2; ++k) \
        acc[ai][bj][m][n] = __builtin_amdgcn_mfma_f32_16x16x32_bf16(Bt[n][k], At[m][k], acc[ai][bj][m][n], 0, 0, 0); __builtin_amdgcn_s_setprio(0); } while (0)
#define PG8_WAIT_V(n) asm volatile("s_waitcnt vmcnt(" #n ")" ::: "memory")
#define PG8_WAIT_L(n) asm volatile("s_waitcnt lgkmcnt(" #n ")" ::: "memory")
#define PG8_BAR __builtin_amdgcn_s_barrier()
#define PG8_SCHED __builtin_amdgcn_sched_barrier(0)
    Unit cur, nxt; int ui = 0;
    if (!S.next(0, cur)) return;
    f32x4 acc[2][2][4][2];
#pragma unroll
    for (int a = 0; a < 2; ++a)
#pragma unroll
        for (int b = 0; b < 2; ++b)
#pragma unroll
            for (int m = 0; m < 4; ++m)
#pragma unroll
                for (int n = 0; n < 2; ++n) acc[a][b][m][n] = (f32x4){0.f, 0.f, 0.f, 0.f};
    bf16x8 At[4][2], B0[2][2], B1[2][2];
    const char* cA = S.a_base(cur); const char* cB = S.b_base(cur);
    if constexpr (Sched::GATHER) { PG8_GATHER_SET(gC, cur); PG8_GATHER_SET(gN, cur); }
    PG8_STAGE(PG8_SB(0, 0), cB, voffB); PG8_STAGE(PG8_SB(0, 1), cB + hstep, voffB); PG8_STAGE_A(PG8_SA(0, 0), cA, 0, false); PG8_STAGE_A(PG8_SA(0, 1), cA, 1, false);
    if (wr == 1) PG8_BAR;
    PG8_WAIT_V(2); PG8_BAR;
    PG8_STAGE(PG8_SB(1, 0), cB + kstep, voffB); PG8_STAGE_A(PG8_SA(1, 0), cA + kstep, 0, false); PG8_STAGE(PG8_SB(1, 1), cB + hstep + kstep, voffB);
    PG8_WAIT_V(6); PG8_BAR;
    for (;;) {
        const bool has_next = S.next(ui + 1, nxt);
        const char* nA = has_next ? S.a_base(nxt) : cA; const char* nB = has_next ? S.b_base(nxt) : cB;
        if constexpr (Sched::GATHER) { if (has_next) { PG8_GATHER_SET(gN, nxt); } }
        for (int t = 0; t < nt; t += 2) {
            const bool last = (t == nt - 2);
            const char* a1 = cA + (size_t)(t + 1) * kstep;
            const char* a2 = last ? nA : cA + (size_t)(t + 2) * kstep; const char* b2 = last ? nB : cB + (size_t)(t + 2) * kstep;
            const char* a3 = a2 + kstep; const char* b3 = b2 + kstep;
            PG8_LDB(B0, 0, 0); PG8_LDB(B1, 0, 1); PG8_SCHED; PG8_LDA(At, 0, 0); PG8_STAGE_A(PG8_SA(1, 1), a1, 1, false);
            PG8_WAIT_V(8); PG8_WAIT_L(0); PG8_BAR; PG8_MMA(0, 0, At, B0); PG8_MMA(0, 1, At, B1); PG8_BAR; PG8_SCHED;
            PG8_LDA(At, 0, 1); PG8_STAGE(PG8_SB(0, 0), b2, voffB); PG8_STAGE(PG8_SB(0, 1), b2 + hstep, voffB); PG8_STAGE_A(PG8_SA(0, 0), a2, 0, last);
            PG8_WAIT_V(8); PG8_WAIT_L(0); PG8_BAR; PG8_MMA(1, 0, At, B0); PG8_MMA(1, 1, At, B1); PG8_BAR; PG8_SCHED;
            PG8_LDB(B0, 1, 0); PG8_LDB(B1, 1, 1); PG8_SCHED; PG8_LDA(At, 1, 0); PG8_STAGE_A(PG8_SA(0, 1), a2, 1, last);
            PG8_WAIT_V(8); PG8_WAIT_L(0); PG8_BAR; PG8_MMA(0, 0, At, B0); PG8_MMA(0, 1, At, B1); PG8_BAR; PG8_SCHED;
            PG8_LDA(At, 1, 1); PG8_STAGE(PG8_SB(1, 0), b3, voffB); PG8_STAGE(PG8_SB(1, 1), b3 + hstep, voffB); PG8_STAGE_A(PG8_SA(1, 0), a3, 0, last);
            PG8_WAIT_V(8); PG8_WAIT_L(0); PG8_BAR; PG8_MMA(1, 0, At, B0); PG8_MMA(1, 1, At, B1); PG8_BAR; PG8_SCHED;
        }
        if constexpr (ALIGN_EPI) { if (wr == 0) PG8_BAR; }
        E(acc, cur, wr, wc, fr, fq);
        if (!has_next) break;
        if (!(Sched::DUAL && cur.e == 0))
#pragma unroll
        for (int a = 0; a < 2; ++a)
#pragma unroll
            for (int b = 0; b < 2; ++b)
#pragma unroll
                for (int m = 0; m < 4; ++m)
#pragma unroll
                    for (int n = 0; n < 2; ++n) acc[a][b][m][n] = (f32x4){0.f, 0.f, 0.f, 0.f};
        cur = nxt; cA = nA; cB = nB; ++ui;
        if constexpr (Sched::GATHER) {
#pragma unroll
            for (int h = 0; h < 2; ++h)
#pragma unroll
                for (int i = 0; i < 2; ++i) gC[h][i] = gN[h][i];
        }
        if constexpr (ALIGN_EPI) { if (wr == 1) PG8_BAR; }
    }
    PG8_WAIT_V(0);
    if constexpr (!ALIGN_EPI) { if (wr == 0) PG8_BAR; }
    PG8_BAR;
#undef PG8_SA
#undef PG8_SB
#undef PG8_STAGE
#undef PG8_STAGE_A
#undef PG8_GATHER_SET
#undef PG8_LDA
#undef PG8_LDB
#undef PG8_MMA
#undef PG8_WAIT_V
#undef PG8_WAIT_L
#undef PG8_BAR
#undef PG8_SCHED
}
}

typedef GAS unsigned gu32;
#define RLX_AGENT __ATOMIC_RELAXED, __HIP_MEMORY_SCOPE_AGENT
#define XB_TMO      128
#define XB_XCNT(j)  (256  + 64 * (j))
#define XB_XSUB(j)  (1280 + 64 * (j))
#define XB_XGEN(j)  (2304 + 64 * (j))
#define XB_TOP      3328
#define XB_TOPGEN   3392
#define XCD_BAR_WORDS 3456
#define XB_SPIN_CAP (1u << 18)
__device__ __forceinline__ unsigned xb_ld(unsigned* p)              { return __hip_atomic_load(p, __ATOMIC_RELAXED, __HIP_MEMORY_SCOPE_AGENT); }
__device__ __forceinline__ unsigned xb_add(unsigned* p, unsigned v) { return __hip_atomic_fetch_add(p, v, __ATOMIC_RELAXED, __HIP_MEMORY_SCOPE_AGENT); }
__device__ __forceinline__ unsigned xb_xcc_id() { return (unsigned)__builtin_amdgcn_s_getreg((3 << 11) | 20) & 0xFu; }
#define XB_SPIN(cond, bar) do { unsigned _sp = 0; while (cond) { __builtin_amdgcn_s_sleep(1); \
    if ((++_sp & 255u) == 0u) { if (xb_ld(&(bar)[XB_TMO])) break; if (_sp > XB_SPIN_CAP) { atomicAdd(&(bar)[XB_TMO], 1u); break; } } } } while (0)
struct XcdBarrier { unsigned* bar; unsigned x; volatile LAS unsigned* st; };
__device__ __forceinline__ XcdBarrier xcd_barrier_post(unsigned* bar, volatile LAS unsigned* st) {
    XcdBarrier b; b.bar = bar; b.x = xb_xcc_id(); b.st = st;
    if (threadIdx.x == 0) (void)xb_add(&bar[XB_XCNT(b.x)], 1u);
    return b;
}
__device__ __forceinline__ void xcd_barrier_complete(unsigned* bar, unsigned x, unsigned& nloc, unsigned& nx) {
    const unsigned G = gridDim.x * gridDim.y * gridDim.z;
    unsigned sum, cnt, mine, sp = 0u;
    for (;;) {
        sum = 0u; cnt = 0u; mine = 0u;
#pragma unroll
        for (unsigned j = 0; j < 16; ++j) { const unsigned c = xb_ld(&bar[XB_XCNT(j)]); sum += c; cnt += (c > 0u) ? 1u : 0u; mine = (j == x) ? c : mine; }
        if (sum == G) break;
        __builtin_amdgcn_s_sleep(1);
        if ((++sp & 255u) == 0u) { if (xb_ld(&bar[XB_TMO])) break; if (sp > XB_SPIN_CAP) { atomicAdd(&bar[XB_TMO], 1u); break; } }
    }
    nloc = mine > 0u ? mine : 1u; nx = cnt > 0u ? cnt : 1u;
}
__device__ __forceinline__ void xcd_barrier(const XcdBarrier& b) {
    asm volatile("s_waitcnt vmcnt(0)" ::: "memory");
    __syncthreads();
    if (threadIdx.x == 0) {
        unsigned* bar = b.bar;
        __builtin_amdgcn_s_waitcnt(0);
        unsigned nloc = b.st[0], nx = b.st[1];
        if (nloc == 0u) { xcd_barrier_complete(bar, b.x, nloc, nx); b.st[0] = nloc; b.st[1] = nx; }
        const unsigned old = xb_add(&bar[XB_XSUB(b.x)], 1u);
        const unsigned gen = old / nloc;
        if (old + 1u == (gen + 1u) * nloc) {
            __builtin_amdgcn_fence(__ATOMIC_RELEASE, "agent");
            asm volatile("s_waitcnt vmcnt(0)" ::: "memory");
            const unsigned og = xb_add(&bar[XB_TOP], 1u);
            const unsigned tg = og / nx;
            if (og + 1u == (tg + 1u) * nx) xb_add(&bar[XB_TOPGEN], 1u);
            else XB_SPIN(xb_ld(&bar[XB_TOPGEN]) == tg, bar);
            __builtin_amdgcn_fence(__ATOMIC_ACQUIRE, "agent");
            xb_add(&bar[XB_XGEN(b.x)], 1u);
            asm volatile("s_waitcnt vmcnt(0)" ::: "memory");
        } else {
            XB_SPIN(xb_ld(&bar[XB_XGEN(b.x)]) == gen, bar);
            __builtin_amdgcn_fence(__ATOMIC_ACQUIRE, "agent");
            asm volatile("s_waitcnt vmcnt(0)" ::: "memory");
        }
    }
    __syncthreads();
}

constexpr int NWAVES = 8, NTHR = 512;
constexpr int LDS_BYTES = 147456, LDSCTL_OFF = LDS_BYTES - 1024, MISC_OFF = LDSCTL_OFF + 320;

struct Args { const float* in[21]; float* out; unsigned char* ws; int ph_lo, ph_hi, li, pad; };

struct Frame {
    LAS unsigned char* lds;
    unsigned char* ws;
    int tid, lane, wave, vcu, G;
};

struct EpiInProj {
    static constexpr bool PERM = true;
    unsigned char* ws; const float* rc; const float* rs;
    __device__ __forceinline__ void operator()(const f32x4 (&acc)[2][2][4][2], const pg8::Unit& u, int wr, int wc, int fr, int fq) const {
        const int seg = u.pn >> 2;
        bf16_t* O = (bf16_t*)(ws + WS_PROJ + (size_t)seg * SEG);
        const int colt = (u.pn & 3) * 256;
        const int row0 = u.pm * 256 + wr * 64 + fr;
        const int d = wc * 32 + 8 * fq;
#pragma unroll
        for (int ai = 0; ai < 2; ++ai)
#pragma unroll
            for (int m = 0; m < 4; ++m) {
                const int row = row0 + ai * 128 + m * 16;
                f32x4 v00 = acc[ai][0][m][0], v01 = acc[ai][0][m][1], v10 = acc[ai][1][m][0], v11 = acc[ai][1][m][1];
                if (seg <= 1) {
                    const int pos = row & (SEQ - 1);
                    const f32x4 c0 = *(const f32x4*)(rc + (size_t)pos * 128 + d), c1 = *(const f32x4*)(rc + (size_t)pos * 128 + d + 4);
                    const f32x4 s0 = *(const f32x4*)(rs + (size_t)pos * 128 + d), s1 = *(const f32x4*)(rs + (size_t)pos * 128 + d + 4);
                    const float sc = seg == 1 ? 0.0625f : 1.0f;
                    const f32x4 a0 = (v00 * c0 - v10 * s0) * sc, a1 = (v01 * c1 - v11 * s1) * sc, b0 = (v00 * s0 + v10 * c0) * sc, b1 = (v01 * s1 + v11 * c1) * sc;
                    v00 = a0; v01 = a1; v10 = b0; v11 = b1;
                } else if (seg == 3) {
#pragma unroll
                    for (int i = 0; i < 4; ++i) { v00[i] = siluf_(v00[i]); v01[i] = siluf_(v01[i]); v10[i] = siluf_(v10[i]); v11[i] = siluf_(v11[i]); }
                } else if (seg == 4) { const float q = 0.18033688011112042f; v00 = v00 * q; v01 = v01 * q; v10 = v10 * q; v11 = v11 * q; }
                else if (seg >= 7) {
#pragma unroll
                    for (int i = 0; i < 4; ++i) { v00[i] = sigmoidf_(v00[i]); v01[i] = sigmoidf_(v01[i]); v10[i] = sigmoidf_(v10[i]); v11[i] = sigmoidf_(v11[i]); }
                }
                u32x4 w0, w1; w0.x = cvtpk(v00[0], v00[1]); w0.y = cvtpk(v00[2], v00[3]); w0.z = cvtpk(v01[0], v01[1]); w0.w = cvtpk(v01[2], v01[3]);
                w1.x = cvtpk(v10[0], v10[1]); w1.y = cvtpk(v10[2], v10[3]); w1.z = cvtpk(v11[0], v11[1]); w1.w = cvtpk(v11[2], v11[3]);
                if (seg == 0) {
                    const int pos = row & (SEQ - 1), il = pos & 127;
                    bf16_t* blkp = O + ((((size_t)(row >> 12) * 4 + (u.pn & 3)) * 32 + (pos >> 7)) * 4 + (il >> 5)) * 8192 + (size_t)(((d >> 3) & 1) * 32 + (il & 31)) * 8;
                    *(u32x4*)(blkp + (d >> 4) * 512) = w0; *(u32x4*)(blkp + ((d >> 4) + 8) * 512) = w1;
                } else if (seg <= 2) { bf16_t* rowp = O + (size_t)row * DM + colt + d; *(u32x4*)rowp = w0; *(u32x4*)(rowp + 128) = w1; }
                else {
                    unsigned char* rowp = (unsigned char*)O + (size_t)row * DM + colt + d;
                    u32x2 f0, f1; f0.x = pk4_fp8(v00[0], v00[1], v00[2], v00[3]); f0.y = pk4_fp8(v01[0], v01[1], v01[2], v01[3]);
                    f1.x = pk4_fp8(v10[0], v10[1], v10[2], v10[3]); f1.y = pk4_fp8(v11[0], v11[1], v11[2], v11[3]);
                    *(u32x2*)rowp = f0; *(u32x2*)(rowp + 128) = f1; }
            }
    }
};
template <bool ADD> struct EpiGateBf16 {
    static constexpr bool PERM = true;
    bf16_t* O; const bf16_t* Gt; const bf16_t* P;
    __device__ __forceinline__ void operator()(const f32x4 (&acc)[2][2][4][2], const pg8::Unit& u, int wr, int wc, int fr, int fq) const {
        const int row0 = u.pm * 256 + wr * 64 + fr, col0 = u.pn * 256 + wc * 32 + 8 * fq;
#pragma unroll
        for (int ai = 0; ai < 2; ++ai)
#pragma unroll
            for (int m = 0; m < 4; ++m) {
                const size_t ro = (size_t)(row0 + ai * 128 + m * 16) * DM + col0;
#pragma unroll
                for (int bj = 0; bj < 2; ++bj) {
                    const u32x4 g = *(const u32x4*)(Gt + ro + bj * 128);
                    f32x4 v0 = acc[ai][bj][m][0], v1 = acc[ai][bj][m][1];
                    v0[0] *= bflo(g.x); v0[1] *= bfhi(g.x); v0[2] *= bflo(g.y); v0[3] *= bfhi(g.y);
                    v1[0] *= bflo(g.z); v1[1] *= bfhi(g.z); v1[2] *= bflo(g.w); v1[3] *= bfhi(g.w);
                    if (ADD) { const u32x4 p = *(const u32x4*)(P + ro + bj * 128);
                        v0[0] += bflo(p.x); v0[1] += bfhi(p.x); v0[2] += bflo(p.y); v0[3] += bfhi(p.y);
                        v1[0] += bflo(p.z); v1[1] += bfhi(p.z); v1[2] += bflo(p.w); v1[3] += bfhi(p.w); }
                    u32x4 w; w.x = cvtpk(v0[0], v0[1]); w.y = cvtpk(v0[2], v0[3]); w.z = cvtpk(v1[0], v1[1]); w.w = cvtpk(v1[2], v1[3]);
                    *(u32x4*)(O + ro + bj * 128) = w;
                }
            }
    }
};
struct EpiMerge {
    static constexpr bool PERM = true;
    bf16_t* O; const unsigned char* Gr; const unsigned char* Ga;
    __device__ __forceinline__ void operator()(f32x4 (&acc)[2][2][4][2], const pg8::Unit& u, int wr, int wc, int fr, int fq) const {
        const int row0 = u.pm * 256 + wr * 64 + fr, col0 = u.pn * 256 + wc * 32 + 8 * fq;
#pragma unroll
        for (int ai = 0; ai < 2; ++ai)
#pragma unroll
            for (int m = 0; m < 4; ++m) {
                const size_t ro = (size_t)(row0 + ai * 128 + m * 16) * DM + col0;
#pragma unroll
                for (int bj = 0; bj < 2; ++bj) {
                    const u32x2 ga = *(const u32x2*)(Ga + ro + bj * 128);
                    const f32x2 ga0 = __builtin_amdgcn_cvt_pk_f32_fp8((int)ga.x, false), ga1 = __builtin_amdgcn_cvt_pk_f32_fp8((int)ga.x, true), ga2 = __builtin_amdgcn_cvt_pk_f32_fp8((int)ga.y, false), ga3 = __builtin_amdgcn_cvt_pk_f32_fp8((int)ga.y, true);
                    f32x4 a0 = (f32x4){ga0.x, ga0.y, ga1.x, ga1.y} * YD_INV, a1 = (f32x4){ga2.x, ga2.y, ga3.x, ga3.y} * YD_INV;
                    if (u.e == 0) {
                        const u32x2 gr = *(const u32x2*)(Gr + ro + bj * 128);
                        const f32x2 gr0 = __builtin_amdgcn_cvt_pk_f32_fp8((int)gr.x, false), gr1 = __builtin_amdgcn_cvt_pk_f32_fp8((int)gr.x, true), gr2 = __builtin_amdgcn_cvt_pk_f32_fp8((int)gr.y, false), gr3 = __builtin_amdgcn_cvt_pk_f32_fp8((int)gr.y, true);
                        const f32x4 r0 = (f32x4){gr0.x, gr0.y, gr1.x, gr1.y} * YD_INV, r1 = (f32x4){gr2.x, gr2.y, gr3.x, gr3.y} * YD_INV;
#pragma unroll
                        for (int i = 0; i < 4; ++i) { acc[ai][bj][m][0][i] *= r0[i] * __builtin_amdgcn_rcpf(fmaxf(a0[i], 1e-30f)); acc[ai][bj][m][1][i] *= r1[i] * __builtin_amdgcn_rcpf(fmaxf(a1[i], 1e-30f)); }
                    } else {
                        const f32x4 v0 = acc[ai][bj][m][0] * a0, v1 = acc[ai][bj][m][1] * a1;
                        u32x4 w; w.x = cvtpk(v0[0], v0[1]); w.y = cvtpk(v0[2], v0[3]); w.z = cvtpk(v1[0], v1[1]); w.w = cvtpk(v1[2], v1[3]);
                        *(u32x4*)(O + ro + bj * 128) = w;
                    }
                }
            }
    }
};
struct EpiOProj {
    static constexpr bool PERM = true;
    const float* x; bf16_t* x1; const float* mod; float* ss;
    __device__ __forceinline__ void operator()(const f32x4 (&acc)[2][2][4][2], const pg8::Unit& u, int wr, int wc, int fr, int fq) const {
        const int row0 = u.pm * 256 + wr * 64 + fr, col0 = u.pn * 256 + wc * 32 + 8 * fq;
        const int b = (u.pm * 256) / SEQ;
        f32x4 gm[2][2];
#pragma unroll
        for (int bj = 0; bj < 2; ++bj)
#pragma unroll
            for (int n = 0; n < 2; ++n) gm[bj][n] = *(const f32x4*)(mod + (size_t)b * 6144 + 2 * DM + col0 + bj * 128 + n * 4);
#pragma unroll
        for (int ai = 0; ai < 2; ++ai)
#pragma unroll
            for (int m = 0; m < 4; ++m) {
                const int row = row0 + ai * 128 + m * 16;
                const size_t ro = (size_t)row * DM + col0; float sq = 0.f;
#pragma unroll
                for (int bj = 0; bj < 2; ++bj) {
                    const f32x4 xa = *(const f32x4*)(x + ro + bj * 128), xb = *(const f32x4*)(x + ro + bj * 128 + 4);
                    const f32x4 o0 = xa + gm[bj][0] * acc[ai][bj][m][0], o1 = xb + gm[bj][1] * acc[ai][bj][m][1];
                    u32x4 w; w.x = cvtpk(o0[0], o0[1]); w.y = cvtpk(o0[2], o0[3]); w.z = cvtpk(o1[0], o1[1]); w.w = cvtpk(o1[2], o1[3]);
                    *(u32x4*)(x1 + ro + bj * 128) = w;
                    sq += (o0[0] * o0[0] + o0[1] * o0[1]) + (o0[2] * o0[2] + o0[3] * o0[3]) + (o1[0] * o1[0] + o1[1] * o1[1]) + (o1[2] * o1[2] + o1[3] * o1[3]); }
                sq += __shfl_xor(sq, 16); sq += __shfl_xor(sq, 32);
                if (fq == 0) ss[(size_t)row * 16 + u.pn * 4 + wc] = sq;
            }
    }
};
struct EpiF32 {
    static constexpr bool PERM = false;
    float* C; int ldc;
    __device__ __forceinline__ void operator()(const f32x4 (&acc)[2][2][4][2], const pg8::Unit& u, int wr, int wc, int fr, int fq) const {
        const int row0 = u.pm * 256 + wr * 64 + fr, col0 = u.pn * 256 + wc * 32 + 4 * fq;
#pragma unroll
        for (int ai = 0; ai < 2; ++ai)
#pragma unroll
            for (int m = 0; m < 4; ++m) { float* rowp = C + (size_t)(row0 + ai * 128 + m * 16) * ldc + col0;
#pragma unroll
                for (int bj = 0; bj < 2; ++bj)
#pragma unroll
                    for (int n = 0; n < 2; ++n) *(f32x4*)(rowp + bj * 128 + n * 16) = acc[ai][bj][m][n]; }
    }
};
struct EpiPlainScratch {
    static constexpr bool PERM = true;
    bf16_t* O;
    __device__ __forceinline__ void operator()(const f32x4 (&acc)[2][2][4][2], const pg8::Unit& u, int wr, int wc, int fr, int fq) const {
        const int row0 = u.pm * 256 + wr * 64 + fr, col0 = (u.pn & 3) * 256 + wc * 32 + 8 * fq;
#pragma unroll
        for (int ai = 0; ai < 2; ++ai)
#pragma unroll
            for (int m = 0; m < 4; ++m) { bf16_t* rowp = O + (size_t)(row0 + ai * 128 + m * 16) * DM + col0;
#pragma unroll
                for (int bj = 0; bj < 2; ++bj) { const f32x4 v0 = acc[ai][bj][m][0], v1 = acc[ai][bj][m][1];
                    u32x4 w; w.x = cvtpk(v0[0], v0[1]); w.y = cvtpk(v0[2], v0[3]); w.z = cvtpk(v1[0], v1[1]); w.w = cvtpk(v1[2], v1[3]); *(u32x4*)(rowp + bj * 128) = w; } }
    }
};
struct EpiNull {
    static constexpr bool PERM = false;
    __device__ __forceinline__ void operator()(const f32x4 (&acc)[2][2][4][2], const pg8::Unit&, int, int, int, int) const {
#pragma unroll
        for (int ai = 0; ai < 2; ++ai)
#pragma unroll
            for (int bj = 0; bj < 2; ++bj)
#pragma unroll
                for (int m = 0; m < 4; ++m)
#pragma unroll
                    for (int n = 0; n < 2; ++n) asm volatile("" :: "v"(acc[ai][bj][m][n]));
    }
};
struct EpiGU {
    static constexpr bool PERM = true;
    bf16_t* hid;
    __device__ __forceinline__ void operator()(const f32x4 (&acc)[2][2][4][2], const pg8::Unit& u, int wr, int wc, int fr, int fq) const {
        const int row0 = u.pm * 256 + wr * 64 + fr, col0 = u.pn * 128 + wc * 32 + 8 * fq;
#pragma unroll
        for (int ai = 0; ai < 2; ++ai)
#pragma unroll
            for (int m = 0; m < 4; ++m) { bf16_t* rowp = hid + (size_t)(row0 + ai * 128 + m * 16) * EH + col0;
                f32x4 h0, h1;
#pragma unroll
                for (int i = 0; i < 4; ++i) { h0[i] = siluf_(acc[ai][0][m][0][i]) * acc[ai][1][m][0][i]; h1[i] = siluf_(acc[ai][0][m][1][i]) * acc[ai][1][m][1][i]; }
                u32x4 w; w.x = cvtpk(h0[0], h0[1]); w.y = cvtpk(h0[2], h0[3]); w.z = cvtpk(h1[0], h1[1]); w.w = cvtpk(h1[2], h1[3]); *(u32x4*)rowp = w; }
    }
};
template <int MODE> struct EpiDownT {
    static constexpr bool PERM = true;
    unsigned char* ws; const LAS int* exp_info;
    __device__ __forceinline__ void operator()(const f32x4 (&acc)[2][2][4][2], const pg8::Unit& u, int wr, int wc, int fr, int fq) const {
        const int shift = __builtin_amdgcn_readfirstlane(exp_info[u.e]), lim = __builtin_amdgcn_readfirstlane(exp_info[512 + u.e]);
        const int row0 = u.pm * 256 + wr * 64 + fr, col0 = u.pn * 256 + wc * 32 + 8 * fq;
#pragma unroll
        for (int ai = 0; ai < 2; ++ai)
#pragma unroll
            for (int m = 0; m < 4; ++m) {
                const int pos = row0 + ai * 128 + m * 16;
                if (pos < lim) {
                    unsigned char* rowp = (MODE == 1 ? ws + WS_SS + (size_t)blockIdx.x * 2048 : ydense_row(ws, pos - shift)) + col0;
#pragma unroll
                    for (int bj = 0; bj < 2; ++bj) { const f32x4 v0 = acc[ai][bj][m][0], v1 = acc[ai][bj][m][1];
                        u32x2 w; w.x = pk4_fp8(v0[0], v0[1], v0[2], v0[3]); w.y = pk4_fp8(v1[0], v1[1], v1[2], v1[3]);
                        *(u32x2*)(rowp + bj * 128) = w; }
                }
            }
    }
};
typedef EpiDownT<0> EpiDown;

__device__ __forceinline__ void transpose_item(const float* W, int N, int K, int k0, int n0, bf16_t* WT, int drow0, LAS float* scr, int lane) {
#pragma unroll 8
    for (int i = 0; i < 32; ++i) { const int kk = 2 * i + (lane >> 5); scr[kk * 33 + (lane & 31)] = W[(size_t)(k0 + kk) * N + n0 + (lane & 31)]; }
    asm volatile("s_waitcnt lgkmcnt(0)" ::: "memory");
    const int c = lane & 7;
#pragma unroll
    for (int j = 0; j < 4; ++j) { const int n = (lane >> 3) + 8 * j; const LAS float* s = scr + (8 * c) * 33 + n;
        u32x4 o; o.x = cvtpk(s[0 * 33], s[1 * 33]); o.y = cvtpk(s[2 * 33], s[3 * 33]); o.z = cvtpk(s[4 * 33], s[5 * 33]); o.w = cvtpk(s[6 * 33], s[7 * 33]);
        *(u32x4*)(WT + (size_t)(drow0 + n) * K + k0 + 8 * c) = o; }
    asm volatile("s_waitcnt lgkmcnt(0)" ::: "memory");
}
__device__ __forceinline__ void transpose_plain(const float* W, int K, int N, bf16_t* WT, LAS float* scr, int item, int lane) {
    const int nblk = N / 32, kb = item / nblk, nb = item % nblk;
    transpose_item(W, N, K, 64 * kb, 32 * nb, WT, 32 * nb, scr, lane);
}

__device__ __forceinline__ int t5_bucket(int rel) {
    const int n = rel < 0 ? -rel : rel;
    int large = 8 + (int)(logf((float)(n > 1 ? n : 1) / 8.0f) / 4.852030263919617f * 8.0f);
    large = large < 15 ? large : 15;
    return (rel > 0 ? 16 : 0) + (n < 8 ? n : large);
}

__device__ __forceinline__ void phase0(Frame& F, const Args& a) {
    const float* c = a.in[1]; const float* w_ada = a.in[2]; const float* b_ada = a.in[3];
    {
        LAS float* cond = (LAS float*)F.lds;
        LAS float* red = (LAS float*)(F.lds + 32768);
        for (int i = F.tid; i < NB * DM; i += NTHR) cond[i] = siluf_(c[i]);
        __syncthreads();
        for (int cg = F.vcu; cg < 256; cg += F.G) {
            const int j = F.tid & 31, kg = F.tid >> 5;
            float s[NB];
#pragma unroll
            for (int b = 0; b < NB; ++b) s[b] = 0.f;
            if (j < 24) {
                for (int k = kg; k < DM; k += 16) { const float w = w_ada[(size_t)k * 6144 + cg * 24 + j];
#pragma unroll
                    for (int b = 0; b < NB; ++b) s[b] += cond[b * DM + k] * w; }
            }
#pragma unroll
            for (int b = 0; b < NB; ++b) red[(kg * NB + b) * 32 + j] = s[b];
            __syncthreads();
            if (F.tid < 192) { const int b = F.tid / 24, jj = F.tid % 24; float t = 0.f;
                for (int g = 0; g < 16; ++g) t += red[(g * NB + b) * 32 + jj];
                ((float*)(F.ws + WS_MOD))[b * 6144 + cg * 24 + jj] = t + b_ada[cg * 24 + jj]; }
            __syncthreads();
        }
    }
    const int gt = F.vcu * NTHR + F.tid, NGT = F.G * NTHR;
    {
        float* rc = (float*)(F.ws + WS_ROPE_C); float* rs = (float*)(F.ws + WS_ROPE_S);
        for (int i = gt; i < SEQ * 128; i += NGT) { const int pos = i >> 7, d = i & 127;
            const float inv = (float)pow(10000.0, -(double)d / 128.0); const float ang = (float)pos * inv;
            rc[i] = (float)cos((double)ang); rs[i] = (float)sin((double)ang); }
    }
    {
        const float* t5 = a.in[7]; float* bt = (float*)(F.ws + WS_BTAB);
        for (int i = gt; i < 3 * 16 * 160; i += NGT) { const int g = i / (16 * 160), h = (i / 160) % 16, j = i % 160;
            const int dil = g == 0 ? 1 : (g == 1 ? 4 : 16);
            bt[i] = j <= 128 ? t5[t5_bucket((j - 64) * dil) * 16 + h] * 1.4426950408889634f : 0.f; }
    }
    { unsigned* z = (unsigned*)(F.ws + WS_H + (size_t)NTOK * DM * 2); for (int i = gt; i < DM / 2; i += NGT) z[i] = 0u; }
    {
        LAS float* scr = (LAS float*)(F.lds + 49152 + F.wave * 8704);
        const int gw = F.vcu * NWAVES + F.wave, NGW = F.G * NWAVES;
        constexpr int I_IN = (DM / 64) * (PROJW / 32), I_SQ = (DM / 64) * (DM / 32), I_R = (DM / 64) * (NEXP / 32);
        constexpr int NITEMS = I_IN + 3 * I_SQ + I_R;
        for (int it = gw; it < NITEMS; it += NGW) {
            int r = it;
            if (r < I_IN) { transpose_plain(a.in[5], DM, PROJW, (bf16_t*)(F.ws + WS_WIN), scr, r, F.lane); continue; } r -= I_IN;
            if (r < I_SQ) { transpose_plain(a.in[8], DM, DM, (bf16_t*)(F.ws + WS_WRU), scr, r, F.lane); continue; } r -= I_SQ;
            if (r < I_SQ) { transpose_plain(a.in[9], DM, DM, (bf16_t*)(F.ws + WS_WAU), scr, r, F.lane); continue; } r -= I_SQ;
            if (r < I_SQ) { transpose_plain(a.in[10], DM, DM, (bf16_t*)(F.ws + WS_WO), scr, r, F.lane); continue; } r -= I_SQ;
            transpose_plain(a.in[12], DM, NEXP, (bf16_t*)(F.ws + WS_WR), scr, r, F.lane);
        }
    }
}

struct TrItem { const float* src; bf16_t* dst; int N, K; };
__device__ __forceinline__ TrItem moe_item(const Args& a, unsigned char* ws, int it) {
    constexpr int PER_E = 256;
    const int e = it / PER_E, r = it % PER_E, kind = r >> 7, q = r & 127;
    TrItem t;
    if (kind < 2) {
        const float* W = e < 256 ? a.in[kind == 0 ? 14 : 15] + (size_t)e * 1024 * 256 : a.in[kind == 0 ? 17 : 18];
        const int kb = q >> 3, n0 = 32 * (q & 7);
        t.src = W + (size_t)(64 * kb) * 256 + n0; t.N = 256; t.K = 1024;
        t.dst = (bf16_t*)(ws + WS_WGU) + (size_t)e * 512 * 1024 + (size_t)((n0 >> 7) * 256 + kind * 128 + (n0 & 127)) * 1024 + 64 * kb;
    } else {
        const float* W = e < 256 ? a.in[16] + (size_t)e * 256 * 1024 : a.in[19];
        const int kb = q >> 5, n0 = 32 * (q & 31);
        t.src = W + (size_t)(64 * kb) * 1024 + n0; t.N = 1024; t.K = 256;
        t.dst = (bf16_t*)(ws + WS_WD) + (size_t)e * 1024 * 256 + (size_t)n0 * 256 + 64 * kb;
    }
    return t;
}
__device__ __forceinline__ void tr_load(const TrItem& t, float (&v)[32], int lane) {
    const float* p = t.src + (size_t)(lane >> 5) * t.N + (lane & 31);
#pragma unroll
    for (int i = 0; i < 32; ++i) v[i] = __builtin_nontemporal_load(p + (size_t)(2 * i) * t.N);
}
__device__ __forceinline__ void tr_store(const TrItem& t, const float (&v)[32], LAS float* scr, int lane) {
#pragma unroll
    for (int i = 0; i < 32; ++i) scr[(2 * i + (lane >> 5)) * 33 + (lane & 31)] = v[i];
    asm volatile("s_waitcnt lgkmcnt(0)" ::: "memory");
    const int c = lane & 7;
#pragma unroll
    for (int j = 0; j < 4; ++j) { const int n = (lane >> 3) + 8 * j; const LAS float* s = scr + (8 * c) * 33 + n;
        u32x4 o; o.x = cvtpk(s[0 * 33], s[1 * 33]); o.y = cvtpk(s[2 * 33], s[3 * 33]); o.z = cvtpk(s[4 * 33], s[5 * 33]); o.w = cvtpk(s[6 * 33], s[7 * 33]);
        *(u32x4*)(t.dst + (size_t)n * t.K + 8 * c) = o; }
    asm volatile("s_waitcnt lgkmcnt(0)" ::: "memory");
}
constexpr int CW_CONVQ = 16384 + 2048;
__device__ __forceinline__ void moe_weight_convert(Frame& F, const Args& a) {
    LAS float* scr = (LAS float*)(F.lds + F.wave * 8704);
    const int total = 257 * 256, nchunks = total / 8;
    unsigned* q = (unsigned*)(F.ws + WS_CTL) + CW_CONVQ;
    float v0[32], v1[32];
    for (;;) {
        unsigned ck = 0;
        if (F.lane == 0) ck = __hip_atomic_fetch_add(q, 1u, __ATOMIC_RELAXED, __HIP_MEMORY_SCOPE_AGENT);
        ck = __builtin_amdgcn_readfirstlane(ck);
        if ((int)ck >= nchunks) break;
        const int it0 = (int)ck * 8;
        TrItem t0 = moe_item(a, F.ws, it0), t1 = t0;
        tr_load(t0, v0, F.lane);
#pragma unroll 1
        for (int k = 0; k < 8; k += 2) {
            t1 = moe_item(a, F.ws, it0 + k + 1); tr_load(t1, v1, F.lane);
            tr_store(t0, v0, scr, F.lane);
            if (k + 2 < 8) { t0 = moe_item(a, F.ws, it0 + k + 2); tr_load(t0, v0, F.lane); }
            tr_store(t1, v1, scr, F.lane);
        }
    }
}

template <bool BF16IN> __device__ __forceinline__ void norm_mod_rows(Frame& F, const void* xin, const float* norm, const float* mod, int shift_off, int scale_off, const float* ssp, bf16_t* out) {
    const float* x = (const float*)xin; const bf16_t* xb = (const bf16_t*)xin;
    const int gw = F.vcu * NWAVES + F.wave, NGW = F.G * NWAVES;
    f32x4 g4[4];
#pragma unroll
    for (int j = 0; j < 4; ++j) g4[j] = *(const f32x4*)(norm + 4 * F.lane + 256 * j);
    f32x4 v[4], vn[4]; float p = 0.f, pn = 0.f;
    int row = gw;
#define NM_LOAD(V, ROW) do { if (BF16IN) { const u32x2* xr_ = (const u32x2*)(xb + (size_t)(ROW) * DM) + F.lane; _Pragma("unroll") for (int j = 0; j < 4; ++j) { const u32x2 t_ = xr_[64 * j]; V[j] = (f32x4){bflo(t_.x), bfhi(t_.x), bflo(t_.y), bfhi(t_.y)}; } } \
        else { const f32x4* xr_ = (const f32x4*)(x + (size_t)(ROW) * DM) + F.lane; _Pragma("unroll") for (int j = 0; j < 4; ++j) V[j] = xr_[64 * j]; } } while (0)
    if (row < NTOK) { NM_LOAD(v, row);
        if (ssp) p = F.lane < 16 ? ssp[(size_t)row * 16 + F.lane] : 0.f; }
#pragma unroll 1
    for (; row < NTOK; row += NGW) {
        const int nrow = row + NGW < NTOK ? row + NGW : row;
        { NM_LOAD(vn, nrow);
          if (ssp) pn = F.lane < 16 ? ssp[(size_t)nrow * 16 + F.lane] : 0.f; }
        const int b = row / SEQ;
        float s = 0.f;
#pragma unroll
        for (int j = 0; j < 4; ++j) s += (v[j][0] * v[j][0] + v[j][1] * v[j][1]) + (v[j][2] * v[j][2] + v[j][3] * v[j][3]);
        const float tot = wave_sum(ssp ? p : s);
        const float rstd = rsqrtf(tot * (1.f / DM) + NORM_EPS);
        u32x2* o8 = (u32x2*)(out + (size_t)row * DM) + F.lane;
#pragma unroll
        for (int j = 0; j < 4; ++j) {
            const int col = 4 * F.lane + 256 * j;
            const f32x4 sc = *(const f32x4*)(mod + (size_t)b * 6144 + scale_off + col), sh = *(const f32x4*)(mod + (size_t)b * 6144 + shift_off + col);
            const f32x4 y = (v[j] * rstd) * g4[j] * (sc + 1.0f) + sh;
            u32x2 w; w.x = cvtpk(y[0], y[1]); w.y = cvtpk(y[2], y[3]); o8[64 * j] = w;
        }
#pragma unroll
        for (int j = 0; j < 4; ++j) v[j] = vn[j];
        p = pn;
    }
}

__device__ __forceinline__ unsigned off_b(unsigned row, unsigned ch) { return 256u * row + 16u * (ch ^ (((row & 3) << 2) | ((row >> 2) & 3))); }
__device__ __forceinline__ int crow(int reg, int h) { return (reg & 3) + 8 * (reg >> 2) + 4 * h; }
__device__ __forceinline__ s16x4 tr_read(LAS unsigned char* p) { return __builtin_bit_cast(s16x4, __builtin_amdgcn_ds_read_tr16_b64_v4i16((LAS s16x4*)p)); }
__device__ __forceinline__ bf16x8 pack8(const f32x16& x, int s) {
    u32x4 p; p.x = cvtpk(x[8 * s], x[8 * s + 1]); p.y = cvtpk(x[8 * s + 2], x[8 * s + 3]); p.z = cvtpk(x[8 * s + 4], x[8 * s + 5]); p.w = cvtpk(x[8 * s + 6], x[8 * s + 7]);
    return __builtin_bit_cast(bf16x8, p);
}
#define MFMA32(a, b, c) __builtin_amdgcn_mfma_f32_32x32x16_bf16((a), (b), (c), 0, 0, 0)

constexpr int RK_STR = 528, RV_STR = 192;
constexpr int RL_K = 0, RL_V = 128 * RK_STR, RL_S = RL_V + 128 * RV_STR, RL_P = RL_S + 64 * RK_STR, RL_END = RL_P + 10 * 2048;
__device__ __forceinline__ void retention_chain_rs(Frame& F, const Args& a, int chain) {
    const int b = chain >> 5, h = (chain >> 3) & 3, dir = (chain >> 2) & 1, es = chain & 3;
    const int lane = F.lane, r = lane & 31, hh = lane >> 5, w = F.wave;
    const bool outw = w < 4; const int ib = w & 3, sw = w & 3;
    const bf16_t* RQ = (const bf16_t*)(F.ws + WS_RQ); const bf16_t* RK = (const bf16_t*)(F.ws + WS_RK); const bf16_t* RV = (const bf16_t*)(F.ws + WS_RV);
    bf16_t* OUT = (bf16_t*)(F.ws + (dir ? WS_OUTB : WS_OUTF));
    const float lg = log1pf(-__expf(a.in[6][dir * 4 + h]));
    const float decayC = __expf(lg * 128.f);
    LAS unsigned char* lds = F.lds;
    f32x16 R[4];
#pragma unroll
    for (int k = 0; k < 4; ++k)
#pragma unroll
        for (int i = 0; i < 16; ++i) R[k][i] = 0.f;
#define QFRAG(s) __builtin_bit_cast(bf16x8, (f32x4){R[(s) >> 2][4 * ((s) & 3)], R[(s) >> 2][4 * ((s) & 3) + 1], R[(s) >> 2][4 * ((s) & 3) + 2], R[(s) >> 2][4 * ((s) & 3) + 3]})
#define QLOAD(s, P) do { const f32x4 t_ = *(const f32x4*)(P); R[(s) >> 2][4 * ((s) & 3)] = t_[0]; R[(s) >> 2][4 * ((s) & 3) + 1] = t_[1]; R[(s) >> 2][4 * ((s) & 3) + 2] = t_[2]; R[(s) >> 2][4 * ((s) & 3) + 3] = t_[3]; } while (0)
    for (int i = F.tid; i < (64 * RK_STR) / 16; i += NTHR) *(LAS u32x4*)(lds + RL_S + i * 16) = (u32x4){0u, 0u, 0u, 0u};
    const int vj = F.tid >> 2, ve0 = (F.tid & 3) * 16;
    const float vscale = __expf(lg * (dir == 0 ? (float)(127 - vj) : (float)vj));
    const int blk = (lane >> 4) & 1, q4 = (lane & 15) >> 2, p4 = lane & 3;
    LAS unsigned char* kbase = lds + RL_K + r * RK_STR + 16 * hh;
    LAS unsigned char* sbase = lds + RL_S + r * RK_STR + 16 * hh;
    LAS unsigned char* vtr = lds + RL_V + (4 * hh + q4) * RV_STR + (16 * blk + 4 * p4) * 2;
    LAS unsigned char* ktr = lds + RL_K + (4 * hh + q4) * RK_STR + (sw * 64 + 16 * blk + 4 * p4) * 2;
    LAS unsigned char* spub = lds + RL_S + r * RK_STR + (sw * 64 + 4 * hh) * 2;
    const float rsc = __expf(lg * (dir == 0 ? (float)(ib * 32 + r - 127) : (float)(-(ib * 32 + r))));
    const char* RKb = (const char*)RK + (size_t)h * 512; const char* RVb = (const char*)RV + (size_t)(h * 256 + es * 64) * 2; const char* RQb = (const char*)RQ + ((size_t)((b * 4 + h) * 32) * 4 + ib) * 16384;
    char* OUTb = (char*)OUT + (size_t)(ib * 32 * DM + h * 256 + es * 64) * 2;
    const unsigned klo = (unsigned)(((F.tid >> 5) * DM + (F.tid & 31) * 8) * 2), vlo = (unsigned)((vj * DM + ve0) * 2), qlo = (unsigned)(lane * 16), olo = (unsigned)((r * DM + 4 * hh) * 2);
    u32x4 kpre[8]; u32x4 vpre[2];
    {
        const size_t t0 = (size_t)b * SEQ + (size_t)(dir == 0 ? 0 : 31) * 128;
        const char* kc = RKb + t0 * (DM * 2); const char* vc = RVb + t0 * (DM * 2); const char* qc = RQb + (size_t)(dir == 0 ? 0 : 31) * 65536;
#pragma unroll
        for (int i = 0; i < 8; ++i) kpre[i] = *(const u32x4*)(kc + (size_t)i * (16 * DM * 2) + klo);
        vpre[0] = *(const u32x4*)(vc + vlo); vpre[1] = *(const u32x4*)(vc + vlo + 16);
        if (outw) {
#pragma unroll
            for (int s = 0; s < 16; ++s) QLOAD(s, qc + qlo + 1024 * s);
        }
    }
#pragma unroll 1
    for (int n = 0; n < 32; ++n) {
        const int cidx = dir == 0 ? n : 31 - n;
        const size_t t0 = (size_t)b * SEQ + (size_t)cidx * 128;
        {
            LAS unsigned char* kw = lds + RL_K + (F.tid >> 5) * RK_STR + (F.tid & 31) * 16;
#pragma unroll
            for (int i = 0; i < 8; ++i) *(LAS u32x4*)(kw + i * 16 * RK_STR) = kpre[i];
#pragma unroll
            for (int i = 0; i < 2; ++i) {
                u32x4 o; o.x = cvtpk(bflo(vpre[i].x) * vscale, bfhi(vpre[i].x) * vscale); o.y = cvtpk(bflo(vpre[i].y) * vscale, bfhi(vpre[i].y) * vscale);
                o.z = cvtpk(bflo(vpre[i].z) * vscale, bfhi(vpre[i].z) * vscale); o.w = cvtpk(bflo(vpre[i].w) * vscale, bfhi(vpre[i].w) * vscale);
                *(LAS u32x4*)(lds + RL_V + vj * RV_STR + ve0 * 2 + 16 * i) = o;
            }
        }
        __syncthreads();
        {
            const int nn = n + 1 < 32 ? n + 1 : n; const int cn = dir == 0 ? nn : 31 - nn;
            const size_t t1 = (size_t)b * SEQ + (size_t)cn * 128;
            const char* kc = RKb + t1 * (DM * 2); const char* vc = RVb + t1 * (DM * 2);
#pragma unroll
            for (int i = 0; i < 8; ++i) kpre[i] = *(const u32x4*)(kc + (size_t)i * (16 * DM * 2) + klo);
            vpre[0] = *(const u32x4*)(vc + vlo); vpre[1] = *(const u32x4*)(vc + vlo + 16);
        }
        if (outw) {
            f32x16 acc0, acc1;
#pragma unroll
            for (int i = 0; i < 16; ++i) { acc0[i] = 0.f; acc1[i] = 0.f; }
            const int jb_lo = dir == 0 ? 0 : ib, jb_hi = dir == 0 ? ib : 3;
#pragma unroll 1
            for (int jb = jb_lo; jb <= jb_hi; ++jb) {
                LAS unsigned char* kb = kbase + jb * (32 * RK_STR);
                f32x16 sT;
#pragma unroll
                for (int i = 0; i < 16; ++i) sT[i] = 0.f;
#pragma unroll
                for (int hb = 0; hb < 2; ++hb) {
                    bf16x8 kf[8];
#pragma unroll
                    for (int s = 0; s < 8; ++s) kf[s] = *(const LAS bf16x8*)(kb + (hb * 8 + s) * 32);
                    __builtin_amdgcn_sched_barrier(0);
#pragma unroll
                    for (int s = 0; s < 8; ++s) sT = MFMA32(kf[s], QFRAG(hb * 8 + s), sT);
                    __builtin_amdgcn_sched_barrier(0);
                }
                if (jb == ib) {
#pragma unroll
                    for (int i = 0; i < 16; ++i) { const int jl = crow(i, hh); const bool keep = dir == 0 ? (jl <= r) : (jl > r); sT[i] = keep ? sT[i] : 0.f; }
                }
                const bf16x8 p0 = pack8(sT, 0), p1 = pack8(sT, 1);
                LAS unsigned char* vb = vtr + jb * (32 * RV_STR);
#pragma unroll
                for (int s2 = 0; s2 < 2; ++s2) {
                    const s16x4 l0 = tr_read(vb + s2 * (16 * RV_STR)), h0 = tr_read(vb + s2 * (16 * RV_STR) + 8 * RV_STR);
                    const s16x4 l1 = tr_read(vb + s2 * (16 * RV_STR) + 64), h1 = tr_read(vb + s2 * (16 * RV_STR) + 8 * RV_STR + 64);
                    acc0 = MFMA32(__builtin_shufflevector(l0, h0, 0, 1, 2, 3, 4, 5, 6, 7), s2 == 0 ? p0 : p1, acc0);
                    acc1 = MFMA32(__builtin_shufflevector(l1, h1, 0, 1, 2, 3, 4, 5, 6, 7), s2 == 0 ? p0 : p1, acc1);
                }
            }
#pragma unroll
            for (int hb = 0; hb < 4; ++hb) {
                bf16x8 sf0[4], sf1[4];
#pragma unroll
                for (int s = 0; s < 4; ++s) { sf0[s] = *(const LAS bf16x8*)(sbase + (hb * 4 + s) * 32); sf1[s] = *(const LAS bf16x8*)(sbase + 32 * RK_STR + (hb * 4 + s) * 32); }
                __builtin_amdgcn_sched_barrier(0);
#pragma unroll
                for (int s = 0; s < 4; ++s) { acc0 = MFMA32(sf0[s], QFRAG(hb * 4 + s), acc0); acc1 = MFMA32(sf1[s], QFRAG(hb * 4 + s), acc1); }
                __builtin_amdgcn_sched_barrier(0);
            }
            u32x2 ow[8];
#pragma unroll
            for (int g = 0; g < 4; ++g) { ow[g].x = cvtpk(acc0[4 * g] * rsc, acc0[4 * g + 1] * rsc); ow[g].y = cvtpk(acc0[4 * g + 2] * rsc, acc0[4 * g + 3] * rsc);
                ow[4 + g].x = cvtpk(acc1[4 * g] * rsc, acc1[4 * g + 1] * rsc); ow[4 + g].y = cvtpk(acc1[4 * g + 2] * rsc, acc1[4 * g + 3] * rsc); }
            {
                const int nn = n + 1 < 32 ? n + 1 : n; const int cn = dir == 0 ? nn : 31 - nn;
                const char* qc = RQb + (size_t)cn * 65536;
#pragma unroll
                for (int s = 0; s < 16; ++s) QLOAD(s, qc + qlo + 1024 * s);
            }
            {
                char* oc = OUTb + t0 * (DM * 2) + olo;
#pragma unroll
                for (int g = 0; g < 4; ++g) { *(u32x2*)(oc + g * 16) = ow[g]; *(u32x2*)(oc + 64 + g * 16) = ow[4 + g]; }
            }
        } else {
#pragma unroll
            for (int ks = 0; ks < 8; ++ks) {
                const s16x4 vl0 = tr_read(vtr + ks * (16 * RV_STR)), vh0 = tr_read(vtr + ks * (16 * RV_STR) + 8 * RV_STR);
                const s16x4 vl1 = tr_read(vtr + ks * (16 * RV_STR) + 64), vh1 = tr_read(vtr + ks * (16 * RV_STR) + 8 * RV_STR + 64);
                const bf16x8 vf0 = __builtin_shufflevector(vl0, vh0, 0, 1, 2, 3, 4, 5, 6, 7), vf1 = __builtin_shufflevector(vl1, vh1, 0, 1, 2, 3, 4, 5, 6, 7);
#pragma unroll
                for (int dd = 0; dd < 2; ++dd) {
                    const s16x4 lo = tr_read(ktr + ks * (16 * RK_STR) + dd * 64), hi = tr_read(ktr + ks * (16 * RK_STR) + 8 * RK_STR + dd * 64);
                    const bf16x8 kt = __builtin_shufflevector(lo, hi, 0, 1, 2, 3, 4, 5, 6, 7);
                    R[2 * dd] = MFMA32(kt, vf0, R[2 * dd]); R[2 * dd + 1] = MFMA32(kt, vf1, R[2 * dd + 1]);
                }
            }
#pragma unroll
            for (int k = 0; k < 4; ++k)
#pragma unroll
                for (int i = 0; i < 16; ++i) R[k][i] *= decayC;
        }
        __syncthreads();
        if (!outw) {
#pragma unroll
            for (int dd = 0; dd < 2; ++dd)
#pragma unroll
                for (int e = 0; e < 2; ++e)
#pragma unroll
                    for (int g = 0; g < 4; ++g) { u32x2 wv; wv.x = cvtpk(R[2 * dd + e][4 * g], R[2 * dd + e][4 * g + 1]); wv.y = cvtpk(R[2 * dd + e][4 * g + 2], R[2 * dd + e][4 * g + 3]);
                        *(LAS u32x2*)(spub + e * (32 * RK_STR) + dd * 64 + g * 16) = wv; }
        }
    }
    __syncthreads();
#undef QFRAG
#undef QLOAD
}

__device__ __forceinline__ u32x4 fp8x8_to_bf16(unsigned w0, unsigned w1) {
    const f32x2 a = __builtin_amdgcn_cvt_pk_f32_fp8((int)w0, false), b = __builtin_amdgcn_cvt_pk_f32_fp8((int)w0, true), c = __builtin_amdgcn_cvt_pk_f32_fp8((int)w1, false), d = __builtin_amdgcn_cvt_pk_f32_fp8((int)w1, true);
    return (u32x4){cvtpk(a.x, a.y), cvtpk(b.x, b.y), cvtpk(c.x, c.y), cvtpk(d.x, d.y)};
}
constexpr int AK_STR = 144, AV_STR = 192;
constexpr int AL_K = 0, AL_V = 384 * AK_STR, AL_B = AL_V + 384 * AV_STR, AL_END = AL_B + 896;
struct AttUnit { int g, dil, length, res, run0, b, head; };
__device__ __forceinline__ AttUnit att_decode(int slot) {
    AttUnit u; const int bh = slot / 48, k = slot % 48, ru = k & 15; u.g = k >> 4;
    u.dil = u.g == 0 ? 1 : (u.g == 1 ? 4 : 16); u.length = SEQ / u.dil; u.res = ru % u.dil; u.run0 = (ru / u.dil) * 256; u.b = bh >> 4; u.head = bh & 15; return u;
}
__device__ __forceinline__ void attention_phase(Frame& F, int u0, int u1, int zero) {
    if (u0 >= u1) return;
    const int lane = F.lane, r = lane & 31, hh = lane >> 5, w = F.wave;
    const unsigned char* AQ = F.ws + WS_AQ; const unsigned char* AK = F.ws + WS_AK; const unsigned char* AV = F.ws + WS_AV;
    LAS unsigned char* lds = F.lds;
    const int blk = (lane >> 4) & 1, q4 = (lane & 15) >> 2, p4 = lane & 3;
    LAS unsigned char* kbase = lds + AL_K + (32 * w + r) * AK_STR + 16 * hh;
    LAS unsigned char* vbase = lds + AL_V + (32 * w + 4 * hh + q4) * AV_STR + (16 * blk + 4 * p4) * 2;
    const LAS float* bt = (const LAS float*)(lds + AL_B) + (4 * hh - r + 32);
    u32x4 kk[3], vv[3]; u32x2 qn[4]; float bnext = 0.f;
    u32x4 kk2[3], vv2[3]; u32x2 qn2[4]; float bnext2 = 0.f;
#define ATT_LOAD(U) do { const AttUnit un_ = att_decode(U); \
        if (F.tid < 224) { const int X_ = F.tid - 32; bnext = (X_ >= 0 && X_ <= 128) ? ((const float*)(F.ws + WS_BTAB))[(un_.g * 16 + un_.head) * 160 + X_] : 0.f; } \
        _Pragma("unroll") for (int i = 0; i < 3; ++i) { const int id = F.tid + i * NTHR, row = id >> 2, ch = id & 3; int idx = un_.run0 - 64 + row; idx = idx < 0 ? 0 : (idx >= un_.length ? un_.length - 1 : idx); \
            const size_t off = ((size_t)un_.b * SEQ + (size_t)idx * un_.dil + un_.res) * DM + un_.head * 64 + ch * 16; kk[i] = *(const u32x4*)(AK + off); vv[i] = *(const u32x4*)(AV + off); } \
        const size_t qt_ = (size_t)un_.b * SEQ + (size_t)(un_.run0 + 32 * w + r) * un_.dil + un_.res; \
        _Pragma("unroll") for (int s = 0; s < 4; ++s) qn[s] = *(const u32x2*)(AQ + qt_ * DM + un_.head * 64 + 16 * s + 8 * hh); } while (0)
#define ATT_LOAD2(U) do { const AttUnit un_ = att_decode(U); \
        if (F.tid < 224) { const int X_ = F.tid - 32; bnext2 = (X_ >= 0 && X_ <= 128) ? ((const float*)(F.ws + WS_BTAB))[(un_.g * 16 + un_.head) * 160 + X_] : 0.f; } \
        _Pragma("unroll") for (int i = 0; i < 3; ++i) { const int id = F.tid + i * NTHR, row = id >> 2, ch = id & 3; int idx = un_.run0 - 64 + row; idx = idx < 0 ? 0 : (idx >= un_.length ? un_.length - 1 : idx); \
            const size_t off = ((size_t)un_.b * SEQ + (size_t)idx * un_.dil + un_.res) * DM + un_.head * 64 + ch * 16; kk2[i] = *(const u32x4*)(AK + off); vv2[i] = *(const u32x4*)(AV + off); } \
        const size_t qt_ = (size_t)un_.b * SEQ + (size_t)(un_.run0 + 32 * w + r) * un_.dil + un_.res; \
        _Pragma("unroll") for (int s = 0; s < 4; ++s) qn2[s] = *(const u32x2*)(AQ + qt_ * DM + un_.head * 64 + 16 * s + 8 * hh); } while (0)
    const int nun = u1 - u0, nit = nun * (PROBE_PHASE == 31 ? 2 : 1);
#define ATT_SLOT(I) (u0 + ((I) >= nit ? nun - 1 : ((I) >= nun ? (I) - nun : (I))))
    ATT_LOAD(ATT_SLOT(0)); ATT_LOAD2(ATT_SLOT(1));
#pragma unroll 1
    for (int it = 0; it < nit; ++it) {
        const int unit = u0 + (it >= nun ? it - nun : it);
        const AttUnit un = att_decode(unit);
        unsigned char* OG = F.ws + WS_OG + (size_t)un.g * (SEG / 2); float* LSE = (float*)(F.ws + WS_LSE) + (size_t)un.g * NTOK * 16;
#pragma unroll
        for (int i = 0; i < 3; ++i) { const int id = F.tid + i * NTHR, row = id >> 2, ch = id & 3;
            *(LAS u32x4*)(lds + AL_K + row * AK_STR + 32 * ch) = fp8x8_to_bf16(kk[i].x, kk[i].y); *(LAS u32x4*)(lds + AL_K + row * AK_STR + 32 * ch + 16) = fp8x8_to_bf16(kk[i].z, kk[i].w);
            *(LAS u32x4*)(lds + AL_V + row * AV_STR + 32 * ch) = fp8x8_to_bf16(vv[i].x, vv[i].y); *(LAS u32x4*)(lds + AL_V + row * AV_STR + 32 * ch + 16) = fp8x8_to_bf16(vv[i].z, vv[i].w); }
        if (F.tid < 224) ((LAS float*)(lds + AL_B))[F.tid] = bnext;
        bf16x8 qf[4];
#pragma unroll
        for (int s = 0; s < 4; ++s) qf[s] = __builtin_bit_cast(bf16x8, fp8x8_to_bf16(qn[s].x, qn[s].y));
        __syncthreads();
#pragma unroll
        for (int i = 0; i < 3; ++i) { kk[i] = kk2[i]; vv[i] = vv2[i]; }
#pragma unroll
        for (int s = 0; s < 4; ++s) qn[s] = qn2[s];
        bnext = bnext2;
        ATT_LOAD2(ATT_SLOT(it + 2));
        const size_t qtok = (size_t)un.b * SEQ + (size_t)(un.run0 + 32 * w + r) * un.dil + un.res;
        const int lv = 4 * hh - r, kv = un.run0 - 64 + 32 * w + 4 * hh;
        const int clo = max(-lv, -kv), chi = min(128 - lv, un.length - 1 - kv);
        const bool edge = (un.run0 == 0) || (un.run0 + 256 == un.length);
        float m = -3.0e38f, lsum = 0.f;
        f32x16 o0, o1;
#pragma unroll 1
        for (int rc_ = 0; rc_ < (PROBE_PHASE == 33 ? 2 + zero : 1); ++rc_) {
        m = -3.0e38f; lsum = 0.f;
#pragma unroll
        for (int i = 0; i < 16; ++i) { o0[i] = 0.f; o1[i] = 0.f; }
#pragma unroll
        for (int kb = 0; kb < 5; ++kb) {
            f32x16 sT;
#pragma unroll
            for (int i = 0; i < 16; ++i) sT[i] = 0.f;
#pragma unroll
            for (int s = 0; s < 4; ++s) sT = MFMA32(*(const LAS bf16x8*)(kbase + kb * (32 * AK_STR) + s * 32), qf[s], sT);
            float bv[16];
#pragma unroll
            for (int i = 0; i < 16; ++i) bv[i] = bt[32 * kb + (i & 3) + 8 * (i >> 2)];
            const bool masked = (kb == 0) || (kb == 4) || edge;
            float bm = -3.0e38f;
            if (masked) {
#pragma unroll
                for (int i = 0; i < 16; ++i) { const int c = 32 * kb + (i & 3) + 8 * (i >> 2); const bool valid = (c >= clo) && (c <= chi);
                    const float sv = sT[i] * (1.0f / 256.0f) + bv[i]; sT[i] = valid ? sv : -3.0e38f; bm = fmaxf(bm, sT[i]); }
            } else {
#pragma unroll
                for (int i = 0; i < 16; ++i) { sT[i] = sT[i] * (1.0f / 256.0f) + bv[i]; bm = fmaxf(bm, sT[i]); }
            }
            bm = fmaxf(bm, __shfl_xor(bm, 32));
            const float mn = fmaxf(m, bm), alpha = __builtin_amdgcn_exp2f(m - mn);
            if (kb > 0 && __any(mn > m)) {
#pragma unroll
                for (int i = 0; i < 16; ++i) { o0[i] *= alpha; o1[i] *= alpha; }
            }
            m = mn; lsum *= alpha;
            if (masked) {
#pragma unroll
                for (int i = 0; i < 16; ++i) { const float p = sT[i] > -1.0e38f ? __builtin_amdgcn_exp2f(sT[i] - mn) : 0.f; sT[i] = p; lsum += p; }
            } else {
#pragma unroll
                for (int i = 0; i < 16; ++i) { const float p = __builtin_amdgcn_exp2f(sT[i] - mn); sT[i] = p; lsum += p; }
            }
#pragma unroll
            for (int s2 = 0; s2 < 2; ++s2) {
                const bf16x8 pb = pack8(sT, s2);
#pragma unroll
                for (int e2 = 0; e2 < 2; ++e2) {
                    const s16x4 lo = tr_read(vbase + kb * (32 * AV_STR) + s2 * (16 * AV_STR) + e2 * 64);
                    const s16x4 hi = tr_read(vbase + kb * (32 * AV_STR) + s2 * (16 * AV_STR) + 8 * AV_STR + e2 * 64);
                    const bf16x8 vf = __builtin_shufflevector(lo, hi, 0, 1, 2, 3, 4, 5, 6, 7);
                    if (e2 == 0) o0 = MFMA32(vf, pb, o0); else o1 = MFMA32(vf, pb, o1);
                }
            }
        }
        }
        lsum += __shfl_xor(lsum, 32);
        if (hh == 0) LSE[qtok * 16 + un.head] = (m + __log2f(lsum)) * 0.6931471805599453f;
        const float linv = YD_INV / lsum;
        __syncthreads();
#pragma unroll 1
        for (int rs_ = 0; rs_ < (PROBE_PHASE == 34 ? 2 + zero : 1); ++rs_)
        {
            LAS unsigned char* ost = lds + AL_K + w * (32 * AK_STR);
#pragma unroll
            for (int g = 0; g < 4; ++g) {
                u32x2 a0, a1; a0.x = cvtpk(o0[4 * g] * linv, o0[4 * g + 1] * linv); a0.y = cvtpk(o0[4 * g + 2] * linv, o0[4 * g + 3] * linv);
                a1.x = cvtpk(o1[4 * g] * linv, o1[4 * g + 1] * linv); a1.y = cvtpk(o1[4 * g + 2] * linv, o1[4 * g + 3] * linv);
                *(LAS u32x2*)(ost + r * AK_STR + 16 * g + 8 * hh) = a0; *(LAS u32x2*)(ost + r * AK_STR + 64 + 16 * g + 8 * hh) = a1;
            }
            asm volatile("s_waitcnt lgkmcnt(0)" ::: "memory");
#pragma unroll
            for (int it = 0; it < 4; ++it) {
                const int ql = 8 * it + (lane >> 3);
                const u32x4 v = *(const LAS u32x4*)(ost + ql * AK_STR + 16 * (lane & 7));
                const size_t tok = (size_t)un.b * SEQ + (size_t)(un.run0 + 32 * w + ql) * un.dil + un.res;
                u32x2 f8; f8.x = pk4_fp8(bflo(v.x), bfhi(v.x), bflo(v.y), bfhi(v.y)); f8.y = pk4_fp8(bflo(v.z), bfhi(v.z), bflo(v.w), bfhi(v.w));
                __builtin_nontemporal_store(f8, (u32x2*)(OG + tok * DM + un.head * 64 + 8 * (lane & 7)));
            }
        }
        __syncthreads();
    }
#undef ATT_LOAD
#undef ATT_LOAD2
#undef ATT_SLOT
}

__device__ __forceinline__ void mixer_post_rows(Frame& F) {
    const int gw = F.vcu * NWAVES + F.wave, NGW = F.G * NWAVES, lane = F.lane;
    const bf16_t* OF = (const bf16_t*)(F.ws + WS_OUTF); const bf16_t* OB = (const bf16_t*)(F.ws + WS_OUTB); const unsigned char* SG = (F.ws + WS_RG);
    const unsigned char* OG = F.ws + WS_OG; const float* LSE = (const float*)(F.ws + WS_LSE);
    bf16_t* RN = (bf16_t*)(F.ws + WS_RETN); bf16_t* AC = (bf16_t*)(F.ws + WS_ATTC);
    const int head = lane >> 2;
    u32x2 fa[4], fb[4], na[4], nb[4]; unsigned sg[4], nsg[4]; u32x4 og[3], nog[3]; float ls[3], nls[3];
#define MP_LOAD(A, B, S, O, L, ROW) do { _Pragma("unroll") for (int h = 0; h < 4; ++h) { const size_t off_ = (size_t)(ROW) * DM + h * 256 + 4 * lane; \
            A[h] = *(const u32x2*)(OF + off_); B[h] = *(const u32x2*)(OB + off_); S[h] = *(const unsigned*)(SG + off_); } \
        _Pragma("unroll") for (int g = 0; g < 3; ++g) { O[g] = *(const u32x4*)(OG + (size_t)g * NTOK * DM + (size_t)(ROW) * DM + 16 * lane); L[g] = LSE[((size_t)g * NTOK + (ROW)) * 16 + head]; } } while (0)
    if (gw >= NTOK) return;
    MP_LOAD(fa, fb, sg, og, ls, gw);
#pragma unroll 1
    for (int row = gw; row < NTOK; row += NGW) {
        const int rn = row + NGW < NTOK ? row + NGW : row;
        MP_LOAD(na, nb, nsg, nog, nls, rn);
        f32x4 v[4];
#pragma unroll
        for (int h = 0; h < 4; ++h) v[h] = (f32x4){bflo(fa[h].x) + bflo(fb[h].x), bfhi(fa[h].x) + bfhi(fb[h].x), bflo(fa[h].y) + bflo(fb[h].y), bfhi(fa[h].y) + bfhi(fb[h].y)};
#pragma unroll
        for (int h = 0; h < 4; ++h) {
            const float mu = wave_sum((v[h][0] + v[h][1]) + (v[h][2] + v[h][3])) * (1.f / 256.f);
            const f32x4 d = v[h] - mu;
            const float var = wave_sum((d[0] * d[0] + d[1] * d[1]) + (d[2] * d[2] + d[3] * d[3])) * (1.f / 256.f);
            const float rs = rsqrtf(var + NORM_EPS);
            const f32x2 g01 = __builtin_amdgcn_cvt_pk_f32_fp8((int)sg[h], false), g23 = __builtin_amdgcn_cvt_pk_f32_fp8((int)sg[h], true); const float rq = rs * YD_INV;
            u32x2 o; o.x = cvtpk(d[0] * rq * g01.x, d[1] * rq * g01.y); o.y = cvtpk(d[2] * rq * g23.x, d[3] * rq * g23.y);
            *(u32x2*)(RN + (size_t)row * DM + h * 256 + 4 * lane) = o;
        }
        const float lm = fmaxf(ls[0], fmaxf(ls[1], ls[2]));
        float wg[3]; float wsum = 0.f;
#pragma unroll
        for (int g = 0; g < 3; ++g) { wg[g] = __expf(ls[g] - lm); wsum += wg[g]; }
        const float winv = 1.f / wsum;
        unsigned res[8];
#pragma unroll
        for (int wI = 0; wI < 4; ++wI) {
            float a0 = 0.f, a1 = 0.f, a2 = 0.f, a3 = 0.f;
#pragma unroll
            for (int g = 0; g < 3; ++g) { const int wd = (int)(wI == 0 ? og[g].x : (wI == 1 ? og[g].y : (wI == 2 ? og[g].z : og[g].w)));
                const f32x2 p0 = __builtin_amdgcn_cvt_pk_f32_fp8(wd, false), p1 = __builtin_amdgcn_cvt_pk_f32_fp8(wd, true);
                a0 += wg[g] * p0.x; a1 += wg[g] * p0.y; a2 += wg[g] * p1.x; a3 += wg[g] * p1.y; }
            const float sc = winv * YD_INV;
            res[2 * wI] = cvtpk(a0 * sc, a1 * sc); res[2 * wI + 1] = cvtpk(a2 * sc, a3 * sc);
        }
        u32x4 oo[2]; oo[0] = (u32x4){res[0], res[1], res[2], res[3]}; oo[1] = (u32x4){res[4], res[5], res[6], res[7]};
        bf16_t* ap = AC + (size_t)row * DM + 16 * lane; *(u32x4*)ap = oo[0]; *(u32x4*)(ap + 8) = oo[1];
#pragma unroll
        for (int h = 0; h < 4; ++h) { fa[h] = na[h]; fb[h] = nb[h]; sg[h] = nsg[h]; }
#pragma unroll
        for (int g = 0; g < 3; ++g) { og[g] = nog[g]; ls[g] = nls[g]; }
    }
#undef MP_LOAD
}

__device__ __forceinline__ void routing_rows(Frame& F, const Args& a) {
    const int gw = F.vcu * NWAVES + F.wave, NGW = F.G * NWAVES, lane = F.lane;
    const float* LOG = (const float*)(F.ws + WS_LOGIT); const float* rb = a.in[13];
    int* EIDX = (int*)(F.ws + WS_EIDX); float* GATE = (float*)(F.ws + WS_GATE);
    LAS unsigned* hist = (LAS unsigned*)(F.lds);
    for (int i = F.tid; i < NEXP; i += NTHR) hist[i] = 0u;
    __syncthreads();
    const f32x4 bias = *(const f32x4*)(rb + 4 * lane);
    for (int row = gw; row < NTOK; row += NGW) {
        const f32x4 lg = *(const f32x4*)(LOG + (size_t)row * NEXP + 4 * lane);
        float sc[4], ch[4];
#pragma unroll
        for (int i = 0; i < 4; ++i) { sc[i] = 1.f / (1.f + expf(-lg[i])); ch[i] = sc[i] + bias[i]; }
        float m1 = fmaxf(ch[0], ch[1]), m2 = fminf(ch[0], ch[1]);
        { const float c2 = ch[2]; const float n1 = fmaxf(m1, c2); m2 = fmaxf(m2, fminf(m1, c2)); m1 = n1; }
        { const float c3 = ch[3]; const float n1 = fmaxf(m1, c3); m2 = fmaxf(m2, fminf(m1, c3)); m1 = n1; }
#pragma unroll
        for (int o = 1; o < 8; o <<= 1) { const float b1 = __shfl_xor(m1, o), b2 = __shfl_xor(m2, o);
            const float n1 = fmaxf(m1, b1); const float n2 = fmaxf(fminf(m1, b1), fmaxf(m2, b2)); m1 = n1; m2 = n2; }
        const float gs = m1 + m2; const int mygrp = lane >> 3;
        int rank = 0;
#pragma unroll
        for (int g = 0; g < 8; ++g) { const float og = __shfl(gs, g * 8); rank += (og > gs || (og == gs && g < mygrp)) ? 1 : 0; }
        const bool elig = rank < 4;
        float cv[4];
#pragma unroll
        for (int i = 0; i < 4; ++i) cv[i] = elig ? ch[i] : -3.0e38f;
        float gsel = 0.f; int esel = 0; float gsum = 0.f;
#pragma unroll
        for (int k = 0; k < TOPK; ++k) {
            float bv = cv[0]; int bi = 4 * lane;
#pragma unroll
            for (int i = 1; i < 4; ++i) if (cv[i] > bv) { bv = cv[i]; bi = 4 * lane + i; }
#pragma unroll
            for (int o = 1; o < 64; o <<= 1) { const float ov = __shfl_xor(bv, o); const int oi = __shfl_xor(bi, o); if (ov > bv || (ov == bv && oi < bi)) { bv = ov; bi = oi; } }
            const int own = bi >> 2, el = bi & 3;
            const float mine = el == 0 ? sc[0] : (el == 1 ? sc[1] : (el == 2 ? sc[2] : sc[3]));
            const float s = __shfl(mine, own);
            if (lane == own) { if (el == 0) cv[0] = -3.0e38f; else if (el == 1) cv[1] = -3.0e38f; else if (el == 2) cv[2] = -3.0e38f; else cv[3] = -3.0e38f; }
            gsum += s;
            if (lane == k) { gsel = s; esel = bi; }
        }
        if (lane < TOPK) { EIDX[row * TOPK + lane] = esel; GATE[row * TOPK + lane] = gsel / gsum * 2.5f; __hip_atomic_fetch_add(&hist[esel], 1u, __ATOMIC_RELAXED, __HIP_MEMORY_SCOPE_WORKGROUP); }
    }
    __syncthreads();
    for (int i = F.tid; i < NEXP; i += NTHR) if (hist[i]) atomicAdd((unsigned*)(F.ws + WS_CTL) + CW_CNT + i, hist[i]);
}

__device__ __forceinline__ void routing_lists(Frame& F) {
    LAS unsigned* cnt = (LAS unsigned*)(F.lds);
    LAS unsigned* pstart = cnt + 256;
    LAS unsigned* lh = pstart + 264;
    LAS unsigned* lbase = lh + 256;
    LAS unsigned* ustart = lbase + 256;
    int* DPOS = (int*)(F.ws + WS_DPOS);
    unsigned* ctl = (unsigned*)(F.ws + WS_CTL);
    const int* EIDX = (const int*)(F.ws + WS_EIDX); int* ROWL = (int*)(F.ws + WS_ROWL); int* TILE_E = (int*)(F.ws + WS_TILE_E);
    for (int i = F.tid; i < NEXP; i += NTHR) { cnt[i] = __hip_atomic_load(ctl + CW_CNT + i, RLX_AGENT); lh[i] = 0u; }
    __syncthreads();
    if (F.tid == 0) { unsigned s = 0, us = 0; for (int e = 0; e < NEXP; ++e) { pstart[e] = s; ustart[e] = us; s += (cnt[e] + 255u) & ~255u; us += cnt[e]; } pstart[NEXP] = s; }
    __syncthreads();
    const unsigned ptotal = pstart[NEXP];
    const int per = (NTOK + F.G - 1) / F.G, tk0 = F.vcu * per, tk1 = (tk0 + per) < NTOK ? (tk0 + per) : NTOK;
    for (int i = tk0 * TOPK + F.tid; i < tk1 * TOPK; i += NTHR) __hip_atomic_fetch_add(&lh[EIDX[i]], 1u, __ATOMIC_RELAXED, __HIP_MEMORY_SCOPE_WORKGROUP);
    __syncthreads();
    for (int e = F.tid; e < NEXP; e += NTHR) { const unsigned c = lh[e]; lbase[e] = c ? atomicAdd(ctl + CW_FILL + e, c) : 0u; lh[e] = 0u; }
    __syncthreads();
    for (int i = tk0 * TOPK + F.tid; i < tk1 * TOPK; i += NTHR) { const int e = EIDX[i]; const unsigned p = __hip_atomic_fetch_add(&lh[e], 1u, __ATOMIC_RELAXED, __HIP_MEMORY_SCOPE_WORKGROUP);
        ROWL[pstart[e] + lbase[e] + p] = (i >> 3) * 16 + (i & 7); DPOS[i] = (int)(ustart[e] + lbase[e] + p); }
    for (int t = tk0 + F.tid; t < tk1; t += NTHR) ROWL[ptotal + t] = t * 16 + 8;
    for (int e = F.vcu; e < NEXP; e += F.G) { const unsigned s = pstart[e] + cnt[e], en = pstart[e + 1]; for (unsigned p = s + F.tid; p < en; p += NTHR) ROWL[p] = -1; }
    if (F.vcu == 0) {
        const int nrt = (int)(ptotal >> 8);
        for (int e = F.tid; e < NEXP; e += NTHR) { for (unsigned t = pstart[e] >> 8; t < (pstart[e + 1] >> 8); ++t) TILE_E[t] = e; TILE_E[4096 + e] = (int)(pstart[e] - ustart[e]); TILE_E[8192 + e] = (int)(pstart[e] + cnt[e]); }
        for (int t = F.tid; t < NTOK / 256; t += NTHR) TILE_E[nrt + t] = NEXP;
        if (F.tid == 0) { TILE_E[4096 + NEXP] = (int)ptotal - YD_SHARED0; TILE_E[8192 + NEXP] = (int)ptotal + NTOK; }
        if (F.tid == 0) TILE_E[MAX_TILES] = nrt + NTOK / 256;
    }
}

__device__ __forceinline__ void final_rows(Frame& F, const Args& a) {
    const int gw = F.vcu * NWAVES + F.wave, NGW = F.G * NWAVES, lane = F.lane;
    const float* mod = (const float*)(F.ws + WS_MOD); const float* nf = a.in[20];
    const int* DPOS = (const int*)(F.ws + WS_DPOS); const float* GATE = (const float*)(F.ws + WS_GATE);
    f32x4 g4[4];
#pragma unroll
    for (int j = 0; j < 4; ++j) g4[j] = *(const f32x4*)(nf + 4 * lane + 256 * j);
    if (gw >= NTOK) return;
    auto clampr = [&](int r) { return r < NTOK ? r : gw; };
    int dcur = DPOS[clampr(gw) * 8 + (lane & 7)]; float gcur = GATE[clampr(gw) * 8 + (lane & 7)];
    int dnxt = DPOS[clampr(gw + NGW) * 8 + (lane & 7)]; float gnxt = GATE[clampr(gw + NGW) * 8 + (lane & 7)];
    f32x4 xw[4], xn[4]; int yw[9][4], yn[9][4];
#define FIN_LOAD(XW, YW, ROW, DV) do { const u32x2* xr_ = (const u32x2*)((const bf16_t*)(F.ws + WS_X1B) + (size_t)(ROW) * DM) + lane; \
        _Pragma("unroll") for (int j = 0; j < 4; ++j) { const u32x2 t_ = xr_[64 * j]; XW[j] = (f32x4){bflo(t_.x), bfhi(t_.x), bflo(t_.y), bfhi(t_.y)}; } \
        _Pragma("unroll") for (int k = 0; k < 9; ++k) { const unsigned char* yr_ = ydense_row(F.ws, k < 8 ? __builtin_amdgcn_readlane((DV), k) : YD_SHARED0 + (ROW)) + 4 * lane; \
            _Pragma("unroll") for (int j = 0; j < 4; ++j) YW[k][j] = *(const int*)(yr_ + 256 * j); } } while (0)
    FIN_LOAD(xw, yw, gw, dcur);
#pragma unroll 1
    for (int row = gw; row < NTOK; row += NGW) {
        const int rn = clampr(row + NGW), rn2 = clampr(row + 2 * NGW);
        FIN_LOAD(xn, yn, rn, dnxt);
        const int dn2 = DPOS[rn2 * 8 + (lane & 7)]; const float gn2 = GATE[rn2 * 8 + (lane & 7)];
        const int b = row / SEQ;
        f32x4 v[4]; float s = 0.f;
#pragma unroll
        for (int j = 0; j < 4; ++j) {
            const int col = 4 * lane + 256 * j;
            f32x4 y = (f32x4){0.f, 0.f, 0.f, 0.f};
#pragma unroll
            for (int k = 0; k < 9; ++k) { const int wv = yw[k][j]; const float gk = (k < 8 ? __uint_as_float(__builtin_amdgcn_readlane(__float_as_uint(gcur), k)) : 1.0f) * YD_INV;
                const f32x2 lo = __builtin_amdgcn_cvt_pk_f32_fp8(wv, false), hi = __builtin_amdgcn_cvt_pk_f32_fp8(wv, true);
                y[0] += gk * lo.x; y[1] += gk * lo.y; y[2] += gk * hi.x; y[3] += gk * hi.y; }
            const f32x4 gf = *(const f32x4*)(mod + (size_t)b * 6144 + 5 * DM + col);
            v[j] = xw[j] + gf * y;
            s += (v[j][0] * v[j][0] + v[j][1] * v[j][1]) + (v[j][2] * v[j][2] + v[j][3] * v[j][3]);
        }
        const float rstd = rsqrtf(wave_sum(s) * (1.f / DM) + NORM_EPS);
        f32x4* xo = (f32x4*)(a.out + (size_t)row * DM) + lane;
#pragma unroll
        for (int j = 0; j < 4; ++j) xo[64 * j] = (v[j] * rstd) * g4[j];
#pragma unroll
        for (int j = 0; j < 4; ++j) xw[j] = xn[j];
#pragma unroll
        for (int k = 0; k < 9; ++k)
#pragma unroll
            for (int j = 0; j < 4; ++j) yw[k][j] = yn[k][j];
        dcur = dnxt; gcur = gnxt; dnxt = dn2; gnxt = gn2;
    }
#undef FIN_LOAD
}

constexpr int MT_OFF = 131072, MT_INFO = MT_OFF + 4096;
__device__ __forceinline__ void moe_tables_to_lds(Frame& F, int ntiles) {
    const int* TILE_E = (const int*)(F.ws + WS_TILE_E);
    LAS unsigned short* te = (LAS unsigned short*)(F.lds + MT_OFF); LAS int* info = (LAS int*)(F.lds + MT_INFO);
    for (int t = F.tid; t < ntiles; t += NTHR) te[t] = (unsigned short)TILE_E[t];
    for (int e = F.tid; e <= NEXP; e += NTHR) { info[e] = TILE_E[4096 + e]; info[512 + e] = TILE_E[8192 + e]; }
    __syncthreads();
}
constexpr int DW_STR = 192;
constexpr int DW_BUF = 256 * DW_STR;
typedef float f32x4_t __attribute__((ext_vector_type(4)));
#define MFMA16(a, b, c) __builtin_amdgcn_mfma_f32_16x16x32_bf16((a), (b), (c), 0, 0, 0)
template <int MODE> __device__ __forceinline__ void down_phase(Frame& F, const Args& a) {
    const int* TILE_E = (const int*)(F.ws + WS_TILE_E); const int ntiles = __builtin_amdgcn_readfirstlane(TILE_E[MAX_TILES]);
    moe_tables_to_lds(F, ntiles);
    const LAS unsigned short* tile_e = (const LAS unsigned short*)(F.lds + MT_OFF); const LAS int* info = (const LAS int*)(F.lds + MT_INFO);
    const int lane = F.lane, w = F.wave, fr = lane & 15, g4 = lane >> 4;
    LAS unsigned char* lds = F.lds;
    const bf16_t* HID = (const bf16_t*)(F.ws + WS_HID);
    const int sk = F.tid >> 4, sn4 = F.tid & 15;
    const int spos = 16 * (sn4 & 3) + 4 * (sn4 >> 2);
    const int q4 = (lane & 15) >> 2, p4 = lane & 3;
    auto next_tile = [&](int i) -> int { const long L = (long)i * F.G + (int)blockIdx.x; return L < ntiles ? pg8::xcd_remap((int)L, ntiles) : -1; };
    int ui = 0, tile = next_tile(0);
    if (tile < 0) return;
    f32x4_t st[8], st2[8];
    auto wd_base = [&](int t) -> const float* { const int e = MODE == 1 ? 0 : (int)tile_e[t]; return e < NEXP ? a.in[16] + (size_t)e * (EH * DM) : a.in[19]; };
#define DW_LOAD(R, WB, C) do { const float* p_ = (WB) + (size_t)sk * DM + (C) * 64 + sn4 * 4; _Pragma("unroll") for (int i = 0; i < 8; ++i) R[i] = *(const f32x4_t*)(p_ + (size_t)i * 32 * DM); } while (0)
#define DW_WRITE(R, SLOT) do { _Pragma("unroll") for (int i = 0; i < 8; ++i) { const int k_ = sk + 32 * i; u32x2 w_; w_.x = cvtpk(R[i][0], R[i][1]); w_.y = cvtpk(R[i][2], R[i][3]); \
        *(LAS u32x2*)(lds + (SLOT) * DW_BUF + k_ * DW_STR + (((spos >> 4) ^ ((k_ >> 3) & 1)) << 5) + (spos & 15) * 2) = w_; } } while (0)
    const float* wb = wd_base(tile);
    int ntile = next_tile(1);
    const float* nwb = ntile >= 0 ? wd_base(ntile) : wb;
    DW_LOAD(st, wb, 0); DW_WRITE(st, 0);
    DW_LOAD(st, wb, 1); DW_LOAD(st2, wb, 2);
    __syncthreads();
    int cc = 0;
    for (;;) {
        const int e = (int)tile_e[tile]; const int shift = info[e], lim = info[512 + e];
        bf16x8 af[2][8];
        { const bf16_t* hp = HID + ((size_t)tile * 256 + 32 * w + fr) * EH + 8 * g4;
#pragma unroll
          for (int m = 0; m < 2; ++m)
#pragma unroll
              for (int ks = 0; ks < 8; ++ks) af[m][ks] = *(const bf16x8*)(hp + (size_t)m * 16 * EH + 32 * ks);
#pragma unroll
          for (int m = 0; m < 2; ++m)
#pragma unroll
              for (int ks = 0; ks < 8; ++ks) asm volatile("" : "+v"(af[m][ks])); }
        const int pos0 = tile * 256 + 32 * w + fr;
#pragma unroll 1
        for (int c = 0; c < 16; c += 2) {
#pragma unroll
            for (int hc = 0; hc < 2; ++hc, ++cc) {
                const int cq = c + hc;
                f32x4 acc[2][4];
                if (MODE == 3) {
#pragma unroll
                    for (int m = 0; m < 2; ++m)
#pragma unroll
                        for (int nf = 0; nf < 4; ++nf) acc[m][nf] = (f32x4){0.f, 0.f, 0.f, 0.f}; }
                LAS unsigned char* bb = lds + (cc & 1) * DW_BUF + (8 * g4 + q4) * DW_STR + 8 * p4;
#pragma unroll 1
                for (int rp_ = 0; rp_ < (MODE == 3 ? a.pad : (PROBE_PHASE == 40 ? 2 + a.pad : 1)); ++rp_) {
#pragma unroll
                for (int m = 0; m < 2; ++m)
#pragma unroll
                    for (int nf = 0; nf < 4; ++nf) acc[m][nf] = (f32x4){0.f, 0.f, 0.f, 0.f};
#pragma unroll
                for (int ks = 0; ks < 8; ++ks) {
#pragma unroll
                    for (int nf = 0; nf < 4; ++nf) {
                        LAS unsigned char* pp = bb + ks * (32 * DW_STR) + ((nf ^ (g4 & 1)) << 5);
                        const s16x4 lo = tr_read(pp), hi = tr_read(pp + 4 * DW_STR);
                        const bf16x8 bf = __builtin_shufflevector(lo, hi, 0, 1, 2, 3, 4, 5, 6, 7);
                        acc[0][nf] = MFMA16(bf, af[0][ks], acc[0][nf]); acc[1][nf] = MFMA16(bf, af[1][ks], acc[1][nf]);
                    }
                }
                }
                u32x4 ow[2];
#pragma unroll
                for (int m = 0; m < 2; ++m) { ow[m].x = pk4_fp8(acc[m][0][0], acc[m][0][1], acc[m][0][2], acc[m][0][3]); ow[m].y = pk4_fp8(acc[m][1][0], acc[m][1][1], acc[m][1][2], acc[m][1][3]);
                    ow[m].z = pk4_fp8(acc[m][2][0], acc[m][2][1], acc[m][2][2], acc[m][2][3]); ow[m].w = pk4_fp8(acc[m][3][0], acc[m][3][1], acc[m][3][2], acc[m][3][3]); }
                const int c3 = cq + 3; const float* b3 = c3 < 16 ? wb : nwb; const int k3 = c3 < 16 ? c3 : c3 - 16;
                if (hc == 0) { DW_WRITE(st, (cc + 1) & 1); DW_LOAD(st, b3, k3); } else { DW_WRITE(st2, (cc + 1) & 1); DW_LOAD(st2, b3, k3); }
#pragma unroll
                for (int m = 0; m < 2; ++m) {
                    const int pos = pos0 + 16 * m;
                    unsigned char* rowp = (pos < lim ? ydense_row(F.ws, pos - shift) : F.ws + WS_SS + (size_t)blockIdx.x * 2048) + 64 * cq + 16 * g4;
                    if (MODE >= 2) asm volatile("" :: "v"(ow[m])); else *(u32x4*)rowp = ow[m];
                }
                __syncthreads();
            }
        }
        if (ntile < 0) break;
        tile = ntile; wb = nwb; ++ui;
        ntile = next_tile(ui + 1); nwb = ntile >= 0 ? wd_base(ntile) : wb;
    }
#undef DW_LOAD
#undef DW_WRITE
}

constexpr int N_PHASES = 13;
__global__ void __launch_bounds__(NTHR, 2) fwd_kernel(Args args) {
    extern __shared__ __attribute__((aligned(16))) unsigned char lds_raw[];
    Frame F;
    F.lds = (LAS unsigned char*)lds_raw; F.ws = args.ws;
    F.tid = threadIdx.x; F.lane = F.tid & 63; F.wave = __builtin_amdgcn_readfirstlane(F.tid >> 6);
    F.G = gridDim.x; { const int bx = blockIdx.x; F.vcu = (F.G % 8 == 0) ? (bx % 8) * (F.G / 8) + bx / 8 : bx; }
    volatile LAS unsigned* MISC = (volatile LAS unsigned*)(F.lds + MISC_OFF);
    for (int u = F.tid; u < (LDS_BYTES - LDSCTL_OFF) / 4; u += NTHR) ((LAS unsigned*)(F.lds + LDSCTL_OFF))[u] = 0u;
    __syncthreads();
    unsigned* ctl = (unsigned*)(F.ws + WS_CTL);
    XcdBarrier bar; bar.bar = ctl + CW_BAR; bar.x = 0; bar.st = nullptr;
    const int lo = args.ph_lo, hi = args.ph_hi;
    if (hi - lo > 1) bar = xcd_barrier_post(ctl + CW_BAR, MISC + 8);
#ifdef ONLY_PHASE
#define IN(k) ((k) == ONLY_PHASE && lo <= (k) && (k) < hi)
#else
#define IN(k) (lo <= (k) && (k) < hi)
#endif
#define SEAM(k) do { if (IN(k) && IN((k) + 1)) xcd_barrier(bar); } while (0)
#ifndef PROBE_PHASE
#define PROBE_PHASE -1
#endif
#define REP(k) _Pragma("unroll 1") for (int rep_ = 0; rep_ < ((k) == PROBE_PHASE ? 2 + args.pad : 1); ++rep_)
    const float* mod = (const float*)(F.ws + WS_MOD);
    bf16_t* HB = (bf16_t*)(F.ws + WS_H);

    if (IN(0)) REP(0) { phase0(F, args); } SEAM(0);
    if (IN(1)) REP(1) { norm_mod_rows<false>(F, args.in[0], args.in[4], mod, 0, DM, nullptr, HB); } SEAM(1);
    if (IN(2)) REP(2) {
        EpiInProj E{F.ws, (const float*)(F.ws + WS_ROPE_C), (const float*)(F.ws + WS_ROPE_S)};
        { pg8::StaticOrder S; S.init(HB, (const bf16_t*)(F.ws + WS_WIN), NTOK, PROJW - 3 * DM, DM, F.G, (int)blockIdx.x, 12);
          pg8::gemm_phase<EpiInProj, pg8::StaticOrder, true>(F.lds, S, E); }
        { pg8::StaticOrder S; S.init(HB, (const bf16_t*)(F.ws + WS_WIN), NTOK, 3 * DM, DM, F.G, (int)blockIdx.x, 0);
          pg8::gemm_phase<EpiInProj, pg8::StaticOrder, true>(F.lds, S, E); }
    } SEAM(2);
    if (IN(3)) {
#ifndef NO_RET
        REP(30) for (int ch = F.vcu; ch < 256; ch += F.G) retention_chain_rs(F, args, ch);
#endif
#ifndef NO_ATT
        const int per = (6144 + F.G - 1) / F.G;
        attention_phase(F, F.vcu * per, (F.vcu + 1) * per < 6144 ? (F.vcu + 1) * per : 6144, args.pad);
#endif
    } SEAM(3);
    if (IN(4)) REP(4) { mixer_post_rows(F); } SEAM(4);
    if (IN(5)) REP(5) {
        pg8::DualOrder S; S.so.init((const bf16_t*)(F.ws + WS_RETN), (const bf16_t*)(F.ws + WS_WRU), NTOK, DM, DM, F.G, (int)blockIdx.x);
        S.A1 = (const bf16_t*)(F.ws + WS_ATTC); S.Bt1 = (const bf16_t*)(F.ws + WS_WAU); S.K = DM;
        EpiMerge E{(bf16_t*)(F.ws + WS_MERGED), F.ws + WS_SGR, F.ws + WS_SGA};
        pg8::gemm_phase<EpiMerge, pg8::DualOrder, true>(F.lds, S, E);
    } SEAM(5);
    if (IN(6)) REP(6) {
        pg8::StaticOrder S; S.init((const bf16_t*)(F.ws + WS_MERGED), (const bf16_t*)(F.ws + WS_WO), NTOK, DM, DM, F.G, (int)blockIdx.x);
        EpiOProj E{args.in[0], (bf16_t*)(F.ws + WS_X1B), mod, (float*)(F.ws + WS_SS)};
        pg8::gemm_phase<EpiOProj, pg8::StaticOrder, true>(F.lds, S, E);
    } SEAM(6);
    if (IN(7)) REP(7) {
        norm_mod_rows<true>(F, F.ws + WS_X1B, args.in[11], mod, 3 * DM, 4 * DM, (const float*)(F.ws + WS_SS), HB);
    } SEAM(7);
    if (IN(8)) {
        pg8::StaticOrder S; S.init(HB, (const bf16_t*)(F.ws + WS_WR), NTOK, NEXP, DM, F.G, (int)blockIdx.x);
        EpiF32 E{(float*)(F.ws + WS_LOGIT), NEXP};
        pg8::gemm_phase<EpiF32, pg8::StaticOrder, true>(F.lds, S, E);
        __syncthreads();
        moe_weight_convert(F, args);
    } SEAM(8);
    if (IN(9)) { routing_rows(F, args); } SEAM(9);
    if (IN(10)) { routing_lists(F); } SEAM(10);
    if (IN(11)) REP(11) {
        const int* TILE_E = (const int*)(F.ws + WS_TILE_E); const int ntiles = __builtin_amdgcn_readfirstlane(TILE_E[MAX_TILES]);
        pg8::MoeOrder<true> S; S.A = HB; S.Bt = (const bf16_t*)(F.ws + WS_WGU); S.K = DM; S.e_stride = (size_t)512 * 1024; S.tile_e = (const LAS unsigned short*)(F.lds + MT_OFF); S.rowlist = (const int*)(F.ws + WS_ROWL); moe_tables_to_lds(F, ntiles);
        S.ntiles = ntiles; S.nN = 2; S.nwg = ntiles * 2; S.G = F.G; S.c = (int)blockIdx.x;
        EpiGU E{(bf16_t*)(F.ws + WS_HID)};
        pg8::gemm_phase<EpiGU, pg8::MoeOrder<true>, true>(F.lds, S, E);
    } SEAM(11);
    if (IN(12)) REP(12) {
        down_phase<0>(F, args);
    } SEAM(12);
    if (IN(13)) { final_rows(F, args); }
#if PROBE_LAUNCH == 14
    if (lo == 14) {
        pg8::StaticOrder S; S.init(HB, (const bf16_t*)(F.ws + WS_WIN), NTOK, PROJW, DM, F.G, (int)blockIdx.x);
        EpiNull E{};
        pg8::gemm_phase<EpiNull, pg8::StaticOrder, true>(F.lds, S, E);
    }
#endif
#if PROBE_LAUNCH == 16
    if (lo == 14) {
        const int* TILE_E = (const int*)(F.ws + WS_TILE_E); const int ntiles = __builtin_amdgcn_readfirstlane(TILE_E[MAX_TILES]);
        pg8::MoeOrder<false> S; S.A = (const bf16_t*)(F.ws + WS_HID); S.Bt = (const bf16_t*)(F.ws + WS_WD); S.K = EH; S.e_stride = (size_t)1024 * 256; S.tile_e = (const LAS unsigned short*)(F.lds + MT_OFF); S.rowlist = (const int*)(F.ws + WS_ROWL); moe_tables_to_lds(F, ntiles);
        S.ntiles = ntiles; S.nN = 4; S.nwg = ntiles * 4; S.G = F.G; S.c = (int)blockIdx.x;
        EpiNull E{};
        pg8::gemm_phase<EpiNull, pg8::MoeOrder<false>, true>(F.lds, S, E);
    }
#endif
#if PROBE_LAUNCH == 18
    if (lo == 14) { down_phase<1>(F, args); }
#endif
#if PROBE_LAUNCH == 19
    if (lo == 14) { down_phase<2>(F, args); }
#endif
#if PROBE_LAUNCH == 20
    if (lo == 14) { down_phase<3>(F, args); }
#endif
#if PROBE_LAUNCH == 17
    if (lo == 14) {
        const int* TILE_E = (const int*)(F.ws + WS_TILE_E); const int ntiles = __builtin_amdgcn_readfirstlane(TILE_E[MAX_TILES]);
        pg8::MoeOrder<false> S; S.A = (const bf16_t*)(F.ws + WS_HID); S.Bt = (const bf16_t*)(F.ws + WS_WD); S.K = EH; S.e_stride = (size_t)1024 * 256; S.tile_e = (const LAS unsigned short*)(F.lds + MT_OFF); S.rowlist = (const int*)(F.ws + WS_ROWL); moe_tables_to_lds(F, ntiles);
        S.ntiles = ntiles; S.nN = 4; S.nwg = ntiles * 4; S.G = F.G; S.c = (int)blockIdx.x;
        EpiDownT<1> E{F.ws, (const LAS int*)(F.lds + MT_INFO)};
        pg8::gemm_phase<EpiDownT<1>, pg8::MoeOrder<false>, true>(F.lds, S, E);
    }
#endif
#if PROBE_LAUNCH == 15
    if (lo == 14) {
        pg8::StaticOrder S; S.init(HB, (const bf16_t*)(F.ws + WS_WIN), NTOK, PROJW, DM, F.G, (int)blockIdx.x);
        EpiPlainScratch E{(bf16_t*)(F.ws + WS_OUTF)};
        pg8::gemm_phase<EpiPlainScratch, pg8::StaticOrder, true>(F.lds, S, E);
    }
#endif
#undef IN
#undef SEAM
}

extern "C" void kernel_launch(void* const* d_in, const int* in_sizes, int n_in, void* d_out, int out_size, void* d_ws, size_t ws_size, hipStream_t stream) {
    static int grid = 0;
    if (grid == 0) {
        if (n_in != 21 || out_size != NTOK * DM || ws_size < WS_END) { fprintf(stderr, "kernel_launch: unexpected shapes (n_in %d out %d ws %zu)\n", n_in, out_size, ws_size); grid = -1; return; }
        int dev = 0, cus = 0, per_cu = 0;
        if (hipGetDevice(&dev) != hipSuccess || hipDeviceGetAttribute(&cus, hipDeviceAttributeMultiprocessorCount, dev) != hipSuccess) { grid = -1; return; }
        if (hipFuncSetAttribute((const void*)fwd_kernel, hipFuncAttributeMaxDynamicSharedMemorySize, LDS_BYTES) != hipSuccess) { fprintf(stderr, "kernel_launch: hipFuncSetAttribute failed\n"); grid = -1; return; }
        if (hipOccupancyMaxActiveBlocksPerMultiprocessor(&per_cu, (const void*)fwd_kernel, NTHR, LDS_BYTES) != hipSuccess || per_cu < 1)
            fprintf(stderr, "kernel_launch: note: occupancy query reports %d\n", per_cu);
        (void)hipGetLastError();
        grid = cus;
    }
    if (grid < 0) return;
    (void)hipMemsetAsync((char*)d_ws + WS_CTL, 0, CTL_ZERO_BYTES, stream);
    Args a{};
    for (int i = 0; i < 21; ++i) a.in[i] = (const float*)d_in[i];
    a.out = (float*)d_out; a.ws = (unsigned char*)d_ws;
#if MK_N_LAUNCHES == 1
    a.ph_lo = 0; a.ph_hi = N_PHASES + 1; a.li = 0;
    hipLaunchKernelGGL(fwd_kernel, dim3(grid), dim3(NTHR), LDS_BYTES, stream, a);
#else
    for (int p = 0; p <= N_PHASES; ++p) {
        if ((PROBE_LAUNCH == 18 || PROBE_LAUNCH == 19 || PROBE_LAUNCH == 20) && p == 12) { a.ph_lo = 14; a.ph_hi = 15; hipLaunchKernelGGL(fwd_kernel, dim3(grid), dim3(NTHR), LDS_BYTES, stream, a); }
        a.ph_lo = p; a.ph_hi = p + 1; a.li = p; hipLaunchKernelGGL(fwd_kernel, dim3(grid), dim3(NTHR), LDS_BYTES, stream, a);
        if (p == PROBE_LAUNCH) hipLaunchKernelGGL(fwd_kernel, dim3(grid), dim3(NTHR), LDS_BYTES, stream, a);
        if (((PROBE_LAUNCH == 14 || PROBE_LAUNCH == 15) && p == 2) || ((PROBE_LAUNCH == 16 || PROBE_LAUNCH == 17) && p == 12)) { a.ph_lo = 14; a.ph_hi = 15; hipLaunchKernelGGL(fwd_kernel, dim3(grid), dim3(NTHR), LDS_BYTES, stream, a); } }
#endif
}
```

```cpp
#include <hip/hip_runtime.h>
#include <cstdio>
#include <cstdint>

#ifndef MK_N_LAUNCHES
#define MK_N_LAUNCHES 1
#endif
#define PROBE_LAUNCH -1
#ifndef PROBE_PHASE
#define PROBE_PHASE -1
#endif

#define LAS __attribute__((address_space(3)))
#define GAS __attribute__((address_space(1)))
typedef unsigned short bf16_t;
typedef short bf16x8 __attribute__((ext_vector_type(8)));
typedef short s16x4 __attribute__((ext_vector_type(4)));
typedef float f32x2 __attribute__((ext_vector_type(2)));
typedef float f32x4 __attribute__((ext_vector_type(4)));
typedef float f32x16 __attribute__((ext_vector_type(16)));
typedef unsigned u32x2 __attribute__((ext_vector_type(2)));
typedef unsigned u32x4 __attribute__((ext_vector_type(4)));
typedef int i32x4 __attribute__((ext_vector_type(4)));
typedef __bf16 bf16x2_t __attribute__((ext_vector_type(2)));

constexpr int NB = 8, SEQ = 4096, DM = 1024, NTOK = NB * SEQ;
constexpr int PROJW = 9216, NEXP = 256, TOPK = 8, EH = 256;
constexpr float NORM_EPS = 1e-6f;

constexpr size_t MiB = 1u << 20;
constexpr size_t WS_CTL = 0, CTL_ZERO_BYTES = 1 * MiB;
constexpr size_t WS_MOD = 1 * MiB;
constexpr size_t WS_BTAB = 1 * MiB + 256 * 1024;
constexpr size_t WS_ROPE_C = 2 * MiB, WS_ROPE_S = 4 * MiB;
constexpr size_t WS_SS = 6 * MiB;
constexpr size_t WS_EIDX = 8 * MiB, WS_GATE = 9 * MiB;
constexpr size_t WS_ROWL = 10 * MiB;
constexpr size_t WS_TILE_E = 12 * MiB;
constexpr size_t WS_WIN = 16 * MiB, WS_WRU = 34 * MiB, WS_WAU = 36 * MiB, WS_WO = 38 * MiB, WS_WR = 40 * MiB;
constexpr size_t WS_H = 48 * MiB;
constexpr size_t WS_PROJ = 120 * MiB;
constexpr size_t SEG = 64 * MiB;
constexpr size_t WS_RQ = WS_PROJ, WS_RK = WS_PROJ + SEG, WS_RV = WS_PROJ + 2 * SEG, WS_RG = WS_PROJ + 3 * SEG, WS_AQ = WS_PROJ + 4 * SEG,
                 WS_AK = WS_PROJ + 5 * SEG, WS_AV = WS_PROJ + 6 * SEG, WS_SGR = WS_PROJ + 7 * SEG, WS_SGA = WS_PROJ + 8 * SEG;
constexpr size_t WS_OUTF = 696 * MiB, WS_OUTB = 760 * MiB, WS_OG = 824 * MiB, WS_LSE = 1016 * MiB;
constexpr size_t WS_RETN = WS_RQ, WS_ATTC = WS_RK, WS_YR = WS_RV, WS_MERGED = WS_AQ;
constexpr size_t WS_WGU = 120 * MiB, WS_WD = 377 * MiB, WS_HID = 512 * MiB, WS_LOGIT = 696 * MiB;
constexpr size_t WS_H8 = 48 * MiB, WS_H8B = 384 * MiB;
constexpr size_t WS_X1B = 448 * MiB;
constexpr size_t WS_END = 1022 * MiB;
constexpr int YD_SPLIT = 262144, YD_SHARED0 = NTOK * TOPK;
constexpr float YD_SCALE = 16.0f, YD_INV = 0.0625f;
__device__ __forceinline__ unsigned char* ydense_row(unsigned char* ws, int row) { return ws + (row < YD_SPLIT ? 120 * MiB : 696 * MiB) + (size_t)(row < YD_SPLIT ? row : row - YD_SPLIT) * DM; }
__device__ __forceinline__ unsigned pk4_fp8(float a, float b, float c, float d) {
    a = __builtin_fminf(__builtin_fmaxf(a * YD_SCALE, -448.f), 448.f); b = __builtin_fminf(__builtin_fmaxf(b * YD_SCALE, -448.f), 448.f);
    c = __builtin_fminf(__builtin_fmaxf(c * YD_SCALE, -448.f), 448.f); d = __builtin_fminf(__builtin_fmaxf(d * YD_SCALE, -448.f), 448.f);
    int w = __builtin_amdgcn_cvt_pk_fp8_f32(a, b, 0, false); w = __builtin_amdgcn_cvt_pk_fp8_f32(c, d, w, true); return (unsigned)w;
}
constexpr float W8_SCALE = 256.0f, FP8_UNSCALE = 1.0f / 4096.0f;
__device__ __forceinline__ unsigned pk4_fp8w(float a, float b, float c, float d) {
    a = __builtin_fminf(__builtin_fmaxf(a * W8_SCALE, -448.f), 448.f); b = __builtin_fminf(__builtin_fmaxf(b * W8_SCALE, -448.f), 448.f);
    c = __builtin_fminf(__builtin_fmaxf(c * W8_SCALE, -448.f), 448.f); d = __builtin_fminf(__builtin_fmaxf(d * W8_SCALE, -448.f), 448.f);
    int w = __builtin_amdgcn_cvt_pk_fp8_f32(a, b, 0, false); w = __builtin_amdgcn_cvt_pk_fp8_f32(c, d, w, true); return (unsigned)w;
}
constexpr size_t WS_DPOS = 13 * MiB;
constexpr int CW_TMO = 0, CW_BAR = 4096, CW_CNT = 16384, CW_FILL = 16384 + 1024;
constexpr int MAX_TILES = 2048;

__device__ __forceinline__ unsigned cvtpk(float lo, float hi) { f32x2 v = {lo, hi}; bf16x2_t b = __builtin_convertvector(v, bf16x2_t); return __builtin_bit_cast(unsigned, b); }
__device__ __forceinline__ float bf2f(unsigned short u) { return __uint_as_float((unsigned)u << 16); }
__device__ __forceinline__ float bflo(unsigned u) { return __uint_as_float(u << 16); }
__device__ __forceinline__ float bfhi(unsigned u) { return __uint_as_float(u & 0xffff0000u); }
__device__ __forceinline__ float wave_sum(float v) {
#pragma unroll
    for (int o = 1; o < 64; o <<= 1) v += __shfl_xor(v, o);
    return v;
}
__device__ __forceinline__ float sigmoidf_(float x) { return __builtin_amdgcn_rcpf(1.f + __builtin_amdgcn_exp2f(x * -1.4426950408889634f)); }
__device__ __forceinline__ float siluf_(float x) { return x * __builtin_amdgcn_rcpf(1.f + __builtin_amdgcn_exp2f(x * -1.4426950408889634f)); }

namespace pg8 {
constexpr int BM = 256, BK = 64, HALF = 128, HTB = HALF * BK * 2, STAGE_BYTES = 8 * HTB, NXCD = 8, WGM = 8;
__host__ __device__ __forceinline__ int lds_byte(int r, int c) { const int st = (r >> 4) * 2 + (c >> 5), rr = r & 15, cc = c & 31, ob = rr * 64 + cc * 2; return st * 1024 + (ob ^ (((ob >> 9) & 1) << 5)); }
__host__ __device__ __forceinline__ void stage_rc(int b, int& R, int& C) { const int st = b / 1024, sb = b % 1024, swz = sb ^ (((sb >> 9) & 1) << 5); R = (st >> 1) * 16 + swz / 64; C = (st & 1) * 32 + (swz % 64) / 2; }
__host__ __device__ __forceinline__ int perm32(int rho) { const int n = rho >> 4, i = rho & 15; return 8 * (i >> 2) + 4 * n + (i & 3); }

struct Unit { int pm, pn, e; };

__device__ __forceinline__ int xcd_remap(int L, int nwg) { const int q = nwg / NXCD, r = nwg % NXCD, xcd = L % NXCD, off = L / NXCD; return (xcd < r ? xcd * (q + 1) : r * (q + 1) + (xcd - r) * q) + off; }

struct StaticOrder {
    static constexpr bool GATHER = false, DUAL = false;
    const bf16_t* A; const bf16_t* Bt; int K;
    int nM, nN, nwg, G, c, pn_off;
    __device__ void init(const bf16_t* A_, const bf16_t* Bt_, int M, int N, int K_, int G_, int c_, int pn_off_ = 0) { A = A_; Bt = Bt_; K = K_; nM = M / BM; nN = N / BM; nwg = nM * nN; G = G_; c = c_; pn_off = pn_off_; }
    __device__ bool next(int i, Unit& u) const {
        const long L = (long)i * G + c; if (L >= nwg) return false;
        const int wgid = xcd_remap((int)L, nwg);
        const int nig = WGM * nN, gid = wgid / nig, fm = gid * WGM, gsz = (nM - fm) < WGM ? (nM - fm) : WGM;
        u.pm = fm + ((wgid % nig) % gsz); u.pn = (wgid % nig) / gsz + pn_off; u.e = 0; return true;
    }
    __device__ __forceinline__ const char* a_base(const Unit& u) const { return (const char*)A + (size_t)u.pm * (size_t)(BM * 2) * K; }
    __device__ __forceinline__ const char* b_base(const Unit& u) const { return (const char*)Bt + (size_t)u.pn * (size_t)(BM * 2) * K; }
    __device__ __forceinline__ unsigned a_row(const Unit&, int) const { return 0u; }
};

struct DualOrder {
    static constexpr bool GATHER = false, DUAL = true;
    StaticOrder so; const bf16_t* A1; const bf16_t* Bt1; int K;
    __device__ bool next(int i, Unit& u) const { if (!so.next(i >> 1, u)) return false; u.e = i & 1; return true; }
    __device__ __forceinline__ const char* a_base(const Unit& u) const { return (const char*)(u.e ? A1 : so.A) + (size_t)u.pm * (size_t)(BM * 2) * K; }
    __device__ __forceinline__ const char* b_base(const Unit& u) const { return (const char*)(u.e ? Bt1 : so.Bt) + (size_t)u.pn * (size_t)(BM * 2) * K; }
    __device__ __forceinline__ unsigned a_row(const Unit&, int) const { return 0u; }
};

template <bool GATHER_>
struct MoeOrder {
    static constexpr bool GATHER = GATHER_, DUAL = false;
    const bf16_t* A; const bf16_t* Bt; int K; size_t e_stride;
    const LAS unsigned short* tile_e; const int* rowlist; int ntiles, nN, nwg, G, c;
    __device__ bool next(int i, Unit& u) const {
        const long L = (long)i * G + c; if (L >= nwg) return false;
        const int wgid = xcd_remap((int)L, nwg);
        u.pm = wgid / nN; u.pn = wgid % nN; u.e = __builtin_amdgcn_readfirstlane((int)tile_e[u.pm]); return true;
    }
    __device__ __forceinline__ const char* a_base(const Unit& u) const { return GATHER ? (const char*)A : (const char*)A + (size_t)u.pm * (size_t)(BM * 2) * K; }
    __device__ __forceinline__ const char* b_base(const Unit& u) const { return (const char*)Bt + ((size_t)u.e * e_stride + (size_t)u.pn * BM * K) * 2; }
    __device__ __forceinline__ unsigned a_row(const Unit& u, int r) const { const int ent = rowlist[(size_t)u.pm * BM + r]; return ent < 0 ? (unsigned)NTOK : (unsigned)(ent >> 4); }
};

template <class Epi, class Sched, bool ALIGN_EPI, bool FP8 = false>
__device__ __forceinline__ void gemm_phase(LAS unsigned char* lds, const Sched& S, const Epi& E) {
    const int tid = threadIdx.x, wid = __builtin_amdgcn_readfirstlane(tid >> 6), lane = tid & 63, wr = wid >> 2, wc = wid & 3, fr = lane & 15, fq = lane >> 4;
    const int K = S.K, nt = K / BK;
    unsigned voffA[2], voffB[2]; int RA[2]; unsigned CA2[2];
#pragma unroll
    for (int i = 0; i < 2; ++i) { int R, C; stage_rc(tid * 16 + i * 8192, R, C); const int Rb = Epi::PERM ? ((R & ~31) + perm32(R & 31)) : R;
        voffA[i] = (unsigned)(R * K + C) * 2u; voffB[i] = (unsigned)(Rb * K + C) * 2u; RA[i] = R; CA2[i] = (unsigned)C * 2u; }
    const size_t kstep = (size_t)(BK * 2);
    const size_t hstep = (size_t)HALF * K * 2;
    const unsigned ldsw = (unsigned)wid * 1024u;
    const int aoff = lds_byte(wr * 64 + fr, fq * 8), boff = lds_byte(wc * 32 + fr, fq * 8);
    unsigned gC[2][2], gN[2][2];
#define PG8_SA(b, h) (((b) * 2 + (h)) * HTB)
#define PG8_SB(b, h) ((4 + (b) * 2 + (h)) * HTB)
#define PG8_STAGE(bufoff, gbase, voff) do { _Pragma("unroll") for (int _i = 0; _i < 2; ++_i) \
        __builtin_amdgcn_global_load_lds((const unsigned*)((const char*)(gbase) + (voff)[_i]), (LAS unsigned*)(lds + (bufoff) + ldsw + _i * 8192), 16, 0, 0); } while (0)
#define PG8_STAGE_A(bufoff, p, h, NX) do { if constexpr (Sched::GATHER) { _Pragma("unroll") for (int _i = 0; _i < 2; ++_i) { const unsigned _v = (NX) ? gN[h][_i] : gC[h][_i]; \
        __builtin_amdgcn_global_load_lds((const unsigned*)((const char*)(p) + _v), (LAS unsigned*)(lds + (bufoff) + ldsw + _i * 8192), 16, 0, 0); } } \
        else { PG8_STAGE(bufoff, (p) + (h) * hstep, voffA); } } while (0)
#define PG8_GATHER_SET(g, u) do { _Pragma("unroll") for (int _h = 0; _h < 2; ++_h) _Pragma("unroll") for (int _i = 0; _i < 2; ++_i) \
        g[_h][_i] = S.a_row(u, _h * HALF + RA[_i]) * (unsigned)(K * 2) + CA2[_i]; } while (0)
#define PG8_LDA(dst, b, h) do { _Pragma("unroll") for (int m = 0; m < 4; ++m) _Pragma("unroll") for (int k = 0; k < 2; ++k) dst[m][k] = *(const LAS bf16x8*)(lds + PG8_SA(b, h) + aoff + m * 2048 + k * 1024); } while (0)
#define PG8_LDB(dst, b, h) do { _Pragma("unroll") for (int n = 0; n < 2; ++n) _Pragma("unroll") for (int k = 0; k < 2; ++k) dst[n][k] = *(const LAS bf16x8*)(lds + PG8_SB(b, h) + boff + n * 2048 + k * 1024); } while (0)
#define PG8_CAT(x0, x1) __builtin_shufflevector(__builtin_bit_cast(i32x4, x0), __builtin_bit_cast(i32x4, x1), 0, 1, 2, 3, 4, 5, 6, 7)
#define PG8_MMA(ai, bj, At, Bt) do { __builtin_amdgcn_s_setprio(1); if constexpr (FP8) { _Pragma("unroll") for (int m = 0; m < 4; ++m) _Pragma("unroll") for (int n = 0; n < 2; ++n) \
        asm volatile("v_mfma_f32_16x16x128_f8f6f4 %0, %1, %2, %0" : "+v"(acc[ai][bj][m][n]) : "v"(PG8_CAT(Bt[n][0], Bt[n][1])), "v"(PG8_CAT(At[m][0], At[m][1]))); } else { \
        _Pragma("unroll") for (int m = 0; m < 4; ++m) _Pragma("unroll") for (int n = 0; n < 2; ++n) _Pragma("unroll") for (int k = 0; k < 2; ++k) \
        acc[ai][bj][m][n] = __builtin_amdgcn_mfma_f32_16x16x32_bf16(Bt[n][k], At[m][k], acc[ai][bj][m][n], 0, 0, 0); } __builtin_amdgcn_s_setprio(0); } while (0)
#define PG8_WAIT_V(n) asm volatile("s_waitcnt vmcnt(" #n ")" ::: "memory")
#define PG8_WAIT_L(n) asm volatile("s_waitcnt lgkmcnt(" #n ")" ::: "memory")
#define PG8_BAR __builtin_amdgcn_s_barrier()
#define PG8_SCHED __builtin_amdgcn_sched_barrier(0)
    Unit cur, nxt; int ui = 0;
    if (!S.next(0, cur)) return;
    f32x4 acc[2][2][4][2];
#pragma unroll
    for (int a = 0; a < 2; ++a)
#pragma unroll
        for (int b = 0; b < 2; ++b)
#pragma unroll
            for (int m = 0; m < 4; ++m)
#pragma unroll
                for (int n = 0; n < 2; ++n) acc[a][b][m][n] = (f32x4){0.f, 0.f, 0.f, 0.f};
    bf16x8 At[4][2], B0[2][2], B1[2][2];
    const char* cA = S.a_base(cur); const char* cB = S.b_base(cur);
    if constexpr (Sched::GATHER) { PG8_GATHER_SET(gC, cur); PG8_GATHER_SET(gN, cur); }
    PG8_STAGE(PG8_SB(0, 0), cB, voffB); PG8_STAGE(PG8_SB(0, 1), cB + hstep, voffB); PG8_STAGE_A(PG8_SA(0, 0), cA, 0, false); PG8_STAGE_A(PG8_SA(0, 1), cA, 1, false);
    if (wr == 1) PG8_BAR;
    PG8_WAIT_V(2); PG8_BAR;
    PG8_STAGE(PG8_SB(1, 0), cB + kstep, voffB); PG8_STAGE_A(PG8_SA(1, 0), cA + kstep, 0, false); PG8_STAGE(PG8_SB(1, 1), cB + hstep + kstep, voffB);
    PG8_WAIT_V(6); PG8_BAR;
    for (;;) {
        const bool has_next = S.next(ui + 1, nxt);
        const char* nA = has_next ? S.a_base(nxt) : cA; const char* nB = has_next ? S.b_base(nxt) : cB;
        if constexpr (Sched::GATHER) { if (has_next) { PG8_GATHER_SET(gN, nxt); } }
        for (int t = 0; t < nt; t += 2) {
            const bool last = (t == nt - 2);
            const char* a1 = cA + (size_t)(t + 1) * kstep;
            const char* a2 = last ? nA : cA + (size_t)(t + 2) * kstep; const char* b2 = last ? nB : cB + (size_t)(t + 2) * kstep;
            const char* a3 = a2 + kstep; const char* b3 = b2 + kstep;
            PG8_LDB(B0, 0, 0); PG8_LDB(B1, 0, 1); PG8_SCHED; PG8_LDA(At, 0, 0); PG8_STAGE_A(PG8_SA(1, 1), a1, 1, false);
            PG8_WAIT_V(8); PG8_WAIT_L(0); PG8_BAR; PG8_MMA(0, 0, At, B0); PG8_MMA(0, 1, At, B1); PG8_BAR; PG8_SCHED;
            PG8_LDA(At, 0, 1); PG8_STAGE(PG8_SB(0, 0), b2, voffB); PG8_STAGE(PG8_SB(0, 1), b2 + hstep, voffB); PG8_STAGE_A(PG8_SA(0, 0), a2, 0, last);
            PG8_WAIT_V(8); PG8_WAIT_L(0); PG8_BAR; PG8_MMA(1, 0, At, B0); PG8_MMA(1, 1, At, B1); PG8_BAR; PG8_SCHED;
            PG8_LDB(B0, 1, 0); PG8_LDB(B1, 1, 1); PG8_SCHED; PG8_LDA(At, 1, 0); PG8_STAGE_A(PG8_SA(0, 1), a2, 1, last);
            PG8_WAIT_V(8); PG8_WAIT_L(0); PG8_BAR; PG8_MMA(0, 0, At, B0); PG8_MMA(0, 1, At, B1); PG8_BAR; PG8_SCHED;
            PG8_LDA(At, 1, 1); PG8_STAGE(PG8_SB(1, 0), b3, voffB); PG8_STAGE(PG8_SB(1, 1), b3 + hstep, voffB); PG8_STAGE_A(PG8_SA(1, 0), a3, 0, last);
            PG8_WAIT_V(8); PG8_WAIT_L(0); PG8_BAR; PG8_MMA(1, 0, At, B0); PG8_MMA(1, 1, At, B1); PG8_BAR; PG8_SCHED;
        }
        if constexpr (ALIGN_EPI) { if (wr == 0) PG8_BAR; }
        if constexpr (FP8) {
            asm volatile("s_nop 15\n\ts_nop 15" ::: "memory");
#pragma unroll
            for (int a = 0; a < 2; ++a)
#pragma unroll
                for (int b = 0; b < 2; ++b)
#pragma unroll
                    for (int m = 0; m < 4; ++m)
#pragma unroll
                        for (int n = 0; n < 2; ++n) acc[a][b][m][n] *= FP8_UNSCALE;
        }
        E(acc, cur, wr, wc, fr, fq);
        if (!has_next) break;
        if (!(Sched::DUAL && cur.e == 0))
#pragma unroll
        for (int a = 0; a < 2; ++a)
#pragma unroll
            for (int b = 0; b < 2; ++b)
#pragma unroll
                for (int m = 0; m < 4; ++m)
#pragma unroll
                    for (int n = 0; n < 2; ++n) acc[a][b][m][n] = (f32x4){0.f, 0.f, 0.f, 0.f};
        cur = nxt; cA = nA; cB = nB; ++ui;
        if constexpr (Sched::GATHER) {
#pragma unroll
            for (int h = 0; h < 2; ++h)
#pragma unroll
                for (int i = 0; i < 2; ++i) gC[h][i] = gN[h][i];
        }
        if constexpr (ALIGN_EPI) { if (wr == 1) PG8_BAR; }
    }
    PG8_WAIT_V(0);
    if constexpr (!ALIGN_EPI) { if (wr == 0) PG8_BAR; }
    PG8_BAR;
#undef PG8_SA
#undef PG8_SB
#undef PG8_STAGE
#undef PG8_STAGE_A
#undef PG8_GATHER_SET
#undef PG8_LDA
#undef PG8_LDB
#undef PG8_MMA
#undef PG8_CAT
#undef PG8_WAIT_V
#undef PG8_WAIT_L
#undef PG8_BAR
#undef PG8_SCHED
}
}

typedef GAS unsigned gu32;
#define RLX_AGENT __ATOMIC_RELAXED, __HIP_MEMORY_SCOPE_AGENT
#define XB_TMO      128
#define XB_XCNT(j)  (256  + 64 * (j))
#define XB_XSUB(j)  (1280 + 64 * (j))
#define XB_XGEN(j)  (2304 + 64 * (j))
#define XB_TOP      3328
#define XB_TOPGEN   3392
#define XCD_BAR_WORDS 3456
#define XB_SPIN_CAP (1u << 18)
__device__ __forceinline__ unsigned xb_ld(unsigned* p)              { return __hip_atomic_load(p, __ATOMIC_RELAXED, __HIP_MEMORY_SCOPE_AGENT); }
__device__ __forceinline__ unsigned xb_add(unsigned* p, unsigned v) { return __hip_atomic_fetch_add(p, v, __ATOMIC_RELAXED, __HIP_MEMORY_SCOPE_AGENT); }
__device__ __forceinline__ unsigned xb_xcc_id() { return (unsigned)__builtin_amdgcn_s_getreg((3 << 11) | 20) & 0xFu; }
#define XB_SPIN(cond, bar) do { unsigned _sp = 0; while (cond) { __builtin_amdgcn_s_sleep(1); \
    if ((++_sp & 255u) == 0u) { if (xb_ld(&(bar)[XB_TMO])) break; if (_sp > XB_SPIN_CAP) { atomicAdd(&(bar)[XB_TMO], 1u); break; } } } } while (0)
struct XcdBarrier { unsigned* bar; unsigned x; volatile LAS unsigned* st; };
__device__ __forceinline__ XcdBarrier xcd_barrier_post(unsigned* bar, volatile LAS unsigned* st) {
    XcdBarrier b; b.bar = bar; b.x = xb_xcc_id(); b.st = st;
    if (threadIdx.x == 0) (void)xb_add(&bar[XB_XCNT(b.x)], 1u);
    return b;
}
__device__ __forceinline__ void xcd_barrier_complete(unsigned* bar, unsigned x, unsigned& nloc, unsigned& nx) {
    const unsigned G = gridDim.x * gridDim.y * gridDim.z;
    unsigned sum, cnt, mine, sp = 0u;
    for (;;) {
        sum = 0u; cnt = 0u; mine = 0u;
#pragma unroll
        for (unsigned j = 0; j < 16; ++j) { const unsigned c = xb_ld(&bar[XB_XCNT(j)]); sum += c; cnt += (c > 0u) ? 1u : 0u; mine = (j == x) ? c : mine; }
        if (sum == G) break;
        __builtin_amdgcn_s_sleep(1);
        if ((++sp & 255u) == 0u) { if (xb_ld(&bar[XB_TMO])) break; if (sp > XB_SPIN_CAP) { atomicAdd(&bar[XB_TMO], 1u); break; } }
    }
    nloc = mine > 0u ? mine : 1u; nx = cnt > 0u ? cnt : 1u;
}
__device__ __forceinline__ void xcd_barrier(const XcdBarrier& b) {
    asm volatile("s_waitcnt vmcnt(0)" ::: "memory");
    __syncthreads();
    if (threadIdx.x == 0) {
        unsigned* bar = b.bar;
        __builtin_amdgcn_s_waitcnt(0);
        unsigned nloc = b.st[0], nx = b.st[1];
        if (nloc == 0u) { xcd_barrier_complete(bar, b.x, nloc, nx); b.st[0] = nloc; b.st[1] = nx; }
        const unsigned old = xb_add(&bar[XB_XSUB(b.x)], 1u);
        const unsigned gen = old / nloc;
        if (old + 1u == (gen + 1u) * nloc) {
            __builtin_amdgcn_fence(__ATOMIC_RELEASE, "agent");
            asm volatile("s_waitcnt vmcnt(0)" ::: "memory");
            const unsigned og = xb_add(&bar[XB_TOP], 1u);
            const unsigned tg = og / nx;
            if (og + 1u == (tg + 1u) * nx) xb_add(&bar[XB_TOPGEN], 1u);
            else XB_SPIN(xb_ld(&bar[XB_TOPGEN]) == tg, bar);
            __builtin_amdgcn_fence(__ATOMIC_ACQUIRE, "agent");
            xb_add(&bar[XB_XGEN(b.x)], 1u);
            asm volatile("s_waitcnt vmcnt(0)" ::: "memory");
        } else {
            XB_SPIN(xb_ld(&bar[XB_XGEN(b.x)]) == gen, bar);
            __builtin_amdgcn_fence(__ATOMIC_ACQUIRE, "agent");
            asm volatile("s_waitcnt vmcnt(0)" ::: "memory");
        }
    }
    __syncthreads();
}

constexpr int NWAVES = 8, NTHR = 512;
constexpr int LDS_BYTES = 147456, LDSCTL_OFF = LDS_BYTES - 1024, MISC_OFF = LDSCTL_OFF + 320;

struct Args { const float* in[21]; float* out; unsigned char* ws; int ph_lo, ph_hi, li, pad; };

struct Frame {
    LAS unsigned char* lds;
    unsigned char* ws;
    int tid, lane, wave, vcu, G;
};

struct EpiInProj {
    static constexpr bool PERM = true;
    unsigned char* ws; const float* rc; const float* rs;
    __device__ __forceinline__ void operator()(const f32x4 (&acc)[2][2][4][2], const pg8::Unit& u, int wr, int wc, int fr, int fq) const {
        const int seg = u.pn >> 2;
        bf16_t* O = (bf16_t*)(ws + WS_PROJ + (size_t)seg * SEG);
        const int colt = (u.pn & 3) * 256;
        const int row0 = u.pm * 256 + wr * 64 + fr;
        const int d = wc * 32 + 8 * fq;
#pragma unroll
        for (int ai = 0; ai < 2; ++ai)
#pragma unroll
            for (int m = 0; m < 4; ++m) {
                const int row = row0 + ai * 128 + m * 16;
                f32x4 v00 = acc[ai][0][m][0], v01 = acc[ai][0][m][1], v10 = acc[ai][1][m][0], v11 = acc[ai][1][m][1];
                if (seg <= 1) {
                    const int pos = row & (SEQ - 1);
                    const f32x4 c0 = *(const f32x4*)(rc + (size_t)pos * 128 + d), c1 = *(const f32x4*)(rc + (size_t)pos * 128 + d + 4);
                    const f32x4 s0 = *(const f32x4*)(rs + (size_t)pos * 128 + d), s1 = *(const f32x4*)(rs + (size_t)pos * 128 + d + 4);
                    const float sc = seg == 1 ? 0.0625f : 1.0f;
                    const f32x4 a0 = (v00 * c0 - v10 * s0) * sc, a1 = (v01 * c1 - v11 * s1) * sc, b0 = (v00 * s0 + v10 * c0) * sc, b1 = (v01 * s1 + v11 * c1) * sc;
                    v00 = a0; v01 = a1; v10 = b0; v11 = b1;
                } else if (seg == 3) {
#pragma unroll
                    for (int i = 0; i < 4; ++i) { v00[i] = siluf_(v00[i]); v01[i] = siluf_(v01[i]); v10[i] = siluf_(v10[i]); v11[i] = siluf_(v11[i]); }
                } else if (seg == 4) { const float q = 0.18033688011112042f; v00 = v00 * q; v01 = v01 * q; v10 = v10 * q; v11 = v11 * q; }
                else if (seg >= 7) {
#pragma unroll
                    for (int i = 0; i < 4; ++i) { v00[i] = sigmoidf_(v00[i]); v01[i] = sigmoidf_(v01[i]); v10[i] = sigmoidf_(v10[i]); v11[i] = sigmoidf_(v11[i]); }
                }
                u32x4 w0, w1; w0.x = cvtpk(v00[0], v00[1]); w0.y = cvtpk(v00[2], v00[3]); w0.z = cvtpk(v01[0], v01[1]); w0.w = cvtpk(v01[2], v01[3]);
                w1.x = cvtpk(v10[0], v10[1]); w1.y = cvtpk(v10[2], v10[3]); w1.z = cvtpk(v11[0], v11[1]); w1.w = cvtpk(v11[2], v11[3]);
                if (seg == 0) {
                    const int pos = row & (SEQ - 1), il = pos & 127;
                    bf16_t* blkp = O + ((((size_t)(row >> 12) * 4 + (u.pn & 3)) * 32 + (pos >> 7)) * 4 + (il >> 5)) * 8192 + (size_t)(((d >> 3) & 1) * 32 + (il & 31)) * 8;
                    *(u32x4*)(blkp + (d >> 4) * 512) = w0; *(u32x4*)(blkp + ((d >> 4) + 8) * 512) = w1;
                } else if (seg <= 2) { bf16_t* rowp = O + (size_t)row * DM + colt + d; *(u32x4*)rowp = w0; *(u32x4*)(rowp + 128) = w1; }
                else {
                    unsigned char* rowp = (unsigned char*)O + (size_t)row * DM + colt + d;
                    u32x2 f0, f1; f0.x = pk4_fp8(v00[0], v00[1], v00[2], v00[3]); f0.y = pk4_fp8(v01[0], v01[1], v01[2], v01[3]);
                    f1.x = pk4_fp8(v10[0], v10[1], v10[2], v10[3]); f1.y = pk4_fp8(v11[0], v11[1], v11[2], v11[3]);
                    *(u32x2*)rowp = f0; *(u32x2*)(rowp + 128) = f1; }
            }
    }
};
template <bool ADD> struct EpiGateBf16 {
    static constexpr bool PERM = true;
    bf16_t* O; const bf16_t* Gt; const bf16_t* P;
    __device__ __forceinline__ void operator()(const f32x4 (&acc)[2][2][4][2], const pg8::Unit& u, int wr, int wc, int fr, int fq) const {
        const int row0 = u.pm * 256 + wr * 64 + fr, col0 = u.pn * 256 + wc * 32 + 8 * fq;
#pragma unroll
        for (int ai = 0; ai < 2; ++ai)
#pragma unroll
            for (int m = 0; m < 4; ++m) {
                const size_t ro = (size_t)(row0 + ai * 128 + m * 16) * DM + col0;
#pragma unroll
                for (int bj = 0; bj < 2; ++bj) {
                    const u32x4 g = *(const u32x4*)(Gt + ro + bj * 128);
                    f32x4 v0 = acc[ai][bj][m][0], v1 = acc[ai][bj][m][1];
                    v0[0] *= bflo(g.x); v0[1] *= bfhi(g.x); v0[2] *= bflo(g.y); v0[3] *= bfhi(g.y);
                    v1[0] *= bflo(g.z); v1[1] *= bfhi(g.z); v1[2] *= bflo(g.w); v1[3] *= bfhi(g.w);
                    if (ADD) { const u32x4 p = *(const u32x4*)(P + ro + bj * 128);
                        v0[0] += bflo(p.x); v0[1] += bfhi(p.x); v0[2] += bflo(p.y); v0[3] += bfhi(p.y);
                        v1[0] += bflo(p.z); v1[1] += bfhi(p.z); v1[2] += bflo(p.w); v1[3] += bfhi(p.w); }
                    u32x4 w; w.x = cvtpk(v0[0], v0[1]); w.y = cvtpk(v0[2], v0[3]); w.z = cvtpk(v1[0], v1[1]); w.w = cvtpk(v1[2], v1[3]);
                    *(u32x4*)(O + ro + bj * 128) = w;
                }
            }
    }
};
struct EpiMerge {
    static constexpr bool PERM = true;
    bf16_t* O; const unsigned char* Gr; const unsigned char* Ga;
    __device__ __forceinline__ void operator()(f32x4 (&acc)[2][2][4][2], const pg8::Unit& u, int wr, int wc, int fr, int fq) const {
        const int row0 = u.pm * 256 + wr * 64 + fr, col0 = u.pn * 256 + wc * 32 + 8 * fq;
#pragma unroll
        for (int ai = 0; ai < 2; ++ai)
#pragma unroll
            for (int m = 0; m < 4; ++m) {
                const size_t ro = (size_t)(row0 + ai * 128 + m * 16) * DM + col0;
#pragma unroll
                for (int bj = 0; bj < 2; ++bj) {
                    const u32x2 ga = *(const u32x2*)(Ga + ro + bj * 128);
                    const f32x2 ga0 = __builtin_amdgcn_cvt_pk_f32_fp8((int)ga.x, false), ga1 = __builtin_amdgcn_cvt_pk_f32_fp8((int)ga.x, true), ga2 = __builtin_amdgcn_cvt_pk_f32_fp8((int)ga.y, false), ga3 = __builtin_amdgcn_cvt_pk_f32_fp8((int)ga.y, true);
                    f32x4 a0 = (f32x4){ga0.x, ga0.y, ga1.x, ga1.y} * YD_INV, a1 = (f32x4){ga2.x, ga2.y, ga3.x, ga3.y} * YD_INV;
                    if (u.e == 0) {
                        const u32x2 gr = *(const u32x2*)(Gr + ro + bj * 128);
                        const f32x2 gr0 = __builtin_amdgcn_cvt_pk_f32_fp8((int)gr.x, false), gr1 = __builtin_amdgcn_cvt_pk_f32_fp8((int)gr.x, true), gr2 = __builtin_amdgcn_cvt_pk_f32_fp8((int)gr.y, false), gr3 = __builtin_amdgcn_cvt_pk_f32_fp8((int)gr.y, true);
                        const f32x4 r0 = (f32x4){gr0.x, gr0.y, gr1.x, gr1.y} * YD_INV, r1 = (f32x4){gr2.x, gr2.y, gr3.x, gr3.y} * YD_INV;
#pragma unroll
                        for (int i = 0; i < 4; ++i) { acc[ai][bj][m][0][i] *= r0[i] * __builtin_amdgcn_rcpf(fmaxf(a0[i], 1e-30f)); acc[ai][bj][m][1][i] *= r1[i] * __builtin_amdgcn_rcpf(fmaxf(a1[i], 1e-30f)); }
                    } else {
                        const f32x4 v0 = acc[ai][bj][m][0] * a0, v1 = acc[ai][bj][m][1] * a1;
                        u32x4 w; w.x = cvtpk(v0[0], v0[1]); w.y = cvtpk(v0[2], v0[3]); w.z = cvtpk(v1[0], v1[1]); w.w = cvtpk(v1[2], v1[3]);
                        *(u32x4*)(O + ro + bj * 128) = w;
                    }
                }
            }
    }
};
struct EpiOProj {
    static constexpr bool PERM = true;
    const float* x; bf16_t* x1; const float* mod; float* ss;
    __device__ __forceinline__ void operator()(const f32x4 (&acc)[2][2][4][2], const pg8::Unit& u, int wr, int wc, int fr, int fq) const {
        const int row0 = u.pm * 256 + wr * 64 + fr, col0 = u.pn * 256 + wc * 32 + 8 * fq;
        const int b = (u.pm * 256) / SEQ;
        f32x4 gm[2][2];
#pragma unroll
        for (int bj = 0; bj < 2; ++bj)
#pragma unroll
            for (int n = 0; n < 2; ++n) gm[bj][n] = *(const f32x4*)(mod + (size_t)b * 6144 + 2 * DM + col0 + bj * 128 + n * 4);
#pragma unroll
        for (int ai = 0; ai < 2; ++ai)
#pragma unroll
            for (int m = 0; m < 4; ++m) {
                const int row = row0 + ai * 128 + m * 16;
                const size_t ro = (size_t)row * DM + col0; float sq = 0.f;
#pragma unroll
                for (int bj = 0; bj < 2; ++bj) {
                    const f32x4 xa = *(const f32x4*)(x + ro + bj * 128), xb = *(const f32x4*)(x + ro + bj * 128 + 4);
                    const f32x4 o0 = xa + gm[bj][0] * acc[ai][bj][m][0], o1 = xb + gm[bj][1] * acc[ai][bj][m][1];
                    u32x4 w; w.x = cvtpk(o0[0], o0[1]); w.y = cvtpk(o0[2], o0[3]); w.z = cvtpk(o1[0], o1[1]); w.w = cvtpk(o1[2], o1[3]);
                    *(u32x4*)(x1 + ro + bj * 128) = w;
                    sq += (o0[0] * o0[0] + o0[1] * o0[1]) + (o0[2] * o0[2] + o0[3] * o0[3]) + (o1[0] * o1[0] + o1[1] * o1[1]) + (o1[2] * o1[2] + o1[3] * o1[3]); }
                sq += __shfl_xor(sq, 16); sq += __shfl_xor(sq, 32);
                if (fq == 0) ss[(size_t)row * 16 + u.pn * 4 + wc] = sq;
            }
    }
};
struct EpiF32 {
    static constexpr bool PERM = false;
    float* C; int ldc;
    __device__ __forceinline__ void operator()(const f32x4 (&acc)[2][2][4][2], const pg8::Unit& u, int wr, int wc, int fr, int fq) const {
        const int row0 = u.pm * 256 + wr * 64 + fr, col0 = u.pn * 256 + wc * 32 + 4 * fq;
#pragma unroll
        for (int ai = 0; ai < 2; ++ai)
#pragma unroll
            for (int m = 0; m < 4; ++m) { float* rowp = C + (size_t)(row0 + ai * 128 + m * 16) * ldc + col0;
#pragma unroll
                for (int bj = 0; bj < 2; ++bj)
#pragma unroll
                    for (int n = 0; n < 2; ++n) *(f32x4*)(rowp + bj * 128 + n * 16) = acc[ai][bj][m][n]; }
    }
};
struct EpiPlainScratch {
    static constexpr bool PERM = true;
    bf16_t* O;
    __device__ __forceinline__ void operator()(const f32x4 (&acc)[2][2][4][2], const pg8::Unit& u, int wr, int wc, int fr, int fq) const {
        const int row0 = u.pm * 256 + wr * 64 + fr, col0 = (u.pn & 3) * 256 + wc * 32 + 8 * fq;
#pragma unroll
        for (int ai = 0; ai < 2; ++ai)
#pragma unroll
            for (int m = 0; m < 4; ++m) { bf16_t* rowp = O + (size_t)(row0 + ai * 128 + m * 16) * DM + col0;
#pragma unroll
                for (int bj = 0; bj < 2; ++bj) { const f32x4 v0 = acc[ai][bj][m][0], v1 = acc[ai][bj][m][1];
                    u32x4 w; w.x = cvtpk(v0[0], v0[1]); w.y = cvtpk(v0[2], v0[3]); w.z = cvtpk(v1[0], v1[1]); w.w = cvtpk(v1[2], v1[3]); *(u32x4*)(rowp + bj * 128) = w; } }
    }
};
struct EpiNull {
    static constexpr bool PERM = false;
    __device__ __forceinline__ void operator()(const f32x4 (&acc)[2][2][4][2], const pg8::Unit&, int, int, int, int) const {
#pragma unroll
        for (int ai = 0; ai < 2; ++ai)
#pragma unroll
            for (int bj = 0; bj < 2; ++bj)
#pragma unroll
                for (int m = 0; m < 4; ++m)
#pragma unroll
                    for (int n = 0; n < 2; ++n) asm volatile("" :: "v"(acc[ai][bj][m][n]));
    }
};
struct EpiGU {
    static constexpr bool PERM = true;
    bf16_t* hid;
    __device__ __forceinline__ void operator()(const f32x4 (&acc)[2][2][4][2], const pg8::Unit& u, int wr, int wc, int fr, int fq) const {
        const int row0 = u.pm * 256 + wr * 64 + fr, col0 = u.pn * 128 + wc * 32 + 8 * fq;
#pragma unroll
        for (int ai = 0; ai < 2; ++ai)
#pragma unroll
            for (int m = 0; m < 4; ++m) { bf16_t* rowp = hid + (size_t)(row0 + ai * 128 + m * 16) * EH + col0;
                f32x4 h0, h1;
#pragma unroll
                for (int i = 0; i < 4; ++i) { h0[i] = siluf_(acc[ai][0][m][0][i]) * acc[ai][1][m][0][i]; h1[i] = siluf_(acc[ai][0][m][1][i]) * acc[ai][1][m][1][i]; }
                u32x4 w; w.x = cvtpk(h0[0], h0[1]); w.y = cvtpk(h0[2], h0[3]); w.z = cvtpk(h1[0], h1[1]); w.w = cvtpk(h1[2], h1[3]); *(u32x4*)rowp = w; }
    }
};
template <int MODE> struct EpiDownT {
    static constexpr bool PERM = true;
    unsigned char* ws; const LAS int* exp_info;
    __device__ __forceinline__ void operator()(const f32x4 (&acc)[2][2][4][2], const pg8::Unit& u, int wr, int wc, int fr, int fq) const {
        const int shift = __builtin_amdgcn_readfirstlane(exp_info[u.e]), lim = __builtin_amdgcn_readfirstlane(exp_info[512 + u.e]);
        const int row0 = u.pm * 256 + wr * 64 + fr, col0 = u.pn * 256 + wc * 32 + 8 * fq;
#pragma unroll
        for (int ai = 0; ai < 2; ++ai)
#pragma unroll
            for (int m = 0; m < 4; ++m) {
                const int pos = row0 + ai * 128 + m * 16;
                if (pos < lim) {
                    unsigned char* rowp = (MODE == 1 ? ws + WS_SS + (size_t)blockIdx.x * 2048 : ydense_row(ws, pos - shift)) + col0;
#pragma unroll
                    for (int bj = 0; bj < 2; ++bj) { const f32x4 v0 = acc[ai][bj][m][0], v1 = acc[ai][bj][m][1];
                        u32x2 w; w.x = pk4_fp8(v0[0], v0[1], v0[2], v0[3]); w.y = pk4_fp8(v1[0], v1[1], v1[2], v1[3]);
                        *(u32x2*)(rowp + bj * 128) = w; }
                }
            }
    }
};
typedef EpiDownT<0> EpiDown;

template <bool F8 = false> __device__ __forceinline__ void transpose_item(const float* W, int N, int K, int k0, int n0, bf16_t* WT, int drow0, LAS float* scr, int lane) {
#pragma unroll 8
    for (int i = 0; i < 32; ++i) { const int kk = 2 * i + (lane >> 5); scr[kk * 33 + (lane & 31)] = W[(size_t)(k0 + kk) * N + n0 + (lane & 31)]; }
    asm volatile("s_waitcnt lgkmcnt(0)" ::: "memory");
    const int c = lane & 7;
#pragma unroll
    for (int j = 0; j < 4; ++j) { const int n = (lane >> 3) + 8 * j; const LAS float* s = scr + (8 * c) * 33 + n;
        if constexpr (F8) { u32x2 o; o.x = pk4_fp8w(s[0 * 33], s[1 * 33], s[2 * 33], s[3 * 33]); o.y = pk4_fp8w(s[4 * 33], s[5 * 33], s[6 * 33], s[7 * 33]);
            *(u32x2*)((unsigned char*)WT + (size_t)(drow0 + n) * K + k0 + 8 * c) = o; }
        else { u32x4 o; o.x = cvtpk(s[0 * 33], s[1 * 33]); o.y = cvtpk(s[2 * 33], s[3 * 33]); o.z = cvtpk(s[4 * 33], s[5 * 33]); o.w = cvtpk(s[6 * 33], s[7 * 33]);
            *(u32x4*)(WT + (size_t)(drow0 + n) * K + k0 + 8 * c) = o; } }
    asm volatile("s_waitcnt lgkmcnt(0)" ::: "memory");
}
template <bool F8 = false> __device__ __forceinline__ void transpose_plain(const float* W, int K, int N, bf16_t* WT, LAS float* scr, int item, int lane) {
    const int nblk = N / 32, kb = item / nblk, nb = item % nblk;
    transpose_item<F8>(W, N, K, 64 * kb, 32 * nb, WT, 32 * nb, scr, lane);
}

__device__ __forceinline__ int t5_bucket(int rel) {
    const int n = rel < 0 ? -rel : rel;
    int large = 8 + (int)(logf((float)(n > 1 ? n : 1) / 8.0f) / 4.852030263919617f * 8.0f);
    large = large < 15 ? large : 15;
    return (rel > 0 ? 16 : 0) + (n < 8 ? n : large);
}

__device__ __forceinline__ void phase0(Frame& F, const Args& a) {
    const float* c = a.in[1]; const float* w_ada = a.in[2]; const float* b_ada = a.in[3];
    {
        LAS float* cond = (LAS float*)F.lds;
        LAS float* red = (LAS float*)(F.lds + 32768);
        for (int i = F.tid; i < NB * DM; i += NTHR) cond[i] = siluf_(c[i]);
        __syncthreads();
        for (int cg = F.vcu; cg < 256; cg += F.G) {
            const int j = F.tid & 31, kg = F.tid >> 5;
            float s[NB];
#pragma unroll
            for (int b = 0; b < NB; ++b) s[b] = 0.f;
            if (j < 24) {
                for (int k = kg; k < DM; k += 16) { const float w = w_ada[(size_t)k * 6144 + cg * 24 + j];
#pragma unroll
                    for (int b = 0; b < NB; ++b) s[b] += cond[b * DM + k] * w; }
            }
#pragma unroll
            for (int b = 0; b < NB; ++b) red[(kg * NB + b) * 32 + j] = s[b];
            __syncthreads();
            if (F.tid < 192) { const int b = F.tid / 24, jj = F.tid % 24; float t = 0.f;
                for (int g = 0; g < 16; ++g) t += red[(g * NB + b) * 32 + jj];
                ((float*)(F.ws + WS_MOD))[b * 6144 + cg * 24 + jj] = t + b_ada[cg * 24 + jj]; }
            __syncthreads();
        }
    }
    const int gt = F.vcu * NTHR + F.tid, NGT = F.G * NTHR;
    {
        float* rc = (float*)(F.ws + WS_ROPE_C); float* rs = (float*)(F.ws + WS_ROPE_S);
        for (int i = gt; i < SEQ * 128; i += NGT) { const int pos = i >> 7, d = i & 127;
            const float inv = (float)pow(10000.0, -(double)d / 128.0); const float ang = (float)pos * inv;
            rc[i] = (float)cos((double)ang); rs[i] = (float)sin((double)ang); }
    }
    {
        const float* t5 = a.in[7]; float* bt = (float*)(F.ws + WS_BTAB);
        for (int i = gt; i < 3 * 16 * 160; i += NGT) { const int g = i / (16 * 160), h = (i / 160) % 16, j = i % 160;
            const int dil = g == 0 ? 1 : (g == 1 ? 4 : 16);
            bt[i] = j <= 128 ? t5[t5_bucket((j - 64) * dil) * 16 + h] * 1.4426950408889634f : 0.f; }
    }
    { unsigned* z = (unsigned*)(F.ws + WS_H + (size_t)NTOK * DM * 2); for (int i = gt; i < DM / 2; i += NGT) z[i] = 0u; }
    {
        LAS float* scr = (LAS float*)(F.lds + 49152 + F.wave * 8704);
        const int gw = F.vcu * NWAVES + F.wave, NGW = F.G * NWAVES;
        constexpr int I_IN = (DM / 64) * (PROJW / 32), I_SQ = (DM / 64) * (DM / 32), I_R = (DM / 64) * (NEXP / 32);
        constexpr int NITEMS = I_IN + 3 * I_SQ + I_R;
        for (int it = gw; it < NITEMS; it += NGW) {
            int r = it;
            if (r < I_IN) { transpose_plain<true>(a.in[5], DM, PROJW, (bf16_t*)(F.ws + WS_WIN), scr, r, F.lane); continue; } r -= I_IN;
            if (r < I_SQ) { transpose_plain(a.in[8], DM, DM, (bf16_t*)(F.ws + WS_WRU), scr, r, F.lane); continue; } r -= I_SQ;
            if (r < I_SQ) { transpose_plain(a.in[9], DM, DM, (bf16_t*)(F.ws + WS_WAU), scr, r, F.lane); continue; } r -= I_SQ;
            if (r < I_SQ) { transpose_plain(a.in[10], DM, DM, (bf16_t*)(F.ws + WS_WO), scr, r, F.lane); continue; } r -= I_SQ;
            transpose_plain(a.in[12], DM, NEXP, (bf16_t*)(F.ws + WS_WR), scr, r, F.lane);
        }
    }
}

struct TrItem { const float* src; unsigned char* dst; int N, K; };
__device__ __forceinline__ TrItem moe_item(const Args& a, unsigned char* ws, int it) {
    constexpr int PER_E = 256;
    const int e = it / PER_E, r = it % PER_E, kind = r >> 7, q = r & 127;
    TrItem t;
    if (kind < 2) {
        const float* W = e < 256 ? a.in[kind == 0 ? 14 : 15] + (size_t)e * 1024 * 256 : a.in[kind == 0 ? 17 : 18];
        const int kb = q >> 3, n0 = 32 * (q & 7);
        t.src = W + (size_t)(64 * kb) * 256 + n0; t.N = 256; t.K = 1024;
        t.dst = ws + WS_WGU + (size_t)e * 512 * 1024 + (size_t)((n0 >> 7) * 256 + kind * 128 + (n0 & 127)) * 1024 + 64 * kb;
    } else {
        const float* W = e < 256 ? a.in[16] + (size_t)e * 256 * 1024 : a.in[19];
        const int kb = q >> 5, n0 = 32 * (q & 31);
        t.src = W + (size_t)(64 * kb) * 1024 + n0; t.N = 1024; t.K = 256;
        t.dst = ws + WS_WD + (size_t)e * 1024 * 256 + (size_t)n0 * 256 + 64 * kb;
    }
    return t;
}
__device__ __forceinline__ void tr_load(const TrItem& t, float (&v)[32], int lane) {
    const float* p = t.src + (size_t)(lane >> 5) * t.N + (lane & 31);
#pragma unroll
    for (int i = 0; i < 32; ++i) v[i] = __builtin_nontemporal_load(p + (size_t)(2 * i) * t.N);
}
__device__ __forceinline__ void tr_store(const TrItem& t, const float (&v)[32], LAS float* scr, int lane) {
#pragma unroll
    for (int i = 0; i < 32; ++i) scr[(2 * i + (lane >> 5)) * 33 + (lane & 31)] = v[i];
    asm volatile("s_waitcnt lgkmcnt(0)" ::: "memory");
    const int c = lane & 7;
#pragma unroll
    for (int j = 0; j < 4; ++j) { const int n = (lane >> 3) + 8 * j; const LAS float* s = scr + (8 * c) * 33 + n;
        u32x2 o; o.x = pk4_fp8w(s[0 * 33], s[1 * 33], s[2 * 33], s[3 * 33]); o.y = pk4_fp8w(s[4 * 33], s[5 * 33], s[6 * 33], s[7 * 33]);
        *(u32x2*)(t.dst + (size_t)n * t.K + 8 * c) = o; }
    asm volatile("s_waitcnt lgkmcnt(0)" ::: "memory");
}
constexpr int CW_CONVQ = 16384 + 2048;
__device__ __forceinline__ void moe_weight_convert(Frame& F, const Args& a) {
    LAS float* scr = (LAS float*)(F.lds + F.wave * 8704);
    const int total = 257 * 256, nchunks = total / 8;
    unsigned* q = (unsigned*)(F.ws + WS_CTL) + CW_CONVQ;
    float v0[32], v1[32];
    for (;;) {
        unsigned ck = 0;
        if (F.lane == 0) ck = __hip_atomic_fetch_add(q, 1u, __ATOMIC_RELAXED, __HIP_MEMORY_SCOPE_AGENT);
        ck = __builtin_amdgcn_readfirstlane(ck);
        if ((int)ck >= nchunks) break;
        const int it0 = (int)ck * 8;
        TrItem t0 = moe_item(a, F.ws, it0), t1 = t0;
        tr_load(t0, v0, F.lane);
#pragma unroll 1
        for (int k = 0; k < 8; k += 2) {
            t1 = moe_item(a, F.ws, it0 + k + 1); tr_load(t1, v1, F.lane);
            tr_store(t0, v0, scr, F.lane);
            if (k + 2 < 8) { t0 = moe_item(a, F.ws, it0 + k + 2); tr_load(t0, v0, F.lane); }
            tr_store(t1, v1, scr, F.lane);
        }
    }
}

template <bool BF16IN, int OUT8> __device__ __forceinline__ void norm_mod_rows(Frame& F, const void* xin, const float* norm, const float* mod, int shift_off, int scale_off, const float* ssp, bf16_t* out, unsigned char* out8) {
    const float* x = (const float*)xin; const bf16_t* xb = (const bf16_t*)xin;
    const int gw = F.vcu * NWAVES + F.wave, NGW = F.G * NWAVES;
    f32x4 g4[4];
#pragma unroll
    for (int j = 0; j < 4; ++j) g4[j] = *(const f32x4*)(norm + 4 * F.lane + 256 * j);
    f32x4 v[4], vn[4]; float p = 0.f, pn = 0.f;
    int row = gw;
#define NM_LOAD(V, ROW) do { if (BF16IN) { const u32x2* xr_ = (const u32x2*)(xb + (size_t)(ROW) * DM) + F.lane; _Pragma("unroll") for (int j = 0; j < 4; ++j) { const u32x2 t_ = xr_[64 * j]; V[j] = (f32x4){bflo(t_.x), bfhi(t_.x), bflo(t_.y), bfhi(t_.y)}; } } \
        else { const f32x4* xr_ = (const f32x4*)(x + (size_t)(ROW) * DM) + F.lane; _Pragma("unroll") for (int j = 0; j < 4; ++j) V[j] = xr_[64 * j]; } } while (0)
    if (row < NTOK) { NM_LOAD(v, row);
        if (ssp) p = F.lane < 16 ? ssp[(size_t)row * 16 + F.lane] : 0.f; }
#pragma unroll 1
    for (; row < NTOK; row += NGW) {
        const int nrow = row + NGW < NTOK ? row + NGW : row;
        { NM_LOAD(vn, nrow);
          if (ssp) pn = F.lane < 16 ? ssp[(size_t)nrow * 16 + F.lane] : 0.f; }
        const int b = row / SEQ;
        float s = 0.f;
#pragma unroll
        for (int j = 0; j < 4; ++j) s += (v[j][0] * v[j][0] + v[j][1] * v[j][1]) + (v[j][2] * v[j][2] + v[j][3] * v[j][3]);
        const float tot = wave_sum(ssp ? p : s);
        const float rstd = rsqrtf(tot * (1.f / DM) + NORM_EPS);
        u32x2* o8 = (u32x2*)(out + (size_t)row * DM) + F.lane;
#pragma unroll
        for (int j = 0; j < 4; ++j) {
            const int col = 4 * F.lane + 256 * j;
            const f32x4 sc = *(const f32x4*)(mod + (size_t)b * 6144 + scale_off + col), sh = *(const f32x4*)(mod + (size_t)b * 6144 + shift_off + col);
            const f32x4 y = (v[j] * rstd) * g4[j] * (sc + 1.0f) + sh;
            if (OUT8 != 1) { u32x2 w; w.x = cvtpk(y[0], y[1]); w.y = cvtpk(y[2], y[3]); o8[64 * j] = w; }
            if (OUT8 != 0) *(unsigned*)(out8 + (size_t)row * DM + col) = pk4_fp8(y[0], y[1], y[2], y[3]);
        }
#pragma unroll
        for (int j = 0; j < 4; ++j) v[j] = vn[j];
        p = pn;
    }
}

__device__ __forceinline__ unsigned off_b(unsigned row, unsigned ch) { return 256u * row + 16u * (ch ^ (((row & 3) << 2) | ((row >> 2) & 3))); }
__device__ __forceinline__ int crow(int reg, int h) { return (reg & 3) + 8 * (reg >> 2) + 4 * h; }
__device__ __forceinline__ s16x4 tr_read(LAS unsigned char* p) { return __builtin_bit_cast(s16x4, __builtin_amdgcn_ds_read_tr16_b64_v4i16((LAS s16x4*)p)); }
__device__ __forceinline__ bf16x8 pack8(const f32x16& x, int s) {
    u32x4 p; p.x = cvtpk(x[8 * s], x[8 * s + 1]); p.y = cvtpk(x[8 * s + 2], x[8 * s + 3]); p.z = cvtpk(x[8 * s + 4], x[8 * s + 5]); p.w = cvtpk(x[8 * s + 6], x[8 * s + 7]);
    return __builtin_bit_cast(bf16x8, p);
}
#define MFMA32(a, b, c) __builtin_amdgcn_mfma_f32_32x32x16_bf16((a), (b), (c), 0, 0, 0)

constexpr int RK_STR = 528, RV_STR = 192;
constexpr int RL_K = 0, RL_V = 128 * RK_STR, RL_S = RL_V + 128 * RV_STR, RL_P = RL_S + 64 * RK_STR, RL_END = RL_P + 10 * 2048;
__device__ __forceinline__ void retention_chain_rs(Frame& F, const Args& a, int chain) {
    const int b = chain >> 5, h = (chain >> 3) & 3, dir = (chain >> 2) & 1, es = chain & 3;
    const int lane = F.lane, r = lane & 31, hh = lane >> 5, w = F.wave;
    const bool outw = w < 4; const int ib = w & 3, sw = w & 3;
    const bf16_t* RQ = (const bf16_t*)(F.ws + WS_RQ); const bf16_t* RK = (const bf16_t*)(F.ws + WS_RK); const bf16_t* RV = (const bf16_t*)(F.ws + WS_RV);
    bf16_t* OUT = (bf16_t*)(F.ws + (dir ? WS_OUTB : WS_OUTF));
    const float lg = log1pf(-__expf(a.in[6][dir * 4 + h]));
    const float decayC = __expf(lg * 128.f);
    LAS unsigned char* lds = F.lds;
    f32x16 R[4];
#pragma unroll
    for (int k = 0; k < 4; ++k)
#pragma unroll
        for (int i = 0; i < 16; ++i) R[k][i] = 0.f;
#define QFRAG(s) __builtin_bit_cast(bf16x8, (f32x4){R[(s) >> 2][4 * ((s) & 3)], R[(s) >> 2][4 * ((s) & 3) + 1], R[(s) >> 2][4 * ((s) & 3) + 2], R[(s) >> 2][4 * ((s) & 3) + 3]})
#define QLOAD(s, P) do { const f32x4 t_ = *(const f32x4*)(P); R[(s) >> 2][4 * ((s) & 3)] = t_[0]; R[(s) >> 2][4 * ((s) & 3) + 1] = t_[1]; R[(s) >> 2][4 * ((s) & 3) + 2] = t_[2]; R[(s) >> 2][4 * ((s) & 3) + 3] = t_[3]; } while (0)
    for (int i = F.tid; i < (64 * RK_STR) / 16; i += NTHR) *(LAS u32x4*)(lds + RL_S + i * 16) = (u32x4){0u, 0u, 0u, 0u};
    const int vj = F.tid >> 2, ve0 = (F.tid & 3) * 16;
    const float vscale = __expf(lg * (dir == 0 ? (float)(127 - vj) : (float)vj));
    const int blk = (lane >> 4) & 1, q4 = (lane & 15) >> 2, p4 = lane & 3;
    LAS unsigned char* kbase = lds + RL_K + r * RK_STR + 16 * hh;
    LAS unsigned char* sbase = lds + RL_S + r * RK_STR + 16 * hh;
    LAS unsigned char* vtr = lds + RL_V + (4 * hh + q4) * RV_STR + (16 * blk + 4 * p4) * 2;
    LAS unsigned char* ktr = lds + RL_K + (4 * hh + q4) * RK_STR + (sw * 64 + 16 * blk + 4 * p4) * 2;
    LAS unsigned char* spub = lds + RL_S + r * RK_STR + (sw * 64 + 4 * hh) * 2;
    const float rsc = __expf(lg * (dir == 0 ? (float)(ib * 32 + r - 127) : (float)(-(ib * 32 + r))));
    const char* RKb = (const char*)RK + (size_t)h * 512; const char* RVb = (const char*)RV + (size_t)(h * 256 + es * 64) * 2; const char* RQb = (const char*)RQ + ((size_t)((b * 4 + h) * 32) * 4 + ib) * 16384;
    char* OUTb = (char*)OUT + (size_t)(ib * 32 * DM + h * 256 + es * 64) * 2;
    const unsigned klo = (unsigned)(((F.tid >> 5) * DM + (F.tid & 31) * 8) * 2), vlo = (unsigned)((vj * DM + ve0) * 2), qlo = (unsigned)(lane * 16), olo = (unsigned)((r * DM + 4 * hh) * 2);
    u32x4 kpre[8]; u32x4 vpre[2];
    {
        const size_t t0 = (size_t)b * SEQ + (size_t)(dir == 0 ? 0 : 31) * 128;
        const char* kc = RKb + t0 * (DM * 2); const char* vc = RVb + t0 * (DM * 2); const char* qc = RQb + (size_t)(dir == 0 ? 0 : 31) * 65536;
#pragma unroll
        for (int i = 0; i < 8; ++i) kpre[i] = *(const u32x4*)(kc + (size_t)i * (16 * DM * 2) + klo);
        vpre[0] = *(const u32x4*)(vc + vlo); vpre[1] = *(const u32x4*)(vc + vlo + 16);
        if (outw) {
#pragma unroll
            for (int s = 0; s < 16; ++s) QLOAD(s, qc + qlo + 1024 * s);
        }
    }
#pragma unroll 1
    for (int n = 0; n < 32; ++n) {
        const int cidx = dir == 0 ? n : 31 - n;
        const size_t t0 = (size_t)b * SEQ + (size_t)cidx * 128;
        {
            LAS unsigned char* kw = lds + RL_K + (F.tid >> 5) * RK_STR + (F.tid & 31) * 16;
#pragma unroll
            for (int i = 0; i < 8; ++i) *(LAS u32x4*)(kw + i * 16 * RK_STR) = kpre[i];
#pragma unroll
            for (int i = 0; i < 2; ++i) {
                u32x4 o; o.x = cvtpk(bflo(vpre[i].x) * vscale, bfhi(vpre[i].x) * vscale); o.y = cvtpk(bflo(vpre[i].y) * vscale, bfhi(vpre[i].y) * vscale);
                o.z = cvtpk(bflo(vpre[i].z) * vscale, bfhi(vpre[i].z) * vscale); o.w = cvtpk(bflo(vpre[i].w) * vscale, bfhi(vpre[i].w) * vscale);
                *(LAS u32x4*)(lds + RL_V + vj * RV_STR + ve0 * 2 + 16 * i) = o;
            }
        }
        __syncthreads();
        {
            const int nn = n + 1 < 32 ? n + 1 : n; const int cn = dir == 0 ? nn : 31 - nn;
            const size_t t1 = (size_t)b * SEQ + (size_t)cn * 128;
            const char* kc = RKb + t1 * (DM * 2); const char* vc = RVb + t1 * (DM * 2);
#pragma unroll
            for (int i = 0; i < 8; ++i) kpre[i] = *(const u32x4*)(kc + (size_t)i * (16 * DM * 2) + klo);
            vpre[0] = *(const u32x4*)(vc + vlo); vpre[1] = *(const u32x4*)(vc + vlo + 16);
        }
        if (outw) {
            f32x16 acc0, acc1;
#pragma unroll
            for (int i = 0; i < 16; ++i) { acc0[i] = 0.f; acc1[i] = 0.f; }
            const int jb_lo = dir == 0 ? 0 : ib, jb_hi = dir == 0 ? ib : 3;
#pragma unroll 1
            for (int jb = jb_lo; jb <= jb_hi; ++jb) {
                LAS unsigned char* kb = kbase + jb * (32 * RK_STR);
                f32x16 sT;
#pragma unroll
                for (int i = 0; i < 16; ++i) sT[i] = 0.f;
#pragma unroll
                for (int hb = 0; hb < 2; ++hb) {
                    bf16x8 kf[8];
#pragma unroll
                    for (int s = 0; s < 8; ++s) kf[s] = *(const LAS bf16x8*)(kb + (hb * 8 + s) * 32);
                    __builtin_amdgcn_sched_barrier(0);
#pragma unroll
                    for (int s = 0; s < 8; ++s) sT = MFMA32(kf[s], QFRAG(hb * 8 + s), sT);
                    __builtin_amdgcn_sched_barrier(0);
                }
                if (jb == ib) {
#pragma unroll
                    for (int i = 0; i < 16; ++i) { const int jl = crow(i, hh); const bool keep = dir == 0 ? (jl <= r) : (jl > r); sT[i] = keep ? sT[i] : 0.f; }
                }
                const bf16x8 p0 = pack8(sT, 0), p1 = pack8(sT, 1);
                LAS unsigned char* vb = vtr + jb * (32 * RV_STR);
#pragma unroll
                for (int s2 = 0; s2 < 2; ++s2) {
                    const s16x4 l0 = tr_read(vb + s2 * (16 * RV_STR)), h0 = tr_read(vb + s2 * (16 * RV_STR) + 8 * RV_STR);
                    const s16x4 l1 = tr_read(vb + s2 * (16 * RV_STR) + 64), h1 = tr_read(vb + s2 * (16 * RV_STR) + 8 * RV_STR + 64);
                    acc0 = MFMA32(__builtin_shufflevector(l0, h0, 0, 1, 2, 3, 4, 5, 6, 7), s2 == 0 ? p0 : p1, acc0);
                    acc1 = MFMA32(__builtin_shufflevector(l1, h1, 0, 1, 2, 3, 4, 5, 6, 7), s2 == 0 ? p0 : p1, acc1);
                }
            }
#pragma unroll
            for (int hb = 0; hb < 4; ++hb) {
                bf16x8 sf0[4], sf1[4];
#pragma unroll
                for (int s = 0; s < 4; ++s) { sf0[s] = *(const LAS bf16x8*)(sbase + (hb * 4 + s) * 32); sf1[s] = *(const LAS bf16x8*)(sbase + 32 * RK_STR + (hb * 4 + s) * 32); }
                __builtin_amdgcn_sched_barrier(0);
#pragma unroll
                for (int s = 0; s < 4; ++s) { acc0 = MFMA32(sf0[s], QFRAG(hb * 4 + s), acc0); acc1 = MFMA32(sf1[s], QFRAG(hb * 4 + s), acc1); }
                __builtin_amdgcn_sched_barrier(0);
            }
            u32x2 ow[8];
#pragma unroll
            for (int g = 0; g < 4; ++g) { ow[g].x = cvtpk(acc0[4 * g] * rsc, acc0[4 * g + 1] * rsc); ow[g].y = cvtpk(acc0[4 * g + 2] * rsc, acc0[4 * g + 3] * rsc);
                ow[4 + g].x = cvtpk(acc1[4 * g] * rsc, acc1[4 * g + 1] * rsc); ow[4 + g].y = cvtpk(acc1[4 * g + 2] * rsc, acc1[4 * g + 3] * rsc); }
            {
                const int nn = n + 1 < 32 ? n + 1 : n; const int cn = dir == 0 ? nn : 31 - nn;
                const char* qc = RQb + (size_t)cn * 65536;
#pragma unroll
                for (int s = 0; s < 16; ++s) QLOAD(s, qc + qlo + 1024 * s);
            }
            {
                char* oc = OUTb + t0 * (DM * 2) + olo;
#pragma unroll
                for (int g = 0; g < 4; ++g) { *(u32x2*)(oc + g * 16) = ow[g]; *(u32x2*)(oc + 64 + g * 16) = ow[4 + g]; }
            }
        } else {
#pragma unroll
            for (int ks = 0; ks < 8; ++ks) {
                const s16x4 vl0 = tr_read(vtr + ks * (16 * RV_STR)), vh0 = tr_read(vtr + ks * (16 * RV_STR) + 8 * RV_STR);
                const s16x4 vl1 = tr_read(vtr + ks * (16 * RV_STR) + 64), vh1 = tr_read(vtr + ks * (16 * RV_STR) + 8 * RV_STR + 64);
                const bf16x8 vf0 = __builtin_shufflevector(vl0, vh0, 0, 1, 2, 3, 4, 5, 6, 7), vf1 = __builtin_shufflevector(vl1, vh1, 0, 1, 2, 3, 4, 5, 6, 7);
#pragma unroll
                for (int dd = 0; dd < 2; ++dd) {
                    const s16x4 lo = tr_read(ktr + ks * (16 * RK_STR) + dd * 64), hi = tr_read(ktr + ks * (16 * RK_STR) + 8 * RK_STR + dd * 64);
                    const bf16x8 kt = __builtin_shufflevector(lo, hi, 0, 1, 2, 3, 4, 5, 6, 7);
                    R[2 * dd] = MFMA32(kt, vf0, R[2 * dd]); R[2 * dd + 1] = MFMA32(kt, vf1, R[2 * dd + 1]);
                }
            }
#pragma unroll
            for (int k = 0; k < 4; ++k)
#pragma unroll
                for (int i = 0; i < 16; ++i) R[k][i] *= decayC;
        }
        __syncthreads();
        if (!outw) {
#pragma unroll
            for (int dd = 0; dd < 2; ++dd)
#pragma unroll
                for (int e = 0; e < 2; ++e)
#pragma unroll
                    for (int g = 0; g < 4; ++g) { u32x2 wv; wv.x = cvtpk(R[2 * dd + e][4 * g], R[2 * dd + e][4 * g + 1]); wv.y = cvtpk(R[2 * dd + e][4 * g + 2], R[2 * dd + e][4 * g + 3]);
                        *(LAS u32x2*)(spub + e * (32 * RK_STR) + dd * 64 + g * 16) = wv; }
        }
    }
    __syncthreads();
#undef QFRAG
#undef QLOAD
}

__device__ __forceinline__ u32x4 fp8x8_to_bf16(unsigned w0, unsigned w1) {
    const f32x2 a = __builtin_amdgcn_cvt_pk_f32_fp8((int)w0, false), b = __builtin_amdgcn_cvt_pk_f32_fp8((int)w0, true), c = __builtin_amdgcn_cvt_pk_f32_fp8((int)w1, false), d = __builtin_amdgcn_cvt_pk_f32_fp8((int)w1, true);
    return (u32x4){cvtpk(a.x, a.y), cvtpk(b.x, b.y), cvtpk(c.x, c.y), cvtpk(d.x, d.y)};
}
constexpr int AK_STR = 144, AV_STR = 192;
constexpr int AL_K = 0, AL_V = 384 * AK_STR, AL_B = AL_V + 384 * AV_STR, AL_END = AL_B + 896;
struct AttUnit { int g, dil, length, res, run0, b, head; };
__device__ __forceinline__ AttUnit att_decode(int slot) {
    AttUnit u; const int bh = slot / 48, k = slot % 48, ru = k & 15; u.g = k >> 4;
    u.dil = u.g == 0 ? 1 : (u.g == 1 ? 4 : 16); u.length = SEQ / u.dil; u.res = ru % u.dil; u.run0 = (ru / u.dil) * 256; u.b = bh >> 4; u.head = bh & 15; return u;
}
__device__ __forceinline__ void attention_phase(Frame& F, int u0, int u1, int zero) {
    if (u0 >= u1) return;
    const int lane = F.lane, r = lane & 31, hh = lane >> 5, w = F.wave;
    const unsigned char* AQ = F.ws + WS_AQ; const unsigned char* AK = F.ws + WS_AK; const unsigned char* AV = F.ws + WS_AV;
    LAS unsigned char* lds = F.lds;
    const int blk = (lane >> 4) & 1, q4 = (lane & 15) >> 2, p4 = lane & 3;
    LAS unsigned char* kbase = lds + AL_K + (32 * w + r) * AK_STR + 16 * hh;
    LAS unsigned char* vbase = lds + AL_V + (32 * w + 4 * hh + q4) * AV_STR + (16 * blk + 4 * p4) * 2;
    const LAS float* bt = (const LAS float*)(lds + AL_B) + (4 * hh - r + 32);
    u32x4 kk[3], vv[3]; u32x2 qn[4]; float bnext = 0.f;
    u32x4 kk2[3], vv2[3]; u32x2 qn2[4]; float bnext2 = 0.f;
#define ATT_LOAD(U) do { const AttUnit un_ = att_decode(U); \
        if (F.tid < 224) { const int X_ = F.tid - 32; bnext = (X_ >= 0 && X_ <= 128) ? ((const float*)(F.ws + WS_BTAB))[(un_.g * 16 + un_.head) * 160 + X_] : 0.f; } \
        _Pragma("unroll") for (int i = 0; i < 3; ++i) { const int id = F.tid + i * NTHR, row = id >> 2, ch = id & 3; int idx = un_.run0 - 64 + row; idx = idx < 0 ? 0 : (idx >= un_.length ? un_.length - 1 : idx); \
            const size_t off = ((size_t)un_.b * SEQ + (size_t)idx * un_.dil + un_.res) * DM + un_.head * 64 + ch * 16; kk[i] = *(const u32x4*)(AK + off); vv[i] = *(const u32x4*)(AV + off); } \
        const size_t qt_ = (size_t)un_.b * SEQ + (size_t)(un_.run0 + 32 * w + r) * un_.dil + un_.res; \
        _Pragma("unroll") for (int s = 0; s < 4; ++s) qn[s] = *(const u32x2*)(AQ + qt_ * DM + un_.head * 64 + 16 * s + 8 * hh); } while (0)
#define ATT_LOAD2(U) do { const AttUnit un_ = att_decode(U); \
        if (F.tid < 224) { const int X_ = F.tid - 32; bnext2 = (X_ >= 0 && X_ <= 128) ? ((const float*)(F.ws + WS_BTAB))[(un_.g * 16 + un_.head) * 160 + X_] : 0.f; } \
        _Pragma("unroll") for (int i = 0; i < 3; ++i) { const int id = F.tid + i * NTHR, row = id >> 2, ch = id & 3; int idx = un_.run0 - 64 + row; idx = idx < 0 ? 0 : (idx >= un_.length ? un_.length - 1 : idx); \
            const size_t off = ((size_t)un_.b * SEQ + (size_t)idx * un_.dil + un_.res) * DM + un_.head * 64 + ch * 16; kk2[i] = *(const u32x4*)(AK + off); vv2[i] = *(const u32x4*)(AV + off); } \
        const size_t qt_ = (size_t)un_.b * SEQ + (size_t)(un_.run0 + 32 * w + r) * un_.dil + un_.res; \
        _Pragma("unroll") for (int s = 0; s < 4; ++s) qn2[s] = *(const u32x2*)(AQ + qt_ * DM + un_.head * 64 + 16 * s + 8 * hh); } while (0)
    const int nun = u1 - u0, nit = nun * (PROBE_PHASE == 31 ? 2 : 1);
#define ATT_SLOT(I) (u0 + ((I) >= nit ? nun - 1 : ((I) >= nun ? (I) - nun : (I))))
    ATT_LOAD(ATT_SLOT(0)); ATT_LOAD2(ATT_SLOT(1));
#pragma unroll 1
    for (int it = 0; it < nit; ++it) {
        const int unit = u0 + (it >= nun ? it - nun : it);
        const AttUnit un = att_decode(unit);
        unsigned char* OG = F.ws + WS_OG + (size_t)un.g * (SEG / 2); float* LSE = (float*)(F.ws + WS_LSE) + (size_t)un.g * NTOK * 16;
#pragma unroll
        for (int i = 0; i < 3; ++i) { const int id = F.tid + i * NTHR, row = id >> 2, ch = id & 3;
            *(LAS u32x4*)(lds + AL_K + row * AK_STR + 32 * ch) = fp8x8_to_bf16(kk[i].x, kk[i].y); *(LAS u32x4*)(lds + AL_K + row * AK_STR + 32 * ch + 16) = fp8x8_to_bf16(kk[i].z, kk[i].w);
            *(LAS u32x4*)(lds + AL_V + row * AV_STR + 32 * ch) = fp8x8_to_bf16(vv[i].x, vv[i].y); *(LAS u32x4*)(lds + AL_V + row * AV_STR + 32 * ch + 16) = fp8x8_to_bf16(vv[i].z, vv[i].w); }
        if (F.tid < 224) ((LAS float*)(lds + AL_B))[F.tid] = bnext;
        bf16x8 qf[4];
#pragma unroll
        for (int s = 0; s < 4; ++s) qf[s] = __builtin_bit_cast(bf16x8, fp8x8_to_bf16(qn[s].x, qn[s].y));
        __syncthreads();
#pragma unroll
        for (int i = 0; i < 3; ++i) { kk[i] = kk2[i]; vv[i] = vv2[i]; }
#pragma unroll
        for (int s = 0; s < 4; ++s) qn[s] = qn2[s];
        bnext = bnext2;
        ATT_LOAD2(ATT_SLOT(it + 2));
        const size_t qtok = (size_t)un.b * SEQ + (size_t)(un.run0 + 32 * w + r) * un.dil + un.res;
        const int lv = 4 * hh - r, kv = un.run0 - 64 + 32 * w + 4 * hh;
        const int clo = max(-lv, -kv), chi = min(128 - lv, un.length - 1 - kv);
        const bool edge = (un.run0 == 0) || (un.run0 + 256 == un.length);
        float m = -3.0e38f, lsum = 0.f;
        f32x16 o0, o1;
#pragma unroll 1
        for (int rc_ = 0; rc_ < (PROBE_PHASE == 33 ? 2 + zero : 1); ++rc_) {
        m = -3.0e38f; lsum = 0.f;
#pragma unroll
        for (int i = 0; i < 16; ++i) { o0[i] = 0.f; o1[i] = 0.f; }
#pragma unroll
        for (int kb = 0; kb < 5; ++kb) {
            f32x16 sT;
#pragma unroll
            for (int i = 0; i < 16; ++i) sT[i] = 0.f;
#pragma unroll
            for (int s = 0; s < 4; ++s) sT = MFMA32(*(const LAS bf16x8*)(kbase + kb * (32 * AK_STR) + s * 32), qf[s], sT);
            float bv[16];
#pragma unroll
            for (int i = 0; i < 16; ++i) bv[i] = bt[32 * kb + (i & 3) + 8 * (i >> 2)];
            const bool masked = (kb == 0) || (kb == 4) || edge;
            float bm = -3.0e38f;
            if (masked) {
#pragma unroll
                for (int i = 0; i < 16; ++i) { const int c = 32 * kb + (i & 3) + 8 * (i >> 2); const bool valid = (c >= clo) && (c <= chi);
                    const float sv = sT[i] * (1.0f / 256.0f) + bv[i]; sT[i] = valid ? sv : -3.0e38f; bm = fmaxf(bm, sT[i]); }
            } else {
#pragma unroll
                for (int i = 0; i < 16; ++i) { sT[i] = sT[i] * (1.0f / 256.0f) + bv[i]; bm = fmaxf(bm, sT[i]); }
            }
            bm = fmaxf(bm, __shfl_xor(bm, 32));
            const float mn = fmaxf(m, bm), alpha = __builtin_amdgcn_exp2f(m - mn);
            if (kb > 0 && __any(mn > m)) {
#pragma unroll
                for (int i = 0; i < 16; ++i) { o0[i] *= alpha; o1[i] *= alpha; }
            }
            m = mn; lsum *= alpha;
            if (masked) {
#pragma unroll
                for (int i = 0; i < 16; ++i) { const float p = sT[i] > -1.0e38f ? __builtin_amdgcn_exp2f(sT[i] - mn) : 0.f; sT[i] = p; lsum += p; }
            } else {
#pragma unroll
                for (int i = 0; i < 16; ++i) { const float p = __builtin_amdgcn_exp2f(sT[i] - mn); sT[i] = p; lsum += p; }
            }
#pragma unroll
            for (int s2 = 0; s2 < 2; ++s2) {
                const bf16x8 pb = pack8(sT, s2);
#pragma unroll
                for (int e2 = 0; e2 < 2; ++e2) {
                    const s16x4 lo = tr_read(vbase + kb * (32 * AV_STR) + s2 * (16 * AV_STR) + e2 * 64);
                    const s16x4 hi = tr_read(vbase + kb * (32 * AV_STR) + s2 * (16 * AV_STR) + 8 * AV_STR + e2 * 64);
                    const bf16x8 vf = __builtin_shufflevector(lo, hi, 0, 1, 2, 3, 4, 5, 6, 7);
                    if (e2 == 0) o0 = MFMA32(vf, pb, o0); else o1 = MFMA32(vf, pb, o1);
                }
            }
        }
        }
        lsum += __shfl_xor(lsum, 32);
        if (hh == 0) LSE[qtok * 16 + un.head] = (m + __log2f(lsum)) * 0.6931471805599453f;
        const float linv = YD_INV / lsum;
        __syncthreads();
#pragma unroll 1
        for (int rs_ = 0; rs_ < (PROBE_PHASE == 34 ? 2 + zero : 1); ++rs_)
        {
            LAS unsigned char* ost = lds + AL_K + w * (32 * AK_STR);
#pragma unroll
            for (int g = 0; g < 4; ++g) {
                u32x2 a0, a1; a0.x = cvtpk(o0[4 * g] * linv, o0[4 * g + 1] * linv); a0.y = cvtpk(o0[4 * g + 2] * linv, o0[4 * g + 3] * linv);
                a1.x = cvtpk(o1[4 * g] * linv, o1[4 * g + 1] * linv); a1.y = cvtpk(o1[4 * g + 2] * linv, o1[4 * g + 3] * linv);
                *(LAS u32x2*)(ost + r * AK_STR + 16 * g + 8 * hh) = a0; *(LAS u32x2*)(ost + r * AK_STR + 64 + 16 * g + 8 * hh) = a1;
            }
            asm volatile("s_waitcnt lgkmcnt(0)" ::: "memory");
#pragma unroll
            for (int it = 0; it < 4; ++it) {
                const int ql = 8 * it + (lane >> 3);
                const u32x4 v = *(const LAS u32x4*)(ost + ql * AK_STR + 16 * (lane & 7));
                const size_t tok = (size_t)un.b * SEQ + (size_t)(un.run0 + 32 * w + ql) * un.dil + un.res;
                u32x2 f8; f8.x = pk4_fp8(bflo(v.x), bfhi(v.x), bflo(v.y), bfhi(v.y)); f8.y = pk4_fp8(bflo(v.z), bfhi(v.z), bflo(v.w), bfhi(v.w));
                __builtin_nontemporal_store(f8, (u32x2*)(OG + tok * DM + un.head * 64 + 8 * (lane & 7)));
            }
        }
        __syncthreads();
    }
#undef ATT_LOAD
#undef ATT_LOAD2
#undef ATT_SLOT
}

__device__ __forceinline__ void mixer_post_rows(Frame& F) {
    const int gw = F.vcu * NWAVES + F.wave, NGW = F.G * NWAVES, lane = F.lane;
    const bf16_t* OF = (const bf16_t*)(F.ws + WS_OUTF); const bf16_t* OB = (const bf16_t*)(F.ws + WS_OUTB); const unsigned char* SG = (F.ws + WS_RG);
    const unsigned char* OG = F.ws + WS_OG; const float* LSE = (const float*)(F.ws + WS_LSE);
    bf16_t* RN = (bf16_t*)(F.ws + WS_RETN); bf16_t* AC = (bf16_t*)(F.ws + WS_ATTC);
    const int head = lane >> 2;
    u32x2 fa[4], fb[4], na[4], nb[4]; unsigned sg[4], nsg[4]; u32x4 og[3], nog[3]; float ls[3], nls[3];
#define MP_LOAD(A, B, S, O, L, ROW) do { _Pragma("unroll") for (int h = 0; h < 4; ++h) { const size_t off_ = (size_t)(ROW) * DM + h * 256 + 4 * lane; \
            A[h] = *(const u32x2*)(OF + off_); B[h] = *(const u32x2*)(OB + off_); S[h] = *(const unsigned*)(SG + off_); } \
        _Pragma("unroll") for (int g = 0; g < 3; ++g) { O[g] = *(const u32x4*)(OG + (size_t)g * NTOK * DM + (size_t)(ROW) * DM + 16 * lane); L[g] = LSE[((size_t)g * NTOK + (ROW)) * 16 + head]; } } while (0)
    if (gw >= NTOK) return;
    MP_LOAD(fa, fb, sg, og, ls, gw);
#pragma unroll 1
    for (int row = gw; row < NTOK; row += NGW) {
        const int rn = row + NGW < NTOK ? row + NGW : row;
        MP_LOAD(na, nb, nsg, nog, nls, rn);
        f32x4 v[4];
#pragma unroll
        for (int h = 0; h < 4; ++h) v[h] = (f32x4){bflo(fa[h].x) + bflo(fb[h].x), bfhi(fa[h].x) + bfhi(fb[h].x), bflo(fa[h].y) + bflo(fb[h].y), bfhi(fa[h].y) + bfhi(fb[h].y)};
#pragma unroll
        for (int h = 0; h < 4; ++h) {
            const float mu = wave_sum((v[h][0] + v[h][1]) + (v[h][2] + v[h][3])) * (1.f / 256.f);
            const f32x4 d = v[h] - mu;
            const float var = wave_sum((d[0] * d[0] + d[1] * d[1]) + (d[2] * d[2] + d[3] * d[3])) * (1.f / 256.f);
            const float rs = rsqrtf(var + NORM_EPS);
            const f32x2 g01 = __builtin_amdgcn_cvt_pk_f32_fp8((int)sg[h], false), g23 = __builtin_amdgcn_cvt_pk_f32_fp8((int)sg[h], true); const float rq = rs * YD_INV;
            u32x2 o; o.x = cvtpk(d[0] * rq * g01.x, d[1] * rq * g01.y); o.y = cvtpk(d[2] * rq * g23.x, d[3] * rq * g23.y);
            *(u32x2*)(RN + (size_t)row * DM + h * 256 + 4 * lane) = o;
        }
        const float lm = fmaxf(ls[0], fmaxf(ls[1], ls[2]));
        float wg[3]; float wsum = 0.f;
#pragma unroll
        for (int g = 0; g < 3; ++g) { wg[g] = __expf(ls[g] - lm); wsum += wg[g]; }
        const float winv = 1.f / wsum;
        unsigned res[8];
#pragma unroll
        for (int wI = 0; wI < 4; ++wI) {
            float a0 = 0.f, a1 = 0.f, a2 = 0.f, a3 = 0.f;
#pragma unroll
            for (int g = 0; g < 3; ++g) { const int wd = (int)(wI == 0 ? og[g].x : (wI == 1 ? og[g].y : (wI == 2 ? og[g].z : og[g].w)));
                const f32x2 p0 = __builtin_amdgcn_cvt_pk_f32_fp8(wd, false), p1 = __builtin_amdgcn_cvt_pk_f32_fp8(wd, true);
                a0 += wg[g] * p0.x; a1 += wg[g] * p0.y; a2 += wg[g] * p1.x; a3 += wg[g] * p1.y; }
            const float sc = winv * YD_INV;
            res[2 * wI] = cvtpk(a0 * sc, a1 * sc); res[2 * wI + 1] = cvtpk(a2 * sc, a3 * sc);
        }
        u32x4 oo[2]; oo[0] = (u32x4){res[0], res[1], res[2], res[3]}; oo[1] = (u32x4){res[4], res[5], res[6], res[7]};
        bf16_t* ap = AC + (size_t)row * DM + 16 * lane; *(u32x4*)ap = oo[0]; *(u32x4*)(ap + 8) = oo[1];
#pragma unroll
        for (int h = 0; h < 4; ++h) { fa[h] = na[h]; fb[h] = nb[h]; sg[h] = nsg[h]; }
#pragma unroll
        for (int g = 0; g < 3; ++g) { og[g] = nog[g]; ls[g] = nls[g]; }
    }
#undef MP_LOAD
}

__device__ __forceinline__ void routing_rows(Frame& F, const Args& a) {
    const int gw = F.vcu * NWAVES + F.wave, NGW = F.G * NWAVES, lane = F.lane;
    const float* LOG = (const float*)(F.ws + WS_LOGIT); const float* rb = a.in[13];
    int* EIDX = (int*)(F.ws + WS_EIDX); float* GATE = (float*)(F.ws + WS_GATE);
    LAS unsigned* hist = (LAS unsigned*)(F.lds);
    for (int i = F.tid; i < NEXP; i += NTHR) hist[i] = 0u;
    __syncthreads();
    const f32x4 bias = *(const f32x4*)(rb + 4 * lane);
    for (int row = gw; row < NTOK; row += NGW) {
        const f32x4 lg = *(const f32x4*)(LOG + (size_t)row * NEXP + 4 * lane);
        float sc[4], ch[4];
#pragma unroll
        for (int i = 0; i < 4; ++i) { sc[i] = 1.f / (1.f + expf(-lg[i])); ch[i] = sc[i] + bias[i]; }
        float m1 = fmaxf(ch[0], ch[1]), m2 = fminf(ch[0], ch[1]);
        { const float c2 = ch[2]; const float n1 = fmaxf(m1, c2); m2 = fmaxf(m2, fminf(m1, c2)); m1 = n1; }
        { const float c3 = ch[3]; const float n1 = fmaxf(m1, c3); m2 = fmaxf(m2, fminf(m1, c3)); m1 = n1; }
#pragma unroll
        for (int o = 1; o < 8; o <<= 1) { const float b1 = __shfl_xor(m1, o), b2 = __shfl_xor(m2, o);
            const float n1 = fmaxf(m1, b1); const float n2 = fmaxf(fminf(m1, b1), fmaxf(m2, b2)); m1 = n1; m2 = n2; }
        const float gs = m1 + m2; const int mygrp = lane >> 3;
        int rank = 0;
#pragma unroll
        for (int g = 0; g < 8; ++g) { const float og = __shfl(gs, g * 8); rank += (og > gs || (og == gs && g < mygrp)) ? 1 : 0; }
        const bool elig = rank < 4;
        float cv[4];
#pragma unroll
        for (int i = 0; i < 4; ++i) cv[i] = elig ? ch[i] : -3.0e38f;
        float gsel = 0.f; int esel = 0; float gsum = 0.f;
#pragma unroll
        for (int k = 0; k < TOPK; ++k) {
            float bv = cv[0]; int bi = 4 * lane;
#pragma unroll
            for (int i = 1; i < 4; ++i) if (cv[i] > bv) { bv = cv[i]; bi = 4 * lane + i; }
#pragma unroll
            for (int o = 1; o < 64; o <<= 1) { const float ov = __shfl_xor(bv, o); const int oi = __shfl_xor(bi, o); if (ov > bv || (ov == bv && oi < bi)) { bv = ov; bi = oi; } }
            const int own = bi >> 2, el = bi & 3;
            const float mine = el == 0 ? sc[0] : (el == 1 ? sc[1] : (el == 2 ? sc[2] : sc[3]));
            const float s = __shfl(mine, own);
            if (lane == own) { if (el == 0) cv[0] = -3.0e38f; else if (el == 1) cv[1] = -3.0e38f; else if (el == 2) cv[2] = -3.0e38f; else cv[3] = -3.0e38f; }
            gsum += s;
            if (lane == k) { gsel = s; esel = bi; }
        }
        if (lane < TOPK) { EIDX[row * TOPK + lane] = esel; GATE[row * TOPK + lane] = gsel / gsum * 2.5f; __hip_atomic_fetch_add(&hist[esel], 1u, __ATOMIC_RELAXED, __HIP_MEMORY_SCOPE_WORKGROUP); }
    }
    __syncthreads();
    for (int i = F.tid; i < NEXP; i += NTHR) if (hist[i]) atomicAdd((unsigned*)(F.ws + WS_CTL) + CW_CNT + i, hist[i]);
}

__device__ __forceinline__ void routing_lists(Frame& F) {
    LAS unsigned* cnt = (LAS unsigned*)(F.lds);
    LAS unsigned* pstart = cnt + 256;
    LAS unsigned* lh = pstart + 264;
    LAS unsigned* lbase = lh + 256;
    LAS unsigned* ustart = lbase + 256;
    int* DPOS = (int*)(F.ws + WS_DPOS);
    unsigned* ctl = (unsigned*)(F.ws + WS_CTL);
    const int* EIDX = (const int*)(F.ws + WS_EIDX); int* ROWL = (int*)(F.ws + WS_ROWL); int* TILE_E = (int*)(F.ws + WS_TILE_E);
    for (int i = F.tid; i < NEXP; i += NTHR) { cnt[i] = __hip_atomic_load(ctl + CW_CNT + i, RLX_AGENT); lh[i] = 0u; }
    __syncthreads();
    if (F.tid == 0) { unsigned s = 0, us = 0; for (int e = 0; e < NEXP; ++e) { pstart[e] = s; ustart[e] = us; s += (cnt[e] + 255u) & ~255u; us += cnt[e]; } pstart[NEXP] = s; }
    __syncthreads();
    const unsigned ptotal = pstart[NEXP];
    const int per = (NTOK + F.G - 1) / F.G, tk0 = F.vcu * per, tk1 = (tk0 + per) < NTOK ? (tk0 + per) : NTOK;
    for (int i = tk0 * TOPK + F.tid; i < tk1 * TOPK; i += NTHR) __hip_atomic_fetch_add(&lh[EIDX[i]], 1u, __ATOMIC_RELAXED, __HIP_MEMORY_SCOPE_WORKGROUP);
    __syncthreads();
    for (int e = F.tid; e < NEXP; e += NTHR) { const unsigned c = lh[e]; lbase[e] = c ? atomicAdd(ctl + CW_FILL + e, c) : 0u; lh[e] = 0u; }
    __syncthreads();
    for (int i = tk0 * TOPK + F.tid; i < tk1 * TOPK; i += NTHR) { const int e = EIDX[i]; const unsigned p = __hip_atomic_fetch_add(&lh[e], 1u, __ATOMIC_RELAXED, __HIP_MEMORY_SCOPE_WORKGROUP);
        ROWL[pstart[e] + lbase[e] + p] = (i >> 3) * 16 + (i & 7); DPOS[i] = (int)(ustart[e] + lbase[e] + p); }
    for (int t = tk0 + F.tid; t < tk1; t += NTHR) ROWL[ptotal + t] = t * 16 + 8;
    for (int e = F.vcu; e < NEXP; e += F.G) { const unsigned s = pstart[e] + cnt[e], en = pstart[e + 1]; for (unsigned p = s + F.tid; p < en; p += NTHR) ROWL[p] = -1; }
    if (F.vcu == 0) {
        const int nrt = (int)(ptotal >> 8);
        for (int e = F.tid; e < NEXP; e += NTHR) { for (unsigned t = pstart[e] >> 8; t < (pstart[e + 1] >> 8); ++t) TILE_E[t] = e; TILE_E[4096 + e] = (int)(pstart[e] - ustart[e]); TILE_E[8192 + e] = (int)(pstart[e] + cnt[e]); }
        for (int t = F.tid; t < NTOK / 256; t += NTHR) TILE_E[nrt + t] = NEXP;
        if (F.tid == 0) { TILE_E[4096 + NEXP] = (int)ptotal - YD_SHARED0; TILE_E[8192 + NEXP] = (int)ptotal + NTOK; }
        if (F.tid == 0) TILE_E[MAX_TILES] = nrt + NTOK / 256;
    }
}

__device__ __forceinline__ void final_rows(Frame& F, const Args& a) {
    const int gw = F.vcu * NWAVES + F.wave, NGW = F.G * NWAVES, lane = F.lane;
    const float* mod = (const float*)(F.ws + WS_MOD); const float* nf = a.in[20];
    const int* DPOS = (const int*)(F.ws + WS_DPOS); const float* GATE = (const float*)(F.ws + WS_GATE);
    f32x4 g4[4];
#pragma unroll
    for (int j = 0; j < 4; ++j) g4[j] = *(const f32x4*)(nf + 4 * lane + 256 * j);
    if (gw >= NTOK) return;
    auto clampr = [&](int r) { return r < NTOK ? r : gw; };
    int dcur = DPOS[clampr(gw) * 8 + (lane & 7)]; float gcur = GATE[clampr(gw) * 8 + (lane & 7)];
    int dnxt = DPOS[clampr(gw + NGW) * 8 + (lane & 7)]; float gnxt = GATE[clampr(gw + NGW) * 8 + (lane & 7)];
    f32x4 xw[4], xn[4]; int yw[9][4], yn[9][4];
#define FIN_LOAD(XW, YW, ROW, DV) do { const u32x2* xr_ = (const u32x2*)((const bf16_t*)(F.ws + WS_X1B) + (size_t)(ROW) * DM) + lane; \
        _Pragma("unroll") for (int j = 0; j < 4; ++j) { const u32x2 t_ = xr_[64 * j]; XW[j] = (f32x4){bflo(t_.x), bfhi(t_.x), bflo(t_.y), bfhi(t_.y)}; } \
        _Pragma("unroll") for (int k = 0; k < 9; ++k) { const unsigned char* yr_ = ydense_row(F.ws, k < 8 ? __builtin_amdgcn_readlane((DV), k) : YD_SHARED0 + (ROW)) + 4 * lane; \
            _Pragma("unroll") for (int j = 0; j < 4; ++j) YW[k][j] = *(const int*)(yr_ + 256 * j); } } while (0)
    FIN_LOAD(xw, yw, gw, dcur);
#pragma unroll 1
    for (int row = gw; row < NTOK; row += NGW) {
        const int rn = clampr(row + NGW), rn2 = clampr(row + 2 * NGW);
        FIN_LOAD(xn, yn, rn, dnxt);
        const int dn2 = DPOS[rn2 * 8 + (lane & 7)]; const float gn2 = GATE[rn2 * 8 + (lane & 7)];
        const int b = row / SEQ;
        f32x4 v[4]; float s = 0.f;
#pragma unroll
        for (int j = 0; j < 4; ++j) {
            const int col = 4 * lane + 256 * j;
            f32x4 y = (f32x4){0.f, 0.f, 0.f, 0.f};
#pragma unroll
            for (int k = 0; k < 9; ++k) { const int wv = yw[k][j]; const float gk = (k < 8 ? __uint_as_float(__builtin_amdgcn_readlane(__float_as_uint(gcur), k)) : 1.0f) * YD_INV;
                const f32x2 lo = __builtin_amdgcn_cvt_pk_f32_fp8(wv, false), hi = __builtin_amdgcn_cvt_pk_f32_fp8(wv, true);
                y[0] += gk * lo.x; y[1] += gk * lo.y; y[2] += gk * hi.x; y[3] += gk * hi.y; }
            const f32x4 gf = *(const f32x4*)(mod + (size_t)b * 6144 + 5 * DM + col);
            v[j] = xw[j] + gf * y;
            s += (v[j][0] * v[j][0] + v[j][1] * v[j][1]) + (v[j][2] * v[j][2] + v[j][3] * v[j][3]);
        }
        const float rstd = rsqrtf(wave_sum(s) * (1.f / DM) + NORM_EPS);
        f32x4* xo = (f32x4*)(a.out + (size_t)row * DM) + lane;
#pragma unroll
        for (int j = 0; j < 4; ++j) xo[64 * j] = (v[j] * rstd) * g4[j];
#pragma unroll
        for (int j = 0; j < 4; ++j) xw[j] = xn[j];
#pragma unroll
        for (int k = 0; k < 9; ++k)
#pragma unroll
            for (int j = 0; j < 4; ++j) yw[k][j] = yn[k][j];
        dcur = dnxt; gcur = gnxt; dnxt = dn2; gnxt = gn2;
    }
#undef FIN_LOAD
}

constexpr int MT_OFF = 131072, MT_INFO = MT_OFF + 4096;
__device__ __forceinline__ void moe_tables_to_lds(Frame& F, int ntiles) {
    const int* TILE_E = (const int*)(F.ws + WS_TILE_E);
    LAS unsigned short* te = (LAS unsigned short*)(F.lds + MT_OFF); LAS int* info = (LAS int*)(F.lds + MT_INFO);
    for (int t = F.tid; t < ntiles; t += NTHR) te[t] = (unsigned short)TILE_E[t];
    for (int e = F.tid; e <= NEXP; e += NTHR) { info[e] = TILE_E[4096 + e]; info[512 + e] = TILE_E[8192 + e]; }
    __syncthreads();
}
constexpr int DW_STR = 192;
constexpr int DW_BUF = 256 * DW_STR;
typedef float f32x4_t __attribute__((ext_vector_type(4)));
#define MFMA16(a, b, c) __builtin_amdgcn_mfma_f32_16x16x32_bf16((a), (b), (c), 0, 0, 0)
template <int MODE> __device__ __forceinline__ void down_phase(Frame& F, const Args& a) {
    const int* TILE_E = (const int*)(F.ws + WS_TILE_E); const int ntiles = __builtin_amdgcn_readfirstlane(TILE_E[MAX_TILES]);
    moe_tables_to_lds(F, ntiles);
    const LAS unsigned short* tile_e = (const LAS unsigned short*)(F.lds + MT_OFF); const LAS int* info = (const LAS int*)(F.lds + MT_INFO);
    const int lane = F.lane, w = F.wave, fr = lane & 15, g4 = lane >> 4;
    LAS unsigned char* lds = F.lds;
    const bf16_t* HID = (const bf16_t*)(F.ws + WS_HID);
    const int sk = F.tid >> 4, sn4 = F.tid & 15;
    const int spos = 16 * (sn4 & 3) + 4 * (sn4 >> 2);
    const int q4 = (lane & 15) >> 2, p4 = lane & 3;
    auto next_tile = [&](int i) -> int { const long L = (long)i * F.G + (int)blockIdx.x; return L < ntiles ? pg8::xcd_remap((int)L, ntiles) : -1; };
    int ui = 0, tile = next_tile(0);
    if (tile < 0) return;
    f32x4_t st[8], st2[8];
    auto wd_base = [&](int t) -> const float* { const int e = MODE == 1 ? 0 : (int)tile_e[t]; return e < NEXP ? a.in[16] + (size_t)e * (EH * DM) : a.in[19]; };
#define DW_LOAD(R, WB, C) do { const float* p_ = (WB) + (size_t)sk * DM + (C) * 64 + sn4 * 4; _Pragma("unroll") for (int i = 0; i < 8; ++i) R[i] = *(const f32x4_t*)(p_ + (size_t)i * 32 * DM); } while (0)
#define DW_WRITE(R, SLOT) do { _Pragma("unroll") for (int i = 0; i < 8; ++i) { const int k_ = sk + 32 * i; u32x2 w_; w_.x = cvtpk(R[i][0], R[i][1]); w_.y = cvtpk(R[i][2], R[i][3]); \
        *(LAS u32x2*)(lds + (SLOT) * DW_BUF + k_ * DW_STR + (((spos >> 4) ^ ((k_ >> 3) & 1)) << 5) + (spos & 15) * 2) = w_; } } while (0)
    const float* wb = wd_base(tile);
    int ntile = next_tile(1);
    const float* nwb = ntile >= 0 ? wd_base(ntile) : wb;
    DW_LOAD(st, wb, 0); DW_WRITE(st, 0);
    DW_LOAD(st, wb, 1); DW_LOAD(st2, wb, 2);
    __syncthreads();
    int cc = 0;
    for (;;) {
        const int e = (int)tile_e[tile]; const int shift = info[e], lim = info[512 + e];
        bf16x8 af[2][8];
        { const bf16_t* hp = HID + ((size_t)tile * 256 + 32 * w + fr) * EH + 8 * g4;
#pragma unroll
          for (int m = 0; m < 2; ++m)
#pragma unroll
              for (int ks = 0; ks < 8; ++ks) af[m][ks] = *(const bf16x8*)(hp + (size_t)m * 16 * EH + 32 * ks);
#pragma unroll
          for (int m = 0; m < 2; ++m)
#pragma unroll
              for (int ks = 0; ks < 8; ++ks) asm volatile("" : "+v"(af[m][ks])); }
        const int pos0 = tile * 256 + 32 * w + fr;
#pragma unroll 1
        for (int c = 0; c < 16; c += 2) {
#pragma unroll
            for (int hc = 0; hc < 2; ++hc, ++cc) {
                const int cq = c + hc;
                f32x4 acc[2][4];
                if (MODE == 3) {
#pragma unroll
                    for (int m = 0; m < 2; ++m)
#pragma unroll
                        for (int nf = 0; nf < 4; ++nf) acc[m][nf] = (f32x4){0.f, 0.f, 0.f, 0.f}; }
                LAS unsigned char* bb = lds + (cc & 1) * DW_BUF + (8 * g4 + q4) * DW_STR + 8 * p4;
#pragma unroll 1
                for (int rp_ = 0; rp_ < (MODE == 3 ? a.pad : (PROBE_PHASE == 40 ? 2 + a.pad : 1)); ++rp_) {
#pragma unroll
                for (int m = 0; m < 2; ++m)
#pragma unroll
                    for (int nf = 0; nf < 4; ++nf) acc[m][nf] = (f32x4){0.f, 0.f, 0.f, 0.f};
#pragma unroll
                for (int ks = 0; ks < 8; ++ks) {
#pragma unroll
                    for (int nf = 0; nf < 4; ++nf) {
                        LAS unsigned char* pp = bb + ks * (32 * DW_STR) + ((nf ^ (g4 & 1)) << 5);
                        const s16x4 lo = tr_read(pp), hi = tr_read(pp + 4 * DW_STR);
                        const bf16x8 bf = __builtin_shufflevector(lo, hi, 0, 1, 2, 3, 4, 5, 6, 7);
                        acc[0][nf] = MFMA16(bf, af[0][ks], acc[0][nf]); acc[1][nf] = MFMA16(bf, af[1][ks], acc[1][nf]);
                    }
                }
                }
                u32x4 ow[2];
#pragma unroll
                for (int m = 0; m < 2; ++m) { ow[m].x = pk4_fp8(acc[m][0][0], acc[m][0][1], acc[m][0][2], acc[m][0][3]); ow[m].y = pk4_fp8(acc[m][1][0], acc[m][1][1], acc[m][1][2], acc[m][1][3]);
                    ow[m].z = pk4_fp8(acc[m][2][0], acc[m][2][1], acc[m][2][2], acc[m][2][3]); ow[m].w = pk4_fp8(acc[m][3][0], acc[m][3][1], acc[m][3][2], acc[m][3][3]); }
                const int c3 = cq + 3; const float* b3 = c3 < 16 ? wb : nwb; const int k3 = c3 < 16 ? c3 : c3 - 16;
                if (hc == 0) { DW_WRITE(st, (cc + 1) & 1); DW_LOAD(st, b3, k3); } else { DW_WRITE(st2, (cc + 1) & 1); DW_LOAD(st2, b3, k3); }
#pragma unroll
                for (int m = 0; m < 2; ++m) {
                    const int pos = pos0 + 16 * m;
                    unsigned char* rowp = (pos < lim ? ydense_row(F.ws, pos - shift) : F.ws + WS_SS + (size_t)blockIdx.x * 2048) + 64 * cq + 16 * g4;
                    if (MODE >= 2) asm volatile("" :: "v"(ow[m])); else *(u32x4*)rowp = ow[m];
                }
                __syncthreads();
            }
        }
        if (ntile < 0) break;
        tile = ntile; wb = nwb; ++ui;
        ntile = next_tile(ui + 1); nwb = ntile >= 0 ? wd_base(ntile) : wb;
    }
#undef DW_LOAD
#undef DW_WRITE
}

constexpr int N_PHASES = 13;
__global__ void __launch_bounds__(NTHR, 2) fwd_kernel(Args args) {
    extern __shared__ __attribute__((aligned(16))) unsigned char lds_raw[];
    Frame F;
    F.lds = (LAS unsigned char*)lds_raw; F.ws = args.ws;
    F.tid = threadIdx.x; F.lane = F.tid & 63; F.wave = __builtin_amdgcn_readfirstlane(F.tid >> 6);
    F.G = gridDim.x; { const int bx = blockIdx.x; F.vcu = (F.G % 8 == 0) ? (bx % 8) * (F.G / 8) + bx / 8 : bx; }
    volatile LAS unsigned* MISC = (volatile LAS unsigned*)(F.lds + MISC_OFF);
    for (int u = F.tid; u < (LDS_BYTES - LDSCTL_OFF) / 4; u += NTHR) ((LAS unsigned*)(F.lds + LDSCTL_OFF))[u] = 0u;
    __syncthreads();
    unsigned* ctl = (unsigned*)(F.ws + WS_CTL);
    XcdBarrier bar; bar.bar = ctl + CW_BAR; bar.x = 0; bar.st = nullptr;
    const int lo = args.ph_lo, hi = args.ph_hi;
    if (hi - lo > 1) bar = xcd_barrier_post(ctl + CW_BAR, MISC + 8);
#ifdef ONLY_PHASE
#define IN(k) ((k) == ONLY_PHASE && lo <= (k) && (k) < hi)
#else
#define IN(k) (lo <= (k) && (k) < hi)
#endif
#define SEAM(k) do { if (IN(k) && IN((k) + 1)) xcd_barrier(bar); } while (0)
#ifndef PROBE_PHASE
#define PROBE_PHASE -1
#endif
#define REP(k) _Pragma("unroll 1") for (int rep_ = 0; rep_ < ((k) == PROBE_PHASE ? 2 + args.pad : 1); ++rep_)
    const float* mod = (const float*)(F.ws + WS_MOD);
    bf16_t* HB = (bf16_t*)(F.ws + WS_H);

    if (IN(0)) REP(0) { phase0(F, args); } SEAM(0);
    if (IN(1)) REP(1) { norm_mod_rows<false, 1>(F, args.in[0], args.in[4], mod, 0, DM, nullptr, HB, F.ws + WS_H8); } SEAM(1);
    if (IN(2)) REP(2) {
        EpiInProj E{F.ws, (const float*)(F.ws + WS_ROPE_C), (const float*)(F.ws + WS_ROPE_S)};
        { pg8::StaticOrder S; S.init((const bf16_t*)(F.ws + WS_H8), (const bf16_t*)(F.ws + WS_WIN), NTOK, PROJW - 3 * DM, DM / 2, F.G, (int)blockIdx.x, 12);
          pg8::gemm_phase<EpiInProj, pg8::StaticOrder, true, true>(F.lds, S, E); }
        { pg8::StaticOrder S; S.init((const bf16_t*)(F.ws + WS_H8), (const bf16_t*)(F.ws + WS_WIN), NTOK, 3 * DM, DM / 2, F.G, (int)blockIdx.x, 0);
          pg8::gemm_phase<EpiInProj, pg8::StaticOrder, true, true>(F.lds, S, E); }
    } SEAM(2);
    if (IN(3)) {
#ifndef NO_RET
        REP(30) for (int ch = F.vcu; ch < 256; ch += F.G) retention_chain_rs(F, args, ch);
#endif
#ifndef NO_ATT
        const int per = (6144 + F.G - 1) / F.G;
        attention_phase(F, F.vcu * per, (F.vcu + 1) * per < 6144 ? (F.vcu + 1) * per : 6144, args.pad);
#endif
    } SEAM(3);
    if (IN(4)) REP(4) { mixer_post_rows(F); } SEAM(4);
    if (IN(5)) REP(5) {
        pg8::DualOrder S; S.so.init((const bf16_t*)(F.ws + WS_RETN), (const bf16_t*)(F.ws + WS_WRU), NTOK, DM, DM, F.G, (int)blockIdx.x);
        S.A1 = (const bf16_t*)(F.ws + WS_ATTC); S.Bt1 = (const bf16_t*)(F.ws + WS_WAU); S.K = DM;
        EpiMerge E{(bf16_t*)(F.ws + WS_MERGED), F.ws + WS_SGR, F.ws + WS_SGA};
        pg8::gemm_phase<EpiMerge, pg8::DualOrder, true>(F.lds, S, E);
    } SEAM(5);
    if (IN(6)) REP(6) {
        pg8::StaticOrder S; S.init((const bf16_t*)(F.ws + WS_MERGED), (const bf16_t*)(F.ws + WS_WO), NTOK, DM, DM, F.G, (int)blockIdx.x);
        EpiOProj E{args.in[0], (bf16_t*)(F.ws + WS_X1B), mod, (float*)(F.ws + WS_SS)};
        pg8::gemm_phase<EpiOProj, pg8::StaticOrder, true>(F.lds, S, E);
    } SEAM(6);
    if (IN(7)) REP(7) {
        norm_mod_rows<true, 2>(F, F.ws + WS_X1B, args.in[11], mod, 3 * DM, 4 * DM, (const float*)(F.ws + WS_SS), HB, F.ws + WS_H8B);
        if (F.vcu == 0 && F.tid < 256) ((unsigned*)(F.ws + WS_H8B + (size_t)NTOK * DM))[F.tid] = 0u;
    } SEAM(7);
    if (IN(8)) {
        pg8::StaticOrder S; S.init(HB, (const bf16_t*)(F.ws + WS_WR), NTOK, NEXP, DM, F.G, (int)blockIdx.x);
        EpiF32 E{(float*)(F.ws + WS_LOGIT), NEXP};
        pg8::gemm_phase<EpiF32, pg8::StaticOrder, true>(F.lds, S, E);
        __syncthreads();
        moe_weight_convert(F, args);
    } SEAM(8);
    if (IN(9)) { routing_rows(F, args); } SEAM(9);
    if (IN(10)) { routing_lists(F); } SEAM(10);
    if (IN(11)) REP(11) {
        const int* TILE_E = (const int*)(F.ws + WS_TILE_E); const int ntiles = __builtin_amdgcn_readfirstlane(TILE_E[MAX_TILES]);
        pg8::MoeOrder<true> S; S.A = (const bf16_t*)(F.ws + WS_H8B); S.Bt = (const bf16_t*)(F.ws + WS_WGU); S.K = DM / 2; S.e_stride = (size_t)512 * 512; S.tile_e = (const LAS unsigned short*)(F.lds + MT_OFF); S.rowlist = (const int*)(F.ws + WS_ROWL); moe_tables_to_lds(F, ntiles);
        S.ntiles = ntiles; S.nN = 2; S.nwg = ntiles * 2; S.G = F.G; S.c = (int)blockIdx.x;
        EpiGU E{(bf16_t*)(F.ws + WS_HID)};
        pg8::gemm_phase<EpiGU, pg8::MoeOrder<true>, true, true>(F.lds, S, E);
    } SEAM(11);
    if (IN(12)) REP(12) {
        down_phase<0>(F, args);
    } SEAM(12);
    if (IN(13)) { final_rows(F, args); }
#if PROBE_LAUNCH == 14
    if (lo == 14) {
        pg8::StaticOrder S; S.init(HB, (const bf16_t*)(F.ws + WS_WIN), NTOK, PROJW, DM, F.G, (int)blockIdx.x);
        EpiNull E{};
        pg8::gemm_phase<EpiNull, pg8::StaticOrder, true>(F.lds, S, E);
    }
#endif
#if PROBE_LAUNCH == 16
    if (lo == 14) {
        const int* TILE_E = (const int*)(F.ws + WS_TILE_E); const int ntiles = __builtin_amdgcn_readfirstlane(TILE_E[MAX_TILES]);
        pg8::MoeOrder<false> S; S.A = (const bf16_t*)(F.ws + WS_HID); S.Bt = (const bf16_t*)(F.ws + WS_WD); S.K = EH; S.e_stride = (size_t)1024 * 256; S.tile_e = (const LAS unsigned short*)(F.lds + MT_OFF); S.rowlist = (const int*)(F.ws + WS_ROWL); moe_tables_to_lds(F, ntiles);
        S.ntiles = ntiles; S.nN = 4; S.nwg = ntiles * 4; S.G = F.G; S.c = (int)blockIdx.x;
        EpiNull E{};
        pg8::gemm_phase<EpiNull, pg8::MoeOrder<false>, true>(F.lds, S, E);
    }
#endif
#if PROBE_LAUNCH == 18
    if (lo == 14) { down_phase<1>(F, args); }
#endif
#if PROBE_LAUNCH == 19
    if (lo == 14) { down_phase<2>(F, args); }
#endif
#if PROBE_LAUNCH == 20
    if (lo == 14) { down_phase<3>(F, args); }
#endif
#if PROBE_LAUNCH == 17
    if (lo == 14) {
        const int* TILE_E = (const int*)(F.ws + WS_TILE_E); const int ntiles = __builtin_amdgcn_readfirstlane(TILE_E[MAX_TILES]);
        pg8::MoeOrder<false> S; S.A = (const bf16_t*)(F.ws + WS_HID); S.Bt = (const bf16_t*)(F.ws + WS_WD); S.K = EH; S.e_stride = (size_t)1024 * 256; S.tile_e = (const LAS unsigned short*)(F.lds + MT_OFF); S.rowlist = (const int*)(F.ws + WS_ROWL); moe_tables_to_lds(F, ntiles);
        S.ntiles = ntiles; S.nN = 4; S.nwg = ntiles * 4; S.G = F.G; S.c = (int)blockIdx.x;
        EpiDownT<1> E{F.ws, (const LAS int*)(F.lds + MT_INFO)};
        pg8::gemm_phase<EpiDownT<1>, pg8::MoeOrder<false>, true>(F.lds, S, E);
    }
#endif
#if PROBE_LAUNCH == 15
    if (lo == 14) {
        pg8::StaticOrder S; S.init(HB, (const bf16_t*)(F.ws + WS_WIN), NTOK, PROJW, DM, F.G, (int)blockIdx.x);
        EpiPlainScratch E{(bf16_t*)(F.ws + WS_OUTF)};
        pg8::gemm_phase<EpiPlainScratch, pg8::StaticOrder, true>(F.lds, S, E);
    }
#endif
#undef IN
#undef SEAM
}

extern "C" void kernel_launch(void* const* d_in, const int* in_sizes, int n_in, void* d_out, int out_size, void* d_ws, size_t ws_size, hipStream_t stream) {
    static int grid = 0;
    if (grid == 0) {
        if (n_in != 21 || out_size != NTOK * DM || ws_size < WS_END) { fprintf(stderr, "kernel_launch: unexpected shapes (n_in %d out %d ws %zu)\n", n_in, out_size, ws_size); grid = -1; return; }
        int dev = 0, cus = 0, per_cu = 0;
        if (hipGetDevice(&dev) != hipSuccess || hipDeviceGetAttribute(&cus, hipDeviceAttributeMultiprocessorCount, dev) != hipSuccess) { grid = -1; return; }
        if (hipFuncSetAttribute((const void*)fwd_kernel, hipFuncAttributeMaxDynamicSharedMemorySize, LDS_BYTES) != hipSuccess) { fprintf(stderr, "kernel_launch: hipFuncSetAttribute failed\n"); grid = -1; return; }
        if (hipOccupancyMaxActiveBlocksPerMultiprocessor(&per_cu, (const void*)fwd_kernel, NTHR, LDS_BYTES) != hipSuccess || per_cu < 1)
            fprintf(stderr, "kernel_launch: note: occupancy query reports %d\n", per_cu);
        (void)hipGetLastError();
        grid = cus;
    }
    if (grid < 0) return;
    (void)hipMemsetAsync((char*)d_ws + WS_CTL, 0, CTL_ZERO_BYTES, stream);
    Args a{};
    for (int i = 0; i < 21; ++i) a.in[i] = (const float*)d_in[i];
    a.out = (float*)d_out; a.ws = (unsigned char*)d_ws;
#if MK_N_LAUNCHES == 1
    a.ph_lo = 0; a.ph_hi = N_PHASES + 1; a.li = 0;
    hipLaunchKernelGGL(fwd_kernel, dim3(grid), dim3(NTHR), LDS_BYTES, stream, a);
#else
    for (int p = 0; p <= N_PHASES; ++p) {
        if ((PROBE_LAUNCH == 18 || PROBE_LAUNCH == 19 || PROBE_LAUNCH == 20) && p == 12) { a.ph_lo = 14; a.ph_hi = 15; hipLaunchKernelGGL(fwd_kernel, dim3(grid), dim3(NTHR), LDS_BYTES, stream, a); }
        a.ph_lo = p; a.ph_hi = p + 1; a.li = p; hipLaunchKernelGGL(fwd_kernel, dim3(grid), dim3(NTHR), LDS_BYTES, stream, a);
        if (p == PROBE_LAUNCH) hipLaunchKernelGGL(fwd_kernel, dim3(grid), dim3(NTHR), LDS_BYTES, stream, a);
        if (((PROBE_LAUNCH == 14 || PROBE_LAUNCH == 15) && p == 2) || ((PROBE_LAUNCH == 16 || PROBE_LAUNCH == 17) && p == 12)) { a.ph_lo = 14; a.ph_hi = 15; hipLaunchKernelGGL(fwd_kernel, dim3(grid), dim3(NTHR), LDS_BYTES, stream, a); } }
#endif
}
```

```cpp
#include <hip/hip_runtime.h>
#include <cstdio>
#include <cstdint>

#ifndef MK_N_LAUNCHES
#define MK_N_LAUNCHES 1
#endif
#define PROBE_LAUNCH -1
#ifndef PROBE_PHASE
#define PROBE_PHASE -1
#endif

#define LAS __attribute__((address_space(3)))
#define GAS __attribute__((address_space(1)))
typedef unsigned short bf16_t;
typedef short bf16x8 __attribute__((ext_vector_type(8)));
typedef short s16x4 __attribute__((ext_vector_type(4)));
typedef float f32x2 __attribute__((ext_vector_type(2)));
typedef float f32x4 __attribute__((ext_vector_type(4)));
typedef float f32x16 __attribute__((ext_vector_type(16)));
typedef unsigned u32x2 __attribute__((ext_vector_type(2)));
typedef unsigned u32x4 __attribute__((ext_vector_type(4)));
typedef int i32x4 __attribute__((ext_vector_type(4)));
typedef __bf16 bf16x2_t __attribute__((ext_vector_type(2)));

constexpr int NB = 8, SEQ = 4096, DM = 1024, NTOK = NB * SEQ;
constexpr int PROJW = 9216, NEXP = 256, TOPK = 8, EH = 256;
constexpr float NORM_EPS = 1e-6f;

constexpr size_t MiB = 1u << 20;
constexpr size_t WS_CTL = 0, CTL_ZERO_BYTES = 1 * MiB;
constexpr size_t WS_MOD = 1 * MiB;
constexpr size_t WS_BTAB = 1 * MiB + 256 * 1024;
constexpr size_t WS_ROPE_C = 2 * MiB, WS_ROPE_S = 4 * MiB;
constexpr size_t WS_SS = 6 * MiB;
constexpr size_t WS_EIDX = 8 * MiB, WS_GATE = 9 * MiB;
constexpr size_t WS_ROWL = 10 * MiB;
constexpr size_t WS_TILE_E = 12 * MiB;
constexpr size_t WS_WIN = 16 * MiB, WS_WRU = 34 * MiB, WS_WAU = 36 * MiB, WS_WO = 38 * MiB, WS_WR = 40 * MiB;
constexpr size_t WS_H = 48 * MiB;
constexpr size_t WS_PROJ = 120 * MiB;
constexpr size_t SEG = 64 * MiB;
constexpr size_t WS_RQ = WS_PROJ, WS_RK = WS_PROJ + SEG, WS_RV = WS_PROJ + 2 * SEG, WS_RG = WS_PROJ + 3 * SEG, WS_AQ = WS_PROJ + 4 * SEG,
                 WS_AK = WS_PROJ + 5 * SEG, WS_AV = WS_PROJ + 6 * SEG, WS_SGR = WS_PROJ + 7 * SEG, WS_SGA = WS_PROJ + 8 * SEG;
constexpr size_t WS_OUTF = 696 * MiB, WS_OUTB = 760 * MiB, WS_OG = 824 * MiB, WS_LSE = 1016 * MiB;
constexpr size_t WS_RETN = WS_RQ, WS_ATTC = WS_RK, WS_YR = WS_RV, WS_MERGED = WS_AQ;
constexpr size_t WS_WGU = 120 * MiB, WS_WD = 377 * MiB, WS_HID = 512 * MiB, WS_LOGIT = 696 * MiB;
constexpr size_t WS_H8 = 48 * MiB, WS_H8B = 384 * MiB;
constexpr size_t WS_X1B = 448 * MiB;
constexpr size_t WS_END = 1022 * MiB;
constexpr int YD_SPLIT = 262144, YD_SHARED0 = NTOK * TOPK;
constexpr float YD_SCALE = 16.0f, YD_INV = 0.0625f;
__device__ __forceinline__ unsigned char* ydense_row(unsigned char* ws, int row) { return ws + (row < YD_SPLIT ? 120 * MiB : 696 * MiB) + (size_t)(row < YD_SPLIT ? row : row - YD_SPLIT) * DM; }
__device__ __forceinline__ unsigned pk4_fp8(float a, float b, float c, float d) {
    a = __builtin_fminf(__builtin_fmaxf(a * YD_SCALE, -448.f), 448.f); b = __builtin_fminf(__builtin_fmaxf(b * YD_SCALE, -448.f), 448.f);
    c = __builtin_fminf(__builtin_fmaxf(c * YD_SCALE, -448.f), 448.f); d = __builtin_fminf(__builtin_fmaxf(d * YD_SCALE, -448.f), 448.f);
    int w = __builtin_amdgcn_cvt_pk_fp8_f32(a, b, 0, false); w = __builtin_amdgcn_cvt_pk_fp8_f32(c, d, w, true); return (unsigned)w;
}
constexpr float W8_SCALE = 256.0f, FP8_UNSCALE = 1.0f / 4096.0f;
__device__ __forceinline__ unsigned pk4_fp8w(float a, float b, float c, float d) {
    a = __builtin_fminf(__builtin_fmaxf(a * W8_SCALE, -448.f), 448.f); b = __builtin_fminf(__builtin_fmaxf(b * W8_SCALE, -448.f), 448.f);
    c = __builtin_fminf(__builtin_fmaxf(c * W8_SCALE, -448.f), 448.f); d = __builtin_fminf(__builtin_fmaxf(d * W8_SCALE, -448.f), 448.f);
    int w = __builtin_amdgcn_cvt_pk_fp8_f32(a, b, 0, false); w = __builtin_amdgcn_cvt_pk_fp8_f32(c, d, w, true); return (unsigned)w;
}
constexpr size_t WS_DPOS = 13 * MiB;
constexpr int CW_TMO = 0, CW_BAR = 4096, CW_CNT = 16384, CW_FILL = 16384 + 1024;
constexpr int MAX_TILES = 2048;

__device__ __forceinline__ unsigned cvtpk(float lo, float hi) { f32x2 v = {lo, hi}; bf16x2_t b = __builtin_convertvector(v, bf16x2_t); return __builtin_bit_cast(unsigned, b); }
__device__ __forceinline__ float bf2f(unsigned short u) { return __uint_as_float((unsigned)u << 16); }
__device__ __forceinline__ float bflo(unsigned u) { return __uint_as_float(u << 16); }
__device__ __forceinline__ float bfhi(unsigned u) { return __uint_as_float(u & 0xffff0000u); }
__device__ __forceinline__ float wave_sum(float v) {
#pragma unroll
    for (int o = 1; o < 64; o <<= 1) v += __shfl_xor(v, o);
    return v;
}
__device__ __forceinline__ float sigmoidf_(float x) { return __builtin_amdgcn_rcpf(1.f + __builtin_amdgcn_exp2f(x * -1.4426950408889634f)); }
__device__ __forceinline__ float siluf_(float x) { return x * __builtin_amdgcn_rcpf(1.f + __builtin_amdgcn_exp2f(x * -1.4426950408889634f)); }

namespace pg8 {
constexpr int BM = 256, BK = 64, HALF = 128, HTB = HALF * BK * 2, STAGE_BYTES = 8 * HTB, NXCD = 8, WGM = 8;
__host__ __device__ __forceinline__ int lds_byte(int r, int c) { const int st = (r >> 4) * 2 + (c >> 5), rr = r & 15, cc = c & 31, ob = rr * 64 + cc * 2; return st * 1024 + (ob ^ (((ob >> 9) & 1) << 5)); }
__host__ __device__ __forceinline__ void stage_rc(int b, int& R, int& C) { const int st = b / 1024, sb = b % 1024, swz = sb ^ (((sb >> 9) & 1) << 5); R = (st >> 1) * 16 + swz / 64; C = (st & 1) * 32 + (swz % 64) / 2; }
__host__ __device__ __forceinline__ int perm32(int rho) { const int n = rho >> 4, i = rho & 15; return 8 * (i >> 2) + 4 * n + (i & 3); }

struct Unit { int pm, pn, e; };

__device__ __forceinline__ int xcd_remap(int L, int nwg) { const int q = nwg / NXCD, r = nwg % NXCD, xcd = L % NXCD, off = L / NXCD; return (xcd < r ? xcd * (q + 1) : r * (q + 1) + (xcd - r) * q) + off; }

struct StaticOrder {
    static constexpr bool GATHER = false, DUAL = false;
    const bf16_t* A; const bf16_t* Bt; int K;
    int nM, nN, nwg, G, c, pn_off;
    __device__ void init(const bf16_t* A_, const bf16_t* Bt_, int M, int N, int K_, int G_, int c_, int pn_off_ = 0) { A = A_; Bt = Bt_; K = K_; nM = M / BM; nN = N / BM; nwg = nM * nN; G = G_; c = c_; pn_off = pn_off_; }
    __device__ bool next(int i, Unit& u) const {
        const long L = (long)i * G + c; if (L >= nwg) return false;
        const int wgid = xcd_remap((int)L, nwg);
        const int nig = WGM * nN, gid = wgid / nig, fm = gid * WGM, gsz = (nM - fm) < WGM ? (nM - fm) : WGM;
        u.pm = fm + ((wgid % nig) % gsz); u.pn = (wgid % nig) / gsz + pn_off; u.e = 0; return true;
    }
    __device__ __forceinline__ const char* a_base(const Unit& u) const { return (const char*)A + (size_t)u.pm * (size_t)(BM * 2) * K; }
    __device__ __forceinline__ const char* b_base(const Unit& u) const { return (const char*)Bt + (size_t)u.pn * (size_t)(BM * 2) * K; }
    __device__ __forceinline__ unsigned a_row(const Unit&, int) const { return 0u; }
};

struct DualOrder {
    static constexpr bool GATHER = false, DUAL = true;
    StaticOrder so; const bf16_t* A1; const bf16_t* Bt1; int K;
    __device__ bool next(int i, Unit& u) const { if (!so.next(i >> 1, u)) return false; u.e = i & 1; return true; }
    __device__ __forceinline__ const char* a_base(const Unit& u) const { return (const char*)(u.e ? A1 : so.A) + (size_t)u.pm * (size_t)(BM * 2) * K; }
    __device__ __forceinline__ const char* b_base(const Unit& u) const { return (const char*)(u.e ? Bt1 : so.Bt) + (size_t)u.pn * (size_t)(BM * 2) * K; }
    __device__ __forceinline__ unsigned a_row(const Unit&, int) const { return 0u; }
};

template <bool GATHER_>
struct MoeOrder {
    static constexpr bool GATHER = GATHER_, DUAL = false;
    const bf16_t* A; const bf16_t* Bt; int K; size_t e_stride;
    const LAS unsigned short* tile_e; const int* rowlist; int ntiles, nN, nwg, G, c;
    __device__ bool next(int i, Unit& u) const {
        const long L = (long)i * G + c; if (L >= nwg) return false;
        const int wgid = xcd_remap((int)L, nwg);
        u.pm = wgid / nN; u.pn = wgid % nN; u.e = __builtin_amdgcn_readfirstlane((int)tile_e[u.pm]); return true;
    }
    __device__ __forceinline__ const char* a_base(const Unit& u) const { return GATHER ? (const char*)A : (const char*)A + (size_t)u.pm * (size_t)(BM * 2) * K; }
    __device__ __forceinline__ const char* b_base(const Unit& u) const { return (const char*)Bt + ((size_t)u.e * e_stride + (size_t)u.pn * BM * K) * 2; }
    __device__ __forceinline__ unsigned a_row(const Unit& u, int r) const { const int ent = rowlist[(size_t)u.pm * BM + r]; return ent < 0 ? (unsigned)NTOK : (unsigned)(ent >> 4); }
};

template <class Epi, class Sched, bool ALIGN_EPI, bool FP8 = false>
__device__ __forceinline__ void gemm_phase(LAS unsigned char* lds, const Sched& S, const Epi& E) {
    const int tid = threadIdx.x, wid = __builtin_amdgcn_readfirstlane(tid >> 6), lane = tid & 63, wr = wid >> 2, wc = wid & 3, fr = lane & 15, fq = lane >> 4;
    const int K = S.K, nt = K / BK;
    unsigned voffA[2], voffB[2]; int RA[2]; unsigned CA2[2];
#pragma unroll
    for (int i = 0; i < 2; ++i) { int R, C; stage_rc(tid * 16 + i * 8192, R, C); const int Rb = Epi::PERM ? ((R & ~31) + perm32(R & 31)) : R;
        voffA[i] = (unsigned)(R * K + C) * 2u; voffB[i] = (unsigned)(Rb * K + C) * 2u; RA[i] = R; CA2[i] = (unsigned)C * 2u; }
    const size_t kstep = (size_t)(BK * 2);
    const size_t hstep = (size_t)HALF * K * 2;
    const unsigned ldsw = (unsigned)wid * 1024u;
    const int aoff = lds_byte(wr * 64 + fr, fq * 8), boff = lds_byte(wc * 32 + fr, fq * 8);
    unsigned gC[2][2], gN[2][2];
#define PG8_SA(b, h) (((b) * 2 + (h)) * HTB)
#define PG8_SB(b, h) ((4 + (b) * 2 + (h)) * HTB)
#define PG8_STAGE(bufoff, gbase, voff) do { _Pragma("unroll") for (int _i = 0; _i < 2; ++_i) \
        __builtin_amdgcn_global_load_lds((const unsigned*)((const char*)(gbase) + (voff)[_i]), (LAS unsigned*)(lds + (bufoff) + ldsw + _i * 8192), 16, 0, 0); } while (0)
#define PG8_STAGE_A(bufoff, p, h, NX) do { if constexpr (Sched::GATHER) { _Pragma("unroll") for (int _i = 0; _i < 2; ++_i) { const unsigned _v = (NX) ? gN[h][_i] : gC[h][_i]; \
        __builtin_amdgcn_global_load_lds((const unsigned*)((const char*)(p) + _v), (LAS unsigned*)(lds + (bufoff) + ldsw + _i * 8192), 16, 0, 0); } } \
        else { PG8_STAGE(bufoff, (p) + (h) * hstep, voffA); } } while (0)
#define PG8_GATHER_SET(g, u) do { _Pragma("unroll") for (int _h = 0; _h < 2; ++_h) _Pragma("unroll") for (int _i = 0; _i < 2; ++_i) \
        g[_h][_i] = S.a_row(u, _h * HALF + RA[_i]) * (unsigned)(K * 2) + CA2[_i]; } while (0)
#define PG8_LDA(dst, b, h) do { _Pragma("unroll") for (int m = 0; m < 4; ++m) _Pragma("unroll") for (int k = 0; k < 2; ++k) dst[m][k] = *(const LAS bf16x8*)(lds + PG8_SA(b, h) + aoff + m * 2048 + k * 1024); } while (0)
#define PG8_LDB(dst, b, h) do { _Pragma("unroll") for (int n = 0; n < 2; ++n) _Pragma("unroll") for (int k = 0; k < 2; ++k) dst[n][k] = *(const LAS bf16x8*)(lds + PG8_SB(b, h) + boff + n * 2048 + k * 1024); } while (0)
#define PG8_CAT(x0, x1) __builtin_shufflevector(__builtin_bit_cast(i32x4, x0), __builtin_bit_cast(i32x4, x1), 0, 1, 2, 3, 4, 5, 6, 7)
#define PG8_MMA(ai, bj, At, Bt) do { __builtin_amdgcn_s_setprio(1); if constexpr (FP8) { _Pragma("unroll") for (int m = 0; m < 4; ++m) _Pragma("unroll") for (int n = 0; n < 2; ++n) \
        asm volatile("v_mfma_f32_16x16x128_f8f6f4 %0, %1, %2, %0" : "+v"(acc[ai][bj][m][n]) : "v"(PG8_CAT(Bt[n][0], Bt[n][1])), "v"(PG8_CAT(At[m][0], At[m][1]))); } else { \
        _Pragma("unroll") for (int m = 0; m < 4; ++m) _Pragma("unroll") for (int n = 0; n < 2; ++n) _Pragma("unroll") for (int k = 0; k < 2; ++k) \
        acc[ai][bj][m][n] = __builtin_amdgcn_mfma_f32_16x16x32_bf16(Bt[n][k], At[m][k], acc[ai][bj][m][n], 0, 0, 0); } __builtin_amdgcn_s_setprio(0); } while (0)
#define PG8_WAIT_V(n) asm volatile("s_waitcnt vmcnt(" #n ")" ::: "memory")
#define PG8_WAIT_L(n) asm volatile("s_waitcnt lgkmcnt(" #n ")" ::: "memory")
#define PG8_BAR __builtin_amdgcn_s_barrier()
#define PG8_SCHED __builtin_amdgcn_sched_barrier(0)
    Unit cur, nxt; int ui = 0;
    if (!S.next(0, cur)) return;
    f32x4 acc[2][2][4][2];
#pragma unroll
    for (int a = 0; a < 2; ++a)
#pragma unroll
        for (int b = 0; b < 2; ++b)
#pragma unroll
            for (int m = 0; m < 4; ++m)
#pragma unroll
                for (int n = 0; n < 2; ++n) acc[a][b][m][n] = (f32x4){0.f, 0.f, 0.f, 0.f};
    bf16x8 At[4][2], B0[2][2], B1[2][2];
    const char* cA = S.a_base(cur); const char* cB = S.b_base(cur);
    if constexpr (Sched::GATHER) { PG8_GATHER_SET(gC, cur); PG8_GATHER_SET(gN, cur); }
    PG8_STAGE(PG8_SB(0, 0), cB, voffB); PG8_STAGE(PG8_SB(0, 1), cB + hstep, voffB); PG8_STAGE_A(PG8_SA(0, 0), cA, 0, false); PG8_STAGE_A(PG8_SA(0, 1), cA, 1, false);
    if (wr == 1) PG8_BAR;
    PG8_WAIT_V(2); PG8_BAR;
    PG8_STAGE(PG8_SB(1, 0), cB + kstep, voffB); PG8_STAGE_A(PG8_SA(1, 0), cA + kstep, 0, false); PG8_STAGE(PG8_SB(1, 1), cB + hstep + kstep, voffB);
    PG8_WAIT_V(6); PG8_BAR;
    for (;;) {
        const bool has_next = S.next(ui + 1, nxt);
        const char* nA = has_next ? S.a_base(nxt) : cA; const char* nB = has_next ? S.b_base(nxt) : cB;
        if constexpr (Sched::GATHER) { if (has_next) { PG8_GATHER_SET(gN, nxt); } }
        for (int t = 0; t < nt; t += 2) {
            const bool last = (t == nt - 2);
            const char* a1 = cA + (size_t)(t + 1) * kstep;
            const char* a2 = last ? nA : cA + (size_t)(t + 2) * kstep; const char* b2 = last ? nB : cB + (size_t)(t + 2) * kstep;
            const char* a3 = a2 + kstep; const char* b3 = b2 + kstep;
            PG8_LDB(B0, 0, 0); PG8_LDB(B1, 0, 1); PG8_SCHED; PG8_LDA(At, 0, 0); PG8_STAGE_A(PG8_SA(1, 1), a1, 1, false);
            PG8_WAIT_V(8); PG8_WAIT_L(0); PG8_BAR; PG8_MMA(0, 0, At, B0); PG8_MMA(0, 1, At, B1); PG8_BAR; PG8_SCHED;
            PG8_LDA(At, 0, 1); PG8_STAGE(PG8_SB(0, 0), b2, voffB); PG8_STAGE(PG8_SB(0, 1), b2 + hstep, voffB); PG8_STAGE_A(PG8_SA(0, 0), a2, 0, last);
            PG8_WAIT_V(8); PG8_WAIT_L(0); PG8_BAR; PG8_MMA(1, 0, At, B0); PG8_MMA(1, 1, At, B1); PG8_BAR; PG8_SCHED;
            PG8_LDB(B0, 1, 0); PG8_LDB(B1, 1, 1); PG8_SCHED; PG8_LDA(At, 1, 0); PG8_STAGE_A(PG8_SA(0, 1), a2, 1, last);
            PG8_WAIT_V(8); PG8_WAIT_L(0); PG8_BAR; PG8_MMA(0, 0, At, B0); PG8_MMA(0, 1, At, B1); PG8_BAR; PG8_SCHED;
            PG8_LDA(At, 1, 1); PG8_STAGE(PG8_SB(1, 0), b3, voffB); PG8_STAGE(PG8_SB(1, 1), b3 + hstep, voffB); PG8_STAGE_A(PG8_SA(1, 0), a3, 0, last);
            PG8_WAIT_V(8); PG8_WAIT_L(0); PG8_BAR; PG8_MMA(1, 0, At, B0); PG8_MMA(1, 1, At, B1); PG8_BAR; PG8_SCHED;
        }
        if constexpr (ALIGN_EPI) { if (wr == 0) PG8_BAR; }
        if constexpr (FP8) {
            asm volatile("s_nop 15\n\ts_nop 15" ::: "memory");
#pragma unroll
            for (int a = 0; a < 2; ++a)
#pragma unroll
                for (int b = 0; b < 2; ++b)
#pragma unroll
                    for (int m = 0; m < 4; ++m)
#pragma unroll
                        for (int n = 0; n < 2; ++n) acc[a][b][m][n] *= (Sched::DUAL && cur.e == 0) ? 1.0f : FP8_UNSCALE;
        }
        E(acc, cur, wr, wc, fr, fq);
        if (!has_next) break;
        if (!(Sched::DUAL && cur.e == 0))
#pragma unroll
        for (int a = 0; a < 2; ++a)
#pragma unroll
            for (int b = 0; b < 2; ++b)
#pragma unroll
                for (int m = 0; m < 4; ++m)
#pragma unroll
                    for (int n = 0; n < 2; ++n) acc[a][b][m][n] = (f32x4){0.f, 0.f, 0.f, 0.f};
        cur = nxt; cA = nA; cB = nB; ++ui;
        if constexpr (Sched::GATHER) {
#pragma unroll
            for (int h = 0; h < 2; ++h)
#pragma unroll
                for (int i = 0; i < 2; ++i) gC[h][i] = gN[h][i];
        }
        if constexpr (ALIGN_EPI) { if (wr == 1) PG8_BAR; }
    }
    PG8_WAIT_V(0);
    if constexpr (!ALIGN_EPI) { if (wr == 0) PG8_BAR; }
    PG8_BAR;
#undef PG8_SA
#undef PG8_SB
#undef PG8_STAGE
#undef PG8_STAGE_A
#undef PG8_GATHER_SET
#undef PG8_LDA
#undef PG8_LDB
#undef PG8_MMA
#undef PG8_CAT
#undef PG8_WAIT_V
#undef PG8_WAIT_L
#undef PG8_BAR
#undef PG8_SCHED
}
}

typedef GAS unsigned gu32;
#define RLX_AGENT __ATOMIC_RELAXED, __HIP_MEMORY_SCOPE_AGENT
#define XB_TMO      128
#define XB_XCNT(j)  (256  + 64 * (j))
#define XB_XSUB(j)  (1280 + 64 * (j))
#define XB_XGEN(j)  (2304 + 64 * (j))
#define XB_TOP      3328
#define XB_TOPGEN   3392
#define XCD_BAR_WORDS 3456
#define XB_SPIN_CAP (1u << 18)
__device__ __forceinline__ unsigned xb_ld(unsigned* p)              { return __hip_atomic_load(p, __ATOMIC_RELAXED, __HIP_MEMORY_SCOPE_AGENT); }
__device__ __forceinline__ unsigned xb_add(unsigned* p, unsigned v) { return __hip_atomic_fetch_add(p, v, __ATOMIC_RELAXED, __HIP_MEMORY_SCOPE_AGENT); }
__device__ __forceinline__ unsigned xb_xcc_id() { return (unsigned)__builtin_amdgcn_s_getreg((3 << 11) | 20) & 0xFu; }
#define XB_SPIN(cond, bar) do { unsigned _sp = 0; while (cond) { __builtin_amdgcn_s_sleep(1); \
    if ((++_sp & 255u) == 0u) { if (xb_ld(&(bar)[XB_TMO])) break; if (_sp > XB_SPIN_CAP) { atomicAdd(&(bar)[XB_TMO], 1u); break; } } } } while (0)
struct XcdBarrier { unsigned* bar; unsigned x; volatile LAS unsigned* st; };
__device__ __forceinline__ XcdBarrier xcd_barrier_post(unsigned* bar, volatile LAS unsigned* st) {
    XcdBarrier b; b.bar = bar; b.x = xb_xcc_id(); b.st = st;
    if (threadIdx.x == 0) (void)xb_add(&bar[XB_XCNT(b.x)], 1u);
    return b;
}
__device__ __forceinline__ void xcd_barrier_complete(unsigned* bar, unsigned x, unsigned& nloc, unsigned& nx) {
    const unsigned G = gridDim.x * gridDim.y * gridDim.z;
    unsigned sum, cnt, mine, sp = 0u;
    for (;;) {
        sum = 0u; cnt = 0u; mine = 0u;
#pragma unroll
        for (unsigned j = 0; j < 16; ++j) { const unsigned c = xb_ld(&bar[XB_XCNT(j)]); sum += c; cnt += (c > 0u) ? 1u : 0u; mine = (j == x) ? c : mine; }
        if (sum == G) break;
        __builtin_amdgcn_s_sleep(1);
        if ((++sp & 255u) == 0u) { if (xb_ld(&bar[XB_TMO])) break; if (sp > XB_SPIN_CAP) { atomicAdd(&bar[XB_TMO], 1u); break; } }
    }
    nloc = mine > 0u ? mine : 1u; nx = cnt > 0u ? cnt : 1u;
}
__device__ __forceinline__ void xcd_barrier(const XcdBarrier& b) {
    asm volatile("s_waitcnt vmcnt(0)" ::: "memory");
    __syncthreads();
    if (threadIdx.x == 0) {
        unsigned* bar = b.bar;
        __builtin_amdgcn_s_waitcnt(0);
        unsigned nloc = b.st[0], nx = b.st[1];
        if (nloc == 0u) { xcd_barrier_complete(bar, b.x, nloc, nx); b.st[0] = nloc; b.st[1] = nx; }
        const unsigned old = xb_add(&bar[XB_XSUB(b.x)], 1u);
        const unsigned gen = old / nloc;
        if (old + 1u == (gen + 1u) * nloc) {
            __builtin_amdgcn_fence(__ATOMIC_RELEASE, "agent");
            asm volatile("s_waitcnt vmcnt(0)" ::: "memory");
            const unsigned og = xb_add(&bar[XB_TOP], 1u);
            const unsigned tg = og / nx;
            if (og + 1u == (tg + 1u) * nx) xb_add(&bar[XB_TOPGEN], 1u);
            else XB_SPIN(xb_ld(&bar[XB_TOPGEN]) == tg, bar);
            __builtin_amdgcn_fence(__ATOMIC_ACQUIRE, "agent");
            xb_add(&bar[XB_XGEN(b.x)], 1u);
            asm volatile("s_waitcnt vmcnt(0)" ::: "memory");
        } else {
            XB_SPIN(xb_ld(&bar[XB_XGEN(b.x)]) == gen, bar);
            __builtin_amdgcn_fence(__ATOMIC_ACQUIRE, "agent");
            asm volatile("s_waitcnt vmcnt(0)" ::: "memory");
        }
    }
    __syncthreads();
}

constexpr int NWAVES = 8, NTHR = 512;
constexpr int LDS_BYTES = 147456, LDSCTL_OFF = LDS_BYTES - 1024, MISC_OFF = LDSCTL_OFF + 320;

struct Args { const float* in[21]; float* out; unsigned char* ws; int ph_lo, ph_hi, li, pad; };

struct Frame {
    LAS unsigned char* lds;
    unsigned char* ws;
    int tid, lane, wave, vcu, G;
};

struct EpiInProj {
    static constexpr bool PERM = true;
    unsigned char* ws; const float* rc; const float* rs;
    __device__ __forceinline__ void operator()(const f32x4 (&acc)[2][2][4][2], const pg8::Unit& u, int wr, int wc, int fr, int fq) const {
        const int seg = u.pn >> 2;
        bf16_t* O = (bf16_t*)(ws + WS_PROJ + (size_t)seg * SEG);
        const int colt = (u.pn & 3) * 256;
        const int row0 = u.pm * 256 + wr * 64 + fr;
        const int d = wc * 32 + 8 * fq;
#pragma unroll
        for (int ai = 0; ai < 2; ++ai)
#pragma unroll
            for (int m = 0; m < 4; ++m) {
                const int row = row0 + ai * 128 + m * 16;
                f32x4 v00 = acc[ai][0][m][0], v01 = acc[ai][0][m][1], v10 = acc[ai][1][m][0], v11 = acc[ai][1][m][1];
                if (seg <= 1) {
                    const int pos = row & (SEQ - 1);
                    const f32x4 c0 = *(const f32x4*)(rc + (size_t)pos * 128 + d), c1 = *(const f32x4*)(rc + (size_t)pos * 128 + d + 4);
                    const f32x4 s0 = *(const f32x4*)(rs + (size_t)pos * 128 + d), s1 = *(const f32x4*)(rs + (size_t)pos * 128 + d + 4);
                    const float sc = seg == 1 ? 0.0625f : 1.0f;
                    const f32x4 a0 = (v00 * c0 - v10 * s0) * sc, a1 = (v01 * c1 - v11 * s1) * sc, b0 = (v00 * s0 + v10 * c0) * sc, b1 = (v01 * s1 + v11 * c1) * sc;
                    v00 = a0; v01 = a1; v10 = b0; v11 = b1;
                } else if (seg == 3) {
#pragma unroll
                    for (int i = 0; i < 4; ++i) { v00[i] = siluf_(v00[i]); v01[i] = siluf_(v01[i]); v10[i] = siluf_(v10[i]); v11[i] = siluf_(v11[i]); }
                } else if (seg == 4) { const float q = 0.18033688011112042f; v00 = v00 * q; v01 = v01 * q; v10 = v10 * q; v11 = v11 * q; }
                else if (seg >= 7) {
#pragma unroll
                    for (int i = 0; i < 4; ++i) { v00[i] = sigmoidf_(v00[i]); v01[i] = sigmoidf_(v01[i]); v10[i] = sigmoidf_(v10[i]); v11[i] = sigmoidf_(v11[i]); }
                }
                u32x4 w0, w1; w0.x = cvtpk(v00[0], v00[1]); w0.y = cvtpk(v00[2], v00[3]); w0.z = cvtpk(v01[0], v01[1]); w0.w = cvtpk(v01[2], v01[3]);
                w1.x = cvtpk(v10[0], v10[1]); w1.y = cvtpk(v10[2], v10[3]); w1.z = cvtpk(v11[0], v11[1]); w1.w = cvtpk(v11[2], v11[3]);
                if (seg == 0) {
                    const int pos = row & (SEQ - 1), il = pos & 127;
                    bf16_t* blkp = O + ((((size_t)(row >> 12) * 4 + (u.pn & 3)) * 32 + (pos >> 7)) * 4 + (il >> 5)) * 8192 + (size_t)(((d >> 3) & 1) * 32 + (il & 31)) * 8;
                    *(u32x4*)(blkp + (d >> 4) * 512) = w0; *(u32x4*)(blkp + ((d >> 4) + 8) * 512) = w1;
                } else if (seg <= 2) { bf16_t* rowp = O + (size_t)row * DM + colt + d; *(u32x4*)rowp = w0; *(u32x4*)(rowp + 128) = w1; }
                else {
                    unsigned char* rowp = (unsigned char*)O + (size_t)row * DM + colt + d;
                    u32x2 f0, f1; f0.x = pk4_fp8(v00[0], v00[1], v00[2], v00[3]); f0.y = pk4_fp8(v01[0], v01[1], v01[2], v01[3]);
                    f1.x = pk4_fp8(v10[0], v10[1], v10[2], v10[3]); f1.y = pk4_fp8(v11[0], v11[1], v11[2], v11[3]);
                    *(u32x2*)rowp = f0; *(u32x2*)(rowp + 128) = f1; }
            }
    }
};
template <bool ADD> struct EpiGateBf16 {
    static constexpr bool PERM = true;
    bf16_t* O; const bf16_t* Gt; const bf16_t* P;
    __device__ __forceinline__ void operator()(const f32x4 (&acc)[2][2][4][2], const pg8::Unit& u, int wr, int wc, int fr, int fq) const {
        const int row0 = u.pm * 256 + wr * 64 + fr, col0 = u.pn * 256 + wc * 32 + 8 * fq;
#pragma unroll
        for (int ai = 0; ai < 2; ++ai)
#pragma unroll
            for (int m = 0; m < 4; ++m) {
                const size_t ro = (size_t)(row0 + ai * 128 + m * 16) * DM + col0;
#pragma unroll
                for (int bj = 0; bj < 2; ++bj) {
                    const u32x4 g = *(const u32x4*)(Gt + ro + bj * 128);
                    f32x4 v0 = acc[ai][bj][m][0], v1 = acc[ai][bj][m][1];
                    v0[0] *= bflo(g.x); v0[1] *= bfhi(g.x); v0[2] *= bflo(g.y); v0[3] *= bfhi(g.y);
                    v1[0] *= bflo(g.z); v1[1] *= bfhi(g.z); v1[2] *= bflo(g.w); v1[3] *= bfhi(g.w);
                    if (ADD) { const u32x4 p = *(const u32x4*)(P + ro + bj * 128);
                        v0[0] += bflo(p.x); v0[1] += bfhi(p.x); v0[2] += bflo(p.y); v0[3] += bfhi(p.y);
                        v1[0] += bflo(p.z); v1[1] += bfhi(p.z); v1[2] += bflo(p.w); v1[3] += bfhi(p.w); }
                    u32x4 w; w.x = cvtpk(v0[0], v0[1]); w.y = cvtpk(v0[2], v0[3]); w.z = cvtpk(v1[0], v1[1]); w.w = cvtpk(v1[2], v1[3]);
                    *(u32x4*)(O + ro + bj * 128) = w;
                }
            }
    }
};
struct EpiMerge {
    static constexpr bool PERM = true;
    unsigned char* O; const unsigned char* Gr; const unsigned char* Ga;
    __device__ __forceinline__ void operator()(f32x4 (&acc)[2][2][4][2], const pg8::Unit& u, int wr, int wc, int fr, int fq) const {
        const int row0 = u.pm * 256 + wr * 64 + fr, col0 = u.pn * 256 + wc * 32 + 8 * fq;
#pragma unroll
        for (int ai = 0; ai < 2; ++ai)
#pragma unroll
            for (int m = 0; m < 4; ++m) {
                const size_t ro = (size_t)(row0 + ai * 128 + m * 16) * DM + col0;
#pragma unroll
                for (int bj = 0; bj < 2; ++bj) {
                    const u32x2 ga = *(const u32x2*)(Ga + ro + bj * 128);
                    const f32x2 ga0 = __builtin_amdgcn_cvt_pk_f32_fp8((int)ga.x, false), ga1 = __builtin_amdgcn_cvt_pk_f32_fp8((int)ga.x, true), ga2 = __builtin_amdgcn_cvt_pk_f32_fp8((int)ga.y, false), ga3 = __builtin_amdgcn_cvt_pk_f32_fp8((int)ga.y, true);
                    f32x4 a0 = (f32x4){ga0.x, ga0.y, ga1.x, ga1.y} * YD_INV, a1 = (f32x4){ga2.x, ga2.y, ga3.x, ga3.y} * YD_INV;
                    if (u.e == 0) {
                        const u32x2 gr = *(const u32x2*)(Gr + ro + bj * 128);
                        const f32x2 gr0 = __builtin_amdgcn_cvt_pk_f32_fp8((int)gr.x, false), gr1 = __builtin_amdgcn_cvt_pk_f32_fp8((int)gr.x, true), gr2 = __builtin_amdgcn_cvt_pk_f32_fp8((int)gr.y, false), gr3 = __builtin_amdgcn_cvt_pk_f32_fp8((int)gr.y, true);
                        const f32x4 r0 = (f32x4){gr0.x, gr0.y, gr1.x, gr1.y} * YD_INV, r1 = (f32x4){gr2.x, gr2.y, gr3.x, gr3.y} * YD_INV;
#pragma unroll
                        for (int i = 0; i < 4; ++i) { acc[ai][bj][m][0][i] *= r0[i] * __builtin_amdgcn_rcpf(fmaxf(a0[i], 1e-30f)); acc[ai][bj][m][1][i] *= r1[i] * __builtin_amdgcn_rcpf(fmaxf(a1[i], 1e-30f)); }
                    } else {
                        const f32x4 v0 = acc[ai][bj][m][0] * a0, v1 = acc[ai][bj][m][1] * a1;
                        u32x2 w; w.x = pk4_fp8(v0[0], v0[1], v0[2], v0[3]); w.y = pk4_fp8(v1[0], v1[1], v1[2], v1[3]);
                        *(u32x2*)(O + ro + bj * 128) = w;
                    }
                }
            }
    }
};
struct EpiOProj {
    static constexpr bool PERM = true;
    const float* x; bf16_t* x1; const float* mod; float* ss;
    __device__ __forceinline__ void operator()(const f32x4 (&acc)[2][2][4][2], const pg8::Unit& u, int wr, int wc, int fr, int fq) const {
        const int row0 = u.pm * 256 + wr * 64 + fr, col0 = u.pn * 256 + wc * 32 + 8 * fq;
        const int b = (u.pm * 256) / SEQ;
        f32x4 gm[2][2];
#pragma unroll
        for (int bj = 0; bj < 2; ++bj)
#pragma unroll
            for (int n = 0; n < 2; ++n) gm[bj][n] = *(const f32x4*)(mod + (size_t)b * 6144 + 2 * DM + col0 + bj * 128 + n * 4);
#pragma unroll
        for (int ai = 0; ai < 2; ++ai)
#pragma unroll
            for (int m = 0; m < 4; ++m) {
                const int row = row0 + ai * 128 + m * 16;
                const size_t ro = (size_t)row * DM + col0; float sq = 0.f;
#pragma unroll
                for (int bj = 0; bj < 2; ++bj) {
                    const f32x4 xa = *(const f32x4*)(x + ro + bj * 128), xb = *(const f32x4*)(x + ro + bj * 128 + 4);
                    const f32x4 o0 = xa + gm[bj][0] * acc[ai][bj][m][0], o1 = xb + gm[bj][1] * acc[ai][bj][m][1];
                    u32x4 w; w.x = cvtpk(o0[0], o0[1]); w.y = cvtpk(o0[2], o0[3]); w.z = cvtpk(o1[0], o1[1]); w.w = cvtpk(o1[2], o1[3]);
                    *(u32x4*)(x1 + ro + bj * 128) = w;
                    sq += (o0[0] * o0[0] + o0[1] * o0[1]) + (o0[2] * o0[2] + o0[3] * o0[3]) + (o1[0] * o1[0] + o1[1] * o1[1]) + (o1[2] * o1[2] + o1[3] * o1[3]); }
                sq += __shfl_xor(sq, 16); sq += __shfl_xor(sq, 32);
                if (fq == 0) ss[(size_t)row * 16 + u.pn * 4 + wc] = sq;
            }
    }
};
struct EpiF32 {
    static constexpr bool PERM = false;
    float* C; int ldc;
    __device__ __forceinline__ void operator()(const f32x4 (&acc)[2][2][4][2], const pg8::Unit& u, int wr, int wc, int fr, int fq) const {
        const int row0 = u.pm * 256 + wr * 64 + fr, col0 = u.pn * 256 + wc * 32 + 4 * fq;
#pragma unroll
        for (int ai = 0; ai < 2; ++ai)
#pragma unroll
            for (int m = 0; m < 4; ++m) { float* rowp = C + (size_t)(row0 + ai * 128 + m * 16) * ldc + col0;
#pragma unroll
                for (int bj = 0; bj < 2; ++bj)
#pragma unroll
                    for (int n = 0; n < 2; ++n) *(f32x4*)(rowp + bj * 128 + n * 16) = acc[ai][bj][m][n]; }
    }
};
struct EpiPlainScratch {
    static constexpr bool PERM = true;
    bf16_t* O;
    __device__ __forceinline__ void operator()(const f32x4 (&acc)[2][2][4][2], const pg8::Unit& u, int wr, int wc, int fr, int fq) const {
        const int row0 = u.pm * 256 + wr * 64 + fr, col0 = (u.pn & 3) * 256 + wc * 32 + 8 * fq;
#pragma unroll
        for (int ai = 0; ai < 2; ++ai)
#pragma unroll
            for (int m = 0; m < 4; ++m) { bf16_t* rowp = O + (size_t)(row0 + ai * 128 + m * 16) * DM + col0;
#pragma unroll
                for (int bj = 0; bj < 2; ++bj) { const f32x4 v0 = acc[ai][bj][m][0], v1 = acc[ai][bj][m][1];
                    u32x4 w; w.x = cvtpk(v0[0], v0[1]); w.y = cvtpk(v0[2], v0[3]); w.z = cvtpk(v1[0], v1[1]); w.w = cvtpk(v1[2], v1[3]); *(u32x4*)(rowp + bj * 128) = w; } }
    }
};
struct EpiNull {
    static constexpr bool PERM = false;
    __device__ __forceinline__ void operator()(const f32x4 (&acc)[2][2][4][2], const pg8::Unit&, int, int, int, int) const {
#pragma unroll
        for (int ai = 0; ai < 2; ++ai)
#pragma unroll
            for (int bj = 0; bj < 2; ++bj)
#pragma unroll
                for (int m = 0; m < 4; ++m)
#pragma unroll
                    for (int n = 0; n < 2; ++n) asm volatile("" :: "v"(acc[ai][bj][m][n]));
    }
};
struct EpiGU {
    static constexpr bool PERM = true;
    bf16_t* hid;
    __device__ __forceinline__ void operator()(const f32x4 (&acc)[2][2][4][2], const pg8::Unit& u, int wr, int wc, int fr, int fq) const {
        const int row0 = u.pm * 256 + wr * 64 + fr, col0 = u.pn * 128 + wc * 32 + 8 * fq;
#pragma unroll
        for (int ai = 0; ai < 2; ++ai)
#pragma unroll
            for (int m = 0; m < 4; ++m) { bf16_t* rowp = hid + (size_t)(row0 + ai * 128 + m * 16) * EH + col0;
                f32x4 h0, h1;
#pragma unroll
                for (int i = 0; i < 4; ++i) { h0[i] = siluf_(acc[ai][0][m][0][i]) * acc[ai][1][m][0][i]; h1[i] = siluf_(acc[ai][0][m][1][i]) * acc[ai][1][m][1][i]; }
                u32x4 w; w.x = cvtpk(h0[0], h0[1]); w.y = cvtpk(h0[2], h0[3]); w.z = cvtpk(h1[0], h1[1]); w.w = cvtpk(h1[2], h1[3]); *(u32x4*)rowp = w; }
    }
};
template <int MODE> struct EpiDownT {
    static constexpr bool PERM = true;
    unsigned char* ws; const LAS int* exp_info;
    __device__ __forceinline__ void operator()(const f32x4 (&acc)[2][2][4][2], const pg8::Unit& u, int wr, int wc, int fr, int fq) const {
        const int shift = __builtin_amdgcn_readfirstlane(exp_info[u.e]), lim = __builtin_amdgcn_readfirstlane(exp_info[512 + u.e]);
        const int row0 = u.pm * 256 + wr * 64 + fr, col0 = u.pn * 256 + wc * 32 + 8 * fq;
#pragma unroll
        for (int ai = 0; ai < 2; ++ai)
#pragma unroll
            for (int m = 0; m < 4; ++m) {
                const int pos = row0 + ai * 128 + m * 16;
                if (pos < lim) {
                    unsigned char* rowp = (MODE == 1 ? ws + WS_SS + (size_t)blockIdx.x * 2048 : ydense_row(ws, pos - shift)) + col0;
#pragma unroll
                    for (int bj = 0; bj < 2; ++bj) { const f32x4 v0 = acc[ai][bj][m][0], v1 = acc[ai][bj][m][1];
                        u32x2 w; w.x = pk4_fp8(v0[0], v0[1], v0[2], v0[3]); w.y = pk4_fp8(v1[0], v1[1], v1[2], v1[3]);
                        *(u32x2*)(rowp + bj * 128) = w; }
                }
            }
    }
};
typedef EpiDownT<0> EpiDown;

template <bool F8 = false> __device__ __forceinline__ void transpose_item(const float* W, int N, int K, int k0, int n0, bf16_t* WT, int drow0, LAS float* scr, int lane) {
#pragma unroll 8
    for (int i = 0; i < 32; ++i) { const int kk = 2 * i + (lane >> 5); scr[kk * 33 + (lane & 31)] = W[(size_t)(k0 + kk) * N + n0 + (lane & 31)]; }
    asm volatile("s_waitcnt lgkmcnt(0)" ::: "memory");
    const int c = lane & 7;
#pragma unroll
    for (int j = 0; j < 4; ++j) { const int n = (lane >> 3) + 8 * j; const LAS float* s = scr + (8 * c) * 33 + n;
        if constexpr (F8) { u32x2 o; o.x = pk4_fp8w(s[0 * 33], s[1 * 33], s[2 * 33], s[3 * 33]); o.y = pk4_fp8w(s[4 * 33], s[5 * 33], s[6 * 33], s[7 * 33]);
            *(u32x2*)((unsigned char*)WT + (size_t)(drow0 + n) * K + k0 + 8 * c) = o; }
        else { u32x4 o; o.x = cvtpk(s[0 * 33], s[1 * 33]); o.y = cvtpk(s[2 * 33], s[3 * 33]); o.z = cvtpk(s[4 * 33], s[5 * 33]); o.w = cvtpk(s[6 * 33], s[7 * 33]);
            *(u32x4*)(WT + (size_t)(drow0 + n) * K + k0 + 8 * c) = o; } }
    asm volatile("s_waitcnt lgkmcnt(0)" ::: "memory");
}
template <bool F8 = false> __device__ __forceinline__ void transpose_plain(const float* W, int K, int N, bf16_t* WT, LAS float* scr, int item, int lane) {
    const int nblk = N / 32, kb = item / nblk, nb = item % nblk;
    transpose_item<F8>(W, N, K, 64 * kb, 32 * nb, WT, 32 * nb, scr, lane);
}

__device__ __forceinline__ int t5_bucket(int rel) {
    const int n = rel < 0 ? -rel : rel;
    int large = 8 + (int)(logf((float)(n > 1 ? n : 1) / 8.0f) / 4.852030263919617f * 8.0f);
    large = large < 15 ? large : 15;
    return (rel > 0 ? 16 : 0) + (n < 8 ? n : large);
}

__device__ __forceinline__ void phase0(Frame& F, const Args& a) {
    const float* c = a.in[1]; const float* w_ada = a.in[2]; const float* b_ada = a.in[3];
    {
        LAS float* cond = (LAS float*)F.lds;
        LAS float* red = (LAS float*)(F.lds + 32768);
        for (int i = F.tid; i < NB * DM; i += NTHR) cond[i] = siluf_(c[i]);
        __syncthreads();
        for (int cg = F.vcu; cg < 256; cg += F.G) {
            const int j = F.tid & 31, kg = F.tid >> 5;
            float s[NB];
#pragma unroll
            for (int b = 0; b < NB; ++b) s[b] = 0.f;
            if (j < 24) {
                for (int k = kg; k < DM; k += 16) { const float w = w_ada[(size_t)k * 6144 + cg * 24 + j];
#pragma unroll
                    for (int b = 0; b < NB; ++b) s[b] += cond[b * DM + k] * w; }
            }
#pragma unroll
            for (int b = 0; b < NB; ++b) red[(kg * NB + b) * 32 + j] = s[b];
            __syncthreads();
            if (F.tid < 192) { const int b = F.tid / 24, jj = F.tid % 24; float t = 0.f;
                for (int g = 0; g < 16; ++g) t += red[(g * NB + b) * 32 + jj];
                ((float*)(F.ws + WS_MOD))[b * 6144 + cg * 24 + jj] = t + b_ada[cg * 24 + jj]; }
            __syncthreads();
        }
    }
    const int gt = F.vcu * NTHR + F.tid, NGT = F.G * NTHR;
    {
        float* rc = (float*)(F.ws + WS_ROPE_C); float* rs = (float*)(F.ws + WS_ROPE_S);
        for (int i = gt; i < SEQ * 128; i += NGT) { const int pos = i >> 7, d = i & 127;
            const float inv = (float)pow(10000.0, -(double)d / 128.0); const float ang = (float)pos * inv;
            rc[i] = (float)cos((double)ang); rs[i] = (float)sin((double)ang); }
    }
    {
        const float* t5 = a.in[7]; float* bt = (float*)(F.ws + WS_BTAB);
        for (int i = gt; i < 3 * 16 * 160; i += NGT) { const int g = i / (16 * 160), h = (i / 160) % 16, j = i % 160;
            const int dil = g == 0 ? 1 : (g == 1 ? 4 : 16);
            bt[i] = j <= 128 ? t5[t5_bucket((j - 64) * dil) * 16 + h] * 1.4426950408889634f : 0.f; }
    }
    { unsigned* z = (unsigned*)(F.ws + WS_H + (size_t)NTOK * DM * 2); for (int i = gt; i < DM / 2; i += NGT) z[i] = 0u; }
    {
        LAS float* scr = (LAS float*)(F.lds + 49152 + F.wave * 8704);
        const int gw = F.vcu * NWAVES + F.wave, NGW = F.G * NWAVES;
        constexpr int I_IN = (DM / 64) * (PROJW / 32), I_SQ = (DM / 64) * (DM / 32), I_R = (DM / 64) * (NEXP / 32);
        constexpr int NITEMS = I_IN + 3 * I_SQ + I_R;
        for (int it = gw; it < NITEMS; it += NGW) {
            int r = it;
            if (r < I_IN) { transpose_plain<true>(a.in[5], DM, PROJW, (bf16_t*)(F.ws + WS_WIN), scr, r, F.lane); continue; } r -= I_IN;
            if (r < I_SQ) { transpose_plain<true>(a.in[8], DM, DM, (bf16_t*)(F.ws + WS_WRU), scr, r, F.lane); continue; } r -= I_SQ;
            if (r < I_SQ) { transpose_plain<true>(a.in[9], DM, DM, (bf16_t*)(F.ws + WS_WAU), scr, r, F.lane); continue; } r -= I_SQ;
            if (r < I_SQ) { transpose_plain<true>(a.in[10], DM, DM, (bf16_t*)(F.ws + WS_WO), scr, r, F.lane); continue; } r -= I_SQ;
            transpose_plain(a.in[12], DM, NEXP, (bf16_t*)(F.ws + WS_WR), scr, r, F.lane);
        }
    }
}

struct TrItem { const float* src; unsigned char* dst; int N, K; };
__device__ __forceinline__ TrItem moe_item(const Args& a, unsigned char* ws, int it) {
    constexpr int PER_E = 256;
    const int e = it / PER_E, r = it % PER_E, kind = r >> 7, q = r & 127;
    TrItem t;
    if (kind < 2) {
        const float* W = e < 256 ? a.in[kind == 0 ? 14 : 15] + (size_t)e * 1024 * 256 : a.in[kind == 0 ? 17 : 18];
        const int kb = q >> 3, n0 = 32 * (q & 7);
        t.src = W + (size_t)(64 * kb) * 256 + n0; t.N = 256; t.K = 1024;
        t.dst = ws + WS_WGU + (size_t)e * 512 * 1024 + (size_t)((n0 >> 7) * 256 + kind * 128 + (n0 & 127)) * 1024 + 64 * kb;
    } else {
        const float* W = e < 256 ? a.in[16] + (size_t)e * 256 * 1024 : a.in[19];
        const int kb = q >> 5, n0 = 32 * (q & 31);
        t.src = W + (size_t)(64 * kb) * 1024 + n0; t.N = 1024; t.K = 256;
        t.dst = ws + WS_WD + (size_t)e * 1024 * 256 + (size_t)n0 * 256 + 64 * kb;
    }
    return t;
}
__device__ __forceinline__ void tr_load(const TrItem& t, float (&v)[32], int lane) {
    const float* p = t.src + (size_t)(lane >> 5) * t.N + (lane & 31);
#pragma unroll
    for (int i = 0; i < 32; ++i) v[i] = __builtin_nontemporal_load(p + (size_t)(2 * i) * t.N);
}
__device__ __forceinline__ void tr_store(const TrItem& t, const float (&v)[32], LAS float* scr, int lane) {
#pragma unroll
    for (int i = 0; i < 32; ++i) scr[(2 * i + (lane >> 5)) * 33 + (lane & 31)] = v[i];
    asm volatile("s_waitcnt lgkmcnt(0)" ::: "memory");
    const int c = lane & 7;
#pragma unroll
    for (int j = 0; j < 4; ++j) { const int n = (lane >> 3) + 8 * j; const LAS float* s = scr + (8 * c) * 33 + n;
        u32x2 o; o.x = pk4_fp8w(s[0 * 33], s[1 * 33], s[2 * 33], s[3 * 33]); o.y = pk4_fp8w(s[4 * 33], s[5 * 33], s[6 * 33], s[7 * 33]);
        *(u32x2*)(t.dst + (size_t)n * t.K + 8 * c) = o; }
    asm volatile("s_waitcnt lgkmcnt(0)" ::: "memory");
}
constexpr int CW_CONVQ = 16384 + 2048;
__device__ __forceinline__ void moe_weight_convert(Frame& F, const Args& a) {
    LAS float* scr = (LAS float*)(F.lds + F.wave * 8704);
    const int total = 257 * 256, nchunks = total / 8;
    unsigned* q = (unsigned*)(F.ws + WS_CTL) + CW_CONVQ;
    float v0[32], v1[32];
    for (;;) {
        unsigned ck = 0;
        if (F.lane == 0) ck = __hip_atomic_fetch_add(q, 1u, __ATOMIC_RELAXED, __HIP_MEMORY_SCOPE_AGENT);
        ck = __builtin_amdgcn_readfirstlane(ck);
        if ((int)ck >= nchunks) break;
        const int it0 = (int)ck * 8;
        TrItem t0 = moe_item(a, F.ws, it0), t1 = t0;
        tr_load(t0, v0, F.lane);
#pragma unroll 1
        for (int k = 0; k < 8; k += 2) {
            t1 = moe_item(a, F.ws, it0 + k + 1); tr_load(t1, v1, F.lane);
            tr_store(t0, v0, scr, F.lane);
            if (k + 2 < 8) { t0 = moe_item(a, F.ws, it0 + k + 2); tr_load(t0, v0, F.lane); }
            tr_store(t1, v1, scr, F.lane);
        }
    }
}

template <bool BF16IN, int OUT8> __device__ __forceinline__ void norm_mod_rows(Frame& F, const void* xin, const float* norm, const float* mod, int shift_off, int scale_off, const float* ssp, bf16_t* out, unsigned char* out8) {
    const float* x = (const float*)xin; const bf16_t* xb = (const bf16_t*)xin;
    const int gw = F.vcu * NWAVES + F.wave, NGW = F.G * NWAVES;
    f32x4 g4[4];
#pragma unroll
    for (int j = 0; j < 4; ++j) g4[j] = *(const f32x4*)(norm + 4 * F.lane + 256 * j);
    f32x4 v[4], vn[4]; float p = 0.f, pn = 0.f;
    int row = gw;
#define NM_LOAD(V, ROW) do { if (BF16IN) { const u32x2* xr_ = (const u32x2*)(xb + (size_t)(ROW) * DM) + F.lane; _Pragma("unroll") for (int j = 0; j < 4; ++j) { const u32x2 t_ = xr_[64 * j]; V[j] = (f32x4){bflo(t_.x), bfhi(t_.x), bflo(t_.y), bfhi(t_.y)}; } } \
        else { const f32x4* xr_ = (const f32x4*)(x + (size_t)(ROW) * DM) + F.lane; _Pragma("unroll") for (int j = 0; j < 4; ++j) V[j] = xr_[64 * j]; } } while (0)
    if (row < NTOK) { NM_LOAD(v, row);
        if (ssp) p = F.lane < 16 ? ssp[(size_t)row * 16 + F.lane] : 0.f; }
#pragma unroll 1
    for (; row < NTOK; row += NGW) {
        const int nrow = row + NGW < NTOK ? row + NGW : row;
        { NM_LOAD(vn, nrow);
          if (ssp) pn = F.lane < 16 ? ssp[(size_t)nrow * 16 + F.lane] : 0.f; }
        const int b = row / SEQ;
        float s = 0.f;
#pragma unroll
        for (int j = 0; j < 4; ++j) s += (v[j][0] * v[j][0] + v[j][1] * v[j][1]) + (v[j][2] * v[j][2] + v[j][3] * v[j][3]);
        const float tot = wave_sum(ssp ? p : s);
        const float rstd = rsqrtf(tot * (1.f / DM) + NORM_EPS);
        u32x2* o8 = (u32x2*)(out + (size_t)row * DM) + F.lane;
#pragma unroll
        for (int j = 0; j < 4; ++j) {
            const int col = 4 * F.lane + 256 * j;
            const f32x4 sc = *(const f32x4*)(mod + (size_t)b * 6144 + scale_off + col), sh = *(const f32x4*)(mod + (size_t)b * 6144 + shift_off + col);
            const f32x4 y = (v[j] * rstd) * g4[j] * (sc + 1.0f) + sh;
            if (OUT8 != 1) { u32x2 w; w.x = cvtpk(y[0], y[1]); w.y = cvtpk(y[2], y[3]); o8[64 * j] = w; }
            if (OUT8 != 0) *(unsigned*)(out8 + (size_t)row * DM + col) = pk4_fp8(y[0], y[1], y[2], y[3]);
        }
#pragma unroll
        for (int j = 0; j < 4; ++j) v[j] = vn[j];
        p = pn;
    }
}

__device__ __forceinline__ unsigned off_b(unsigned row, unsigned ch) { return 256u * row + 16u * (ch ^ (((row & 3) << 2) | ((row >> 2) & 3))); }
__device__ __forceinline__ int crow(int reg, int h) { return (reg & 3) + 8 * (reg >> 2) + 4 * h; }
__device__ __forceinline__ s16x4 tr_read(LAS unsigned char* p) { return __builtin_bit_cast(s16x4, __builtin_amdgcn_ds_read_tr16_b64_v4i16((LAS s16x4*)p)); }
__device__ __forceinline__ bf16x8 pack8(const f32x16& x, int s) {
    u32x4 p; p.x = cvtpk(x[8 * s], x[8 * s + 1]); p.y = cvtpk(x[8 * s + 2], x[8 * s + 3]); p.z = cvtpk(x[8 * s + 4], x[8 * s + 5]); p.w = cvtpk(x[8 * s + 6], x[8 * s + 7]);
    return __builtin_bit_cast(bf16x8, p);
}
#define MFMA32(a, b, c) __builtin_amdgcn_mfma_f32_32x32x16_bf16((a), (b), (c), 0, 0, 0)

constexpr int RK_STR = 528, RV_STR = 192;
constexpr int RL_K = 0, RL_V = 128 * RK_STR, RL_S = RL_V + 128 * RV_STR, RL_P = RL_S + 64 * RK_STR, RL_END = RL_P + 10 * 2048;
__device__ __forceinline__ void retention_chain_rs(Frame& F, const Args& a, int chain) {
    const int b = chain >> 5, h = (chain >> 3) & 3, dir = (chain >> 2) & 1, es = chain & 3;
    const int lane = F.lane, r = lane & 31, hh = lane >> 5, w = F.wave;
    const bool outw = w < 4; const int ib = w & 3, sw = w & 3;
    const bf16_t* RQ = (const bf16_t*)(F.ws + WS_RQ); const bf16_t* RK = (const bf16_t*)(F.ws + WS_RK); const bf16_t* RV = (const bf16_t*)(F.ws + WS_RV);
    bf16_t* OUT = (bf16_t*)(F.ws + (dir ? WS_OUTB : WS_OUTF));
    const float lg = log1pf(-__expf(a.in[6][dir * 4 + h]));
    const float decayC = __expf(lg * 128.f);
    LAS unsigned char* lds = F.lds;
    f32x16 R[4];
#pragma unroll
    for (int k = 0; k < 4; ++k)
#pragma unroll
        for (int i = 0; i < 16; ++i) R[k][i] = 0.f;
#define QFRAG(s) __builtin_bit_cast(bf16x8, (f32x4){R[(s) >> 2][4 * ((s) & 3)], R[(s) >> 2][4 * ((s) & 3) + 1], R[(s) >> 2][4 * ((s) & 3) + 2], R[(s) >> 2][4 * ((s) & 3) + 3]})
#define QLOAD(s, P) do { const f32x4 t_ = *(const f32x4*)(P); R[(s) >> 2][4 * ((s) & 3)] = t_[0]; R[(s) >> 2][4 * ((s) & 3) + 1] = t_[1]; R[(s) >> 2][4 * ((s) & 3) + 2] = t_[2]; R[(s) >> 2][4 * ((s) & 3) + 3] = t_[3]; } while (0)
    for (int i = F.tid; i < (64 * RK_STR) / 16; i += NTHR) *(LAS u32x4*)(lds + RL_S + i * 16) = (u32x4){0u, 0u, 0u, 0u};
    const int vj = F.tid >> 2, ve0 = (F.tid & 3) * 16;
    const float vscale = __expf(lg * (dir == 0 ? (float)(127 - vj) : (float)vj));
    const int blk = (lane >> 4) & 1, q4 = (lane & 15) >> 2, p4 = lane & 3;
    LAS unsigned char* kbase = lds + RL_K + r * RK_STR + 16 * hh;
    LAS unsigned char* sbase = lds + RL_S + r * RK_STR + 16 * hh;
    LAS unsigned char* vtr = lds + RL_V + (4 * hh + q4) * RV_STR + (16 * blk + 4 * p4) * 2;
    LAS unsigned char* ktr = lds + RL_K + (4 * hh + q4) * RK_STR + (sw * 64 + 16 * blk + 4 * p4) * 2;
    LAS unsigned char* spub = lds + RL_S + r * RK_STR + (sw * 64 + 4 * hh) * 2;
    const float rsc = __expf(lg * (dir == 0 ? (float)(ib * 32 + r - 127) : (float)(-(ib * 32 + r))));
    const char* RKb = (const char*)RK + (size_t)h * 512; const char* RVb = (const char*)RV + (size_t)(h * 256 + es * 64) * 2; const char* RQb = (const char*)RQ + ((size_t)((b * 4 + h) * 32) * 4 + ib) * 16384;
    char* OUTb = (char*)OUT + (size_t)(ib * 32 * DM + h * 256 + es * 64) * 2;
    const unsigned klo = (unsigned)(((F.tid >> 5) * DM + (F.tid & 31) * 8) * 2), vlo = (unsigned)((vj * DM + ve0) * 2), qlo = (unsigned)(lane * 16), olo = (unsigned)((r * DM + 4 * hh) * 2);
    u32x4 kpre[8]; u32x4 vpre[2];
    {
        const size_t t0 = (size_t)b * SEQ + (size_t)(dir == 0 ? 0 : 31) * 128;
        const char* kc = RKb + t0 * (DM * 2); const char* vc = RVb + t0 * (DM * 2); const char* qc = RQb + (size_t)(dir == 0 ? 0 : 31) * 65536;
#pragma unroll
        for (int i = 0; i < 8; ++i) kpre[i] = *(const u32x4*)(kc + (size_t)i * (16 * DM * 2) + klo);
        vpre[0] = *(const u32x4*)(vc + vlo); vpre[1] = *(const u32x4*)(vc + vlo + 16);
        if (outw) {
#pragma unroll
            for (int s = 0; s < 16; ++s) QLOAD(s, qc + qlo + 1024 * s);
        }
    }
#pragma unroll 1
    for (int n = 0; n < 32; ++n) {
        const int cidx = dir == 0 ? n : 31 - n;
        const size_t t0 = (size_t)b * SEQ + (size_t)cidx * 128;
        {
            LAS unsigned char* kw = lds + RL_K + (F.tid >> 5) * RK_STR + (F.tid & 31) * 16;
#pragma unroll
            for (int i = 0; i < 8; ++i) *(LAS u32x4*)(kw + i * 16 * RK_STR) = kpre[i];
#pragma unroll
            for (int i = 0; i < 2; ++i) {
                u32x4 o; o.x = cvtpk(bflo(vpre[i].x) * vscale, bfhi(vpre[i].x) * vscale); o.y = cvtpk(bflo(vpre[i].y) * vscale, bfhi(vpre[i].y) * vscale);
                o.z = cvtpk(bflo(vpre[i].z) * vscale, bfhi(vpre[i].z) * vscale); o.w = cvtpk(bflo(vpre[i].w) * vscale, bfhi(vpre[i].w) * vscale);
                *(LAS u32x4*)(lds + RL_V + vj * RV_STR + ve0 * 2 + 16 * i) = o;
            }
        }
        __syncthreads();
        {
            const int nn = n + 1 < 32 ? n + 1 : n; const int cn = dir == 0 ? nn : 31 - nn;
            const size_t t1 = (size_t)b * SEQ + (size_t)cn * 128;
            const char* kc = RKb + t1 * (DM * 2); const char* vc = RVb + t1 * (DM * 2);
#pragma unroll
            for (int i = 0; i < 8; ++i) kpre[i] = *(const u32x4*)(kc + (size_t)i * (16 * DM * 2) + klo);
            vpre[0] = *(const u32x4*)(vc + vlo); vpre[1] = *(const u32x4*)(vc + vlo + 16);
        }
        if (outw) {
            f32x16 acc0, acc1;
#pragma unroll
            for (int i = 0; i < 16; ++i) { acc0[i] = 0.f; acc1[i] = 0.f; }
            const int jb_lo = dir == 0 ? 0 : ib, jb_hi = dir == 0 ? ib : 3;
#pragma unroll 1
            for (int jb = jb_lo; jb <= jb_hi; ++jb) {
                LAS unsigned char* kb = kbase + jb * (32 * RK_STR);
                f32x16 sT;
#pragma unroll
                for (int i = 0; i < 16; ++i) sT[i] = 0.f;
#pragma unroll
                for (int hb = 0; hb < 2; ++hb) {
                    bf16x8 kf[8];
#pragma unroll
                    for (int s = 0; s < 8; ++s) kf[s] = *(const LAS bf16x8*)(kb + (hb * 8 + s) * 32);
                    __builtin_amdgcn_sched_barrier(0);
#pragma unroll
                    for (int s = 0; s < 8; ++s) sT = MFMA32(kf[s], QFRAG(hb * 8 + s), sT);
                    __builtin_amdgcn_sched_barrier(0);
                }
                if (jb == ib) {
#pragma unroll
                    for (int i = 0; i < 16; ++i) { const int jl = crow(i, hh); const bool keep = dir == 0 ? (jl <= r) : (jl > r); sT[i] = keep ? sT[i] : 0.f; }
                }
                const bf16x8 p0 = pack8(sT, 0), p1 = pack8(sT, 1);
                LAS unsigned char* vb = vtr + jb * (32 * RV_STR);
#pragma unroll
                for (int s2 = 0; s2 < 2; ++s2) {
                    const s16x4 l0 = tr_read(vb + s2 * (16 * RV_STR)), h0 = tr_read(vb + s2 * (16 * RV_STR) + 8 * RV_STR);
                    const s16x4 l1 = tr_read(vb + s2 * (16 * RV_STR) + 64), h1 = tr_read(vb + s2 * (16 * RV_STR) + 8 * RV_STR + 64);
                    acc0 = MFMA32(__builtin_shufflevector(l0, h0, 0, 1, 2, 3, 4, 5, 6, 7), s2 == 0 ? p0 : p1, acc0);
                    acc1 = MFMA32(__builtin_shufflevector(l1, h1, 0, 1, 2, 3, 4, 5, 6, 7), s2 == 0 ? p0 : p1, acc1);
                }
            }
#pragma unroll
            for (int hb = 0; hb < 4; ++hb) {
                bf16x8 sf0[4], sf1[4];
#pragma unroll
                for (int s = 0; s < 4; ++s) { sf0[s] = *(const LAS bf16x8*)(sbase + (hb * 4 + s) * 32); sf1[s] = *(const LAS bf16x8*)(sbase + 32 * RK_STR + (hb * 4 + s) * 32); }
                __builtin_amdgcn_sched_barrier(0);
#pragma unroll
                for (int s = 0; s < 4; ++s) { acc0 = MFMA32(sf0[s], QFRAG(hb * 4 + s), acc0); acc1 = MFMA32(sf1[s], QFRAG(hb * 4 + s), acc1); }
                __builtin_amdgcn_sched_barrier(0);
            }
            u32x2 ow[8];
#pragma unroll
            for (int g = 0; g < 4; ++g) { ow[g].x = cvtpk(acc0[4 * g] * rsc, acc0[4 * g + 1] * rsc); ow[g].y = cvtpk(acc0[4 * g + 2] * rsc, acc0[4 * g + 3] * rsc);
                ow[4 + g].x = cvtpk(acc1[4 * g] * rsc, acc1[4 * g + 1] * rsc); ow[4 + g].y = cvtpk(acc1[4 * g + 2] * rsc, acc1[4 * g + 3] * rsc); }
            {
                const int nn = n + 1 < 32 ? n + 1 : n; const int cn = dir == 0 ? nn : 31 - nn;
                const char* qc = RQb + (size_t)cn * 65536;
#pragma unroll
                for (int s = 0; s < 16; ++s) QLOAD(s, qc + qlo + 1024 * s);
            }
            {
                char* oc = OUTb + t0 * (DM * 2) + olo;
#pragma unroll
                for (int g = 0; g < 4; ++g) { *(u32x2*)(oc + g * 16) = ow[g]; *(u32x2*)(oc + 64 + g * 16) = ow[4 + g]; }
            }
        } else {
#pragma unroll
            for (int ks = 0; ks < 8; ++ks) {
                const s16x4 vl0 = tr_read(vtr + ks * (16 * RV_STR)), vh0 = tr_read(vtr + ks * (16 * RV_STR) + 8 * RV_STR);
                const s16x4 vl1 = tr_read(vtr + ks * (16 * RV_STR) + 64), vh1 = tr_read(vtr + ks * (16 * RV_STR) + 8 * RV_STR + 64);
                const bf16x8 vf0 = __builtin_shufflevector(vl0, vh0, 0, 1, 2, 3, 4, 5, 6, 7), vf1 = __builtin_shufflevector(vl1, vh1, 0, 1, 2, 3, 4, 5, 6, 7);
#pragma unroll
                for (int dd = 0; dd < 2; ++dd) {
                    const s16x4 lo = tr_read(ktr + ks * (16 * RK_STR) + dd * 64), hi = tr_read(ktr + ks * (16 * RK_STR) + 8 * RK_STR + dd * 64);
                    const bf16x8 kt = __builtin_shufflevector(lo, hi, 0, 1, 2, 3, 4, 5, 6, 7);
                    R[2 * dd] = MFMA32(kt, vf0, R[2 * dd]); R[2 * dd + 1] = MFMA32(kt, vf1, R[2 * dd + 1]);
                }
            }
#pragma unroll
            for (int k = 0; k < 4; ++k)
#pragma unroll
                for (int i = 0; i < 16; ++i) R[k][i] *= decayC;
        }
        __syncthreads();
        if (!outw) {
#pragma unroll
            for (int dd = 0; dd < 2; ++dd)
#pragma unroll
                for (int e = 0; e < 2; ++e)
#pragma unroll
                    for (int g = 0; g < 4; ++g) { u32x2 wv; wv.x = cvtpk(R[2 * dd + e][4 * g], R[2 * dd + e][4 * g + 1]); wv.y = cvtpk(R[2 * dd + e][4 * g + 2], R[2 * dd + e][4 * g + 3]);
                        *(LAS u32x2*)(spub + e * (32 * RK_STR) + dd * 64 + g * 16) = wv; }
        }
    }
    __syncthreads();
#undef QFRAG
#undef QLOAD
}

__device__ __forceinline__ u32x4 fp8x8_to_bf16(unsigned w0, unsigned w1) {
    const f32x2 a = __builtin_amdgcn_cvt_pk_f32_fp8((int)w0, false), b = __builtin_amdgcn_cvt_pk_f32_fp8((int)w0, true), c = __builtin_amdgcn_cvt_pk_f32_fp8((int)w1, false), d = __builtin_amdgcn_cvt_pk_f32_fp8((int)w1, true);
    return (u32x4){cvtpk(a.x, a.y), cvtpk(b.x, b.y), cvtpk(c.x, c.y), cvtpk(d.x, d.y)};
}
constexpr int AK_STR = 144, AV_STR = 192;
constexpr int AL_K = 0, AL_V = 384 * AK_STR, AL_B = AL_V + 384 * AV_STR, AL_END = AL_B + 896;
struct AttUnit { int g, dil, length, res, run0, b, head; };
__device__ __forceinline__ AttUnit att_decode(int slot) {
    AttUnit u; const int bh = slot / 48, k = slot % 48, ru = k & 15; u.g = k >> 4;
    u.dil = u.g == 0 ? 1 : (u.g == 1 ? 4 : 16); u.length = SEQ / u.dil; u.res = ru % u.dil; u.run0 = (ru / u.dil) * 256; u.b = bh >> 4; u.head = bh & 15; return u;
}
__device__ __forceinline__ void attention_phase(Frame& F, int u0, int u1, int zero) {
    if (u0 >= u1) return;
    const int lane = F.lane, r = lane & 31, hh = lane >> 5, w = F.wave;
    const unsigned char* AQ = F.ws + WS_AQ; const unsigned char* AK = F.ws + WS_AK; const unsigned char* AV = F.ws + WS_AV;
    LAS unsigned char* lds = F.lds;
    const int blk = (lane >> 4) & 1, q4 = (lane & 15) >> 2, p4 = lane & 3;
    LAS unsigned char* kbase = lds + AL_K + (32 * w + r) * AK_STR + 16 * hh;
    LAS unsigned char* vbase = lds + AL_V + (32 * w + 4 * hh + q4) * AV_STR + (16 * blk + 4 * p4) * 2;
    const LAS float* bt = (const LAS float*)(lds + AL_B) + (4 * hh - r + 32);
    u32x4 kk[3], vv[3]; u32x2 qn[4]; float bnext = 0.f;
    u32x4 kk2[3], vv2[3]; u32x2 qn2[4]; float bnext2 = 0.f;
#define ATT_LOAD(U) do { const AttUnit un_ = att_decode(U); \
        if (F.tid < 224) { const int X_ = F.tid - 32; bnext = (X_ >= 0 && X_ <= 128) ? ((const float*)(F.ws + WS_BTAB))[(un_.g * 16 + un_.head) * 160 + X_] : 0.f; } \
        _Pragma("unroll") for (int i = 0; i < 3; ++i) { const int id = F.tid + i * NTHR, row = id >> 2, ch = id & 3; int idx = un_.run0 - 64 + row; idx = idx < 0 ? 0 : (idx >= un_.length ? un_.length - 1 : idx); \
            const size_t off = ((size_t)un_.b * SEQ + (size_t)idx * un_.dil + un_.res) * DM + un_.head * 64 + ch * 16; kk[i] = *(const u32x4*)(AK + off); vv[i] = *(const u32x4*)(AV + off); } \
        const size_t qt_ = (size_t)un_.b * SEQ + (size_t)(un_.run0 + 32 * w + r) * un_.dil + un_.res; \
        _Pragma("unroll") for (int s = 0; s < 4; ++s) qn[s] = *(const u32x2*)(AQ + qt_ * DM + un_.head * 64 + 16 * s + 8 * hh); } while (0)
#define ATT_LOAD2(U) do { const AttUnit un_ = att_decode(U); \
        if (F.tid < 224) { const int X_ = F.tid - 32; bnext2 = (X_ >= 0 && X_ <= 128) ? ((const float*)(F.ws + WS_BTAB))[(un_.g * 16 + un_.head) * 160 + X_] : 0.f; } \
        _Pragma("unroll") for (int i = 0; i < 3; ++i) { const int id = F.tid + i * NTHR, row = id >> 2, ch = id & 3; int idx = un_.run0 - 64 + row; idx = idx < 0 ? 0 : (idx >= un_.length ? un_.length - 1 : idx); \
            const size_t off = ((size_t)un_.b * SEQ + (size_t)idx * un_.dil + un_.res) * DM + un_.head * 64 + ch * 16; kk2[i] = *(const u32x4*)(AK + off); vv2[i] = *(const u32x4*)(AV + off); } \
        const size_t qt_ = (size_t)un_.b * SEQ + (size_t)(un_.run0 + 32 * w + r) * un_.dil + un_.res; \
        _Pragma("unroll") for (int s = 0; s < 4; ++s) qn2[s] = *(const u32x2*)(AQ + qt_ * DM + un_.head * 64 + 16 * s + 8 * hh); } while (0)
    const int nun = u1 - u0, nit = nun * (PROBE_PHASE == 31 ? 2 : 1);
#define ATT_SLOT(I) (u0 + ((I) >= nit ? nun - 1 : ((I) >= nun ? (I) - nun : (I))))
    ATT_LOAD(ATT_SLOT(0)); ATT_LOAD2(ATT_SLOT(1));
#pragma unroll 1
    for (int it = 0; it < nit; ++it) {
        const int unit = u0 + (it >= nun ? it - nun : it);
        const AttUnit un = att_decode(unit);
        unsigned char* OG = F.ws + WS_OG + (size_t)un.g * (SEG / 2); float* LSE = (float*)(F.ws + WS_LSE) + (size_t)un.g * NTOK * 16;
#pragma unroll
        for (int i = 0; i < 3; ++i) { const int id = F.tid + i * NTHR, row = id >> 2, ch = id & 3;
            *(LAS u32x4*)(lds + AL_K + row * AK_STR + 32 * ch) = fp8x8_to_bf16(kk[i].x, kk[i].y); *(LAS u32x4*)(lds + AL_K + row * AK_STR + 32 * ch + 16) = fp8x8_to_bf16(kk[i].z, kk[i].w);
            *(LAS u32x4*)(lds + AL_V + row * AV_STR + 32 * ch) = fp8x8_to_bf16(vv[i].x, vv[i].y); *(LAS u32x4*)(lds + AL_V + row * AV_STR + 32 * ch + 16) = fp8x8_to_bf16(vv[i].z, vv[i].w); }
        if (F.tid < 224) ((LAS float*)(lds + AL_B))[F.tid] = bnext;
        bf16x8 qf[4];
#pragma unroll
        for (int s = 0; s < 4; ++s) qf[s] = __builtin_bit_cast(bf16x8, fp8x8_to_bf16(qn[s].x, qn[s].y));
        __syncthreads();
#pragma unroll
        for (int i = 0; i < 3; ++i) { kk[i] = kk2[i]; vv[i] = vv2[i]; }
#pragma unroll
        for (int s = 0; s < 4; ++s) qn[s] = qn2[s];
        bnext = bnext2;
        ATT_LOAD2(ATT_SLOT(it + 2));
        const size_t qtok = (size_t)un.b * SEQ + (size_t)(un.run0 + 32 * w + r) * un.dil + un.res;
        const int lv = 4 * hh - r, kv = un.run0 - 64 + 32 * w + 4 * hh;
        const int clo = max(-lv, -kv), chi = min(128 - lv, un.length - 1 - kv);
        const bool edge = (un.run0 == 0) || (un.run0 + 256 == un.length);
        float m = -3.0e38f, lsum = 0.f;
        f32x16 o0, o1;
#pragma unroll 1
        for (int rc_ = 0; rc_ < (PROBE_PHASE == 33 ? 2 + zero : 1); ++rc_) {
        m = -3.0e38f; lsum = 0.f;
#pragma unroll
        for (int i = 0; i < 16; ++i) { o0[i] = 0.f; o1[i] = 0.f; }
#pragma unroll
        for (int kb = 0; kb < 5; ++kb) {
            f32x16 sT;
#pragma unroll
            for (int i = 0; i < 16; ++i) sT[i] = 0.f;
#pragma unroll
            for (int s = 0; s < 4; ++s) sT = MFMA32(*(const LAS bf16x8*)(kbase + kb * (32 * AK_STR) + s * 32), qf[s], sT);
            float bv[16];
#pragma unroll
            for (int i = 0; i < 16; ++i) bv[i] = bt[32 * kb + (i & 3) + 8 * (i >> 2)];
            const bool masked = (kb == 0) || (kb == 4) || edge;
            float bm = -3.0e38f;
            if (masked) {
#pragma unroll
                for (int i = 0; i < 16; ++i) { const int c = 32 * kb + (i & 3) + 8 * (i >> 2); const bool valid = (c >= clo) && (c <= chi);
                    const float sv = sT[i] * (1.0f / 256.0f) + bv[i]; sT[i] = valid ? sv : -3.0e38f; bm = fmaxf(bm, sT[i]); }
            } else {
#pragma unroll
                for (int i = 0; i < 16; ++i) { sT[i] = sT[i] * (1.0f / 256.0f) + bv[i]; bm = fmaxf(bm, sT[i]); }
            }
            bm = fmaxf(bm, __shfl_xor(bm, 32));
            const float mn = fmaxf(m, bm), alpha = __builtin_amdgcn_exp2f(m - mn);
            if (kb > 0 && __any(mn > m)) {
#pragma unroll
                for (int i = 0; i < 16; ++i) { o0[i] *= alpha; o1[i] *= alpha; }
            }
            m = mn; lsum *= alpha;
            if (masked) {
#pragma unroll
                for (int i = 0; i < 16; ++i) { const float p = sT[i] > -1.0e38f ? __builtin_amdgcn_exp2f(sT[i] - mn) : 0.f; sT[i] = p; lsum += p; }
            } else {
#pragma unroll
                for (int i = 0; i < 16; ++i) { const float p = __builtin_amdgcn_exp2f(sT[i] - mn); sT[i] = p; lsum += p; }
            }
#pragma unroll
            for (int s2 = 0; s2 < 2; ++s2) {
                const bf16x8 pb = pack8(sT, s2);
#pragma unroll
                for (int e2 = 0; e2 < 2; ++e2) {
                    const s16x4 lo = tr_read(vbase + kb * (32 * AV_STR) + s2 * (16 * AV_STR) + e2 * 64);
                    const s16x4 hi = tr_read(vbase + kb * (32 * AV_STR) + s2 * (16 * AV_STR) + 8 * AV_STR + e2 * 64);
                    const bf16x8 vf = __builtin_shufflevector(lo, hi, 0, 1, 2, 3, 4, 5, 6, 7);
                    if (e2 == 0) o0 = MFMA32(vf, pb, o0); else o1 = MFMA32(vf, pb, o1);
                }
            }
        }
        }
        lsum += __shfl_xor(lsum, 32);
        if (hh == 0) LSE[qtok * 16 + un.head] = (m + __log2f(lsum)) * 0.6931471805599453f;
        const float linv = YD_INV / lsum;
        __syncthreads();
#pragma unroll 1
        for (int rs_ = 0; rs_ < (PROBE_PHASE == 34 ? 2 + zero : 1); ++rs_)
        {
            LAS unsigned char* ost = lds + AL_K + w * (32 * AK_STR);
#pragma unroll
            for (int g = 0; g < 4; ++g) {
                u32x2 a0, a1; a0.x = cvtpk(o0[4 * g] * linv, o0[4 * g + 1] * linv); a0.y = cvtpk(o0[4 * g + 2] * linv, o0[4 * g + 3] * linv);
                a1.x = cvtpk(o1[4 * g] * linv, o1[4 * g + 1] * linv); a1.y = cvtpk(o1[4 * g + 2] * linv, o1[4 * g + 3] * linv);
                *(LAS u32x2*)(ost + r * AK_STR + 16 * g + 8 * hh) = a0; *(LAS u32x2*)(ost + r * AK_STR + 64 + 16 * g + 8 * hh) = a1;
            }
            asm volatile("s_waitcnt lgkmcnt(0)" ::: "memory");
#pragma unroll
            for (int it = 0; it < 4; ++it) {
                const int ql = 8 * it + (lane >> 3);
                const u32x4 v = *(const LAS u32x4*)(ost + ql * AK_STR + 16 * (lane & 7));
                const size_t tok = (size_t)un.b * SEQ + (size_t)(un.run0 + 32 * w + ql) * un.dil + un.res;
                u32x2 f8; f8.x = pk4_fp8(bflo(v.x), bfhi(v.x), bflo(v.y), bfhi(v.y)); f8.y = pk4_fp8(bflo(v.z), bfhi(v.z), bflo(v.w), bfhi(v.w));
                __builtin_nontemporal_store(f8, (u32x2*)(OG + tok * DM + un.head * 64 + 8 * (lane & 7)));
            }
        }
        __syncthreads();
    }
#undef ATT_LOAD
#undef ATT_LOAD2
#undef ATT_SLOT
}

__device__ __forceinline__ void mixer_post_rows(Frame& F) {
    const int gw = F.vcu * NWAVES + F.wave, NGW = F.G * NWAVES, lane = F.lane;
    const bf16_t* OF = (const bf16_t*)(F.ws + WS_OUTF); const bf16_t* OB = (const bf16_t*)(F.ws + WS_OUTB); const unsigned char* SG = (F.ws + WS_RG);
    const unsigned char* OG = F.ws + WS_OG; const float* LSE = (const float*)(F.ws + WS_LSE);
    unsigned char* RN = F.ws + WS_RETN; unsigned char* AC = F.ws + WS_ATTC;
    const int head = lane >> 2;
    u32x2 fa[4], fb[4], na[4], nb[4]; unsigned sg[4], nsg[4]; u32x4 og[3], nog[3]; float ls[3], nls[3];
#define MP_LOAD(A, B, S, O, L, ROW) do { _Pragma("unroll") for (int h = 0; h < 4; ++h) { const size_t off_ = (size_t)(ROW) * DM + h * 256 + 4 * lane; \
            A[h] = *(const u32x2*)(OF + off_); B[h] = *(const u32x2*)(OB + off_); S[h] = *(const unsigned*)(SG + off_); } \
        _Pragma("unroll") for (int g = 0; g < 3; ++g) { O[g] = *(const u32x4*)(OG + (size_t)g * NTOK * DM + (size_t)(ROW) * DM + 16 * lane); L[g] = LSE[((size_t)g * NTOK + (ROW)) * 16 + head]; } } while (0)
    if (gw >= NTOK) return;
    MP_LOAD(fa, fb, sg, og, ls, gw);
#pragma unroll 1
    for (int row = gw; row < NTOK; row += NGW) {
        const int rn = row + NGW < NTOK ? row + NGW : row;
        MP_LOAD(na, nb, nsg, nog, nls, rn);
        f32x4 v[4];
#pragma unroll
        for (int h = 0; h < 4; ++h) v[h] = (f32x4){bflo(fa[h].x) + bflo(fb[h].x), bfhi(fa[h].x) + bfhi(fb[h].x), bflo(fa[h].y) + bflo(fb[h].y), bfhi(fa[h].y) + bfhi(fb[h].y)};
#pragma unroll
        for (int h = 0; h < 4; ++h) {
            const float mu = wave_sum((v[h][0] + v[h][1]) + (v[h][2] + v[h][3])) * (1.f / 256.f);
            const f32x4 d = v[h] - mu;
            const float var = wave_sum((d[0] * d[0] + d[1] * d[1]) + (d[2] * d[2] + d[3] * d[3])) * (1.f / 256.f);
            const float rs = rsqrtf(var + NORM_EPS);
            const f32x2 g01 = __builtin_amdgcn_cvt_pk_f32_fp8((int)sg[h], false), g23 = __builtin_amdgcn_cvt_pk_f32_fp8((int)sg[h], true); const float rq = rs * YD_INV;
            *(unsigned*)(RN + (size_t)row * DM + h * 256 + 4 * lane) = pk4_fp8(d[0] * rq * g01.x, d[1] * rq * g01.y, d[2] * rq * g23.x, d[3] * rq * g23.y);
        }
        const float lm = fmaxf(ls[0], fmaxf(ls[1], ls[2]));
        float wg[3]; float wsum = 0.f;
#pragma unroll
        for (int g = 0; g < 3; ++g) { wg[g] = __expf(ls[g] - lm); wsum += wg[g]; }
        const float winv = 1.f / wsum;
        unsigned res[4];
#pragma unroll
        for (int wI = 0; wI < 4; ++wI) {
            float a0 = 0.f, a1 = 0.f, a2 = 0.f, a3 = 0.f;
#pragma unroll
            for (int g = 0; g < 3; ++g) { const int wd = (int)(wI == 0 ? og[g].x : (wI == 1 ? og[g].y : (wI == 2 ? og[g].z : og[g].w)));
                const f32x2 p0 = __builtin_amdgcn_cvt_pk_f32_fp8(wd, false), p1 = __builtin_amdgcn_cvt_pk_f32_fp8(wd, true);
                a0 += wg[g] * p0.x; a1 += wg[g] * p0.y; a2 += wg[g] * p1.x; a3 += wg[g] * p1.y; }
            const float sc = winv * YD_INV;
            res[wI] = pk4_fp8(a0 * sc, a1 * sc, a2 * sc, a3 * sc);
        }
        *(u32x4*)(AC + (size_t)row * DM + 16 * lane) = (u32x4){res[0], res[1], res[2], res[3]};
#pragma unroll
        for (int h = 0; h < 4; ++h) { fa[h] = na[h]; fb[h] = nb[h]; sg[h] = nsg[h]; }
#pragma unroll
        for (int g = 0; g < 3; ++g) { og[g] = nog[g]; ls[g] = nls[g]; }
    }
#undef MP_LOAD
}

__device__ __forceinline__ void routing_rows(Frame& F, const Args& a) {
    const int gw = F.vcu * NWAVES + F.wave, NGW = F.G * NWAVES, lane = F.lane;
    const float* LOG = (const float*)(F.ws + WS_LOGIT); const float* rb = a.in[13];
    int* EIDX = (int*)(F.ws + WS_EIDX); float* GATE = (float*)(F.ws + WS_GATE);
    LAS unsigned* hist = (LAS unsigned*)(F.lds);
    for (int i = F.tid; i < NEXP; i += NTHR) hist[i] = 0u;
    __syncthreads();
    const f32x4 bias = *(const f32x4*)(rb + 4 * lane);
    for (int row = gw; row < NTOK; row += NGW) {
        const f32x4 lg = *(const f32x4*)(LOG + (size_t)row * NEXP + 4 * lane);
        float sc[4], ch[4];
#pragma unroll
        for (int i = 0; i < 4; ++i) { sc[i] = 1.f / (1.f + expf(-lg[i])); ch[i] = sc[i] + bias[i]; }
        float m1 = fmaxf(ch[0], ch[1]), m2 = fminf(ch[0], ch[1]);
        { const float c2 = ch[2]; const float n1 = fmaxf(m1, c2); m2 = fmaxf(m2, fminf(m1, c2)); m1 = n1; }
        { const float c3 = ch[3]; const float n1 = fmaxf(m1, c3); m2 = fmaxf(m2, fminf(m1, c3)); m1 = n1; }
#pragma unroll
        for (int o = 1; o < 8; o <<= 1) { const float b1 = __shfl_xor(m1, o), b2 = __shfl_xor(m2, o);
            const float n1 = fmaxf(m1, b1); const float n2 = fmaxf(fminf(m1, b1), fmaxf(m2, b2)); m1 = n1; m2 = n2; }
        const float gs = m1 + m2; const int mygrp = lane >> 3;
        int rank = 0;
#pragma unroll
        for (int g = 0; g < 8; ++g) { const float og = __shfl(gs, g * 8); rank += (og > gs || (og == gs && g < mygrp)) ? 1 : 0; }
        const bool elig = rank < 4;
        float cv[4];
#pragma unroll
        for (int i = 0; i < 4; ++i) cv[i] = elig ? ch[i] : -3.0e38f;
        float gsel = 0.f; int esel = 0; float gsum = 0.f;
#pragma unroll
        for (int k = 0; k < TOPK; ++k) {
            float bv = cv[0]; int bi = 4 * lane;
#pragma unroll
            for (int i = 1; i < 4; ++i) if (cv[i] > bv) { bv = cv[i]; bi = 4 * lane + i; }
#pragma unroll
            for (int o = 1; o < 64; o <<= 1) { const float ov = __shfl_xor(bv, o); const int oi = __shfl_xor(bi, o); if (ov > bv || (ov == bv && oi < bi)) { bv = ov; bi = oi; } }
            const int own = bi >> 2, el = bi & 3;
            const float mine = el == 0 ? sc[0] : (el == 1 ? sc[1] : (el == 2 ? sc[2] : sc[3]));
            const float s = __shfl(mine, own);
            if (lane == own) { if (el == 0) cv[0] = -3.0e38f; else if (el == 1) cv[1] = -3.0e38f; else if (el == 2) cv[2] = -3.0e38f; else cv[3] = -3.0e38f; }
            gsum += s;
            if (lane == k) { gsel = s; esel = bi; }
        }
        if (lane < TOPK) { EIDX[row * TOPK + lane] = esel; GATE[row * TOPK + lane] = gsel / gsum * 2.5f; __hip_atomic_fetch_add(&hist[esel], 1u, __ATOMIC_RELAXED, __HIP_MEMORY_SCOPE_WORKGROUP); }
    }
    __syncthreads();
    for (int i = F.tid; i < NEXP; i += NTHR) if (hist[i]) atomicAdd((unsigned*)(F.ws + WS_CTL) + CW_CNT + i, hist[i]);
}

__device__ __forceinline__ void routing_lists(Frame& F) {
    LAS unsigned* cnt = (LAS unsigned*)(F.lds);
    LAS unsigned* pstart = cnt + 256;
    LAS unsigned* lh = pstart + 264;
    LAS unsigned* lbase = lh + 256;
    LAS unsigned* ustart = lbase + 256;
    int* DPOS = (int*)(F.ws + WS_DPOS);
    unsigned* ctl = (unsigned*)(F.ws + WS_CTL);
    const int* EIDX = (const int*)(F.ws + WS_EIDX); int* ROWL = (int*)(F.ws + WS_ROWL); int* TILE_E = (int*)(F.ws + WS_TILE_E);
    for (int i = F.tid; i < NEXP; i += NTHR) { cnt[i] = __hip_atomic_load(ctl + CW_CNT + i, RLX_AGENT); lh[i] = 0u; }
    __syncthreads();
    if (F.tid == 0) { unsigned s = 0, us = 0; for (int e = 0; e < NEXP; ++e) { pstart[e] = s; ustart[e] = us; s += (cnt[e] + 255u) & ~255u; us += cnt[e]; } pstart[NEXP] = s; }
    __syncthreads();
    const unsigned ptotal = pstart[NEXP];
    const int per = (NTOK + F.G - 1) / F.G, tk0 = F.vcu * per, tk1 = (tk0 + per) < NTOK ? (tk0 + per) : NTOK;
    for (int i = tk0 * TOPK + F.tid; i < tk1 * TOPK; i += NTHR) __hip_atomic_fetch_add(&lh[EIDX[i]], 1u, __ATOMIC_RELAXED, __HIP_MEMORY_SCOPE_WORKGROUP);
    __syncthreads();
    for (int e = F.tid; e < NEXP; e += NTHR) { const unsigned c = lh[e]; lbase[e] = c ? atomicAdd(ctl + CW_FILL + e, c) : 0u; lh[e] = 0u; }
    __syncthreads();
    for (int i = tk0 * TOPK + F.tid; i < tk1 * TOPK; i += NTHR) { const int e = EIDX[i]; const unsigned p = __hip_atomic_fetch_add(&lh[e], 1u, __ATOMIC_RELAXED, __HIP_MEMORY_SCOPE_WORKGROUP);
        ROWL[pstart[e] + lbase[e] + p] = (i >> 3) * 16 + (i & 7); DPOS[i] = (int)(ustart[e] + lbase[e] + p); }
    for (int t = tk0 + F.tid; t < tk1; t += NTHR) ROWL[ptotal + t] = t * 16 + 8;
    for (int e = F.vcu; e < NEXP; e += F.G) { const unsigned s = pstart[e] + cnt[e], en = pstart[e + 1]; for (unsigned p = s + F.tid; p < en; p += NTHR) ROWL[p] = -1; }
    if (F.vcu == 0) {
        const int nrt = (int)(ptotal >> 8);
        for (int e = F.tid; e < NEXP; e += NTHR) { for (unsigned t = pstart[e] >> 8; t < (pstart[e + 1] >> 8); ++t) TILE_E[t] = e; TILE_E[4096 + e] = (int)(pstart[e] - ustart[e]); TILE_E[8192 + e] = (int)(pstart[e] + cnt[e]); }
        for (int t = F.tid; t < NTOK / 256; t += NTHR) TILE_E[nrt + t] = NEXP;
        if (F.tid == 0) { TILE_E[4096 + NEXP] = (int)ptotal - YD_SHARED0; TILE_E[8192 + NEXP] = (int)ptotal + NTOK; }
        if (F.tid == 0) TILE_E[MAX_TILES] = nrt + NTOK / 256;
    }
}

__device__ __forceinline__ void final_rows(Frame& F, const Args& a) {
    const int gw = F.vcu * NWAVES + F.wave, NGW = F.G * NWAVES, lane = F.lane;
    const float* mod = (const float*)(F.ws + WS_MOD); const float* nf = a.in[20];
    const int* DPOS = (const int*)(F.ws + WS_DPOS); const float* GATE = (const float*)(F.ws + WS_GATE);
    f32x4 g4[4];
#pragma unroll
    for (int j = 0; j < 4; ++j) g4[j] = *(const f32x4*)(nf + 4 * lane + 256 * j);
    if (gw >= NTOK) return;
    auto clampr = [&](int r) { return r < NTOK ? r : gw; };
    int dcur = DPOS[clampr(gw) * 8 + (lane & 7)]; float gcur = GATE[clampr(gw) * 8 + (lane & 7)];
    int dnxt = DPOS[clampr(gw + NGW) * 8 + (lane & 7)]; float gnxt = GATE[clampr(gw + NGW) * 8 + (lane & 7)];
    f32x4 xw[4], xn[4]; int yw[9][4], yn[9][4];
#define FIN_LOAD(XW, YW, ROW, DV) do { const u32x2* xr_ = (const u32x2*)((const bf16_t*)(F.ws + WS_X1B) + (size_t)(ROW) * DM) + lane; \
        _Pragma("unroll") for (int j = 0; j < 4; ++j) { const u32x2 t_ = xr_[64 * j]; XW[j] = (f32x4){bflo(t_.x), bfhi(t_.x), bflo(t_.y), bfhi(t_.y)}; } \
        _Pragma("unroll") for (int k = 0; k < 9; ++k) { const unsigned char* yr_ = ydense_row(F.ws, k < 8 ? __builtin_amdgcn_readlane((DV), k) : YD_SHARED0 + (ROW)) + 4 * lane; \
            _Pragma("unroll") for (int j = 0; j < 4; ++j) YW[k][j] = *(const int*)(yr_ + 256 * j); } } while (0)
    FIN_LOAD(xw, yw, gw, dcur);
#pragma unroll 1
    for (int row = gw; row < NTOK; row += NGW) {
        const int rn = clampr(row + NGW), rn2 = clampr(row + 2 * NGW);
        FIN_LOAD(xn, yn, rn, dnxt);
        const int dn2 = DPOS[rn2 * 8 + (lane & 7)]; const float gn2 = GATE[rn2 * 8 + (lane & 7)];
        const int b = row / SEQ;
        f32x4 v[4]; float s = 0.f;
#pragma unroll
        for (int j = 0; j < 4; ++j) {
            const int col = 4 * lane + 256 * j;
            f32x4 y = (f32x4){0.f, 0.f, 0.f, 0.f};
#pragma unroll
            for (int k = 0; k < 9; ++k) { const int wv = yw[k][j]; const float gk = (k < 8 ? __uint_as_float(__builtin_amdgcn_readlane(__float_as_uint(gcur), k)) : 1.0f) * YD_INV;
                const f32x2 lo = __builtin_amdgcn_cvt_pk_f32_fp8(wv, false), hi = __builtin_amdgcn_cvt_pk_f32_fp8(wv, true);
                y[0] += gk * lo.x; y[1] += gk * lo.y; y[2] += gk * hi.x; y[3] += gk * hi.y; }
            const f32x4 gf = *(const f32x4*)(mod + (size_t)b * 6144 + 5 * DM + col);
            v[j] = xw[j] + gf * y;
            s += (v[j][0] * v[j][0] + v[j][1] * v[j][1]) + (v[j][2] * v[j][2] + v[j][3] * v[j][3]);
        }
        const float rstd = rsqrtf(wave_sum(s) * (1.f / DM) + NORM_EPS);
        f32x4* xo = (f32x4*)(a.out + (size_t)row * DM) + lane;
#pragma unroll
        for (int j = 0; j < 4; ++j) xo[64 * j] = (v[j] * rstd) * g4[j];
#pragma unroll
        for (int j = 0; j < 4; ++j) xw[j] = xn[j];
#pragma unroll
        for (int k = 0; k < 9; ++k)
#pragma unroll
            for (int j = 0; j < 4; ++j) yw[k][j] = yn[k][j];
        dcur = dnxt; gcur = gnxt; dnxt = dn2; gnxt = gn2;
    }
#undef FIN_LOAD
}

constexpr int MT_OFF = 131072, MT_INFO = MT_OFF + 4096;
__device__ __forceinline__ void moe_tables_to_lds(Frame& F, int ntiles) {
    const int* TILE_E = (const int*)(F.ws + WS_TILE_E);
    LAS unsigned short* te = (LAS unsigned short*)(F.lds + MT_OFF); LAS int* info = (LAS int*)(F.lds + MT_INFO);
    for (int t = F.tid; t < ntiles; t += NTHR) te[t] = (unsigned short)TILE_E[t];
    for (int e = F.tid; e <= NEXP; e += NTHR) { info[e] = TILE_E[4096 + e]; info[512 + e] = TILE_E[8192 + e]; }
    __syncthreads();
}
constexpr int DW_STR = 192;
constexpr int DW_BUF = 256 * DW_STR;
typedef float f32x4_t __attribute__((ext_vector_type(4)));
#define MFMA16(a, b, c) __builtin_amdgcn_mfma_f32_16x16x32_bf16((a), (b), (c), 0, 0, 0)
template <int MODE> __device__ __forceinline__ void down_phase(Frame& F, const Args& a) {
    const int* TILE_E = (const int*)(F.ws + WS_TILE_E); const int ntiles = __builtin_amdgcn_readfirstlane(TILE_E[MAX_TILES]);
    moe_tables_to_lds(F, ntiles);
    const LAS unsigned short* tile_e = (const LAS unsigned short*)(F.lds + MT_OFF); const LAS int* info = (const LAS int*)(F.lds + MT_INFO);
    const int lane = F.lane, w = F.wave, fr = lane & 15, g4 = lane >> 4;
    LAS unsigned char* lds = F.lds;
    const bf16_t* HID = (const bf16_t*)(F.ws + WS_HID);
    const int sk = F.tid >> 4, sn4 = F.tid & 15;
    const int spos = 16 * (sn4 & 3) + 4 * (sn4 >> 2);
    const int q4 = (lane & 15) >> 2, p4 = lane & 3;
    auto next_tile = [&](int i) -> int { const long L = (long)i * F.G + (int)blockIdx.x; return L < ntiles ? pg8::xcd_remap((int)L, ntiles) : -1; };
    int ui = 0, tile = next_tile(0);
    if (tile < 0) return;
    f32x4_t st[8], st2[8];
    auto wd_base = [&](int t) -> const float* { const int e = MODE == 1 ? 0 : (int)tile_e[t]; return e < NEXP ? a.in[16] + (size_t)e * (EH * DM) : a.in[19]; };
#define DW_LOAD(R, WB, C) do { const float* p_ = (WB) + (size_t)sk * DM + (C) * 64 + sn4 * 4; _Pragma("unroll") for (int i = 0; i < 8; ++i) R[i] = *(const f32x4_t*)(p_ + (size_t)i * 32 * DM); } while (0)
#define DW_WRITE(R, SLOT) do { _Pragma("unroll") for (int i = 0; i < 8; ++i) { const int k_ = sk + 32 * i; u32x2 w_; w_.x = cvtpk(R[i][0], R[i][1]); w_.y = cvtpk(R[i][2], R[i][3]); \
        *(LAS u32x2*)(lds + (SLOT) * DW_BUF + k_ * DW_STR + (((spos >> 4) ^ ((k_ >> 3) & 1)) << 5) + (spos & 15) * 2) = w_; } } while (0)
    const float* wb = wd_base(tile);
    int ntile = next_tile(1);
    const float* nwb = ntile >= 0 ? wd_base(ntile) : wb;
    DW_LOAD(st, wb, 0); DW_WRITE(st, 0);
    DW_LOAD(st, wb, 1); DW_LOAD(st2, wb, 2);
    __syncthreads();
    int cc = 0;
    for (;;) {
        const int e = (int)tile_e[tile]; const int shift = info[e], lim = info[512 + e];
        bf16x8 af[2][8];
        { const bf16_t* hp = HID + ((size_t)tile * 256 + 32 * w + fr) * EH + 8 * g4;
#pragma unroll
          for (int m = 0; m < 2; ++m)
#pragma unroll
              for (int ks = 0; ks < 8; ++ks) af[m][ks] = *(const bf16x8*)(hp + (size_t)m * 16 * EH + 32 * ks);
#pragma unroll
          for (int m = 0; m < 2; ++m)
#pragma unroll
              for (int ks = 0; ks < 8; ++ks) asm volatile("" : "+v"(af[m][ks])); }
        const int pos0 = tile * 256 + 32 * w + fr;
#pragma unroll 1
        for (int c = 0; c < 16; c += 2) {
#pragma unroll
            for (int hc = 0; hc < 2; ++hc, ++cc) {
                const int cq = c + hc;
                f32x4 acc[2][4];
                if (MODE == 3) {
#pragma unroll
                    for (int m = 0; m < 2; ++m)
#pragma unroll
                        for (int nf = 0; nf < 4; ++nf) acc[m][nf] = (f32x4){0.f, 0.f, 0.f, 0.f}; }
                LAS unsigned char* bb = lds + (cc & 1) * DW_BUF + (8 * g4 + q4) * DW_STR + 8 * p4;
#pragma unroll 1
                for (int rp_ = 0; rp_ < (MODE == 3 ? a.pad : (PROBE_PHASE == 40 ? 2 + a.pad : 1)); ++rp_) {
#pragma unroll
                for (int m = 0; m < 2; ++m)
#pragma unroll
                    for (int nf = 0; nf < 4; ++nf) acc[m][nf] = (f32x4){0.f, 0.f, 0.f, 0.f};
#pragma unroll
                for (int ks = 0; ks < 8; ++ks) {
#pragma unroll
                    for (int nf = 0; nf < 4; ++nf) {
                        LAS unsigned char* pp = bb + ks * (32 * DW_STR) + ((nf ^ (g4 & 1)) << 5);
                        const s16x4 lo = tr_read(pp), hi = tr_read(pp + 4 * DW_STR);
                        const bf16x8 bf = __builtin_shufflevector(lo, hi, 0, 1, 2, 3, 4, 5, 6, 7);
                        acc[0][nf] = MFMA16(bf, af[0][ks], acc[0][nf]); acc[1][nf] = MFMA16(bf, af[1][ks], acc[1][nf]);
                    }
                }
                }
                u32x4 ow[2];
#pragma unroll
                for (int m = 0; m < 2; ++m) { ow[m].x = pk4_fp8(acc[m][0][0], acc[m][0][1], acc[m][0][2], acc[m][0][3]); ow[m].y = pk4_fp8(acc[m][1][0], acc[m][1][1], acc[m][1][2], acc[m][1][3]);
                    ow[m].z = pk4_fp8(acc[m][2][0], acc[m][2][1], acc[m][2][2], acc[m][2][3]); ow[m].w = pk4_fp8(acc[m][3][0], acc[m][3][1], acc[m][3][2], acc[m][3][3]); }
                const int c3 = cq + 3; const float* b3 = c3 < 16 ? wb : nwb; const int k3 = c3 < 16 ? c3 : c3 - 16;
                if (hc == 0) { DW_WRITE(st, (cc + 1) & 1); DW_LOAD(st, b3, k3); } else { DW_WRITE(st2, (cc + 1) & 1); DW_LOAD(st2, b3, k3); }
#pragma unroll
                for (int m = 0; m < 2; ++m) {
                    const int pos = pos0 + 16 * m;
                    unsigned char* rowp = (pos < lim ? ydense_row(F.ws, pos - shift) : F.ws + WS_SS + (size_t)blockIdx.x * 2048) + 64 * cq + 16 * g4;
                    if (MODE >= 2) asm volatile("" :: "v"(ow[m])); else *(u32x4*)rowp = ow[m];
                }
                __syncthreads();
            }
        }
        if (ntile < 0) break;
        tile = ntile; wb = nwb; ++ui;
        ntile = next_tile(ui + 1); nwb = ntile >= 0 ? wd_base(ntile) : wb;
    }
#undef DW_LOAD
#undef DW_WRITE
}

constexpr int N_PHASES = 13;
__global__ void __launch_bounds__(NTHR, 2) fwd_kernel(Args args) {
    extern __shared__ __attribute__((aligned(16))) unsigned char lds_raw[];
    Frame F;
    F.lds = (LAS unsigned char*)lds_raw; F.ws = args.ws;
    F.tid = threadIdx.x; F.lane = F.tid & 63; F.wave = __builtin_amdgcn_readfirstlane(F.tid >> 6);
    F.G = gridDim.x; { const int bx = blockIdx.x; F.vcu = (F.G % 8 == 0) ? (bx % 8) * (F.G / 8) + bx / 8 : bx; }
    volatile LAS unsigned* MISC = (volatile LAS unsigned*)(F.lds + MISC_OFF);
    for (int u = F.tid; u < (LDS_BYTES - LDSCTL_OFF) / 4; u += NTHR) ((LAS unsigned*)(F.lds + LDSCTL_OFF))[u] = 0u;
    __syncthreads();
    unsigned* ctl = (unsigned*)(F.ws + WS_CTL);
    XcdBarrier bar; bar.bar = ctl + CW_BAR; bar.x = 0; bar.st = nullptr;
    const int lo = args.ph_lo, hi = args.ph_hi;
    if (hi - lo > 1) bar = xcd_barrier_post(ctl + CW_BAR, MISC + 8);
#ifdef ONLY_PHASE
#define IN(k) ((k) == ONLY_PHASE && lo <= (k) && (k) < hi)
#else
#define IN(k) (lo <= (k) && (k) < hi)
#endif
#define SEAM(k) do { if (IN(k) && IN((k) + 1)) xcd_barrier(bar); } while (0)
#ifndef PROBE_PHASE
#define PROBE_PHASE -1
#endif
#define REP(k) _Pragma("unroll 1") for (int rep_ = 0; rep_ < ((k) == PROBE_PHASE ? 2 + args.pad : 1); ++rep_)
    const float* mod = (const float*)(F.ws + WS_MOD);
    bf16_t* HB = (bf16_t*)(F.ws + WS_H);

    if (IN(0)) REP(0) { phase0(F, args); } SEAM(0);
    if (IN(1)) REP(1) { norm_mod_rows<false, 1>(F, args.in[0], args.in[4], mod, 0, DM, nullptr, HB, F.ws + WS_H8); } SEAM(1);
    if (IN(2)) REP(2) {
        EpiInProj E{F.ws, (const float*)(F.ws + WS_ROPE_C), (const float*)(F.ws + WS_ROPE_S)};
        { pg8::StaticOrder S; S.init((const bf16_t*)(F.ws + WS_H8), (const bf16_t*)(F.ws + WS_WIN), NTOK, PROJW - 3 * DM, DM / 2, F.G, (int)blockIdx.x, 12);
          pg8::gemm_phase<EpiInProj, pg8::StaticOrder, true, true>(F.lds, S, E); }
        { pg8::StaticOrder S; S.init((const bf16_t*)(F.ws + WS_H8), (const bf16_t*)(F.ws + WS_WIN), NTOK, 3 * DM, DM / 2, F.G, (int)blockIdx.x, 0);
          pg8::gemm_phase<EpiInProj, pg8::StaticOrder, true, true>(F.lds, S, E); }
    } SEAM(2);
    if (IN(3)) {
#ifndef NO_RET
        REP(30) for (int ch = F.vcu; ch < 256; ch += F.G) retention_chain_rs(F, args, ch);
#endif
#ifndef NO_ATT
        const int per = (6144 + F.G - 1) / F.G;
        attention_phase(F, F.vcu * per, (F.vcu + 1) * per < 6144 ? (F.vcu + 1) * per : 6144, args.pad);
#endif
    } SEAM(3);
    if (IN(4)) REP(4) { mixer_post_rows(F); } SEAM(4);
    if (IN(5)) REP(5) {
        pg8::DualOrder S; S.so.init((const bf16_t*)(F.ws + WS_RETN), (const bf16_t*)(F.ws + WS_WRU), NTOK, DM, DM / 2, F.G, (int)blockIdx.x);
        S.A1 = (const bf16_t*)(F.ws + WS_ATTC); S.Bt1 = (const bf16_t*)(F.ws + WS_WAU); S.K = DM / 2;
        EpiMerge E{F.ws + WS_MERGED, F.ws + WS_SGR, F.ws + WS_SGA};
        pg8::gemm_phase<EpiMerge, pg8::DualOrder, true, true>(F.lds, S, E);
    } SEAM(5);
    if (IN(6)) REP(6) {
        pg8::StaticOrder S; S.init((const bf16_t*)(F.ws + WS_MERGED), (const bf16_t*)(F.ws + WS_WO), NTOK, DM, DM / 2, F.G, (int)blockIdx.x);
        EpiOProj E{args.in[0], (bf16_t*)(F.ws + WS_X1B), mod, (float*)(F.ws + WS_SS)};
        pg8::gemm_phase<EpiOProj, pg8::StaticOrder, true, true>(F.lds, S, E);
    } SEAM(6);
    if (IN(7)) REP(7) {
        norm_mod_rows<true, 2>(F, F.ws + WS_X1B, args.in[11], mod, 3 * DM, 4 * DM, (const float*)(F.ws + WS_SS), HB, F.ws + WS_H8B);
        if (F.vcu == 0 && F.tid < 256) ((unsigned*)(F.ws + WS_H8B + (size_t)NTOK * DM))[F.tid] = 0u;
    } SEAM(7);
    if (IN(8)) {
        pg8::StaticOrder S; S.init(HB, (const bf16_t*)(F.ws + WS_WR), NTOK, NEXP, DM, F.G, (int)blockIdx.x);
        EpiF32 E{(float*)(F.ws + WS_LOGIT), NEXP};
        pg8::gemm_phase<EpiF32, pg8::StaticOrder, true>(F.lds, S, E);
        __syncthreads();
        moe_weight_convert(F, args);
    } SEAM(8);
    if (IN(9)) { routing_rows(F, args); } SEAM(9);
    if (IN(10)) { routing_lists(F); } SEAM(10);
    if (IN(11)) REP(11) {
        const int* TILE_E = (const int*)(F.ws + WS_TILE_E); const int ntiles = __builtin_amdgcn_readfirstlane(TILE_E[MAX_TILES]);
        pg8::MoeOrder<true> S; S.A = (const bf16_t*)(F.ws + WS_H8B); S.Bt = (const bf16_t*)(F.ws + WS_WGU); S.K = DM / 2; S.e_stride = (size_t)512 * 512; S.tile_e = (const LAS unsigned short*)(F.lds + MT_OFF); S.rowlist = (const int*)(F.ws + WS_ROWL); moe_tables_to_lds(F, ntiles);
        S.ntiles = ntiles; S.nN = 2; S.nwg = ntiles * 2; S.G = F.G; S.c = (int)blockIdx.x;
        EpiGU E{(bf16_t*)(F.ws + WS_HID)};
        pg8::gemm_phase<EpiGU, pg8::MoeOrder<true>, true, true>(F.lds, S, E);
    } SEAM(11);
    if (IN(12)) REP(12) {
        down_phase<0>(F, args);
    } SEAM(12);
    if (IN(13)) { final_rows(F, args); }
#if PROBE_LAUNCH == 14
    if (lo == 14) {
        pg8::StaticOrder S; S.init(HB, (const bf16_t*)(F.ws + WS_WIN), NTOK, PROJW, DM, F.G, (int)blockIdx.x);
        EpiNull E{};
        pg8::gemm_phase<EpiNull, pg8::StaticOrder, true>(F.lds, S, E);
    }
#endif
#if PROBE_LAUNCH == 16
    if (lo == 14) {
        const int* TILE_E = (const int*)(F.ws + WS_TILE_E); const int ntiles = __builtin_amdgcn_readfirstlane(TILE_E[MAX_TILES]);
        pg8::MoeOrder<false> S; S.A = (const bf16_t*)(F.ws + WS_HID); S.Bt = (const bf16_t*)(F.ws + WS_WD); S.K = EH; S.e_stride = (size_t)1024 * 256; S.tile_e = (const LAS unsigned short*)(F.lds + MT_OFF); S.rowlist = (const int*)(F.ws + WS_ROWL); moe_tables_to_lds(F, ntiles);
        S.ntiles = ntiles; S.nN = 4; S.nwg = ntiles * 4; S.G = F.G; S.c = (int)blockIdx.x;
        EpiNull E{};
        pg8::gemm_phase<EpiNull, pg8::MoeOrder<false>, true>(F.lds, S, E);
    }
#endif
#if PROBE_LAUNCH == 18
    if (lo == 14) { down_phase<1>(F, args); }
#endif
#if PROBE_LAUNCH == 19
    if (lo == 14) { down_phase<2>(F, args); }
#endif
#if PROBE_LAUNCH == 20
    if (lo == 14) { down_phase<3>(F, args); }
#endif
#if PROBE_LAUNCH == 17
    if (lo == 14) {
        const int* TILE_E = (const int*)(F.ws + WS_TILE_E); const int ntiles = __builtin_amdgcn_readfirstlane(TILE_E[MAX_TILES]);
        pg8::MoeOrder<false> S; S.A = (const bf16_t*)(F.ws + WS_HID); S.Bt = (const bf16_t*)(F.ws + WS_WD); S.K = EH; S.e_stride = (size_t)1024 * 256; S.tile_e = (const LAS unsigned short*)(F.lds + MT_OFF); S.rowlist = (const int*)(F.ws + WS_ROWL); moe_tables_to_lds(F, ntiles);
        S.ntiles = ntiles; S.nN = 4; S.nwg = ntiles * 4; S.G = F.G; S.c = (int)blockIdx.x;
        EpiDownT<1> E{F.ws, (const LAS int*)(F.lds + MT_INFO)};
        pg8::gemm_phase<EpiDownT<1>, pg8::MoeOrder<false>, true>(F.lds, S, E);
    }
#endif
#if PROBE_LAUNCH == 15
    if (lo == 14) {
        pg8::StaticOrder S; S.init(HB, (const bf16_t*)(F.ws + WS_WIN), NTOK, PROJW, DM, F.G, (int)blockIdx.x);
        EpiPlainScratch E{(bf16_t*)(F.ws + WS_OUTF)};
        pg8::gemm_phase<EpiPlainScratch, pg8::StaticOrder, true>(F.lds, S, E);
    }
#endif
#undef IN
#undef SEAM
}

extern "C" void kernel_launch(void* const* d_in, const int* in_sizes, int n_in, void* d_out, int out_size, void* d_ws, size_t ws_size, hipStream_t stream) {
    static int grid = 0;
    if (grid == 0) {
        if (n_in != 21 || out_size != NTOK * DM || ws_size < WS_END) { fprintf(stderr, "kernel_launch: unexpected shapes (n_in %d out %d ws %zu)\n", n_in, out_size, ws_size); grid = -1; return; }
        int dev = 0, cus = 0, per_cu = 0;
        if (hipGetDevice(&dev) != hipSuccess || hipDeviceGetAttribute(&cus, hipDeviceAttributeMultiprocessorCount, dev) != hipSuccess) { grid = -1; return; }
        if (hipFuncSetAttribute((const void*)fwd_kernel, hipFuncAttributeMaxDynamicSharedMemorySize, LDS_BYTES) != hipSuccess) { fprintf(stderr, "kernel_launch: hipFuncSetAttribute failed\n"); grid = -1; return; }
        if (hipOccupancyMaxActiveBlocksPerMultiprocessor(&per_cu, (const void*)fwd_kernel, NTHR, LDS_BYTES) != hipSuccess || per_cu < 1)
            fprintf(stderr, "kernel_launch: note: occupancy query reports %d\n", per_cu);
        (void)hipGetLastError();
        grid = cus;
    }
    if (grid < 0) return;
    (void)hipMemsetAsync((char*)d_ws + WS_CTL, 0, CTL_ZERO_BYTES, stream);
    Args a{};
    for (int i = 0; i < 21; ++i) a.in[i] = (const float*)d_in[i];
    a.out = (float*)d_out; a.ws = (unsigned char*)d_ws;
#if MK_N_LAUNCHES == 1
    a.ph_lo = 0; a.ph_hi = N_PHASES + 1; a.li = 0;
    hipLaunchKernelGGL(fwd_kernel, dim3(grid), dim3(NTHR), LDS_BYTES, stream, a);
#else
    for (int p = 0; p <= N_PHASES; ++p) {
        if ((PROBE_LAUNCH == 18 || PROBE_LAUNCH == 19 || PROBE_LAUNCH == 20) && p == 12) { a.ph_lo = 14; a.ph_hi = 15; hipLaunchKernelGGL(fwd_kernel, dim3(grid), dim3(NTHR), LDS_BYTES, stream, a); }
        a.ph_lo = p; a.ph_hi = p + 1; a.li = p; hipLaunchKernelGGL(fwd_kernel, dim3(grid), dim3(NTHR), LDS_BYTES, stream, a);
        if (p == PROBE_LAUNCH) hipLaunchKernelGGL(fwd_kernel, dim3(grid), dim3(NTHR), LDS_BYTES, stream, a);
        if (((PROBE_LAUNCH == 14 || PROBE_LAUNCH == 15) && p == 2) || ((PROBE_LAUNCH == 16 || PROBE_LAUNCH == 17) && p == 12)) { a.ph_lo = 14; a.ph_hi = 15; hipLaunchKernelGGL(fwd_kernel, dim3(grid), dim3(NTHR), LDS_BYTES, stream, a); } }
#endif
}
```

```cpp
#include <hip/hip_runtime.h>
#include <cstdio>
#include <cstdint>

#ifndef MK_N_LAUNCHES
#define MK_N_LAUNCHES 1
#endif
#define PROBE_LAUNCH -1
#ifndef PROBE_PHASE
#define PROBE_PHASE -1
#endif

#define LAS __attribute__((address_space(3)))
#define GAS __attribute__((address_space(1)))
typedef unsigned short bf16_t;
typedef short bf16x8 __attribute__((ext_vector_type(8)));
typedef short s16x4 __attribute__((ext_vector_type(4)));
typedef float f32x2 __attribute__((ext_vector_type(2)));
typedef float f32x4 __attribute__((ext_vector_type(4)));
typedef float f32x16 __attribute__((ext_vector_type(16)));
typedef unsigned u32x2 __attribute__((ext_vector_type(2)));
typedef unsigned u32x4 __attribute__((ext_vector_type(4)));
typedef int i32x4 __attribute__((ext_vector_type(4)));
typedef __bf16 bf16x2_t __attribute__((ext_vector_type(2)));

constexpr int NB = 8, SEQ = 4096, DM = 1024, NTOK = NB * SEQ;
constexpr int PROJW = 9216, NEXP = 256, TOPK = 8, EH = 256;
constexpr float NORM_EPS = 1e-6f;

constexpr size_t MiB = 1u << 20;
constexpr size_t WS_CTL = 0, CTL_ZERO_BYTES = 1 * MiB;
constexpr size_t WS_MOD = 1 * MiB;
constexpr size_t WS_BTAB = 1 * MiB + 256 * 1024;
constexpr size_t WS_ROPE_C = 2 * MiB;
constexpr size_t WS_SS = 6 * MiB;
constexpr size_t WS_EIDX = 8 * MiB, WS_GATE = 9 * MiB;
constexpr size_t WS_ROWL = 10 * MiB;
constexpr size_t WS_TILE_E = 12 * MiB;
constexpr size_t WS_WIN = 16 * MiB, WS_WRU = 34 * MiB, WS_WAU = 36 * MiB, WS_WO = 38 * MiB, WS_WR = 40 * MiB;
constexpr size_t WS_H = 48 * MiB;
constexpr size_t WS_PROJ = 120 * MiB;
constexpr size_t SEG = 64 * MiB;
constexpr size_t WS_RQ = WS_PROJ, WS_RK = WS_PROJ + SEG, WS_RV = WS_PROJ + 2 * SEG, WS_RG = WS_PROJ + 3 * SEG, WS_AQ = WS_PROJ + 4 * SEG,
                 WS_AK = WS_PROJ + 5 * SEG, WS_AV = WS_PROJ + 6 * SEG, WS_SGR = WS_PROJ + 7 * SEG, WS_SGA = WS_PROJ + 8 * SEG;
constexpr size_t WS_OUTF = 696 * MiB, WS_OUTB = 760 * MiB, WS_OG = 824 * MiB, WS_LSE = 1016 * MiB;
constexpr size_t WS_RETN = WS_RQ, WS_ATTC = WS_RK, WS_YR = WS_RV, WS_MERGED = WS_AQ;
constexpr size_t WS_WGU = 120 * MiB, WS_WD = 377 * MiB, WS_HID = 512 * MiB, WS_LOGIT = 696 * MiB;
constexpr size_t WS_H8 = 48 * MiB, WS_H8B = 384 * MiB;
constexpr size_t WS_X1B = 448 * MiB;
constexpr size_t WS_END = 1022 * MiB;
constexpr int YD_SPLIT = 262144, YD_SHARED0 = NTOK * TOPK;
constexpr float YD_SCALE = 16.0f, YD_INV = 0.0625f;
__device__ __forceinline__ unsigned char* ydense_row(unsigned char* ws, int row) { return ws + (row < YD_SPLIT ? 120 * MiB : 696 * MiB) + (size_t)(row < YD_SPLIT ? row : row - YD_SPLIT) * DM; }
__device__ __forceinline__ unsigned pk4_fp8(float a, float b, float c, float d) {
    a = __builtin_fminf(__builtin_fmaxf(a * YD_SCALE, -448.f), 448.f); b = __builtin_fminf(__builtin_fmaxf(b * YD_SCALE, -448.f), 448.f);
    c = __builtin_fminf(__builtin_fmaxf(c * YD_SCALE, -448.f), 448.f); d = __builtin_fminf(__builtin_fmaxf(d * YD_SCALE, -448.f), 448.f);
    int w = __builtin_amdgcn_cvt_pk_fp8_f32(a, b, 0, false); w = __builtin_amdgcn_cvt_pk_fp8_f32(c, d, w, true); return (unsigned)w;
}
constexpr float W8_SCALE = 256.0f, FP8_UNSCALE = 1.0f / 4096.0f;
__device__ __forceinline__ unsigned pk4_fp8w(float a, float b, float c, float d) {
    a = __builtin_fminf(__builtin_fmaxf(a * W8_SCALE, -448.f), 448.f); b = __builtin_fminf(__builtin_fmaxf(b * W8_SCALE, -448.f), 448.f);
    c = __builtin_fminf(__builtin_fmaxf(c * W8_SCALE, -448.f), 448.f); d = __builtin_fminf(__builtin_fmaxf(d * W8_SCALE, -448.f), 448.f);
    int w = __builtin_amdgcn_cvt_pk_fp8_f32(a, b, 0, false); w = __builtin_amdgcn_cvt_pk_fp8_f32(c, d, w, true); return (unsigned)w;
}
__device__ __forceinline__ unsigned pk4_fp8_clamped(float a, float b, float c, float d) {
    a = __builtin_amdgcn_fmed3f(a, -448.f, 448.f); b = __builtin_amdgcn_fmed3f(b, -448.f, 448.f); c = __builtin_amdgcn_fmed3f(c, -448.f, 448.f); d = __builtin_amdgcn_fmed3f(d, -448.f, 448.f);
    int w = __builtin_amdgcn_cvt_pk_fp8_f32(a, b, 0, false); w = __builtin_amdgcn_cvt_pk_fp8_f32(c, d, w, true); return (unsigned)w;
}
__device__ __forceinline__ unsigned pk4_fp8_noclamp(float a, float b, float c, float d) {
    int w = __builtin_amdgcn_cvt_pk_fp8_f32(a, b, 0, false); w = __builtin_amdgcn_cvt_pk_fp8_f32(c, d, w, true); return (unsigned)w;
}
constexpr size_t WS_DPOS = 13 * MiB;
constexpr int CW_TMO = 0, CW_BAR = 4096, CW_CNT = 16384, CW_FILL = 16384 + 1024;
constexpr int MAX_TILES = 2048;

__device__ __forceinline__ unsigned cvtpk(float lo, float hi) { f32x2 v = {lo, hi}; bf16x2_t b = __builtin_convertvector(v, bf16x2_t); return __builtin_bit_cast(unsigned, b); }
__device__ __forceinline__ float bf2f(unsigned short u) { return __uint_as_float((unsigned)u << 16); }
__device__ __forceinline__ float bflo(unsigned u) { return __uint_as_float(u << 16); }
__device__ __forceinline__ float bfhi(unsigned u) { return __uint_as_float(u & 0xffff0000u); }
__device__ __forceinline__ float wave_sum(float v) {
#pragma unroll
    for (int o = 1; o < 64; o <<= 1) v += __shfl_xor(v, o);
    return v;
}
__device__ __forceinline__ float sigmoidf_(float x) { return __builtin_amdgcn_rcpf(1.f + __builtin_amdgcn_exp2f(x * -1.4426950408889634f)); }
__device__ __forceinline__ float siluf_(float x) { return x * __builtin_amdgcn_rcpf(1.f + __builtin_amdgcn_exp2f(x * -1.4426950408889634f)); }

namespace pg8 {
constexpr int BM = 256, BK = 64, HALF = 128, HTB = HALF * BK * 2, STAGE_BYTES = 8 * HTB, NXCD = 8, WGM = 8;
__host__ __device__ __forceinline__ int lds_byte(int r, int c) { const int st = (r >> 4) * 2 + (c >> 5), rr = r & 15, cc = c & 31, ob = rr * 64 + cc * 2; return st * 1024 + (ob ^ (((ob >> 9) & 1) << 5)); }
__host__ __device__ __forceinline__ void stage_rc(int b, int& R, int& C) { const int st = b / 1024, sb = b % 1024, swz = sb ^ (((sb >> 9) & 1) << 5); R = (st >> 1) * 16 + swz / 64; C = (st & 1) * 32 + (swz % 64) / 2; }
__host__ __device__ __forceinline__ int perm32(int rho) { const int n = rho >> 4, i = rho & 15; return 8 * (i >> 2) + 4 * n + (i & 3); }

struct Unit { int pm, pn, e; };

__device__ __forceinline__ int xcd_remap(int L, int nwg) { const int q = nwg / NXCD, r = nwg % NXCD, xcd = L % NXCD, off = L / NXCD; return (xcd < r ? xcd * (q + 1) : r * (q + 1) + (xcd - r) * q) + off; }

struct StaticOrder {
    static constexpr bool GATHER = false, DUAL = false, B_IMG = false;
    const bf16_t* A; const bf16_t* Bt; int K;
    int nM, nN, nwg, G, c, pn_off;
    __device__ void init(const bf16_t* A_, const bf16_t* Bt_, int M, int N, int K_, int G_, int c_, int pn_off_ = 0) { A = A_; Bt = Bt_; K = K_; nM = M / BM; nN = N / BM; nwg = nM * nN; G = G_; c = c_; pn_off = pn_off_; }
    __device__ bool next(int i, Unit& u) const {
        const long L = (long)i * G + c; if (L >= nwg) return false;
        const int wgid = xcd_remap((int)L, nwg);
        const int nig = WGM * nN, gid = wgid / nig, fm = gid * WGM, gsz = (nM - fm) < WGM ? (nM - fm) : WGM;
        u.pm = fm + ((wgid % nig) % gsz); u.pn = (wgid % nig) / gsz + pn_off; u.e = 0; return true;
    }
    __device__ __forceinline__ const char* a_base(const Unit& u) const { return (const char*)A + (size_t)u.pm * (size_t)(BM * 2) * K; }
    __device__ __forceinline__ const char* b_base(const Unit& u) const { return (const char*)Bt + (size_t)u.pn * (size_t)(BM * 2) * K; }
    __device__ __forceinline__ unsigned a_row(const Unit&, int) const { return 0u; }
};

struct DualOrder {
    static constexpr bool GATHER = false, DUAL = true, B_IMG = false;
    StaticOrder so; const bf16_t* A1; const bf16_t* Bt1; int K;
    __device__ bool next(int i, Unit& u) const { if (!so.next(i >> 1, u)) return false; u.e = i & 1; return true; }
    __device__ __forceinline__ const char* a_base(const Unit& u) const { return (const char*)(u.e ? A1 : so.A) + (size_t)u.pm * (size_t)(BM * 2) * K; }
    __device__ __forceinline__ const char* b_base(const Unit& u) const { return (const char*)(u.e ? Bt1 : so.Bt) + (size_t)u.pn * (size_t)(BM * 2) * K; }
    __device__ __forceinline__ unsigned a_row(const Unit&, int) const { return 0u; }
};

template <bool GATHER_, bool B_IMG_ = false>
struct MoeOrder {
    static constexpr bool GATHER = GATHER_, DUAL = false, B_IMG = B_IMG_;
    const bf16_t* A; const bf16_t* Bt; int K; size_t e_stride;
    const LAS unsigned short* tile_e; const int* rowlist; int ntiles, nN, nwg, G, c;
    __device__ bool next(int i, Unit& u) const {
        const long L = (long)i * G + c; if (L >= nwg) return false;
        const int wgid = xcd_remap((int)L, nwg);
        u.pm = wgid / nN; u.pn = wgid % nN; u.e = __builtin_amdgcn_readfirstlane((int)tile_e[u.pm]); return true;
    }
    __device__ __forceinline__ const char* a_base(const Unit& u) const { return GATHER ? (const char*)A : (const char*)A + (size_t)u.pm * (size_t)(BM * 2) * K; }
    __device__ __forceinline__ const char* b_base(const Unit& u) const { return B_IMG ? (const char*)Bt + (size_t)u.e * e_stride + (size_t)u.pn * (size_t)(BM * 2) * K : (const char*)Bt + ((size_t)u.e * e_stride + (size_t)u.pn * BM * K) * 2; }
    __device__ __forceinline__ unsigned a_row(const Unit& u, int r) const { const int ent = rowlist[(size_t)u.pm * BM + r]; return ent < 0 ? (unsigned)NTOK : (unsigned)(ent >> 4); }
};

template <class Epi, class Sched, bool ALIGN_EPI, bool FP8 = false>
__device__ __forceinline__ void gemm_phase(LAS unsigned char* lds, const Sched& S, const Epi& E) {
    const int tid = threadIdx.x, wid = __builtin_amdgcn_readfirstlane(tid >> 6), lane = tid & 63, wr = wid >> 2, wc = wid & 3, fr = lane & 15, fq = lane >> 4;
    const int K = S.K, nt = K / BK;
    unsigned voffA[2], voffB[2]; int RA[2]; unsigned CA2[2];
#pragma unroll
    for (int i = 0; i < 2; ++i) { int R, C; stage_rc(tid * 16 + i * 8192, R, C); const int Rb = Epi::PERM ? ((R & ~31) + perm32(R & 31)) : R;
        voffA[i] = (unsigned)(R * K + C) * 2u; voffB[i] = Sched::B_IMG ? (unsigned)(tid * 16 + i * 8192) : (unsigned)(Rb * K + C) * 2u; RA[i] = R; CA2[i] = (unsigned)C * 2u; }
    const size_t kstep = (size_t)(BK * 2);
    const size_t hstep = (size_t)HALF * K * 2;
    const size_t bk = Sched::B_IMG ? (size_t)32768 : kstep, bh = Sched::B_IMG ? (size_t)16384 : hstep;
    const unsigned ldsw = (unsigned)wid * 1024u;
    const int aoff = lds_byte(wr * 64 + fr, fq * 8), boff = lds_byte(wc * 32 + fr, fq * 8);
    unsigned gC[2][2], gN[2][2];
#define PG8_SA(b, h) (((b) * 2 + (h)) * HTB)
#define PG8_SB(b, h) ((4 + (b) * 2 + (h)) * HTB)
#define PG8_STAGE(bufoff, gbase, voff) do { _Pragma("unroll") for (int _i = 0; _i < 2; ++_i) \
        __builtin_amdgcn_global_load_lds((const unsigned*)((const char*)(gbase) + (voff)[_i]), (LAS unsigned*)(lds + (bufoff) + ldsw + _i * 8192), 16, 0, 0); } while (0)
#define PG8_STAGE_A(bufoff, p, h, NX) do { if constexpr (Sched::GATHER) { _Pragma("unroll") for (int _i = 0; _i < 2; ++_i) { const unsigned _v = (NX) ? gN[h][_i] : gC[h][_i]; \
        __builtin_amdgcn_global_load_lds((const unsigned*)((const char*)(p) + _v), (LAS unsigned*)(lds + (bufoff) + ldsw + _i * 8192), 16, 0, 0); } } \
        else { PG8_STAGE(bufoff, (p) + (h) * hstep, voffA); } } while (0)
#define PG8_GATHER_SET(g, u) do { _Pragma("unroll") for (int _h = 0; _h < 2; ++_h) _Pragma("unroll") for (int _i = 0; _i < 2; ++_i) \
        g[_h][_i] = S.a_row(u, _h * HALF + RA[_i]) * (unsigned)(K * 2) + CA2[_i]; } while (0)
#define PG8_LDA(dst, b, h) do { _Pragma("unroll") for (int m = 0; m < 4; ++m) _Pragma("unroll") for (int k = 0; k < 2; ++k) dst[m][k] = *(const LAS bf16x8*)(lds + PG8_SA(b, h) + aoff + m * 2048 + k * 1024); } while (0)
#define PG8_LDB(dst, b, h) do { _Pragma("unroll") for (int n = 0; n < 2; ++n) _Pragma("unroll") for (int k = 0; k < 2; ++k) dst[n][k] = *(const LAS bf16x8*)(lds + PG8_SB(b, h) + boff + n * 2048 + k * 1024); } while (0)
#define PG8_CAT(x0, x1) __builtin_shufflevector(__builtin_bit_cast(i32x4, x0), __builtin_bit_cast(i32x4, x1), 0, 1, 2, 3, 4, 5, 6, 7)
#define PG8_MMA(ai, bj, At, Bt) do { __builtin_amdgcn_s_setprio(1); if constexpr (FP8) { _Pragma("unroll") for (int m = 0; m < 4; ++m) _Pragma("unroll") for (int n = 0; n < 2; ++n) \
        asm volatile("v_mfma_f32_16x16x128_f8f6f4 %0, %1, %2, %0" : "+v"(acc[ai][bj][m][n]) : "v"(PG8_CAT(Bt[n][0], Bt[n][1])), "v"(PG8_CAT(At[m][0], At[m][1]))); } else { \
        _Pragma("unroll") for (int m = 0; m < 4; ++m) _Pragma("unroll") for (int n = 0; n < 2; ++n) _Pragma("unroll") for (int k = 0; k < 2; ++k) \
        acc[ai][bj][m][n] = __builtin_amdgcn_mfma_f32_16x16x32_bf16(Bt[n][k], At[m][k], acc[ai][bj][m][n], 0, 0, 0); } __builtin_amdgcn_s_setprio(0); } while (0)
#define PG8_WAIT_V(n) asm volatile("s_waitcnt vmcnt(" #n ")" ::: "memory")
#define PG8_WAIT_L(n) asm volatile("s_waitcnt lgkmcnt(" #n ")" ::: "memory")
#define PG8_BAR __builtin_amdgcn_s_barrier()
#define PG8_SCHED __builtin_amdgcn_sched_barrier(0)
    Unit cur, nxt; int ui = 0;
    if (!S.next(0, cur)) return;
    f32x4 acc[2][2][4][2];
#pragma unroll
    for (int a = 0; a < 2; ++a)
#pragma unroll
        for (int b = 0; b < 2; ++b)
#pragma unroll
            for (int m = 0; m < 4; ++m)
#pragma unroll
                for (int n = 0; n < 2; ++n) acc[a][b][m][n] = (f32x4){0.f, 0.f, 0.f, 0.f};
    bf16x8 At[4][2], B0[2][2], B1[2][2];
    const char* cA = S.a_base(cur); const char* cB = S.b_base(cur);
    if constexpr (Sched::GATHER) { PG8_GATHER_SET(gC, cur); PG8_GATHER_SET(gN, cur); }
    PG8_STAGE(PG8_SB(0, 0), cB, voffB); PG8_STAGE(PG8_SB(0, 1), cB + bh, voffB); PG8_STAGE_A(PG8_SA(0, 0), cA, 0, false); PG8_STAGE_A(PG8_SA(0, 1), cA, 1, false);
    if (wr == 1) PG8_BAR;
    PG8_WAIT_V(2); PG8_BAR;
    PG8_STAGE(PG8_SB(1, 0), cB + bk, voffB); PG8_STAGE_A(PG8_SA(1, 0), cA + kstep, 0, false); PG8_STAGE(PG8_SB(1, 1), cB + bh + bk, voffB);
    PG8_WAIT_V(6); PG8_BAR;
    for (;;) {
        const bool has_next = S.next(ui + 1, nxt);
        const char* nA = has_next ? S.a_base(nxt) : cA; const char* nB = has_next ? S.b_base(nxt) : cB;
        if constexpr (Sched::GATHER) { if (has_next) { PG8_GATHER_SET(gN, nxt); } }
        for (int t = 0; t < nt; t += 2) {
            const bool last = (t == nt - 2);
            const char* a1 = cA + (size_t)(t + 1) * kstep;
            const char* a2 = last ? nA : cA + (size_t)(t + 2) * kstep; const char* b2 = last ? nB : cB + (size_t)(t + 2) * bk;
            const char* a3 = a2 + kstep; const char* b3 = b2 + bk;
            PG8_LDB(B0, 0, 0); PG8_LDB(B1, 0, 1); PG8_SCHED; PG8_LDA(At, 0, 0); PG8_STAGE_A(PG8_SA(1, 1), a1, 1, false);
            PG8_WAIT_V(8); PG8_WAIT_L(0); PG8_BAR; PG8_MMA(0, 0, At, B0); PG8_MMA(0, 1, At, B1); PG8_BAR; PG8_SCHED;
            PG8_LDA(At, 0, 1); PG8_STAGE(PG8_SB(0, 0), b2, voffB); PG8_STAGE(PG8_SB(0, 1), b2 + bh, voffB); PG8_STAGE_A(PG8_SA(0, 0), a2, 0, last);
            PG8_WAIT_V(8); PG8_WAIT_L(0); PG8_BAR; PG8_MMA(1, 0, At, B0); PG8_MMA(1, 1, At, B1); PG8_BAR; PG8_SCHED;
            PG8_LDB(B0, 1, 0); PG8_LDB(B1, 1, 1); PG8_SCHED; PG8_LDA(At, 1, 0); PG8_STAGE_A(PG8_SA(0, 1), a2, 1, last);
            PG8_WAIT_V(8); PG8_WAIT_L(0); PG8_BAR; PG8_MMA(0, 0, At, B0); PG8_MMA(0, 1, At, B1); PG8_BAR; PG8_SCHED;
            PG8_LDA(At, 1, 1); PG8_STAGE(PG8_SB(1, 0), b3, voffB); PG8_STAGE(PG8_SB(1, 1), b3 + bh, voffB); PG8_STAGE_A(PG8_SA(1, 0), a3, 0, last);
            PG8_WAIT_V(8); PG8_WAIT_L(0); PG8_BAR; PG8_MMA(1, 0, At, B0); PG8_MMA(1, 1, At, B1); PG8_BAR; PG8_SCHED;
        }
        if constexpr (ALIGN_EPI) { if (wr == 0) PG8_BAR; }
        if constexpr (FP8) {
            asm volatile("s_nop 15\n\ts_nop 15" ::: "memory");
            if constexpr (!Epi::RAW)
#pragma unroll
            for (int a = 0; a < 2; ++a)
#pragma unroll
                for (int b = 0; b < 2; ++b)
#pragma unroll
                    for (int m = 0; m < 4; ++m)
#pragma unroll
                        for (int n = 0; n < 2; ++n) acc[a][b][m][n] *= (Sched::DUAL && cur.e == 0) ? 1.0f : FP8_UNSCALE;
        }
        E(acc, cur, wr, wc, fr, fq);
        if (!has_next) break;
        if (!(Sched::DUAL && cur.e == 0))
#pragma unroll
        for (int a = 0; a < 2; ++a)
#pragma unroll
            for (int b = 0; b < 2; ++b)
#pragma unroll
                for (int m = 0; m < 4; ++m)
#pragma unroll
                    for (int n = 0; n < 2; ++n) acc[a][b][m][n] = (f32x4){0.f, 0.f, 0.f, 0.f};
        cur = nxt; cA = nA; cB = nB; ++ui;
        if constexpr (Sched::GATHER) {
#pragma unroll
            for (int h = 0; h < 2; ++h)
#pragma unroll
                for (int i = 0; i < 2; ++i) gC[h][i] = gN[h][i];
        }
        if constexpr (ALIGN_EPI) { if (wr == 1) PG8_BAR; }
    }
    PG8_WAIT_V(0);
    if constexpr (!ALIGN_EPI) { if (wr == 0) PG8_BAR; }
    PG8_BAR;
#undef PG8_SA
#undef PG8_SB
#undef PG8_STAGE
#undef PG8_STAGE_A
#undef PG8_GATHER_SET
#undef PG8_LDA
#undef PG8_LDB
#undef PG8_MMA
#undef PG8_CAT
#undef PG8_WAIT_V
#undef PG8_WAIT_L
#undef PG8_BAR
#undef PG8_SCHED
}
}

typedef GAS unsigned gu32;
#define RLX_AGENT __ATOMIC_RELAXED, __HIP_MEMORY_SCOPE_AGENT
#define XB_TMO      128
#define XB_XCNT(j)  (256  + 64 * (j))
#define XB_XSUB(j)  (1280 + 64 * (j))
#define XB_XGEN(j)  (2304 + 64 * (j))
#define XB_TOP      3328
#define XB_TOPGEN   3392
#define XCD_BAR_WORDS 3456
#define XB_SPIN_CAP (1u << 18)
__device__ __forceinline__ unsigned xb_ld(unsigned* p)              { return __hip_atomic_load(p, __ATOMIC_RELAXED, __HIP_MEMORY_SCOPE_AGENT); }
__device__ __forceinline__ unsigned xb_add(unsigned* p, unsigned v) { return __hip_atomic_fetch_add(p, v, __ATOMIC_RELAXED, __HIP_MEMORY_SCOPE_AGENT); }
__device__ __forceinline__ unsigned xb_xcc_id() { return (unsigned)__builtin_amdgcn_s_getreg((3 << 11) | 20) & 0xFu; }
#define XB_SPIN(cond, bar) do { unsigned _sp = 0; while (cond) { __builtin_amdgcn_s_sleep(1); \
    if ((++_sp & 255u) == 0u) { if (xb_ld(&(bar)[XB_TMO])) break; if (_sp > XB_SPIN_CAP) { atomicAdd(&(bar)[XB_TMO], 1u); break; } } } } while (0)
struct XcdBarrier { unsigned* bar; unsigned x; volatile LAS unsigned* st; };
__device__ __forceinline__ XcdBarrier xcd_barrier_post(unsigned* bar, volatile LAS unsigned* st) {
    XcdBarrier b; b.bar = bar; b.x = xb_xcc_id(); b.st = st;
    if (threadIdx.x == 0) (void)xb_add(&bar[XB_XCNT(b.x)], 1u);
    return b;
}
__device__ __forceinline__ void xcd_barrier_complete(unsigned* bar, unsigned x, unsigned& nloc, unsigned& nx) {
    const unsigned G = gridDim.x * gridDim.y * gridDim.z;
    unsigned sum, cnt, mine, sp = 0u;
    for (;;) {
        sum = 0u; cnt = 0u; mine = 0u;
#pragma unroll
        for (unsigned j = 0; j < 16; ++j) { const unsigned c = xb_ld(&bar[XB_XCNT(j)]); sum += c; cnt += (c > 0u) ? 1u : 0u; mine = (j == x) ? c : mine; }
        if (sum == G) break;
        __builtin_amdgcn_s_sleep(1);
        if ((++sp & 255u) == 0u) { if (xb_ld(&bar[XB_TMO])) break; if (sp > XB_SPIN_CAP) { atomicAdd(&bar[XB_TMO], 1u); break; } }
    }
    nloc = mine > 0u ? mine : 1u; nx = cnt > 0u ? cnt : 1u;
}
__device__ __forceinline__ void xcd_barrier(const XcdBarrier& b) {
    asm volatile("s_waitcnt vmcnt(0)" ::: "memory");
    __syncthreads();
    if (threadIdx.x == 0) {
        unsigned* bar = b.bar;
        __builtin_amdgcn_s_waitcnt(0);
        unsigned nloc = b.st[0], nx = b.st[1];
        if (nloc == 0u) { xcd_barrier_complete(bar, b.x, nloc, nx); b.st[0] = nloc; b.st[1] = nx; }
        const unsigned old = xb_add(&bar[XB_XSUB(b.x)], 1u);
        const unsigned gen = old / nloc;
        if (old + 1u == (gen + 1u) * nloc) {
            __builtin_amdgcn_fence(__ATOMIC_RELEASE, "agent");
            asm volatile("s_waitcnt vmcnt(0)" ::: "memory");
            const unsigned og = xb_add(&bar[XB_TOP], 1u);
            const unsigned tg = og / nx;
            if (og + 1u == (tg + 1u) * nx) xb_add(&bar[XB_TOPGEN], 1u);
            else XB_SPIN(xb_ld(&bar[XB_TOPGEN]) == tg, bar);
            __builtin_amdgcn_fence(__ATOMIC_ACQUIRE, "agent");
            xb_add(&bar[XB_XGEN(b.x)], 1u);
            asm volatile("s_waitcnt vmcnt(0)" ::: "memory");
        } else {
            XB_SPIN(xb_ld(&bar[XB_XGEN(b.x)]) == gen, bar);
            __builtin_amdgcn_fence(__ATOMIC_ACQUIRE, "agent");
            asm volatile("s_waitcnt vmcnt(0)" ::: "memory");
        }
    }
    __syncthreads();
}

constexpr int NWAVES = 8, NTHR = 512;
constexpr int LDS_BYTES = 147456, LDSCTL_OFF = LDS_BYTES - 1024, MISC_OFF = LDSCTL_OFF + 320;

struct Args { const float* in[21]; float* out; unsigned char* ws; int ph_lo, ph_hi, li, pad; };

struct Frame {
    LAS unsigned char* lds;
    unsigned char* ws;
    int tid, lane, wave, vcu, G;
};

template <int MODE = 0> struct EpiInProjT {
    static constexpr bool PERM = true; static constexpr bool RAW = true;
    unsigned char* ws; const u32x4* rope;
    __device__ __forceinline__ void operator()(const f32x4 (&acc)[2][2][4][2], const pg8::Unit& u, int wr, int wc, int fr, int fq) const {
        const int seg = MODE == 4 ? 5 : (u.pn >> 2);
        bf16_t* O = (bf16_t*)(MODE == 0 ? ws + WS_PROJ + (size_t)seg * SEG : ws + WS_OUTF + (size_t)(seg % 5) * SEG);
        const int colt = (u.pn & 3) * 256;
        const int row0 = (MODE == 3 ? (u.pm & 3) : u.pm) * 256 + wr * 64 + fr;
        const int d = wc * 32 + 8 * fq;
        auto emit = [&](int row, f32x4 v00, f32x4 v01, f32x4 v10, f32x4 v11) {
            if (seg <= 2) {
                u32x4 w0, w1; w0.x = cvtpk(v00[0], v00[1]); w0.y = cvtpk(v00[2], v00[3]); w0.z = cvtpk(v01[0], v01[1]); w0.w = cvtpk(v01[2], v01[3]);
                w1.x = cvtpk(v10[0], v10[1]); w1.y = cvtpk(v10[2], v10[3]); w1.z = cvtpk(v11[0], v11[1]); w1.w = cvtpk(v11[2], v11[3]);
                if (seg == 0) {
                    const int pos = row & (SEQ - 1), il = pos & 127;
                    bf16_t* blkp = O + ((((size_t)(row >> 12) * 4 + (u.pn & 3)) * 32 + (pos >> 7)) * 4 + (il >> 5)) * 8192 + (size_t)(((d >> 3) & 1) * 32 + (il & 31)) * 8;
                    if (MODE == 2 || MODE == 4) asm volatile("" :: "v"(w0), "v"(w1), "v"(blkp)); else { *(u32x4*)(blkp + (d >> 4) * 512) = w0; *(u32x4*)(blkp + ((d >> 4) + 8) * 512) = w1; }
                } else { bf16_t* rowp = O + (size_t)row * DM + colt + d; if (MODE == 2 || MODE == 4) asm volatile("" :: "v"(w0), "v"(w1), "v"(rowp)); else { *(u32x4*)rowp = w0; *(u32x4*)(rowp + 128) = w1; } }
            } else {
                unsigned char* rowp = (unsigned char*)O + (size_t)row * DM + colt + d;
                u32x2 f0, f1;
                if (seg >= 7) { f0.x = pk4_fp8_noclamp(v00[0], v00[1], v00[2], v00[3]); f0.y = pk4_fp8_noclamp(v01[0], v01[1], v01[2], v01[3]); f1.x = pk4_fp8_noclamp(v10[0], v10[1], v10[2], v10[3]); f1.y = pk4_fp8_noclamp(v11[0], v11[1], v11[2], v11[3]); }
                else { f0.x = pk4_fp8_clamped(v00[0], v00[1], v00[2], v00[3]); f0.y = pk4_fp8_clamped(v01[0], v01[1], v01[2], v01[3]); f1.x = pk4_fp8_clamped(v10[0], v10[1], v10[2], v10[3]); f1.y = pk4_fp8_clamped(v11[0], v11[1], v11[2], v11[3]); }
                if (MODE == 2 || MODE == 4) asm volatile("" :: "v"(f0), "v"(f1), "v"(rowp)); else { *(u32x2*)rowp = f0; *(u32x2*)(rowp + 128) = f1; }
            }
        };
        if (seg <= 1) {
            u32x4 cs[8][2];
#pragma unroll
            for (int it = 0; it < 8; ++it) { const int pos = (row0 + (it >> 2) * 128 + (it & 3) * 16) & (SEQ - 1); const u32x4* p = rope + ((size_t)pos * 16 + (d >> 3)) * 2; cs[it][0] = p[0]; cs[it][1] = p[1]; }
            const float sc = seg == 1 ? 0.0625f * FP8_UNSCALE : FP8_UNSCALE;
#pragma unroll
            for (int it = 0; it < 8; ++it) {
                const int ai = it >> 2, m = it & 3;
                const f32x4 v00 = acc[ai][0][m][0], v01 = acc[ai][0][m][1], v10 = acc[ai][1][m][0], v11 = acc[ai][1][m][1];
                const u32x4 c = cs[it][0], sn = cs[it][1];
                const f32x4 c0 = (f32x4){bflo(c.x), bfhi(c.x), bflo(c.y), bfhi(c.y)} * sc, c1 = (f32x4){bflo(c.z), bfhi(c.z), bflo(c.w), bfhi(c.w)} * sc;
                const f32x4 s0 = (f32x4){bflo(sn.x), bfhi(sn.x), bflo(sn.y), bfhi(sn.y)} * sc, s1 = (f32x4){bflo(sn.z), bfhi(sn.z), bflo(sn.w), bfhi(sn.w)} * sc;
                emit(row0 + ai * 128 + m * 16, v00 * c0 - v10 * s0, v01 * c1 - v11 * s1, v00 * s0 + v10 * c0, v01 * s1 + v11 * c1);
            }
            return;
        }
#pragma unroll
        for (int ai = 0; ai < 2; ++ai)
#pragma unroll
            for (int m = 0; m < 4; ++m) {
                f32x4 v00 = acc[ai][0][m][0], v01 = acc[ai][0][m][1], v10 = acc[ai][1][m][0], v11 = acc[ai][1][m][1];
                if (seg == 2) { v00 = v00 * FP8_UNSCALE; v01 = v01 * FP8_UNSCALE; v10 = v10 * FP8_UNSCALE; v11 = v11 * FP8_UNSCALE; }
                else if (seg == 3) {
                    constexpr float ce = -FP8_UNSCALE * 1.4426950408889634f, cm = YD_SCALE * FP8_UNSCALE;
#pragma unroll
                    for (int i = 0; i < 4; ++i) { v00[i] = (v00[i] * cm) * __builtin_amdgcn_rcpf(1.f + __builtin_amdgcn_exp2f(v00[i] * ce)); v01[i] = (v01[i] * cm) * __builtin_amdgcn_rcpf(1.f + __builtin_amdgcn_exp2f(v01[i] * ce));
                        v10[i] = (v10[i] * cm) * __builtin_amdgcn_rcpf(1.f + __builtin_amdgcn_exp2f(v10[i] * ce)); v11[i] = (v11[i] * cm) * __builtin_amdgcn_rcpf(1.f + __builtin_amdgcn_exp2f(v11[i] * ce)); }
                } else if (seg <= 6) { const float q = (seg == 4 ? 0.18033688011112042f : 1.0f) * (YD_SCALE * FP8_UNSCALE); v00 = v00 * q; v01 = v01 * q; v10 = v10 * q; v11 = v11 * q; }
                else {
                    constexpr float ce = -FP8_UNSCALE * 1.4426950408889634f;
#pragma unroll
                    for (int i = 0; i < 4; ++i) { v00[i] = __builtin_amdgcn_rcpf(__builtin_fmaf(__builtin_amdgcn_exp2f(v00[i] * ce), YD_INV, YD_INV)); v01[i] = __builtin_amdgcn_rcpf(__builtin_fmaf(__builtin_amdgcn_exp2f(v01[i] * ce), YD_INV, YD_INV));
                        v10[i] = __builtin_amdgcn_rcpf(__builtin_fmaf(__builtin_amdgcn_exp2f(v10[i] * ce), YD_INV, YD_INV)); v11[i] = __builtin_amdgcn_rcpf(__builtin_fmaf(__builtin_amdgcn_exp2f(v11[i] * ce), YD_INV, YD_INV)); }
                }
                emit(row0 + ai * 128 + m * 16, v00, v01, v10, v11);
            }
    }
};
using EpiInProj = EpiInProjT<0>;
template <bool ADD> struct EpiGateBf16 {
    static constexpr bool PERM = true; static constexpr bool RAW = false;
    bf16_t* O; const bf16_t* Gt; const bf16_t* P;
    __device__ __forceinline__ void operator()(const f32x4 (&acc)[2][2][4][2], const pg8::Unit& u, int wr, int wc, int fr, int fq) const {
        const int row0 = u.pm * 256 + wr * 64 + fr, col0 = u.pn * 256 + wc * 32 + 8 * fq;
#pragma unroll
        for (int ai = 0; ai < 2; ++ai)
#pragma unroll
            for (int m = 0; m < 4; ++m) {
                const size_t ro = (size_t)(row0 + ai * 128 + m * 16) * DM + col0;
#pragma unroll
                for (int bj = 0; bj < 2; ++bj) {
                    const u32x4 g = *(const u32x4*)(Gt + ro + bj * 128);
                    f32x4 v0 = acc[ai][bj][m][0], v1 = acc[ai][bj][m][1];
                    v0[0] *= bflo(g.x); v0[1] *= bfhi(g.x); v0[2] *= bflo(g.y); v0[3] *= bfhi(g.y);
                    v1[0] *= bflo(g.z); v1[1] *= bfhi(g.z); v1[2] *= bflo(g.w); v1[3] *= bfhi(g.w);
                    if (ADD) { const u32x4 p = *(const u32x4*)(P + ro + bj * 128);
                        v0[0] += bflo(p.x); v0[1] += bfhi(p.x); v0[2] += bflo(p.y); v0[3] += bfhi(p.y);
                        v1[0] += bflo(p.z); v1[1] += bfhi(p.z); v1[2] += bflo(p.w); v1[3] += bfhi(p.w); }
                    u32x4 w; w.x = cvtpk(v0[0], v0[1]); w.y = cvtpk(v0[2], v0[3]); w.z = cvtpk(v1[0], v1[1]); w.w = cvtpk(v1[2], v1[3]);
                    *(u32x4*)(O + ro + bj * 128) = w;
                }
            }
    }
};
struct EpiMerge {
    static constexpr bool PERM = true; static constexpr bool RAW = false;
    unsigned char* O; const unsigned char* Gr; const unsigned char* Ga;
    __device__ __forceinline__ void operator()(f32x4 (&acc)[2][2][4][2], const pg8::Unit& u, int wr, int wc, int fr, int fq) const {
        const int row0 = u.pm * 256 + wr * 64 + fr, col0 = u.pn * 256 + wc * 32 + 8 * fq;
        u32x2 ga[8][2], gr[8][2];
#pragma unroll
        for (int it = 0; it < 8; ++it)
#pragma unroll
            for (int bj = 0; bj < 2; ++bj) { const size_t ro = (size_t)(row0 + (it >> 2) * 128 + (it & 3) * 16) * DM + col0 + bj * 128;
                ga[it][bj] = *(const u32x2*)(Ga + ro); gr[it][bj] = *(const u32x2*)(Gr + (u.e == 0 ? ro : 0)); }
#pragma unroll
        for (int it = 0; it < 8; ++it) {
            const int ai = it >> 2, m = it & 3;
            const size_t ro = (size_t)(row0 + ai * 128 + m * 16) * DM + col0;
#pragma unroll
            for (int bj = 0; bj < 2; ++bj) {
                const u32x2 g = ga[it][bj];
                const f32x2 ga0 = __builtin_amdgcn_cvt_pk_f32_fp8((int)g.x, false), ga1 = __builtin_amdgcn_cvt_pk_f32_fp8((int)g.x, true), ga2 = __builtin_amdgcn_cvt_pk_f32_fp8((int)g.y, false), ga3 = __builtin_amdgcn_cvt_pk_f32_fp8((int)g.y, true);
                f32x4 a0 = (f32x4){ga0.x, ga0.y, ga1.x, ga1.y} * YD_INV, a1 = (f32x4){ga2.x, ga2.y, ga3.x, ga3.y} * YD_INV;
                if (u.e == 0) {
                    const u32x2 h = gr[it][bj];
                    const f32x2 gr0 = __builtin_amdgcn_cvt_pk_f32_fp8((int)h.x, false), gr1 = __builtin_amdgcn_cvt_pk_f32_fp8((int)h.x, true), gr2 = __builtin_amdgcn_cvt_pk_f32_fp8((int)h.y, false), gr3 = __builtin_amdgcn_cvt_pk_f32_fp8((int)h.y, true);
                    const f32x4 r0 = (f32x4){gr0.x, gr0.y, gr1.x, gr1.y} * YD_INV, r1 = (f32x4){gr2.x, gr2.y, gr3.x, gr3.y} * YD_INV;
#pragma unroll
                    for (int i = 0; i < 4; ++i) { acc[ai][bj][m][0][i] *= r0[i] * __builtin_amdgcn_rcpf(fmaxf(a0[i], 1e-30f)); acc[ai][bj][m][1][i] *= r1[i] * __builtin_amdgcn_rcpf(fmaxf(a1[i], 1e-30f)); }
                } else {
                    const f32x4 v0 = acc[ai][bj][m][0] * a0, v1 = acc[ai][bj][m][1] * a1;
                    u32x2 w; w.x = pk4_fp8(v0[0], v0[1], v0[2], v0[3]); w.y = pk4_fp8(v1[0], v1[1], v1[2], v1[3]);
                    *(u32x2*)(O + ro + bj * 128) = w;
                }
            }
        }
    }
};
struct EpiOProj {
    static constexpr bool PERM = true; static constexpr bool RAW = false;
    const float* x; bf16_t* x1; const float* mod; float* ss;
    __device__ __forceinline__ void operator()(const f32x4 (&acc)[2][2][4][2], const pg8::Unit& u, int wr, int wc, int fr, int fq) const {
        const int row0 = u.pm * 256 + wr * 64 + fr, col0 = u.pn * 256 + wc * 32 + 8 * fq;
        const int b = (u.pm * 256) / SEQ;
        f32x4 gm[2][2];
#pragma unroll
        for (int bj = 0; bj < 2; ++bj)
#pragma unroll
            for (int n = 0; n < 2; ++n) gm[bj][n] = *(const f32x4*)(mod + (size_t)b * 6144 + 2 * DM + col0 + bj * 128 + n * 4);
        f32x4 xv[4][2][2]; u32x4 wv[4][2]; float sqv[4];
#define OP_LOAD(ai) do { _Pragma("unroll") for (int m = 0; m < 4; ++m) _Pragma("unroll") for (int bj = 0; bj < 2; ++bj) { const float* p_ = x + (size_t)(row0 + (ai) * 128 + m * 16) * DM + col0 + bj * 128; \
            xv[m][bj][0] = *(const f32x4*)p_; xv[m][bj][1] = *(const f32x4*)(p_ + 4); } } while (0)
#define OP_CALC(ai) do { _Pragma("unroll") for (int m = 0; m < 4; ++m) { float sq = 0.f; _Pragma("unroll") for (int bj = 0; bj < 2; ++bj) { \
            const f32x4 o0 = xv[m][bj][0] + gm[bj][0] * acc[ai][bj][m][0], o1 = xv[m][bj][1] + gm[bj][1] * acc[ai][bj][m][1]; \
            u32x4 w; w.x = cvtpk(o0[0], o0[1]); w.y = cvtpk(o0[2], o0[3]); w.z = cvtpk(o1[0], o1[1]); w.w = cvtpk(o1[2], o1[3]); wv[m][bj] = w; \
            sq += (o0[0] * o0[0] + o0[1] * o0[1]) + (o0[2] * o0[2] + o0[3] * o0[3]) + (o1[0] * o1[0] + o1[1] * o1[1]) + (o1[2] * o1[2] + o1[3] * o1[3]); } \
            sq += __shfl_xor(sq, 16); sq += __shfl_xor(sq, 32); sqv[m] = sq; } } while (0)
#define OP_STORE(ai) do { _Pragma("unroll") for (int m = 0; m < 4; ++m) { const int row = row0 + (ai) * 128 + m * 16; const size_t ro = (size_t)row * DM + col0; \
            *(u32x4*)(x1 + ro) = wv[m][0]; *(u32x4*)(x1 + ro + 128) = wv[m][1]; if (fq == 0) ss[(size_t)row * 16 + u.pn * 4 + wc] = sqv[m]; } } while (0)
        OP_LOAD(0); OP_CALC(0); OP_LOAD(1); OP_STORE(0); OP_CALC(1); OP_STORE(1);
#undef OP_LOAD
#undef OP_CALC
#undef OP_STORE
    }
};
struct EpiF32 {
    static constexpr bool PERM = false; static constexpr bool RAW = false;
    float* C; int ldc;
    __device__ __forceinline__ void operator()(const f32x4 (&acc)[2][2][4][2], const pg8::Unit& u, int wr, int wc, int fr, int fq) const {
        const int row0 = u.pm * 256 + wr * 64 + fr, col0 = u.pn * 256 + wc * 32 + 4 * fq;
#pragma unroll
        for (int ai = 0; ai < 2; ++ai)
#pragma unroll
            for (int m = 0; m < 4; ++m) { float* rowp = C + (size_t)(row0 + ai * 128 + m * 16) * ldc + col0;
#pragma unroll
                for (int bj = 0; bj < 2; ++bj)
#pragma unroll
                    for (int n = 0; n < 2; ++n) *(f32x4*)(rowp + bj * 128 + n * 16) = acc[ai][bj][m][n]; }
    }
};
struct EpiPlainScratch {
    static constexpr bool PERM = true; static constexpr bool RAW = false;
    bf16_t* O;
    __device__ __forceinline__ void operator()(const f32x4 (&acc)[2][2][4][2], const pg8::Unit& u, int wr, int wc, int fr, int fq) const {
        const int row0 = u.pm * 256 + wr * 64 + fr, col0 = (u.pn & 3) * 256 + wc * 32 + 8 * fq;
#pragma unroll
        for (int ai = 0; ai < 2; ++ai)
#pragma unroll
            for (int m = 0; m < 4; ++m) { bf16_t* rowp = O + (size_t)(row0 + ai * 128 + m * 16) * DM + col0;
#pragma unroll
                for (int bj = 0; bj < 2; ++bj) { const f32x4 v0 = acc[ai][bj][m][0], v1 = acc[ai][bj][m][1];
                    u32x4 w; w.x = cvtpk(v0[0], v0[1]); w.y = cvtpk(v0[2], v0[3]); w.z = cvtpk(v1[0], v1[1]); w.w = cvtpk(v1[2], v1[3]); *(u32x4*)(rowp + bj * 128) = w; } }
    }
};
struct EpiNull {
    static constexpr bool PERM = false; static constexpr bool RAW = false;
    __device__ __forceinline__ void operator()(const f32x4 (&acc)[2][2][4][2], const pg8::Unit&, int, int, int, int) const {
#pragma unroll
        for (int ai = 0; ai < 2; ++ai)
#pragma unroll
            for (int bj = 0; bj < 2; ++bj)
#pragma unroll
                for (int m = 0; m < 4; ++m)
#pragma unroll
                    for (int n = 0; n < 2; ++n) asm volatile("" :: "v"(acc[ai][bj][m][n]));
    }
};
struct EpiGU {
    static constexpr bool PERM = true; static constexpr bool RAW = false;
    bf16_t* hid;
    __device__ __forceinline__ void operator()(const f32x4 (&acc)[2][2][4][2], const pg8::Unit& u, int wr, int wc, int fr, int fq) const {
        const int row0 = u.pm * 256 + wr * 64 + fr, col0 = u.pn * 128 + wc * 32 + 8 * fq;
#pragma unroll
        for (int ai = 0; ai < 2; ++ai)
#pragma unroll
            for (int m = 0; m < 4; ++m) { bf16_t* rowp = hid + (size_t)(row0 + ai * 128 + m * 16) * EH + col0;
                f32x4 h0, h1;
#pragma unroll
                for (int i = 0; i < 4; ++i) { h0[i] = siluf_(acc[ai][0][m][0][i]) * acc[ai][1][m][0][i]; h1[i] = siluf_(acc[ai][0][m][1][i]) * acc[ai][1][m][1][i]; }
                u32x4 w; w.x = cvtpk(h0[0], h0[1]); w.y = cvtpk(h0[2], h0[3]); w.z = cvtpk(h1[0], h1[1]); w.w = cvtpk(h1[2], h1[3]); *(u32x4*)rowp = w; }
    }
};
template <int MODE> struct EpiDownT {
    static constexpr bool PERM = true; static constexpr bool RAW = false;
    unsigned char* ws; const LAS int* exp_info;
    __device__ __forceinline__ void operator()(const f32x4 (&acc)[2][2][4][2], const pg8::Unit& u, int wr, int wc, int fr, int fq) const {
        const int shift = __builtin_amdgcn_readfirstlane(exp_info[u.e]), lim = __builtin_amdgcn_readfirstlane(exp_info[512 + u.e]);
        const int row0 = u.pm * 256 + wr * 64 + fr, col0 = u.pn * 256 + wc * 32 + 8 * fq;
#pragma unroll
        for (int ai = 0; ai < 2; ++ai)
#pragma unroll
            for (int m = 0; m < 4; ++m) {
                const int pos = row0 + ai * 128 + m * 16;
                if (pos < lim) {
                    unsigned char* rowp = (MODE == 1 ? ws + WS_SS + (size_t)blockIdx.x * 2048 : ydense_row(ws, pos - shift)) + col0;
#pragma unroll
                    for (int bj = 0; bj < 2; ++bj) { const f32x4 v0 = acc[ai][bj][m][0], v1 = acc[ai][bj][m][1];
                        u32x2 w; w.x = pk4_fp8(v0[0], v0[1], v0[2], v0[3]); w.y = pk4_fp8(v1[0], v1[1], v1[2], v1[3]);
                        *(u32x2*)(rowp + bj * 128) = w; }
                }
            }
    }
};
typedef EpiDownT<0> EpiDown;

template <bool F8 = false> __device__ __forceinline__ void transpose_item(const float* W, int N, int K, int k0, int n0, bf16_t* WT, int drow0, LAS float* scr, int lane) {
#pragma unroll 8
    for (int i = 0; i < 32; ++i) { const int kk = 2 * i + (lane >> 5); scr[kk * 33 + (lane & 31)] = W[(size_t)(k0 + kk) * N + n0 + (lane & 31)]; }
    asm volatile("s_waitcnt lgkmcnt(0)" ::: "memory");
    const int c = lane & 7;
#pragma unroll
    for (int j = 0; j < 4; ++j) { const int n = (lane >> 3) + 8 * j; const LAS float* s = scr + (8 * c) * 33 + n;
        if constexpr (F8) { u32x2 o; o.x = pk4_fp8w(s[0 * 33], s[1 * 33], s[2 * 33], s[3 * 33]); o.y = pk4_fp8w(s[4 * 33], s[5 * 33], s[6 * 33], s[7 * 33]);
            *(u32x2*)((unsigned char*)WT + (size_t)(drow0 + n) * K + k0 + 8 * c) = o; }
        else { u32x4 o; o.x = cvtpk(s[0 * 33], s[1 * 33]); o.y = cvtpk(s[2 * 33], s[3 * 33]); o.z = cvtpk(s[4 * 33], s[5 * 33]); o.w = cvtpk(s[6 * 33], s[7 * 33]);
            *(u32x4*)(WT + (size_t)(drow0 + n) * K + k0 + 8 * c) = o; } }
    asm volatile("s_waitcnt lgkmcnt(0)" ::: "memory");
}
template <bool F8 = false> __device__ __forceinline__ void transpose_plain(const float* W, int K, int N, bf16_t* WT, LAS float* scr, int item, int lane) {
    const int nblk = N / 32, kb = item / nblk, nb = item % nblk;
    transpose_item<F8>(W, N, K, 64 * kb, 32 * nb, WT, 32 * nb, scr, lane);
}

__device__ __forceinline__ int t5_bucket(int rel) {
    const int n = rel < 0 ? -rel : rel;
    int large = 8 + (int)(logf((float)(n > 1 ? n : 1) / 8.0f) / 4.852030263919617f * 8.0f);
    large = large < 15 ? large : 15;
    return (rel > 0 ? 16 : 0) + (n < 8 ? n : large);
}

__device__ __forceinline__ void phase0(Frame& F, const Args& a) {
    const float* c = a.in[1]; const float* w_ada = a.in[2]; const float* b_ada = a.in[3];
    {
        LAS float* cond = (LAS float*)F.lds;
        LAS float* red = (LAS float*)(F.lds + 32768);
        for (int i = F.tid; i < NB * DM; i += NTHR) cond[i] = siluf_(c[i]);
        __syncthreads();
        for (int cg = F.vcu; cg < 256; cg += F.G) {
            const int j = F.tid & 31, kg = F.tid >> 5;
            float s[NB];
#pragma unroll
            for (int b = 0; b < NB; ++b) s[b] = 0.f;
            if (j < 24) {
                for (int k = kg; k < DM; k += 16) { const float w = w_ada[(size_t)k * 6144 + cg * 24 + j];
#pragma unroll
                    for (int b = 0; b < NB; ++b) s[b] += cond[b * DM + k] * w; }
            }
#pragma unroll
            for (int b = 0; b < NB; ++b) red[(kg * NB + b) * 32 + j] = s[b];
            __syncthreads();
            if (F.tid < 192) { const int b = F.tid / 24, jj = F.tid % 24; float t = 0.f;
                for (int g = 0; g < 16; ++g) t += red[(g * NB + b) * 32 + jj];
                ((float*)(F.ws + WS_MOD))[b * 6144 + cg * 24 + jj] = t + b_ada[cg * 24 + jj]; }
            __syncthreads();
        }
    }
    const int gt = F.vcu * NTHR + F.tid, NGT = F.G * NTHR;
    {
        unsigned short* rt = (unsigned short*)(F.ws + WS_ROPE_C);
        for (int i = gt; i < SEQ * 128; i += NGT) { const int pos = i >> 7, d = i & 127;
            const float inv = (float)pow(10000.0, -(double)d / 128.0); const float ang = (float)pos * inv;
            const size_t o = ((size_t)pos * 16 + (d >> 3)) * 16 + (d & 7);
            rt[o] = (unsigned short)(cvtpk((float)cos((double)ang), 0.f) & 0xffffu); rt[o + 8] = (unsigned short)(cvtpk((float)sin((double)ang), 0.f) & 0xffffu); }
    }
    {
        const float* t5 = a.in[7]; float* bt = (float*)(F.ws + WS_BTAB);
        for (int i = gt; i < 3 * 16 * 160; i += NGT) { const int g = i / (16 * 160), h = (i / 160) % 16, j = i % 160;
            const int dil = g == 0 ? 1 : (g == 1 ? 4 : 16);
            bt[i] = j <= 128 ? t5[t5_bucket((j - 64) * dil) * 16 + h] * 1.4426950408889634f : 0.f; }
    }
    { unsigned* z = (unsigned*)(F.ws + WS_H + (size_t)NTOK * DM * 2); for (int i = gt; i < DM / 2; i += NGT) z[i] = 0u; }
    {
        LAS float* scr = (LAS float*)(F.lds + 49152 + F.wave * 8704);
        const int gw = F.vcu * NWAVES + F.wave, NGW = F.G * NWAVES;
        constexpr int I_IN = (DM / 64) * (PROJW / 32), I_SQ = (DM / 64) * (DM / 32), I_R = (DM / 64) * (NEXP / 32);
        constexpr int NITEMS = I_IN + 3 * I_SQ + I_R;
        for (int it = gw; it < NITEMS; it += NGW) {
            int r = it;
            if (r < I_IN) { transpose_plain<true>(a.in[5], DM, PROJW, (bf16_t*)(F.ws + WS_WIN), scr, r, F.lane); continue; } r -= I_IN;
            if (r < I_SQ) { transpose_plain<true>(a.in[8], DM, DM, (bf16_t*)(F.ws + WS_WRU), scr, r, F.lane); continue; } r -= I_SQ;
            if (r < I_SQ) { transpose_plain<true>(a.in[9], DM, DM, (bf16_t*)(F.ws + WS_WAU), scr, r, F.lane); continue; } r -= I_SQ;
            if (r < I_SQ) { transpose_plain<true>(a.in[10], DM, DM, (bf16_t*)(F.ws + WS_WO), scr, r, F.lane); continue; } r -= I_SQ;
            transpose_plain(a.in[12], DM, NEXP, (bf16_t*)(F.ws + WS_WR), scr, r, F.lane);
        }
    }
}

constexpr int CW_CONVQ = 16384 + 2048;
constexpr size_t WGU_E_BYTES = 512 * 1024, WGU_T_BYTES = 256 * 1024;
__device__ __forceinline__ void moe_weight_convert(Frame& F, const Args& a) {
    LAS unsigned char* img = F.lds + F.wave * 16384;
    const int total = 257 * 2 * 16, c = F.lane;
    unsigned* q = (unsigned*)(F.ws + WS_CTL) + CW_CONVQ;
    const int R0 = 32 * ((c >> 3) & 3) + 16 * (c & 1) + 4 * ((c & 7) >> 1);
    const int lbase = (c >> 5) * 8192 + (R0 >> 4) * 1024 + (R0 & 15) * 64;
    f32x4 va[16], vb[16];
#define CV_SRC(it) ((((it) >> 5) < 256 ? a.in[14 + (((it) >> 4) & 1)] + (size_t)((it) >> 5) * 1024 * 256 : a.in[17 + (((it) >> 4) & 1)]) + (size_t)((it) & 15) * 64 * 256 + 4 * c)
#define CV_LOAD(V, p, s) do { _Pragma("unroll") for (int r = 0; r < 16; ++r) V[r] = __builtin_nontemporal_load((const f32x4*)((p) + (size_t)(16 * (s) + r) * 256)); } while (0)
#define CV_PROC(V, s) do { _Pragma("unroll") for (int nn = 0; nn < 4; ++nn) { u32x4 pc; pc.x = pk4_fp8w(V[0][nn], V[1][nn], V[2][nn], V[3][nn]); pc.y = pk4_fp8w(V[4][nn], V[5][nn], V[6][nn], V[7][nn]); \
        pc.z = pk4_fp8w(V[8][nn], V[9][nn], V[10][nn], V[11][nn]); pc.w = pk4_fp8w(V[12][nn], V[13][nn], V[14][nn], V[15][nn]); \
        const int o_ = lbase + nn * 64 + 16 * (s); *(LAS u32x4*)(img + (o_ ^ (((o_ >> 9) & 1) << 5))) = pc; } } while (0)
    unsigned cur = 0;
    if (c == 0) cur = __hip_atomic_fetch_add(q, 1u, __ATOMIC_RELAXED, __HIP_MEMORY_SCOPE_AGENT);
    cur = __builtin_amdgcn_readfirstlane(cur);
    if ((int)cur >= total) return;
    const float* sp = CV_SRC(cur);
    CV_LOAD(va, sp, 0);
#pragma unroll 1
    for (;;) {
        unsigned nxt = 0;
        if (c == 0) nxt = __hip_atomic_fetch_add(q, 1u, __ATOMIC_RELAXED, __HIP_MEMORY_SCOPE_AGENT);
        nxt = __builtin_amdgcn_readfirstlane(nxt);
        const bool more = (int)nxt < total;
        const float* np = more ? CV_SRC(nxt) : sp;
        CV_LOAD(vb, sp, 1); CV_PROC(va, 0);
        CV_LOAD(va, sp, 2); CV_PROC(vb, 1);
        CV_LOAD(vb, sp, 3); CV_PROC(va, 2);
        CV_LOAD(va, np, 0); CV_PROC(vb, 3);
        asm volatile("s_waitcnt lgkmcnt(0)" ::: "memory");
        const int e = cur >> 5, kind = (cur >> 4) & 1, kb = cur & 15;
        unsigned char* dst = F.ws + WS_WGU + (size_t)e * WGU_E_BYTES + (size_t)(kb >> 1) * 32768 + (size_t)kind * 16384 + (size_t)(kb & 1) * 1024 + 16 * c;
#pragma unroll
        for (int j = 0; j < 16; ++j) *(u32x4*)(dst + (size_t)(j >> 3) * WGU_T_BYTES + (size_t)(j & 7) * 2048) = *(const LAS u32x4*)(img + j * 1024 + 16 * c);
        asm volatile("s_waitcnt lgkmcnt(0)" ::: "memory");
        if (!more) break;
        cur = nxt; sp = np;
    }
#undef CV_SRC
#undef CV_LOAD
#undef CV_PROC
}

template <bool BF16IN, int OUT8> __device__ __forceinline__ void norm_mod_rows(Frame& F, const void* xin, const float* norm, const float* mod, int shift_off, int scale_off, const float* ssp, bf16_t* out, unsigned char* out8) {
    const float* x = (const float*)xin; const bf16_t* xb = (const bf16_t*)xin;
    const int gw = F.vcu * NWAVES + F.wave, NGW = F.G * NWAVES;
    f32x4 g4[4];
#pragma unroll
    for (int j = 0; j < 4; ++j) g4[j] = *(const f32x4*)(norm + 4 * F.lane + 256 * j);
    f32x4 v[4], vn[4]; float p = 0.f, pn = 0.f;
    int row = gw;
#define NM_LOAD(V, ROW) do { if (BF16IN) { const u32x2* xr_ = (const u32x2*)(xb + (size_t)(ROW) * DM) + F.lane; _Pragma("unroll") for (int j = 0; j < 4; ++j) { const u32x2 t_ = xr_[64 * j]; V[j] = (f32x4){bflo(t_.x), bfhi(t_.x), bflo(t_.y), bfhi(t_.y)}; } } \
        else { const f32x4* xr_ = (const f32x4*)(x + (size_t)(ROW) * DM) + F.lane; _Pragma("unroll") for (int j = 0; j < 4; ++j) V[j] = xr_[64 * j]; } } while (0)
    if (row < NTOK) { NM_LOAD(v, row);
        if (ssp) p = F.lane < 16 ? ssp[(size_t)row * 16 + F.lane] : 0.f; }
#pragma unroll 1
    for (; row < NTOK; row += NGW) {
        const int nrow = row + NGW < NTOK ? row + NGW : row;
        { NM_LOAD(vn, nrow);
          if (ssp) pn = F.lane < 16 ? ssp[(size_t)nrow * 16 + F.lane] : 0.f; }
        const int b = row / SEQ;
        float s = 0.f;
#pragma unroll
        for (int j = 0; j < 4; ++j) s += (v[j][0] * v[j][0] + v[j][1] * v[j][1]) + (v[j][2] * v[j][2] + v[j][3] * v[j][3]);
        const float tot = wave_sum(ssp ? p : s);
        const float rstd = rsqrtf(tot * (1.f / DM) + NORM_EPS);
        u32x2* o8 = (u32x2*)(out + (size_t)row * DM) + F.lane;
#pragma unroll
        for (int j = 0; j < 4; ++j) {
            const int col = 4 * F.lane + 256 * j;
            const f32x4 sc = *(const f32x4*)(mod + (size_t)b * 6144 + scale_off + col), sh = *(const f32x4*)(mod + (size_t)b * 6144 + shift_off + col);
            const f32x4 y = (v[j] * rstd) * g4[j] * (sc + 1.0f) + sh;
            if (OUT8 != 1) { u32x2 w; w.x = cvtpk(y[0], y[1]); w.y = cvtpk(y[2], y[3]); o8[64 * j] = w; }
            if (OUT8 != 0) *(unsigned*)(out8 + (size_t)row * DM + col) = pk4_fp8(y[0], y[1], y[2], y[3]);
        }
#pragma unroll
        for (int j = 0; j < 4; ++j) v[j] = vn[j];
        p = pn;
    }
}

__device__ __forceinline__ unsigned off_b(unsigned row, unsigned ch) { return 256u * row + 16u * (ch ^ (((row & 3) << 2) | ((row >> 2) & 3))); }
__device__ __forceinline__ int crow(int reg, int h) { return (reg & 3) + 8 * (reg >> 2) + 4 * h; }
__device__ __forceinline__ s16x4 tr_read(LAS unsigned char* p) { return __builtin_bit_cast(s16x4, __builtin_amdgcn_ds_read_tr16_b64_v4i16((LAS s16x4*)p)); }
__device__ __forceinline__ bf16x8 pack8(const f32x16& x, int s) {
    u32x4 p; p.x = cvtpk(x[8 * s], x[8 * s + 1]); p.y = cvtpk(x[8 * s + 2], x[8 * s + 3]); p.z = cvtpk(x[8 * s + 4], x[8 * s + 5]); p.w = cvtpk(x[8 * s + 6], x[8 * s + 7]);
    return __builtin_bit_cast(bf16x8, p);
}
#define MFMA32(a, b, c) __builtin_amdgcn_mfma_f32_32x32x16_bf16((a), (b), (c), 0, 0, 0)

constexpr int RK_STR = 528, RV_STR = 192;
constexpr int RL_K = 0, RL_V = 128 * RK_STR, RL_S = RL_V + 128 * RV_STR, RL_P = RL_S + 64 * RK_STR, RL_END = RL_P + 10 * 2048;
__device__ __forceinline__ void retention_chain_rs(Frame& F, const Args& a, int chain) {
    const int b = chain >> 5, h = (chain >> 3) & 3, dir = (chain >> 2) & 1, es = chain & 3;
    const int lane = F.lane, r = lane & 31, hh = lane >> 5, w = F.wave;
    const bool outw = w < 4; const int ib = w & 3, sw = w & 3;
    const bf16_t* RQ = (const bf16_t*)(F.ws + WS_RQ); const bf16_t* RK = (const bf16_t*)(F.ws + WS_RK); const bf16_t* RV = (const bf16_t*)(F.ws + WS_RV);
    bf16_t* OUT = (bf16_t*)(F.ws + (dir ? WS_OUTB : WS_OUTF));
    const float lg = log1pf(-__expf(a.in[6][dir * 4 + h]));
    const float decayC = __expf(lg * 128.f);
    LAS unsigned char* lds = F.lds;
    f32x16 R[4];
#pragma unroll
    for (int k = 0; k < 4; ++k)
#pragma unroll
        for (int i = 0; i < 16; ++i) R[k][i] = 0.f;
#define QFRAG(s) __builtin_bit_cast(bf16x8, (f32x4){R[(s) >> 2][4 * ((s) & 3)], R[(s) >> 2][4 * ((s) & 3) + 1], R[(s) >> 2][4 * ((s) & 3) + 2], R[(s) >> 2][4 * ((s) & 3) + 3]})
#define QLOAD(s, P) do { const f32x4 t_ = *(const f32x4*)(P); R[(s) >> 2][4 * ((s) & 3)] = t_[0]; R[(s) >> 2][4 * ((s) & 3) + 1] = t_[1]; R[(s) >> 2][4 * ((s) & 3) + 2] = t_[2]; R[(s) >> 2][4 * ((s) & 3) + 3] = t_[3]; } while (0)
    for (int i = F.tid; i < (64 * RK_STR) / 16; i += NTHR) *(LAS u32x4*)(lds + RL_S + i * 16) = (u32x4){0u, 0u, 0u, 0u};
    const int vj = F.tid >> 2, ve0 = (F.tid & 3) * 16;
    const float vscale = __expf(lg * (dir == 0 ? (float)(127 - vj) : (float)vj));
    const int blk = (lane >> 4) & 1, q4 = (lane & 15) >> 2, p4 = lane & 3;
    LAS unsigned char* kbase = lds + RL_K + r * RK_STR + 16 * hh;
    LAS unsigned char* sbase = lds + RL_S + r * RK_STR + 16 * hh;
    LAS unsigned char* vtr = lds + RL_V + (4 * hh + q4) * RV_STR + (16 * blk + 4 * p4) * 2;
    LAS unsigned char* ktr = lds + RL_K + (4 * hh + q4) * RK_STR + (sw * 64 + 16 * blk + 4 * p4) * 2;
    LAS unsigned char* spub = lds + RL_S + r * RK_STR + (sw * 64 + 4 * hh) * 2;
    const float rsc = __expf(lg * (dir == 0 ? (float)(ib * 32 + r - 127) : (float)(-(ib * 32 + r))));
    const char* RKb = (const char*)RK + (size_t)h * 512; const char* RVb = (const char*)RV + (size_t)(h * 256 + es * 64) * 2; const char* RQb = (const char*)RQ + ((size_t)((b * 4 + h) * 32) * 4 + ib) * 16384;
    char* OUTb = (char*)OUT + (size_t)(ib * 32 * DM + h * 256 + es * 64) * 2;
    const unsigned klo = (unsigned)(((F.tid >> 5) * DM + (F.tid & 31) * 8) * 2), vlo = (unsigned)((vj * DM + ve0) * 2), qlo = (unsigned)(lane * 16), olo = (unsigned)((r * DM + 4 * hh) * 2);
    u32x4 kpre[8]; u32x4 vpre[2];
    {
        const size_t t0 = (size_t)b * SEQ + (size_t)(dir == 0 ? 0 : 31) * 128;
        const char* kc = RKb + t0 * (DM * 2); const char* vc = RVb + t0 * (DM * 2); const char* qc = RQb + (size_t)(dir == 0 ? 0 : 31) * 65536;
#pragma unroll
        for (int i = 0; i < 8; ++i) kpre[i] = *(const u32x4*)(kc + (size_t)i * (16 * DM * 2) + klo);
        vpre[0] = *(const u32x4*)(vc + vlo); vpre[1] = *(const u32x4*)(vc + vlo + 16);
        if (outw) {
#pragma unroll
            for (int s = 0; s < 16; ++s) QLOAD(s, qc + qlo + 1024 * s);
        }
    }
#pragma unroll 1
    for (int n = 0; n < 32; ++n) {
        const int cidx = dir == 0 ? n : 31 - n;
        const size_t t0 = (size_t)b * SEQ + (size_t)cidx * 128;
        {
            LAS unsigned char* kw = lds + RL_K + (F.tid >> 5) * RK_STR + (F.tid & 31) * 16;
#pragma unroll
            for (int i = 0; i < 8; ++i) *(LAS u32x4*)(kw + i * 16 * RK_STR) = kpre[i];
#pragma unroll
            for (int i = 0; i < 2; ++i) {
                u32x4 o; o.x = cvtpk(bflo(vpre[i].x) * vscale, bfhi(vpre[i].x) * vscale); o.y = cvtpk(bflo(vpre[i].y) * vscale, bfhi(vpre[i].y) * vscale);
                o.z = cvtpk(bflo(vpre[i].z) * vscale, bfhi(vpre[i].z) * vscale); o.w = cvtpk(bflo(vpre[i].w) * vscale, bfhi(vpre[i].w) * vscale);
                *(LAS u32x4*)(lds + RL_V + vj * RV_STR + ve0 * 2 + 16 * i) = o;
            }
        }
        __syncthreads();
        {
            const int nn = n + 1 < 32 ? n + 1 : n; const int cn = dir == 0 ? nn : 31 - nn;
            const size_t t1 = (size_t)b * SEQ + (size_t)cn * 128;
            const char* kc = RKb + t1 * (DM * 2); const char* vc = RVb + t1 * (DM * 2);
#pragma unroll
            for (int i = 0; i < 8; ++i) kpre[i] = *(const u32x4*)(kc + (size_t)i * (16 * DM * 2) + klo);
            vpre[0] = *(const u32x4*)(vc + vlo); vpre[1] = *(const u32x4*)(vc + vlo + 16);
        }
        if (outw) {
            f32x16 acc0, acc1;
#pragma unroll
            for (int i = 0; i < 16; ++i) { acc0[i] = 0.f; acc1[i] = 0.f; }
            const int jb_lo = dir == 0 ? 0 : ib, jb_hi = dir == 0 ? ib : 3;
#pragma unroll 1
            for (int jb = jb_lo; jb <= jb_hi; ++jb) {
                LAS unsigned char* kb = kbase + jb * (32 * RK_STR);
                f32x16 sT;
#pragma unroll
                for (int i = 0; i < 16; ++i) sT[i] = 0.f;
#pragma unroll
                for (int hb = 0; hb < 2; ++hb) {
                    bf16x8 kf[8];
#pragma unroll
                    for (int s = 0; s < 8; ++s) kf[s] = *(const LAS bf16x8*)(kb + (hb * 8 + s) * 32);
                    __builtin_amdgcn_sched_barrier(0);
#pragma unroll
                    for (int s = 0; s < 8; ++s) sT = MFMA32(kf[s], QFRAG(hb * 8 + s), sT);
                    __builtin_amdgcn_sched_barrier(0);
                }
                if (jb == ib) {
#pragma unroll
                    for (int i = 0; i < 16; ++i) { const int jl = crow(i, hh); const bool keep = dir == 0 ? (jl <= r) : (jl > r); sT[i] = keep ? sT[i] : 0.f; }
                }
                const bf16x8 p0 = pack8(sT, 0), p1 = pack8(sT, 1);
                LAS unsigned char* vb = vtr + jb * (32 * RV_STR);
#pragma unroll
                for (int s2 = 0; s2 < 2; ++s2) {
                    const s16x4 l0 = tr_read(vb + s2 * (16 * RV_STR)), h0 = tr_read(vb + s2 * (16 * RV_STR) + 8 * RV_STR);
                    const s16x4 l1 = tr_read(vb + s2 * (16 * RV_STR) + 64), h1 = tr_read(vb + s2 * (16 * RV_STR) + 8 * RV_STR + 64);
                    acc0 = MFMA32(__builtin_shufflevector(l0, h0, 0, 1, 2, 3, 4, 5, 6, 7), s2 == 0 ? p0 : p1, acc0);
                    acc1 = MFMA32(__builtin_shufflevector(l1, h1, 0, 1, 2, 3, 4, 5, 6, 7), s2 == 0 ? p0 : p1, acc1);
                }
            }
#pragma unroll
            for (int hb = 0; hb < 4; ++hb) {
                bf16x8 sf0[4], sf1[4];
#pragma unroll
                for (int s = 0; s < 4; ++s) { sf0[s] = *(const LAS bf16x8*)(sbase + (hb * 4 + s) * 32); sf1[s] = *(const LAS bf16x8*)(sbase + 32 * RK_STR + (hb * 4 + s) * 32); }
                __builtin_amdgcn_sched_barrier(0);
#pragma unroll
                for (int s = 0; s < 4; ++s) { acc0 = MFMA32(sf0[s], QFRAG(hb * 4 + s), acc0); acc1 = MFMA32(sf1[s], QFRAG(hb * 4 + s), acc1); }
                __builtin_amdgcn_sched_barrier(0);
            }
            u32x2 ow[8];
#pragma unroll
            for (int g = 0; g < 4; ++g) { ow[g].x = cvtpk(acc0[4 * g] * rsc, acc0[4 * g + 1] * rsc); ow[g].y = cvtpk(acc0[4 * g + 2] * rsc, acc0[4 * g + 3] * rsc);
                ow[4 + g].x = cvtpk(acc1[4 * g] * rsc, acc1[4 * g + 1] * rsc); ow[4 + g].y = cvtpk(acc1[4 * g + 2] * rsc, acc1[4 * g + 3] * rsc); }
            {
                const int nn = n + 1 < 32 ? n + 1 : n; const int cn = dir == 0 ? nn : 31 - nn;
                const char* qc = RQb + (size_t)cn * 65536;
#pragma unroll
                for (int s = 0; s < 16; ++s) QLOAD(s, qc + qlo + 1024 * s);
            }
            {
                char* oc = OUTb + t0 * (DM * 2) + olo;
#pragma unroll
                for (int g = 0; g < 4; ++g) { *(u32x2*)(oc + g * 16) = ow[g]; *(u32x2*)(oc + 64 + g * 16) = ow[4 + g]; }
            }
        } else {
#pragma unroll
            for (int ks = 0; ks < 8; ++ks) {
                const s16x4 vl0 = tr_read(vtr + ks * (16 * RV_STR)), vh0 = tr_read(vtr + ks * (16 * RV_STR) + 8 * RV_STR);
                const s16x4 vl1 = tr_read(vtr + ks * (16 * RV_STR) + 64), vh1 = tr_read(vtr + ks * (16 * RV_STR) + 8 * RV_STR + 64);
                const bf16x8 vf0 = __builtin_shufflevector(vl0, vh0, 0, 1, 2, 3, 4, 5, 6, 7), vf1 = __builtin_shufflevector(vl1, vh1, 0, 1, 2, 3, 4, 5, 6, 7);
#pragma unroll
                for (int dd = 0; dd < 2; ++dd) {
                    const s16x4 lo = tr_read(ktr + ks * (16 * RK_STR) + dd * 64), hi = tr_read(ktr + ks * (16 * RK_STR) + 8 * RK_STR + dd * 64);
                    const bf16x8 kt = __builtin_shufflevector(lo, hi, 0, 1, 2, 3, 4, 5, 6, 7);
                    R[2 * dd] = MFMA32(kt, vf0, R[2 * dd]); R[2 * dd + 1] = MFMA32(kt, vf1, R[2 * dd + 1]);
                }
            }
#pragma unroll
            for (int k = 0; k < 4; ++k)
#pragma unroll
                for (int i = 0; i < 16; ++i) R[k][i] *= decayC;
        }
        __syncthreads();
        if (!outw) {
#pragma unroll
            for (int dd = 0; dd < 2; ++dd)
#pragma unroll
                for (int e = 0; e < 2; ++e)
#pragma unroll
                    for (int g = 0; g < 4; ++g) { u32x2 wv; wv.x = cvtpk(R[2 * dd + e][4 * g], R[2 * dd + e][4 * g + 1]); wv.y = cvtpk(R[2 * dd + e][4 * g + 2], R[2 * dd + e][4 * g + 3]);
                        *(LAS u32x2*)(spub + e * (32 * RK_STR) + dd * 64 + g * 16) = wv; }
        }
    }
    __syncthreads();
#undef QFRAG
#undef QLOAD
}

__device__ __forceinline__ u32x4 fp8x8_to_bf16(unsigned w0, unsigned w1) {
    const f32x2 a = __builtin_amdgcn_cvt_pk_f32_fp8((int)w0, false), b = __builtin_amdgcn_cvt_pk_f32_fp8((int)w0, true), c = __builtin_amdgcn_cvt_pk_f32_fp8((int)w1, false), d = __builtin_amdgcn_cvt_pk_f32_fp8((int)w1, true);
    return (u32x4){cvtpk(a.x, a.y), cvtpk(b.x, b.y), cvtpk(c.x, c.y), cvtpk(d.x, d.y)};
}
constexpr int AK_STR = 144, AV_STR = 192;
constexpr int AL_K = 0, AL_V = 384 * AK_STR, AL_B = AL_V + 384 * AV_STR, AL_END = AL_B + 896;
struct AttUnit { int g, dil, length, res, run0, b, head; };
__device__ __forceinline__ AttUnit att_decode(int slot) {
    AttUnit u; const int bh = slot / 48, k = slot % 48, ru = k & 15; u.g = k >> 4;
    u.dil = u.g == 0 ? 1 : (u.g == 1 ? 4 : 16); u.length = SEQ / u.dil; u.res = ru % u.dil; u.run0 = (ru / u.dil) * 256; u.b = bh >> 4; u.head = bh & 15; return u;
}
__device__ __forceinline__ void attention_phase(Frame& F, int u0, int u1, int zero) {
    if (u0 >= u1) return;
    const int lane = F.lane, r = lane & 31, hh = lane >> 5, w = F.wave;
    const unsigned char* AQ = F.ws + WS_AQ; const unsigned char* AK = F.ws + WS_AK; const unsigned char* AV = F.ws + WS_AV;
    LAS unsigned char* lds = F.lds;
    const int blk = (lane >> 4) & 1, q4 = (lane & 15) >> 2, p4 = lane & 3;
    LAS unsigned char* kbase = lds + AL_K + (32 * w + r) * AK_STR + 16 * hh;
    LAS unsigned char* vbase = lds + AL_V + (32 * w + 4 * hh + q4) * AV_STR + (16 * blk + 4 * p4) * 2;
    const LAS float* bt = (const LAS float*)(lds + AL_B) + (4 * hh - r + 32);
    u32x4 kk[3], vv[3]; u32x2 qn[4]; float bnext = 0.f;
    u32x4 kk2[3], vv2[3]; u32x2 qn2[4]; float bnext2 = 0.f;
#define ATT_LOAD(U) do { const AttUnit un_ = att_decode(U); \
        if (F.tid < 224) { const int X_ = F.tid - 32; bnext = (X_ >= 0 && X_ <= 128) ? ((const float*)(F.ws + WS_BTAB))[(un_.g * 16 + un_.head) * 160 + X_] : 0.f; } \
        _Pragma("unroll") for (int i = 0; i < 3; ++i) { const int id = F.tid + i * NTHR, row = id >> 2, ch = id & 3; int idx = un_.run0 - 64 + row; idx = idx < 0 ? 0 : (idx >= un_.length ? un_.length - 1 : idx); \
            const size_t off = ((size_t)un_.b * SEQ + (size_t)idx * un_.dil + un_.res) * DM + un_.head * 64 + ch * 16; kk[i] = *(const u32x4*)(AK + off); vv[i] = *(const u32x4*)(AV + off); } \
        const size_t qt_ = (size_t)un_.b * SEQ + (size_t)(un_.run0 + 32 * w + r) * un_.dil + un_.res; \
        _Pragma("unroll") for (int s = 0; s < 4; ++s) qn[s] = *(const u32x2*)(AQ + qt_ * DM + un_.head * 64 + 16 * s + 8 * hh); } while (0)
#define ATT_LOAD2(U) do { const AttUnit un_ = att_decode(U); \
        if (F.tid < 224) { const int X_ = F.tid - 32; bnext2 = (X_ >= 0 && X_ <= 128) ? ((const float*)(F.ws + WS_BTAB))[(un_.g * 16 + un_.head) * 160 + X_] : 0.f; } \
        _Pragma("unroll") for (int i = 0; i < 3; ++i) { const int id = F.tid + i * NTHR, row = id >> 2, ch = id & 3; int idx = un_.run0 - 64 + row; idx = idx < 0 ? 0 : (idx >= un_.length ? un_.length - 1 : idx); \
            const size_t off = ((size_t)un_.b * SEQ + (size_t)idx * un_.dil + un_.res) * DM + un_.head * 64 + ch * 16; kk2[i] = *(const u32x4*)(AK + off); vv2[i] = *(const u32x4*)(AV + off); } \
        const size_t qt_ = (size_t)un_.b * SEQ + (size_t)(un_.run0 + 32 * w + r) * un_.dil + un_.res; \
        _Pragma("unroll") for (int s = 0; s < 4; ++s) qn2[s] = *(const u32x2*)(AQ + qt_ * DM + un_.head * 64 + 16 * s + 8 * hh); } while (0)
    const int nun = u1 - u0, nit = nun * (PROBE_PHASE == 31 ? 2 : 1);
#define ATT_SLOT(I) (u0 + ((I) >= nit ? nun - 1 : ((I) >= nun ? (I) - nun : (I))))
    ATT_LOAD(ATT_SLOT(0)); ATT_LOAD2(ATT_SLOT(1));
#pragma unroll 1
    for (int it = 0; it < nit; ++it) {
        const int unit = u0 + (it >= nun ? it - nun : it);
        const AttUnit un = att_decode(unit);
        unsigned char* OG = F.ws + WS_OG + (size_t)un.g * (SEG / 2); float* LSE = (float*)(F.ws + WS_LSE) + (size_t)un.g * NTOK * 16;
#pragma unroll
        for (int i = 0; i < 3; ++i) { const int id = F.tid + i * NTHR, row = id >> 2, ch = id & 3;
            *(LAS u32x4*)(lds + AL_K + row * AK_STR + 32 * ch) = fp8x8_to_bf16(kk[i].x, kk[i].y); *(LAS u32x4*)(lds + AL_K + row * AK_STR + 32 * ch + 16) = fp8x8_to_bf16(kk[i].z, kk[i].w);
            *(LAS u32x4*)(lds + AL_V + row * AV_STR + 32 * ch) = fp8x8_to_bf16(vv[i].x, vv[i].y); *(LAS u32x4*)(lds + AL_V + row * AV_STR + 32 * ch + 16) = fp8x8_to_bf16(vv[i].z, vv[i].w); }
        if (F.tid < 224) ((LAS float*)(lds + AL_B))[F.tid] = bnext;
        bf16x8 qf[4];
#pragma unroll
        for (int s = 0; s < 4; ++s) qf[s] = __builtin_bit_cast(bf16x8, fp8x8_to_bf16(qn[s].x, qn[s].y));
        __syncthreads();
#pragma unroll
        for (int i = 0; i < 3; ++i) { kk[i] = kk2[i]; vv[i] = vv2[i]; }
#pragma unroll
        for (int s = 0; s < 4; ++s) qn[s] = qn2[s];
        bnext = bnext2;
        ATT_LOAD2(ATT_SLOT(it + 2));
        const size_t qtok = (size_t)un.b * SEQ + (size_t)(un.run0 + 32 * w + r) * un.dil + un.res;
        const int lv = 4 * hh - r, kv = un.run0 - 64 + 32 * w + 4 * hh;
        const int clo = max(-lv, -kv), chi = min(128 - lv, un.length - 1 - kv);
        const bool edge = (un.run0 == 0) || (un.run0 + 256 == un.length);
        float m = -3.0e38f, lsum = 0.f;
        f32x16 o0, o1;
#pragma unroll 1
        for (int rc_ = 0; rc_ < (PROBE_PHASE == 33 ? 2 + zero : 1); ++rc_) {
        m = -3.0e38f; lsum = 0.f;
#pragma unroll
        for (int i = 0; i < 16; ++i) { o0[i] = 0.f; o1[i] = 0.f; }
#pragma unroll
        for (int kb = 0; kb < 5; ++kb) {
            f32x16 sT;
#pragma unroll
            for (int i = 0; i < 16; ++i) sT[i] = 0.f;
#pragma unroll
            for (int s = 0; s < 4; ++s) sT = MFMA32(*(const LAS bf16x8*)(kbase + kb * (32 * AK_STR) + s * 32), qf[s], sT);
            float bv[16];
#pragma unroll
            for (int i = 0; i < 16; ++i) bv[i] = bt[32 * kb + (i & 3) + 8 * (i >> 2)];
            const bool masked = (kb == 0) || (kb == 4) || edge;
            float bm = -3.0e38f;
            if (masked) {
#pragma unroll
                for (int i = 0; i < 16; ++i) { const int c = 32 * kb + (i & 3) + 8 * (i >> 2); const bool valid = (c >= clo) && (c <= chi);
                    const float sv = sT[i] * (1.0f / 256.0f) + bv[i]; sT[i] = valid ? sv : -3.0e38f; bm = fmaxf(bm, sT[i]); }
            } else {
#pragma unroll
                for (int i = 0; i < 16; ++i) { sT[i] = sT[i] * (1.0f / 256.0f) + bv[i]; bm = fmaxf(bm, sT[i]); }
            }
            bm = fmaxf(bm, __shfl_xor(bm, 32));
            const float mn = fmaxf(m, bm), alpha = __builtin_amdgcn_exp2f(m - mn);
            if (kb > 0 && __any(mn > m)) {
#pragma unroll
                for (int i = 0; i < 16; ++i) { o0[i] *= alpha; o1[i] *= alpha; }
            }
            m = mn; lsum *= alpha;
            if (masked) {
#pragma unroll
                for (int i = 0; i < 16; ++i) { const float p = sT[i] > -1.0e38f ? __builtin_amdgcn_exp2f(sT[i] - mn) : 0.f; sT[i] = p; lsum += p; }
            } else {
#pragma unroll
                for (int i = 0; i < 16; ++i) { const float p = __builtin_amdgcn_exp2f(sT[i] - mn); sT[i] = p; lsum += p; }
            }
#pragma unroll
            for (int s2 = 0; s2 < 2; ++s2) {
                const bf16x8 pb = pack8(sT, s2);
#pragma unroll
                for (int e2 = 0; e2 < 2; ++e2) {
                    const s16x4 lo = tr_read(vbase + kb * (32 * AV_STR) + s2 * (16 * AV_STR) + e2 * 64);
                    const s16x4 hi = tr_read(vbase + kb * (32 * AV_STR) + s2 * (16 * AV_STR) + 8 * AV_STR + e2 * 64);
                    const bf16x8 vf = __builtin_shufflevector(lo, hi, 0, 1, 2, 3, 4, 5, 6, 7);
                    if (e2 == 0) o0 = MFMA32(vf, pb, o0); else o1 = MFMA32(vf, pb, o1);
                }
            }
        }
        }
        lsum += __shfl_xor(lsum, 32);
        if (hh == 0) LSE[qtok * 16 + un.head] = (m + __log2f(lsum)) * 0.6931471805599453f;
        const float linv = YD_INV / lsum;
        __syncthreads();
#pragma unroll 1
        for (int rs_ = 0; rs_ < (PROBE_PHASE == 34 ? 2 + zero : 1); ++rs_)
        {
            LAS unsigned char* ost = lds + AL_K + w * (32 * AK_STR);
#pragma unroll
            for (int g = 0; g < 4; ++g) {
                u32x2 a0, a1; a0.x = cvtpk(o0[4 * g] * linv, o0[4 * g + 1] * linv); a0.y = cvtpk(o0[4 * g + 2] * linv, o0[4 * g + 3] * linv);
                a1.x = cvtpk(o1[4 * g] * linv, o1[4 * g + 1] * linv); a1.y = cvtpk(o1[4 * g + 2] * linv, o1[4 * g + 3] * linv);
                *(LAS u32x2*)(ost + r * AK_STR + 16 * g + 8 * hh) = a0; *(LAS u32x2*)(ost + r * AK_STR + 64 + 16 * g + 8 * hh) = a1;
            }
            asm volatile("s_waitcnt lgkmcnt(0)" ::: "memory");
#pragma unroll
            for (int it = 0; it < 4; ++it) {
                const int ql = 8 * it + (lane >> 3);
                const u32x4 v = *(const LAS u32x4*)(ost + ql * AK_STR + 16 * (lane & 7));
                const size_t tok = (size_t)un.b * SEQ + (size_t)(un.run0 + 32 * w + ql) * un.dil + un.res;
                u32x2 f8; f8.x = pk4_fp8(bflo(v.x), bfhi(v.x), bflo(v.y), bfhi(v.y)); f8.y = pk4_fp8(bflo(v.z), bfhi(v.z), bflo(v.w), bfhi(v.w));
                __builtin_nontemporal_store(f8, (u32x2*)(OG + tok * DM + un.head * 64 + 8 * (lane & 7)));
            }
        }
        __syncthreads();
    }
#undef ATT_LOAD
#undef ATT_LOAD2
#undef ATT_SLOT
}

__device__ __forceinline__ void mixer_post_rows(Frame& F) {
    const int gw = F.vcu * NWAVES + F.wave, NGW = F.G * NWAVES, lane = F.lane;
    const bf16_t* OF = (const bf16_t*)(F.ws + WS_OUTF); const bf16_t* OB = (const bf16_t*)(F.ws + WS_OUTB); const unsigned char* SG = (F.ws + WS_RG);
    const unsigned char* OG = F.ws + WS_OG; const float* LSE = (const float*)(F.ws + WS_LSE);
    unsigned char* RN = F.ws + WS_RETN; unsigned char* AC = F.ws + WS_ATTC;
    const int head = lane >> 2;
    u32x2 fa[4], fb[4], na[4], nb[4]; unsigned sg[4], nsg[4]; u32x4 og[3], nog[3]; float ls[3], nls[3];
#define MP_LOAD(A, B, S, O, L, ROW) do { _Pragma("unroll") for (int h = 0; h < 4; ++h) { const size_t off_ = (size_t)(ROW) * DM + h * 256 + 4 * lane; \
            A[h] = *(const u32x2*)(OF + off_); B[h] = *(const u32x2*)(OB + off_); S[h] = *(const unsigned*)(SG + off_); } \
        _Pragma("unroll") for (int g = 0; g < 3; ++g) { O[g] = *(const u32x4*)(OG + (size_t)g * NTOK * DM + (size_t)(ROW) * DM + 16 * lane); L[g] = LSE[((size_t)g * NTOK + (ROW)) * 16 + head]; } } while (0)
    if (gw >= NTOK) return;
    MP_LOAD(fa, fb, sg, og, ls, gw);
#pragma unroll 1
    for (int row = gw; row < NTOK; row += NGW) {
        const int rn = row + NGW < NTOK ? row + NGW : row;
        MP_LOAD(na, nb, nsg, nog, nls, rn);
        f32x4 v[4];
#pragma unroll
        for (int h = 0; h < 4; ++h) v[h] = (f32x4){bflo(fa[h].x) + bflo(fb[h].x), bfhi(fa[h].x) + bfhi(fb[h].x), bflo(fa[h].y) + bflo(fb[h].y), bfhi(fa[h].y) + bfhi(fb[h].y)};
#pragma unroll
        for (int h = 0; h < 4; ++h) {
            const float mu = wave_sum((v[h][0] + v[h][1]) + (v[h][2] + v[h][3])) * (1.f / 256.f);
            const f32x4 d = v[h] - mu;
            const float var = wave_sum((d[0] * d[0] + d[1] * d[1]) + (d[2] * d[2] + d[3] * d[3])) * (1.f / 256.f);
            const float rs = rsqrtf(var + NORM_EPS);
            const f32x2 g01 = __builtin_amdgcn_cvt_pk_f32_fp8((int)sg[h], false), g23 = __builtin_amdgcn_cvt_pk_f32_fp8((int)sg[h], true); const float rq = rs * YD_INV;
            *(unsigned*)(RN + (size_t)row * DM + h * 256 + 4 * lane) = pk4_fp8(d[0] * rq * g01.x, d[1] * rq * g01.y, d[2] * rq * g23.x, d[3] * rq * g23.y);
        }
        const float lm = fmaxf(ls[0], fmaxf(ls[1], ls[2]));
        float wg[3]; float wsum = 0.f;
#pragma unroll
        for (int g = 0; g < 3; ++g) { wg[g] = __expf(ls[g] - lm); wsum += wg[g]; }
        const float winv = 1.f / wsum;
        unsigned res[4];
#pragma unroll
        for (int wI = 0; wI < 4; ++wI) {
            float a0 = 0.f, a1 = 0.f, a2 = 0.f, a3 = 0.f;
#pragma unroll
            for (int g = 0; g < 3; ++g) { const int wd = (int)(wI == 0 ? og[g].x : (wI == 1 ? og[g].y : (wI == 2 ? og[g].z : og[g].w)));
                const f32x2 p0 = __builtin_amdgcn_cvt_pk_f32_fp8(wd, false), p1 = __builtin_amdgcn_cvt_pk_f32_fp8(wd, true);
                a0 += wg[g] * p0.x; a1 += wg[g] * p0.y; a2 += wg[g] * p1.x; a3 += wg[g] * p1.y; }
            const float sc = winv * YD_INV;
            res[wI] = pk4_fp8(a0 * sc, a1 * sc, a2 * sc, a3 * sc);
        }
        *(u32x4*)(AC + (size_t)row * DM + 16 * lane) = (u32x4){res[0], res[1], res[2], res[3]};
#pragma unroll
        for (int h = 0; h < 4; ++h) { fa[h] = na[h]; fb[h] = nb[h]; sg[h] = nsg[h]; }
#pragma unroll
        for (int g = 0; g < 3; ++g) { og[g] = nog[g]; ls[g] = nls[g]; }
    }
#undef MP_LOAD
}

__device__ __forceinline__ void routing_rows(Frame& F, const Args& a) {
    const int gw = F.vcu * NWAVES + F.wave, NGW = F.G * NWAVES, lane = F.lane;
    const float* LOG = (const float*)(F.ws + WS_LOGIT); const float* rb = a.in[13];
    int* EIDX = (int*)(F.ws + WS_EIDX); float* GATE = (float*)(F.ws + WS_GATE);
    LAS unsigned* hist = (LAS unsigned*)(F.lds);
    for (int i = F.tid; i < NEXP; i += NTHR) hist[i] = 0u;
    __syncthreads();
    const f32x4 bias = *(const f32x4*)(rb + 4 * lane);
    for (int row = gw; row < NTOK; row += NGW) {
        const f32x4 lg = *(const f32x4*)(LOG + (size_t)row * NEXP + 4 * lane);
        float sc[4], ch[4];
#pragma unroll
        for (int i = 0; i < 4; ++i) { sc[i] = 1.f / (1.f + expf(-lg[i])); ch[i] = sc[i] + bias[i]; }
        float m1 = fmaxf(ch[0], ch[1]), m2 = fminf(ch[0], ch[1]);
        { const float c2 = ch[2]; const float n1 = fmaxf(m1, c2); m2 = fmaxf(m2, fminf(m1, c2)); m1 = n1; }
        { const float c3 = ch[3]; const float n1 = fmaxf(m1, c3); m2 = fmaxf(m2, fminf(m1, c3)); m1 = n1; }
#pragma unroll
        for (int o = 1; o < 8; o <<= 1) { const float b1 = __shfl_xor(m1, o), b2 = __shfl_xor(m2, o);
            const float n1 = fmaxf(m1, b1); const float n2 = fmaxf(fminf(m1, b1), fmaxf(m2, b2)); m1 = n1; m2 = n2; }
        const float gs = m1 + m2; const int mygrp = lane >> 3;
        int rank = 0;
#pragma unroll
        for (int g = 0; g < 8; ++g) { const float og = __shfl(gs, g * 8); rank += (og > gs || (og == gs && g < mygrp)) ? 1 : 0; }
        const bool elig = rank < 4;
        float cv[4];
#pragma unroll
        for (int i = 0; i < 4; ++i) cv[i] = elig ? ch[i] : -3.0e38f;
        float gsel = 0.f; int esel = 0; float gsum = 0.f;
#pragma unroll
        for (int k = 0; k < TOPK; ++k) {
            float bv = cv[0]; int bi = 4 * lane;
#pragma unroll
            for (int i = 1; i < 4; ++i) if (cv[i] > bv) { bv = cv[i]; bi = 4 * lane + i; }
#pragma unroll
            for (int o = 1; o < 64; o <<= 1) { const float ov = __shfl_xor(bv, o); const int oi = __shfl_xor(bi, o); if (ov > bv || (ov == bv && oi < bi)) { bv = ov; bi = oi; } }
            const int own = bi >> 2, el = bi & 3;
            const float mine = el == 0 ? sc[0] : (el == 1 ? sc[1] : (el == 2 ? sc[2] : sc[3]));
            const float s = __shfl(mine, own);
            if (lane == own) { if (el == 0) cv[0] = -3.0e38f; else if (el == 1) cv[1] = -3.0e38f; else if (el == 2) cv[2] = -3.0e38f; else cv[3] = -3.0e38f; }
            gsum += s;
            if (lane == k) { gsel = s; esel = bi; }
        }
        if (lane < TOPK) { EIDX[row * TOPK + lane] = esel; GATE[row * TOPK + lane] = gsel / gsum * 2.5f; __hip_atomic_fetch_add(&hist[esel], 1u, __ATOMIC_RELAXED, __HIP_MEMORY_SCOPE_WORKGROUP); }
    }
    __syncthreads();
    for (int i = F.tid; i < NEXP; i += NTHR) if (hist[i]) atomicAdd((unsigned*)(F.ws + WS_CTL) + CW_CNT + i, hist[i]);
}

__device__ __forceinline__ void routing_lists(Frame& F) {
    LAS unsigned* cnt = (LAS unsigned*)(F.lds);
    LAS unsigned* pstart = cnt + 256;
    LAS unsigned* lh = pstart + 264;
    LAS unsigned* lbase = lh + 256;
    LAS unsigned* ustart = lbase + 256;
    int* DPOS = (int*)(F.ws + WS_DPOS);
    unsigned* ctl = (unsigned*)(F.ws + WS_CTL);
    const int* EIDX = (const int*)(F.ws + WS_EIDX); int* ROWL = (int*)(F.ws + WS_ROWL); int* TILE_E = (int*)(F.ws + WS_TILE_E);
    for (int i = F.tid; i < NEXP; i += NTHR) { cnt[i] = __hip_atomic_load(ctl + CW_CNT + i, RLX_AGENT); lh[i] = 0u; }
    __syncthreads();
    if (F.tid == 0) { unsigned s = 0, us = 0; for (int e = 0; e < NEXP; ++e) { pstart[e] = s; ustart[e] = us; s += (cnt[e] + 255u) & ~255u; us += cnt[e]; } pstart[NEXP] = s; }
    __syncthreads();
    const unsigned ptotal = pstart[NEXP];
    const int per = (NTOK + F.G - 1) / F.G, tk0 = F.vcu * per, tk1 = (tk0 + per) < NTOK ? (tk0 + per) : NTOK;
    for (int i = tk0 * TOPK + F.tid; i < tk1 * TOPK; i += NTHR) __hip_atomic_fetch_add(&lh[EIDX[i]], 1u, __ATOMIC_RELAXED, __HIP_MEMORY_SCOPE_WORKGROUP);
    __syncthreads();
    for (int e = F.tid; e < NEXP; e += NTHR) { const unsigned c = lh[e]; lbase[e] = c ? atomicAdd(ctl + CW_FILL + e, c) : 0u; lh[e] = 0u; }
    __syncthreads();
    for (int i = tk0 * TOPK + F.tid; i < tk1 * TOPK; i += NTHR) { const int e = EIDX[i]; const unsigned p = __hip_atomic_fetch_add(&lh[e], 1u, __ATOMIC_RELAXED, __HIP_MEMORY_SCOPE_WORKGROUP);
        ROWL[pstart[e] + lbase[e] + p] = (i >> 3) * 16 + (i & 7); DPOS[i] = (int)(ustart[e] + lbase[e] + p); }
    for (int t = tk0 + F.tid; t < tk1; t += NTHR) ROWL[ptotal + t] = t * 16 + 8;
    for (int e = F.vcu; e < NEXP; e += F.G) { const unsigned s = pstart[e] + cnt[e], en = pstart[e + 1]; for (unsigned p = s + F.tid; p < en; p += NTHR) ROWL[p] = -1; }
    if (F.vcu == 0) {
        const int nrt = (int)(ptotal >> 8);
        for (int e = F.tid; e < NEXP; e += NTHR) { for (unsigned t = pstart[e] >> 8; t < (pstart[e + 1] >> 8); ++t) TILE_E[t] = e; TILE_E[4096 + e] = (int)(pstart[e] - ustart[e]); TILE_E[8192 + e] = (int)(pstart[e] + cnt[e]); }
        for (int t = F.tid; t < NTOK / 256; t += NTHR) TILE_E[nrt + t] = NEXP;
        if (F.tid == 0) { TILE_E[4096 + NEXP] = (int)ptotal - YD_SHARED0; TILE_E[8192 + NEXP] = (int)ptotal + NTOK; }
        if (F.tid == 0) TILE_E[MAX_TILES] = nrt + NTOK / 256;
    }
}

__device__ __forceinline__ void final_rows(Frame& F, const Args& a) {
    const int gw = F.vcu * NWAVES + F.wave, NGW = F.G * NWAVES, lane = F.lane;
    const float* mod = (const float*)(F.ws + WS_MOD); const float* nf = a.in[20];
    const int* DPOS = (const int*)(F.ws + WS_DPOS); const float* GATE = (const float*)(F.ws + WS_GATE);
    f32x4 g4[4];
#pragma unroll
    for (int j = 0; j < 4; ++j) g4[j] = *(const f32x4*)(nf + 4 * lane + 256 * j);
    if (gw >= NTOK) return;
    auto clampr = [&](int r) { return r < NTOK ? r : gw; };
    int dcur = DPOS[clampr(gw) * 8 + (lane & 7)]; float gcur = GATE[clampr(gw) * 8 + (lane & 7)];
    int dnxt = DPOS[clampr(gw + NGW) * 8 + (lane & 7)]; float gnxt = GATE[clampr(gw + NGW) * 8 + (lane & 7)];
    f32x4 xw[4], xn[4]; int yw[9][4], yn[9][4];
#define FIN_LOAD(XW, YW, ROW, DV) do { const u32x2* xr_ = (const u32x2*)((const bf16_t*)(F.ws + WS_X1B) + (size_t)(ROW) * DM) + lane; \
        _Pragma("unroll") for (int j = 0; j < 4; ++j) { const u32x2 t_ = xr_[64 * j]; XW[j] = (f32x4){bflo(t_.x), bfhi(t_.x), bflo(t_.y), bfhi(t_.y)}; } \
        _Pragma("unroll") for (int k = 0; k < 9; ++k) { const unsigned char* yr_ = ydense_row(F.ws, k < 8 ? __builtin_amdgcn_readlane((DV), k) : YD_SHARED0 + (ROW)) + 4 * lane; \
            _Pragma("unroll") for (int j = 0; j < 4; ++j) YW[k][j] = *(const int*)(yr_ + 256 * j); } } while (0)
    FIN_LOAD(xw, yw, gw, dcur);
#pragma unroll 1
    for (int row = gw; row < NTOK; row += NGW) {
        const int rn = clampr(row + NGW), rn2 = clampr(row + 2 * NGW);
        FIN_LOAD(xn, yn, rn, dnxt);
        const int dn2 = DPOS[rn2 * 8 + (lane & 7)]; const float gn2 = GATE[rn2 * 8 + (lane & 7)];
        const int b = row / SEQ;
        f32x4 v[4]; float s = 0.f;
#pragma unroll
        for (int j = 0; j < 4; ++j) {
            const int col = 4 * lane + 256 * j;
            f32x4 y = (f32x4){0.f, 0.f, 0.f, 0.f};
#pragma unroll
            for (int k = 0; k < 9; ++k) { const int wv = yw[k][j]; const float gk = (k < 8 ? __uint_as_float(__builtin_amdgcn_readlane(__float_as_uint(gcur), k)) : 1.0f) * YD_INV;
                const f32x2 lo = __builtin_amdgcn_cvt_pk_f32_fp8(wv, false), hi = __builtin_amdgcn_cvt_pk_f32_fp8(wv, true);
                y[0] += gk * lo.x; y[1] += gk * lo.y; y[2] += gk * hi.x; y[3] += gk * hi.y; }
            const f32x4 gf = *(const f32x4*)(mod + (size_t)b * 6144 + 5 * DM + col);
            v[j] = xw[j] + gf * y;
            s += (v[j][0] * v[j][0] + v[j][1] * v[j][1]) + (v[j][2] * v[j][2] + v[j][3] * v[j][3]);
        }
        const float rstd = rsqrtf(wave_sum(s) * (1.f / DM) + NORM_EPS);
        f32x4* xo = (f32x4*)(a.out + (size_t)row * DM) + lane;
#pragma unroll
        for (int j = 0; j < 4; ++j) xo[64 * j] = (v[j] * rstd) * g4[j];
#pragma unroll
        for (int j = 0; j < 4; ++j) xw[j] = xn[j];
#pragma unroll
        for (int k = 0; k < 9; ++k)
#pragma unroll
            for (int j = 0; j < 4; ++j) yw[k][j] = yn[k][j];
        dcur = dnxt; gcur = gnxt; dnxt = dn2; gnxt = gn2;
    }
#undef FIN_LOAD
}

constexpr int MT_OFF = 131072, MT_INFO = MT_OFF + 4096;
__device__ __forceinline__ void moe_tables_to_lds(Frame& F, int ntiles) {
    const int* TILE_E = (const int*)(F.ws + WS_TILE_E);
    LAS unsigned short* te = (LAS unsigned short*)(F.lds + MT_OFF); LAS int* info = (LAS int*)(F.lds + MT_INFO);
    for (int t = F.tid; t < ntiles; t += NTHR) te[t] = (unsigned short)TILE_E[t];
    for (int e = F.tid; e <= NEXP; e += NTHR) { info[e] = TILE_E[4096 + e]; info[512 + e] = TILE_E[8192 + e]; }
    __syncthreads();
}
constexpr int DW_STR = 192;
constexpr int DW_BUF = 256 * DW_STR;
typedef float f32x4_t __attribute__((ext_vector_type(4)));
#define MFMA16(a, b, c) __builtin_amdgcn_mfma_f32_16x16x32_bf16((a), (b), (c), 0, 0, 0)
template <int MODE> __device__ __forceinline__ void down_phase(Frame& F, const Args& a) {
    const int* TILE_E = (const int*)(F.ws + WS_TILE_E); const int ntiles = __builtin_amdgcn_readfirstlane(TILE_E[MAX_TILES]);
    moe_tables_to_lds(F, ntiles);
    const LAS unsigned short* tile_e = (const LAS unsigned short*)(F.lds + MT_OFF); const LAS int* info = (const LAS int*)(F.lds + MT_INFO);
    const int lane = F.lane, w = F.wave, fr = lane & 15, g4 = lane >> 4;
    LAS unsigned char* lds = F.lds;
    const bf16_t* HID = (const bf16_t*)(F.ws + WS_HID);
    const int sk = F.tid >> 4, sn4 = F.tid & 15;
    const int spos = 16 * (sn4 & 3) + 4 * (sn4 >> 2);
    const int q4 = (lane & 15) >> 2, p4 = lane & 3;
    auto next_tile = [&](int i) -> int { const long L = (long)i * F.G + (int)blockIdx.x; return L < ntiles ? pg8::xcd_remap((int)L, ntiles) : -1; };
    int ui = 0, tile = next_tile(0);
    if (tile < 0) return;
    f32x4_t st[8], st2[8];
    auto wd_base = [&](int t) -> const float* { const int e = MODE == 1 ? 0 : (int)tile_e[t]; return e < NEXP ? a.in[16] + (size_t)e * (EH * DM) : a.in[19]; };
#define DW_LOAD(R, WB, C) do { const float* p_ = (WB) + (size_t)sk * DM + (C) * 64 + sn4 * 4; _Pragma("unroll") for (int i = 0; i < 8; ++i) R[i] = *(const f32x4_t*)(p_ + (size_t)i * 32 * DM); } while (0)
#define DW_WRITE(R, SLOT) do { _Pragma("unroll") for (int i = 0; i < 8; ++i) { const int k_ = sk + 32 * i; u32x2 w_; w_.x = cvtpk(R[i][0], R[i][1]); w_.y = cvtpk(R[i][2], R[i][3]); \
        *(LAS u32x2*)(lds + (SLOT) * DW_BUF + k_ * DW_STR + (((spos >> 4) ^ ((k_ >> 3) & 1)) << 5) + (spos & 15) * 2) = w_; } } while (0)
    const float* wb = wd_base(tile);
    int ntile = next_tile(1);
    const float* nwb = ntile >= 0 ? wd_base(ntile) : wb;
    DW_LOAD(st, wb, 0); DW_WRITE(st, 0);
    DW_LOAD(st, wb, 1); DW_LOAD(st2, wb, 2);
    __syncthreads();
    int cc = 0;
    for (;;) {
        const int e = (int)tile_e[tile]; const int shift = info[e], lim = info[512 + e];
        bf16x8 af[2][8];
        { const bf16_t* hp = HID + ((size_t)tile * 256 + 32 * w + fr) * EH + 8 * g4;
#pragma unroll
          for (int m = 0; m < 2; ++m)
#pragma unroll
              for (int ks = 0; ks < 8; ++ks) af[m][ks] = *(const bf16x8*)(hp + (size_t)m * 16 * EH + 32 * ks);
#pragma unroll
          for (int m = 0; m < 2; ++m)
#pragma unroll
              for (int ks = 0; ks < 8; ++ks) asm volatile("" : "+v"(af[m][ks])); }
        const int pos0 = tile * 256 + 32 * w + fr;
#pragma unroll 1
        for (int c = 0; c < 16; c += 2) {
#pragma unroll
            for (int hc = 0; hc < 2; ++hc, ++cc) {
                const int cq = c + hc;
                f32x4 acc[2][4];
                if (MODE == 3) {
#pragma unroll
                    for (int m = 0; m < 2; ++m)
#pragma unroll
                        for (int nf = 0; nf < 4; ++nf) acc[m][nf] = (f32x4){0.f, 0.f, 0.f, 0.f}; }
                LAS unsigned char* bb = lds + (cc & 1) * DW_BUF + (8 * g4 + q4) * DW_STR + 8 * p4;
#pragma unroll 1
                for (int rp_ = 0; rp_ < (MODE == 3 ? a.pad : (PROBE_PHASE == 40 ? 2 + a.pad : 1)); ++rp_) {
#pragma unroll
                for (int m = 0; m < 2; ++m)
#pragma unroll
                    for (int nf = 0; nf < 4; ++nf) acc[m][nf] = (f32x4){0.f, 0.f, 0.f, 0.f};
#pragma unroll
                for (int ks = 0; ks < 8; ++ks) {
#pragma unroll
                    for (int nf = 0; nf < 4; ++nf) {
                        LAS unsigned char* pp = bb + ks * (32 * DW_STR) + ((nf ^ (g4 & 1)) << 5);
                        const s16x4 lo = tr_read(pp), hi = tr_read(pp + 4 * DW_STR);
                        const bf16x8 bf = __builtin_shufflevector(lo, hi, 0, 1, 2, 3, 4, 5, 6, 7);
                        acc[0][nf] = MFMA16(bf, af[0][ks], acc[0][nf]); acc[1][nf] = MFMA16(bf, af[1][ks], acc[1][nf]);
                    }
                }
                }
                u32x4 ow[2];
#pragma unroll
                for (int m = 0; m < 2; ++m) { ow[m].x = pk4_fp8(acc[m][0][0], acc[m][0][1], acc[m][0][2], acc[m][0][3]); ow[m].y = pk4_fp8(acc[m][1][0], acc[m][1][1], acc[m][1][2], acc[m][1][3]);
                    ow[m].z = pk4_fp8(acc[m][2][0], acc[m][2][1], acc[m][2][2], acc[m][2][3]); ow[m].w = pk4_fp8(acc[m][3][0], acc[m][3][1], acc[m][3][2], acc[m][3][3]); }
                const int c3 = cq + 3; const float* b3 = c3 < 16 ? wb : nwb; const int k3 = c3 < 16 ? c3 : c3 - 16;
                if (hc == 0) { DW_WRITE(st, (cc + 1) & 1); DW_LOAD(st, b3, k3); } else { DW_WRITE(st2, (cc + 1) & 1); DW_LOAD(st2, b3, k3); }
#pragma unroll
                for (int m = 0; m < 2; ++m) {
                    const int pos = pos0 + 16 * m;
                    unsigned char* rowp = (pos < lim ? ydense_row(F.ws, pos - shift) : F.ws + WS_SS + (size_t)blockIdx.x * 2048) + 64 * cq + 16 * g4;
                    if (MODE >= 2) asm volatile("" :: "v"(ow[m])); else *(u32x4*)rowp = ow[m];
                }
                __syncthreads();
            }
        }
        if (ntile < 0) break;
        tile = ntile; wb = nwb; ++ui;
        ntile = next_tile(ui + 1); nwb = ntile >= 0 ? wd_base(ntile) : wb;
    }
#undef DW_LOAD
#undef DW_WRITE
}

constexpr int N_PHASES = 13;
__global__ void __launch_bounds__(NTHR, 2) fwd_kernel(Args args) {
    extern __shared__ __attribute__((aligned(16))) unsigned char lds_raw[];
    Frame F;
    F.lds = (LAS unsigned char*)lds_raw; F.ws = args.ws;
    F.tid = threadIdx.x; F.lane = F.tid & 63; F.wave = __builtin_amdgcn_readfirstlane(F.tid >> 6);
    F.G = gridDim.x; { const int bx = blockIdx.x; F.vcu = (F.G % 8 == 0) ? (bx % 8) * (F.G / 8) + bx / 8 : bx; }
    volatile LAS unsigned* MISC = (volatile LAS unsigned*)(F.lds + MISC_OFF);
    for (int u = F.tid; u < (LDS_BYTES - LDSCTL_OFF) / 4; u += NTHR) ((LAS unsigned*)(F.lds + LDSCTL_OFF))[u] = 0u;
    __syncthreads();
    unsigned* ctl = (unsigned*)(F.ws + WS_CTL);
    XcdBarrier bar; bar.bar = ctl + CW_BAR; bar.x = 0; bar.st = nullptr;
    const int lo = args.ph_lo, hi = args.ph_hi;
    if (hi - lo > 1) bar = xcd_barrier_post(ctl + CW_BAR, MISC + 8);
#ifdef ONLY_PHASE
#define IN(k) ((k) == ONLY_PHASE && lo <= (k) && (k) < hi)
#else
#define IN(k) (lo <= (k) && (k) < hi)
#endif
#define SEAM(k) do { if (IN(k) && IN((k) + 1)) xcd_barrier(bar); } while (0)
#ifndef PROBE_PHASE
#define PROBE_PHASE -1
#endif
#define REP(k) _Pragma("unroll 1") for (int rep_ = 0; rep_ < ((k) == PROBE_PHASE ? 2 + args.pad : 1); ++rep_)
    const float* mod = (const float*)(F.ws + WS_MOD);
    bf16_t* HB = (bf16_t*)(F.ws + WS_H);

    if (IN(0)) REP(0) { phase0(F, args); } SEAM(0);
    if (IN(1)) REP(1) { norm_mod_rows<false, 1>(F, args.in[0], args.in[4], mod, 0, DM, nullptr, HB, F.ws + WS_H8); } SEAM(1);
    if (IN(2)) REP(2) {
        EpiInProj E{F.ws, (const u32x4*)(F.ws + WS_ROPE_C)};
        { pg8::StaticOrder S; S.init((const bf16_t*)(F.ws + WS_H8), (const bf16_t*)(F.ws + WS_WIN), NTOK, PROJW - 3 * DM, DM / 2, F.G, (int)blockIdx.x, 12);
          pg8::gemm_phase<EpiInProj, pg8::StaticOrder, true, true>(F.lds, S, E); }
        { pg8::StaticOrder S; S.init((const bf16_t*)(F.ws + WS_H8), (const bf16_t*)(F.ws + WS_WIN), NTOK, 3 * DM, DM / 2, F.G, (int)blockIdx.x, 0);
          pg8::gemm_phase<EpiInProj, pg8::StaticOrder, true, true>(F.lds, S, E); }
    } SEAM(2);
    if (IN(3)) {
#ifndef NO_RET
        REP(30) for (int ch = F.vcu; ch < 256; ch += F.G) retention_chain_rs(F, args, ch);
#endif
#ifndef NO_ATT
        const int per = (6144 + F.G - 1) / F.G;
        attention_phase(F, F.vcu * per, (F.vcu + 1) * per < 6144 ? (F.vcu + 1) * per : 6144, args.pad);
#endif
    } SEAM(3);
    if (IN(4)) REP(4) { mixer_post_rows(F); } SEAM(4);
    if (IN(5)) REP(5) {
        pg8::DualOrder S; S.so.init((const bf16_t*)(F.ws + WS_RETN), (const bf16_t*)(F.ws + WS_WRU), NTOK, DM, DM / 2, F.G, (int)blockIdx.x);
        S.A1 = (const bf16_t*)(F.ws + WS_ATTC); S.Bt1 = (const bf16_t*)(F.ws + WS_WAU); S.K = DM / 2;
        EpiMerge E{F.ws + WS_MERGED, F.ws + WS_SGR, F.ws + WS_SGA};
        pg8::gemm_phase<EpiMerge, pg8::DualOrder, true, true>(F.lds, S, E);
    } SEAM(5);
    if (IN(6)) REP(6) {
        pg8::StaticOrder S; S.init((const bf16_t*)(F.ws + WS_MERGED), (const bf16_t*)(F.ws + WS_WO), NTOK, DM, DM / 2, F.G, (int)blockIdx.x);
        EpiOProj E{args.in[0], (bf16_t*)(F.ws + WS_X1B), mod, (float*)(F.ws + WS_SS)};
        pg8::gemm_phase<EpiOProj, pg8::StaticOrder, true, true>(F.lds, S, E);
    } SEAM(6);
    if (IN(7)) REP(7) {
        norm_mod_rows<true, 2>(F, F.ws + WS_X1B, args.in[11], mod, 3 * DM, 4 * DM, (const float*)(F.ws + WS_SS), HB, F.ws + WS_H8B);
        if (F.vcu == 0 && F.tid < 256) ((unsigned*)(F.ws + WS_H8B + (size_t)NTOK * DM))[F.tid] = 0u;
    } SEAM(7);
    if (IN(8)) {
        pg8::StaticOrder S; S.init(HB, (const bf16_t*)(F.ws + WS_WR), NTOK, NEXP, DM, F.G, (int)blockIdx.x);
        EpiF32 E{(float*)(F.ws + WS_LOGIT), NEXP};
        pg8::gemm_phase<EpiF32, pg8::StaticOrder, true>(F.lds, S, E);
        __syncthreads();
        moe_weight_convert(F, args);
    } SEAM(8);
    if (IN(9)) { routing_rows(F, args); } SEAM(9);
    if (IN(10)) { routing_lists(F); } SEAM(10);
    if (IN(11)) REP(11) {
        const int* TILE_E = (const int*)(F.ws + WS_TILE_E); const int ntiles = __builtin_amdgcn_readfirstlane(TILE_E[MAX_TILES]);
        pg8::MoeOrder<true, true> S; S.A = (const bf16_t*)(F.ws + WS_H8B); S.Bt = (const bf16_t*)(F.ws + WS_WGU); S.K = DM / 2; S.e_stride = WGU_E_BYTES; S.tile_e = (const LAS unsigned short*)(F.lds + MT_OFF); S.rowlist = (const int*)(F.ws + WS_ROWL); moe_tables_to_lds(F, ntiles);
        S.ntiles = ntiles; S.nN = 2; S.nwg = ntiles * 2; S.G = F.G; S.c = (int)blockIdx.x;
        EpiGU E{(bf16_t*)(F.ws + WS_HID)};
        pg8::gemm_phase<EpiGU, pg8::MoeOrder<true, true>, true, true>(F.lds, S, E);
    } SEAM(11);
    if (IN(12)) REP(12) {
        down_phase<0>(F, args);
    } SEAM(12);
    if (IN(13)) { final_rows(F, args); }
#if PROBE_LAUNCH == 14
    if (lo == 14) {
        pg8::StaticOrder S; S.init((const bf16_t*)(F.ws + WS_H8), (const bf16_t*)(F.ws + WS_WIN), NTOK, PROJW, DM / 2, F.G, (int)blockIdx.x);
        EpiNull E{};
        pg8::gemm_phase<EpiNull, pg8::StaticOrder, true, true>(F.lds, S, E);
    }
#endif
#if PROBE_LAUNCH == 16
    if (lo == 14) {
        const int* TILE_E = (const int*)(F.ws + WS_TILE_E); const int ntiles = __builtin_amdgcn_readfirstlane(TILE_E[MAX_TILES]);
        pg8::MoeOrder<false> S; S.A = (const bf16_t*)(F.ws + WS_HID); S.Bt = (const bf16_t*)(F.ws + WS_WD); S.K = EH; S.e_stride = (size_t)1024 * 256; S.tile_e = (const LAS unsigned short*)(F.lds + MT_OFF); S.rowlist = (const int*)(F.ws + WS_ROWL); moe_tables_to_lds(F, ntiles);
        S.ntiles = ntiles; S.nN = 4; S.nwg = ntiles * 4; S.G = F.G; S.c = (int)blockIdx.x;
        EpiNull E{};
        pg8::gemm_phase<EpiNull, pg8::MoeOrder<false>, true>(F.lds, S, E);
    }
#endif
#if PROBE_LAUNCH == 18
    if (lo == 14) { down_phase<1>(F, args); }
#endif
#if PROBE_LAUNCH == 19
    if (lo == 14) { down_phase<2>(F, args); }
#endif
#if PROBE_LAUNCH == 20
    if (lo == 14) { down_phase<3>(F, args); }
#endif
#if PROBE_LAUNCH == 17
    if (lo == 14) {
        const int* TILE_E = (const int*)(F.ws + WS_TILE_E); const int ntiles = __builtin_amdgcn_readfirstlane(TILE_E[MAX_TILES]);
        pg8::MoeOrder<false> S; S.A = (const bf16_t*)(F.ws + WS_HID); S.Bt = (const bf16_t*)(F.ws + WS_WD); S.K = EH; S.e_stride = (size_t)1024 * 256; S.tile_e = (const LAS unsigned short*)(F.lds + MT_OFF); S.rowlist = (const int*)(F.ws + WS_ROWL); moe_tables_to_lds(F, ntiles);
        S.ntiles = ntiles; S.nN = 4; S.nwg = ntiles * 4; S.G = F.G; S.c = (int)blockIdx.x;
        EpiDownT<1> E{F.ws, (const LAS int*)(F.lds + MT_INFO)};
        pg8::gemm_phase<EpiDownT<1>, pg8::MoeOrder<false>, true>(F.lds, S, E);
    }
#endif
#if PROBE_LAUNCH == 15
    if (lo == 14) {
        EpiInProjT<1> E{F.ws, (const u32x4*)(F.ws + WS_ROPE_C)};
        { pg8::StaticOrder S; S.init((const bf16_t*)(F.ws + WS_H8), (const bf16_t*)(F.ws + WS_WIN), NTOK, PROJW - 3 * DM, DM / 2, F.G, (int)blockIdx.x, 12);
          pg8::gemm_phase<EpiInProjT<1>, pg8::StaticOrder, true, true>(F.lds, S, E); }
        { pg8::StaticOrder S; S.init((const bf16_t*)(F.ws + WS_H8), (const bf16_t*)(F.ws + WS_WIN), NTOK, 3 * DM, DM / 2, F.G, (int)blockIdx.x, 0);
          pg8::gemm_phase<EpiInProjT<1>, pg8::StaticOrder, true, true>(F.lds, S, E); }
    }
#endif
#if PROBE_LAUNCH == 21 || PROBE_LAUNCH == 22 || PROBE_LAUNCH == 23
    if (lo == 14) {
        constexpr int PM_ = PROBE_LAUNCH == 21 ? 2 : (PROBE_LAUNCH == 22 ? 3 : 4);
        EpiInProjT<PM_> E{F.ws, (const u32x4*)(F.ws + WS_ROPE_C)};
        { pg8::StaticOrder S; S.init((const bf16_t*)(F.ws + WS_H8), (const bf16_t*)(F.ws + WS_WIN), NTOK, PROJW - 3 * DM, DM / 2, F.G, (int)blockIdx.x, 12);
          pg8::gemm_phase<EpiInProjT<PM_>, pg8::StaticOrder, true, true>(F.lds, S, E); }
        { pg8::StaticOrder S; S.init((const bf16_t*)(F.ws + WS_H8), (const bf16_t*)(F.ws + WS_WIN), NTOK, 3 * DM, DM / 2, F.G, (int)blockIdx.x, 0);
          pg8::gemm_phase<EpiInProjT<PM_>, pg8::StaticOrder, true, true>(F.lds, S, E); }
    }
#endif
#undef IN
#undef SEAM
}

extern "C" void kernel_launch(void* const* d_in, const int* in_sizes, int n_in, void* d_out, int out_size, void* d_ws, size_t ws_size, hipStream_t stream) {
    static int grid = 0;
    if (grid == 0) {
        if (n_in != 21 || out_size != NTOK * DM || ws_size < WS_END) { fprintf(stderr, "kernel_launch: unexpected shapes (n_in %d out %d ws %zu)\n", n_in, out_size, ws_size); grid = -1; return; }
        int dev = 0, cus = 0, per_cu = 0;
        if (hipGetDevice(&dev) != hipSuccess || hipDeviceGetAttribute(&cus, hipDeviceAttributeMultiprocessorCount, dev) != hipSuccess) { grid = -1; return; }
        if (hipFuncSetAttribute((const void*)fwd_kernel, hipFuncAttributeMaxDynamicSharedMemorySize, LDS_BYTES) != hipSuccess) { fprintf(stderr, "kernel_launch: hipFuncSetAttribute failed\n"); grid = -1; return; }
        if (hipOccupancyMaxActiveBlocksPerMultiprocessor(&per_cu, (const void*)fwd_kernel, NTHR, LDS_BYTES) != hipSuccess || per_cu < 1)
            fprintf(stderr, "kernel_launch: note: occupancy query reports %d\n", per_cu);
        (void)hipGetLastError();
        grid = cus;
    }
    if (grid < 0) return;
    (void)hipMemsetAsync((char*)d_ws + WS_CTL, 0, CTL_ZERO_BYTES, stream);
    Args a{};
    for (int i = 0; i < 21; ++i) a.in[i] = (const float*)d_in[i];
    a.out = (float*)d_out; a.ws = (unsigned char*)d_ws;
#if MK_N_LAUNCHES == 1
    a.ph_lo = 0; a.ph_hi = N_PHASES + 1; a.li = 0;
    hipLaunchKernelGGL(fwd_kernel, dim3(grid), dim3(NTHR), LDS_BYTES, stream, a);
#else
    for (int p = 0; p <= N_PHASES; ++p) {
        if ((PROBE_LAUNCH == 18 || PROBE_LAUNCH == 19 || PROBE_LAUNCH == 20) && p == 12) { a.ph_lo = 14; a.ph_hi = 15; hipLaunchKernelGGL(fwd_kernel, dim3(grid), dim3(NTHR), LDS_BYTES, stream, a); }
        a.ph_lo = p; a.ph_hi = p + 1; a.li = p; hipLaunchKernelGGL(fwd_kernel, dim3(grid), dim3(NTHR), LDS_BYTES, stream, a);
        if (p == PROBE_LAUNCH) { if (p == 8) (void)hipMemsetAsync((char*)d_ws + WS_CTL + (size_t)CW_CONVQ * 4, 0, 4, stream); hipLaunchKernelGGL(fwd_kernel, dim3(grid), dim3(NTHR), LDS_BYTES, stream, a); }
        if (((PROBE_LAUNCH == 14 || PROBE_LAUNCH == 15 || PROBE_LAUNCH == 21 || PROBE_LAUNCH == 22 || PROBE_LAUNCH == 23) && p == 2) || ((PROBE_LAUNCH == 16 || PROBE_LAUNCH == 17) && p == 12)) { a.ph_lo = 14; a.ph_hi = 15; hipLaunchKernelGGL(fwd_kernel, dim3(grid), dim3(NTHR), LDS_BYTES, stream, a); } }
#endif
}
```

```cpp
#include <hip/hip_runtime.h>
#include <cstdio>
#include <cstdint>

#ifndef MK_N_LAUNCHES
#define MK_N_LAUNCHES 1
#endif
#define PROBE_LAUNCH -1
#ifndef PROBE_PHASE
#define PROBE_PHASE -1
#endif

#define LAS __attribute__((address_space(3)))
#define GAS __attribute__((address_space(1)))
typedef unsigned short bf16_t;
typedef short bf16x8 __attribute__((ext_vector_type(8)));
typedef short s16x4 __attribute__((ext_vector_type(4)));
typedef float f32x2 __attribute__((ext_vector_type(2)));
typedef float f32x4 __attribute__((ext_vector_type(4)));
typedef float f32x16 __attribute__((ext_vector_type(16)));
typedef unsigned u32x2 __attribute__((ext_vector_type(2)));
typedef unsigned u32x4 __attribute__((ext_vector_type(4)));
typedef int i32x4 __attribute__((ext_vector_type(4)));
typedef __bf16 bf16x2_t __attribute__((ext_vector_type(2)));

constexpr int NB = 8, SEQ = 4096, DM = 1024, NTOK = NB * SEQ;
constexpr int PROJW = 9216, NEXP = 256, TOPK = 8, EH = 256;
constexpr float NORM_EPS = 1e-6f;

constexpr size_t MiB = 1u << 20;
constexpr size_t WS_CTL = 0, CTL_ZERO_BYTES = 1 * MiB;
constexpr size_t WS_MOD = 1 * MiB;
constexpr size_t WS_BTAB = 1 * MiB + 256 * 1024;
constexpr size_t WS_ROPE_C = 2 * MiB;
constexpr size_t WS_SS = 6 * MiB;
constexpr size_t WS_EIDX = 8 * MiB, WS_GATE = 9 * MiB;
constexpr size_t WS_ROWL = 10 * MiB;
constexpr size_t WS_TILE_E = 12 * MiB;
constexpr size_t WS_WIN = 16 * MiB, WS_WRU = 34 * MiB, WS_WAU = 36 * MiB, WS_WO = 38 * MiB, WS_WR = 40 * MiB;
constexpr size_t WS_H = 48 * MiB;
constexpr size_t WS_PROJ = 120 * MiB;
constexpr size_t SEG = 64 * MiB;
constexpr size_t WS_RQ = WS_PROJ, WS_RK = WS_PROJ + SEG, WS_RV = WS_PROJ + 2 * SEG, WS_RG = WS_PROJ + 3 * SEG, WS_AQ = WS_PROJ + 4 * SEG,
                 WS_AK = WS_PROJ + 5 * SEG, WS_AV = WS_PROJ + 6 * SEG, WS_SGR = WS_PROJ + 7 * SEG, WS_SGA = WS_PROJ + 8 * SEG;
constexpr size_t WS_OUTF = 696 * MiB, WS_OUTB = 760 * MiB, WS_OG = 824 * MiB, WS_LSE = 1016 * MiB;
constexpr size_t WS_RETN = WS_RQ, WS_ATTC = WS_RK, WS_YR = WS_RV, WS_MERGED = WS_AQ;
constexpr size_t WS_WGU = 120 * MiB, WS_WD = 377 * MiB, WS_HID = 512 * MiB, WS_LOGIT = 696 * MiB;
constexpr size_t WS_H8 = 48 * MiB, WS_H8B = 384 * MiB;
constexpr size_t WS_X1B = 448 * MiB;
constexpr size_t WS_END = 1022 * MiB;
constexpr int YD_SPLIT = 262144, YD_SHARED0 = NTOK * TOPK;
constexpr float YD_SCALE = 16.0f, YD_INV = 0.0625f;
__device__ __forceinline__ unsigned char* ydense_row(unsigned char* ws, int row) { return ws + (row < YD_SPLIT ? 120 * MiB : 696 * MiB) + (size_t)(row < YD_SPLIT ? row : row - YD_SPLIT) * DM; }
__device__ __forceinline__ unsigned pk4_fp8(float a, float b, float c, float d) {
    a = __builtin_fminf(__builtin_fmaxf(a * YD_SCALE, -448.f), 448.f); b = __builtin_fminf(__builtin_fmaxf(b * YD_SCALE, -448.f), 448.f);
    c = __builtin_fminf(__builtin_fmaxf(c * YD_SCALE, -448.f), 448.f); d = __builtin_fminf(__builtin_fmaxf(d * YD_SCALE, -448.f), 448.f);
    int w = __builtin_amdgcn_cvt_pk_fp8_f32(a, b, 0, false); w = __builtin_amdgcn_cvt_pk_fp8_f32(c, d, w, true); return (unsigned)w;
}
constexpr float W8_SCALE = 256.0f, FP8_UNSCALE = 1.0f / 4096.0f;
__device__ __forceinline__ unsigned pk4_fp8w(float a, float b, float c, float d) {
    a = __builtin_fminf(__builtin_fmaxf(a * W8_SCALE, -448.f), 448.f); b = __builtin_fminf(__builtin_fmaxf(b * W8_SCALE, -448.f), 448.f);
    c = __builtin_fminf(__builtin_fmaxf(c * W8_SCALE, -448.f), 448.f); d = __builtin_fminf(__builtin_fmaxf(d * W8_SCALE, -448.f), 448.f);
    int w = __builtin_amdgcn_cvt_pk_fp8_f32(a, b, 0, false); w = __builtin_amdgcn_cvt_pk_fp8_f32(c, d, w, true); return (unsigned)w;
}
__device__ __forceinline__ unsigned pk4_fp8_clamped(float a, float b, float c, float d) {
    a = __builtin_amdgcn_fmed3f(a, -448.f, 448.f); b = __builtin_amdgcn_fmed3f(b, -448.f, 448.f); c = __builtin_amdgcn_fmed3f(c, -448.f, 448.f); d = __builtin_amdgcn_fmed3f(d, -448.f, 448.f);
    int w = __builtin_amdgcn_cvt_pk_fp8_f32(a, b, 0, false); w = __builtin_amdgcn_cvt_pk_fp8_f32(c, d, w, true); return (unsigned)w;
}
__device__ __forceinline__ unsigned pk4_fp8_noclamp(float a, float b, float c, float d) {
    int w = __builtin_amdgcn_cvt_pk_fp8_f32(a, b, 0, false); w = __builtin_amdgcn_cvt_pk_fp8_f32(c, d, w, true); return (unsigned)w;
}
constexpr size_t WS_DPOS = 13 * MiB;
constexpr int CW_TMO = 0, CW_BAR = 4096, CW_CNT = 16384, CW_FILL = 16384 + 1024;
constexpr int MAX_TILES = 2048;

__device__ __forceinline__ unsigned cvtpk(float lo, float hi) { f32x2 v = {lo, hi}; bf16x2_t b = __builtin_convertvector(v, bf16x2_t); return __builtin_bit_cast(unsigned, b); }
__device__ __forceinline__ float bf2f(unsigned short u) { return __uint_as_float((unsigned)u << 16); }
__device__ __forceinline__ float bflo(unsigned u) { return __uint_as_float(u << 16); }
__device__ __forceinline__ float bfhi(unsigned u) { return __uint_as_float(u & 0xffff0000u); }
__device__ __forceinline__ float wave_sum(float v) {
#pragma unroll
    for (int o = 1; o < 64; o <<= 1) v += __shfl_xor(v, o);
    return v;
}
__device__ __forceinline__ float sigmoidf_(float x) { return __builtin_amdgcn_rcpf(1.f + __builtin_amdgcn_exp2f(x * -1.4426950408889634f)); }
__device__ __forceinline__ float siluf_(float x) { return x * __builtin_amdgcn_rcpf(1.f + __builtin_amdgcn_exp2f(x * -1.4426950408889634f)); }

namespace pg8 {
constexpr int BM = 256, BK = 64, HALF = 128, HTB = HALF * BK * 2, STAGE_BYTES = 8 * HTB, NXCD = 8, WGM = 8;
__host__ __device__ __forceinline__ int lds_byte(int r, int c) { const int st = (r >> 4) * 2 + (c >> 5), rr = r & 15, cc = c & 31, ob = rr * 64 + cc * 2; return st * 1024 + (ob ^ (((ob >> 9) & 1) << 5)); }
__host__ __device__ __forceinline__ void stage_rc(int b, int& R, int& C) { const int st = b / 1024, sb = b % 1024, swz = sb ^ (((sb >> 9) & 1) << 5); R = (st >> 1) * 16 + swz / 64; C = (st & 1) * 32 + (swz % 64) / 2; }
__host__ __device__ __forceinline__ int perm32(int rho) { const int n = rho >> 4, i = rho & 15; return 8 * (i >> 2) + 4 * n + (i & 3); }

struct Unit { int pm, pn, e; };

__device__ __forceinline__ int xcd_remap(int L, int nwg) { const int q = nwg / NXCD, r = nwg % NXCD, xcd = L % NXCD, off = L / NXCD; return (xcd < r ? xcd * (q + 1) : r * (q + 1) + (xcd - r) * q) + off; }

struct StaticOrder {
    static constexpr bool GATHER = false, DUAL = false, B_IMG = false;
    const bf16_t* A; const bf16_t* Bt; int K;
    int nM, nN, nwg, G, c, pn_off;
    __device__ void init(const bf16_t* A_, const bf16_t* Bt_, int M, int N, int K_, int G_, int c_, int pn_off_ = 0) { A = A_; Bt = Bt_; K = K_; nM = M / BM; nN = N / BM; nwg = nM * nN; G = G_; c = c_; pn_off = pn_off_; }
    __device__ bool next(int i, Unit& u) const {
        const long L = (long)i * G + c; if (L >= nwg) return false;
        const int wgid = xcd_remap((int)L, nwg);
        const int nig = WGM * nN, gid = wgid / nig, fm = gid * WGM, gsz = (nM - fm) < WGM ? (nM - fm) : WGM;
        u.pm = fm + ((wgid % nig) % gsz); u.pn = (wgid % nig) / gsz + pn_off; u.e = 0; return true;
    }
    __device__ __forceinline__ const char* a_base(const Unit& u) const { return (const char*)A + (size_t)u.pm * (size_t)(BM * 2) * K; }
    __device__ __forceinline__ const char* b_base(const Unit& u) const { return (const char*)Bt + (size_t)u.pn * (size_t)(BM * 2) * K; }
    __device__ __forceinline__ unsigned a_row(const Unit&, int) const { return 0u; }
};

struct DualOrder {
    static constexpr bool GATHER = false, DUAL = true, B_IMG = false;
    StaticOrder so; const bf16_t* A1; const bf16_t* Bt1; int K;
    __device__ bool next(int i, Unit& u) const { if (!so.next(i >> 1, u)) return false; u.e = i & 1; return true; }
    __device__ __forceinline__ const char* a_base(const Unit& u) const { return (const char*)(u.e ? A1 : so.A) + (size_t)u.pm * (size_t)(BM * 2) * K; }
    __device__ __forceinline__ const char* b_base(const Unit& u) const { return (const char*)(u.e ? Bt1 : so.Bt) + (size_t)u.pn * (size_t)(BM * 2) * K; }
    __device__ __forceinline__ unsigned a_row(const Unit&, int) const { return 0u; }
};

template <bool GATHER_, bool B_IMG_ = false>
struct MoeOrder {
    static constexpr bool GATHER = GATHER_, DUAL = false, B_IMG = B_IMG_;
    const bf16_t* A; const bf16_t* Bt; int K; size_t e_stride;
    const LAS unsigned short* tile_e; const int* rowlist; int ntiles, nN, nwg, G, c;
    __device__ bool next(int i, Unit& u) const {
        const long L = (long)i * G + c; if (L >= nwg) return false;
        const int wgid = xcd_remap((int)L, nwg);
        u.pm = wgid / nN; u.pn = wgid % nN; u.e = __builtin_amdgcn_readfirstlane((int)tile_e[u.pm]); return true;
    }
    __device__ __forceinline__ const char* a_base(const Unit& u) const { return GATHER ? (const char*)A : (const char*)A + (size_t)u.pm * (size_t)(BM * 2) * K; }
    __device__ __forceinline__ const char* b_base(const Unit& u) const { return B_IMG ? (const char*)Bt + (size_t)u.e * e_stride + (size_t)u.pn * (size_t)(BM * 2) * K : (const char*)Bt + ((size_t)u.e * e_stride + (size_t)u.pn * BM * K) * 2; }
    __device__ __forceinline__ unsigned a_row(const Unit& u, int r) const { const int ent = rowlist[(size_t)u.pm * BM + r]; return ent < 0 ? (unsigned)NTOK : (unsigned)(ent >> 4); }
};

template <class Epi, class Sched, bool ALIGN_EPI, bool FP8 = false>
__device__ __forceinline__ void gemm_phase(LAS unsigned char* lds, const Sched& S, const Epi& E) {
    const int tid = threadIdx.x, wid = __builtin_amdgcn_readfirstlane(tid >> 6), lane = tid & 63, wr = wid >> 2, wc = wid & 3, fr = lane & 15, fq = lane >> 4;
    const int K = S.K, nt = K / BK;
    unsigned voffA[2], voffB[2]; int RA[2]; unsigned CA2[2];
#pragma unroll
    for (int i = 0; i < 2; ++i) { int R, C; stage_rc(tid * 16 + i * 8192, R, C); const int Rb = Epi::PERM ? ((R & ~31) + perm32(R & 31)) : R;
        voffA[i] = (unsigned)(R * K + C) * 2u; voffB[i] = Sched::B_IMG ? (unsigned)(tid * 16 + i * 8192) : (unsigned)(Rb * K + C) * 2u; RA[i] = R; CA2[i] = (unsigned)C * 2u; }
    const size_t kstep = (size_t)(BK * 2);
    const size_t hstep = (size_t)HALF * K * 2;
    const size_t bk = Sched::B_IMG ? (size_t)32768 : kstep, bh = Sched::B_IMG ? (size_t)16384 : hstep;
    const unsigned ldsw = (unsigned)wid * 1024u;
    const int aoff = lds_byte(wr * 64 + fr, fq * 8), boff = lds_byte(wc * 32 + fr, fq * 8);
    unsigned gC[2][2], gN[2][2];
#define PG8_SA(b, h) (((b) * 2 + (h)) * HTB)
#define PG8_SB(b, h) ((4 + (b) * 2 + (h)) * HTB)
#define PG8_STAGE(bufoff, gbase, voff) do { _Pragma("unroll") for (int _i = 0; _i < 2; ++_i) \
        __builtin_amdgcn_global_load_lds((const unsigned*)((const char*)(gbase) + (voff)[_i]), (LAS unsigned*)(lds + (bufoff) + ldsw + _i * 8192), 16, 0, 0); } while (0)
#define PG8_STAGE_A(bufoff, p, h, NX) do { if constexpr (Sched::GATHER) { _Pragma("unroll") for (int _i = 0; _i < 2; ++_i) { const unsigned _v = (NX) ? gN[h][_i] : gC[h][_i]; \
        __builtin_amdgcn_global_load_lds((const unsigned*)((const char*)(p) + _v), (LAS unsigned*)(lds + (bufoff) + ldsw + _i * 8192), 16, 0, 0); } } \
        else { PG8_STAGE(bufoff, (p) + (h) * hstep, voffA); } } while (0)
#define PG8_GATHER_SET(g, u) do { _Pragma("unroll") for (int _h = 0; _h < 2; ++_h) _Pragma("unroll") for (int _i = 0; _i < 2; ++_i) \
        g[_h][_i] = S.a_row(u, _h * HALF + RA[_i]) * (unsigned)(K * 2) + CA2[_i]; } while (0)
#define PG8_LDA(dst, b, h) do { _Pragma("unroll") for (int m = 0; m < 4; ++m) _Pragma("unroll") for (int k = 0; k < 2; ++k) dst[m][k] = *(const LAS bf16x8*)(lds + PG8_SA(b, h) + aoff + m * 2048 + k * 1024); } while (0)
#define PG8_LDB(dst, b, h) do { _Pragma("unroll") for (int n = 0; n < 2; ++n) _Pragma("unroll") for (int k = 0; k < 2; ++k) dst[n][k] = *(const LAS bf16x8*)(lds + PG8_SB(b, h) + boff + n * 2048 + k * 1024); } while (0)
#define PG8_CAT(x0, x1) __builtin_shufflevector(__builtin_bit_cast(i32x4, x0), __builtin_bit_cast(i32x4, x1), 0, 1, 2, 3, 4, 5, 6, 7)
#define PG8_MMA(ai, bj, At, Bt) do { __builtin_amdgcn_s_setprio(1); if constexpr (FP8) { _Pragma("unroll") for (int m = 0; m < 4; ++m) _Pragma("unroll") for (int n = 0; n < 2; ++n) \
        asm volatile("v_mfma_f32_16x16x128_f8f6f4 %0, %1, %2, %0" : "+v"(acc[ai][bj][m][n]) : "v"(PG8_CAT(Bt[n][0], Bt[n][1])), "v"(PG8_CAT(At[m][0], At[m][1]))); } else { \
        _Pragma("unroll") for (int m = 0; m < 4; ++m) _Pragma("unroll") for (int n = 0; n < 2; ++n) _Pragma("unroll") for (int k = 0; k < 2; ++k) \
        acc[ai][bj][m][n] = __builtin_amdgcn_mfma_f32_16x16x32_bf16(Bt[n][k], At[m][k], acc[ai][bj][m][n], 0, 0, 0); } __builtin_amdgcn_s_setprio(0); } while (0)
#define PG8_WAIT_V(n) asm volatile("s_waitcnt vmcnt(" #n ")" ::: "memory")
#define PG8_WAIT_L(n) asm volatile("s_waitcnt lgkmcnt(" #n ")" ::: "memory")
#define PG8_BAR __builtin_amdgcn_s_barrier()
#define PG8_SCHED __builtin_amdgcn_sched_barrier(0)
    Unit cur, nxt; int ui = 0;
    if (!S.next(0, cur)) return;
    f32x4 acc[2][2][4][2];
#pragma unroll
    for (int a = 0; a < 2; ++a)
#pragma unroll
        for (int b = 0; b < 2; ++b)
#pragma unroll
            for (int m = 0; m < 4; ++m)
#pragma unroll
                for (int n = 0; n < 2; ++n) acc[a][b][m][n] = (f32x4){0.f, 0.f, 0.f, 0.f};
    bf16x8 At[4][2], B0[2][2], B1[2][2];
    const char* cA = S.a_base(cur); const char* cB = S.b_base(cur);
    if constexpr (Sched::GATHER) { PG8_GATHER_SET(gC, cur); PG8_GATHER_SET(gN, cur); }
    PG8_STAGE(PG8_SB(0, 0), cB, voffB); PG8_STAGE(PG8_SB(0, 1), cB + bh, voffB); PG8_STAGE_A(PG8_SA(0, 0), cA, 0, false); PG8_STAGE_A(PG8_SA(0, 1), cA, 1, false);
    if (wr == 1) PG8_BAR;
    PG8_WAIT_V(2); PG8_BAR;
    PG8_STAGE(PG8_SB(1, 0), cB + bk, voffB); PG8_STAGE_A(PG8_SA(1, 0), cA + kstep, 0, false); PG8_STAGE(PG8_SB(1, 1), cB + bh + bk, voffB);
    PG8_WAIT_V(6); PG8_BAR;
    for (;;) {
        const bool has_next = S.next(ui + 1, nxt);
        const char* nA = has_next ? S.a_base(nxt) : cA; const char* nB = has_next ? S.b_base(nxt) : cB;
        if constexpr (Sched::GATHER) { if (has_next) { PG8_GATHER_SET(gN, nxt); } }
        for (int t = 0; t < nt; t += 2) {
            const bool last = (t == nt - 2);
            const char* a1 = cA + (size_t)(t + 1) * kstep;
            const char* a2 = last ? nA : cA + (size_t)(t + 2) * kstep; const char* b2 = last ? nB : cB + (size_t)(t + 2) * bk;
            const char* a3 = a2 + kstep; const char* b3 = b2 + bk;
            PG8_LDB(B0, 0, 0); PG8_LDB(B1, 0, 1); PG8_SCHED; PG8_LDA(At, 0, 0); PG8_STAGE_A(PG8_SA(1, 1), a1, 1, false);
            PG8_WAIT_V(8); PG8_WAIT_L(0); PG8_BAR; PG8_MMA(0, 0, At, B0); PG8_MMA(0, 1, At, B1); PG8_BAR; PG8_SCHED;
            PG8_LDA(At, 0, 1); PG8_STAGE(PG8_SB(0, 0), b2, voffB); PG8_STAGE(PG8_SB(0, 1), b2 + bh, voffB); PG8_STAGE_A(PG8_SA(0, 0), a2, 0, last);
            PG8_WAIT_V(8); PG8_WAIT_L(0); PG8_BAR; PG8_MMA(1, 0, At, B0); PG8_MMA(1, 1, At, B1); PG8_BAR; PG8_SCHED;
            PG8_LDB(B0, 1, 0); PG8_LDB(B1, 1, 1); PG8_SCHED; PG8_LDA(At, 1, 0); PG8_STAGE_A(PG8_SA(0, 1), a2, 1, last);
            PG8_WAIT_V(8); PG8_WAIT_L(0); PG8_BAR; PG8_MMA(0, 0, At, B0); PG8_MMA(0, 1, At, B1); PG8_BAR; PG8_SCHED;
            PG8_LDA(At, 1, 1); PG8_STAGE(PG8_SB(1, 0), b3, voffB); PG8_STAGE(PG8_SB(1, 1), b3 + bh, voffB); PG8_STAGE_A(PG8_SA(1, 0), a3, 0, last);
            PG8_WAIT_V(8); PG8_WAIT_L(0); PG8_BAR; PG8_MMA(1, 0, At, B0); PG8_MMA(1, 1, At, B1); PG8_BAR; PG8_SCHED;
        }
        if constexpr (ALIGN_EPI) { if (wr == 0) PG8_BAR; }
        if constexpr (FP8) {
            asm volatile("s_nop 15\n\ts_nop 15" ::: "memory");
            if constexpr (!Epi::RAW)
#pragma unroll
            for (int a = 0; a < 2; ++a)
#pragma unroll
                for (int b = 0; b < 2; ++b)
#pragma unroll
                    for (int m = 0; m < 4; ++m)
#pragma unroll
                        for (int n = 0; n < 2; ++n) acc[a][b][m][n] *= (Sched::DUAL && cur.e == 0) ? 1.0f : FP8_UNSCALE;
        }
        E(acc, cur, wr, wc, fr, fq);
        if (!has_next) break;
        if (!(Sched::DUAL && cur.e == 0))
#pragma unroll
        for (int a = 0; a < 2; ++a)
#pragma unroll
            for (int b = 0; b < 2; ++b)
#pragma unroll
                for (int m = 0; m < 4; ++m)
#pragma unroll
                    for (int n = 0; n < 2; ++n) acc[a][b][m][n] = (f32x4){0.f, 0.f, 0.f, 0.f};
        cur = nxt; cA = nA; cB = nB; ++ui;
        if constexpr (Sched::GATHER) {
#pragma unroll
            for (int h = 0; h < 2; ++h)
#pragma unroll
                for (int i = 0; i < 2; ++i) gC[h][i] = gN[h][i];
        }
        if constexpr (ALIGN_EPI) { if (wr == 1) PG8_BAR; }
    }
    PG8_WAIT_V(0);
    if constexpr (!ALIGN_EPI) { if (wr == 0) PG8_BAR; }
    PG8_BAR;
#undef PG8_SA
#undef PG8_SB
#undef PG8_STAGE
#undef PG8_STAGE_A
#undef PG8_GATHER_SET
#undef PG8_LDA
#undef PG8_LDB
#undef PG8_MMA
#undef PG8_CAT
#undef PG8_WAIT_V
#undef PG8_WAIT_L
#undef PG8_BAR
#undef PG8_SCHED
}
}

typedef GAS unsigned gu32;
#define RLX_AGENT __ATOMIC_RELAXED, __HIP_MEMORY_SCOPE_AGENT
#define XB_TMO      128
#define XB_XCNT(j)  (256  + 64 * (j))
#define XB_XSUB(j)  (1280 + 64 * (j))
#define XB_XGEN(j)  (2304 + 64 * (j))
#define XB_TOP      3328
#define XB_TOPGEN   3392
#define XCD_BAR_WORDS 3456
#define XB_SPIN_CAP (1u << 18)
__device__ __forceinline__ unsigned xb_ld(unsigned* p)              { return __hip_atomic_load(p, __ATOMIC_RELAXED, __HIP_MEMORY_SCOPE_AGENT); }
__device__ __forceinline__ unsigned xb_add(unsigned* p, unsigned v) { return __hip_atomic_fetch_add(p, v, __ATOMIC_RELAXED, __HIP_MEMORY_SCOPE_AGENT); }
__device__ __forceinline__ unsigned xb_xcc_id() { return (unsigned)__builtin_amdgcn_s_getreg((3 << 11) | 20) & 0xFu; }
#define XB_SPIN(cond, bar) do { unsigned _sp = 0; while (cond) { __builtin_amdgcn_s_sleep(1); \
    if ((++_sp & 255u) == 0u) { if (xb_ld(&(bar)[XB_TMO])) break; if (_sp > XB_SPIN_CAP) { atomicAdd(&(bar)[XB_TMO], 1u); break; } } } } while (0)
struct XcdBarrier { unsigned* bar; unsigned x; volatile LAS unsigned* st; };
__device__ __forceinline__ XcdBarrier xcd_barrier_post(unsigned* bar, volatile LAS unsigned* st) {
    XcdBarrier b; b.bar = bar; b.x = xb_xcc_id(); b.st = st;
    if (threadIdx.x == 0) (void)xb_add(&bar[XB_XCNT(b.x)], 1u);
    return b;
}
__device__ __forceinline__ void xcd_barrier_complete(unsigned* bar, unsigned x, unsigned& nloc, unsigned& nx) {
    const unsigned G = gridDim.x * gridDim.y * gridDim.z;
    unsigned sum, cnt, mine, sp = 0u;
    for (;;) {
        sum = 0u; cnt = 0u; mine = 0u;
#pragma unroll
        for (unsigned j = 0; j < 16; ++j) { const unsigned c = xb_ld(&bar[XB_XCNT(j)]); sum += c; cnt += (c > 0u) ? 1u : 0u; mine = (j == x) ? c : mine; }
        if (sum == G) break;
        __builtin_amdgcn_s_sleep(1);
        if ((++sp & 255u) == 0u) { if (xb_ld(&bar[XB_TMO])) break; if (sp > XB_SPIN_CAP) { atomicAdd(&bar[XB_TMO], 1u); break; } }
    }
    nloc = mine > 0u ? mine : 1u; nx = cnt > 0u ? cnt : 1u;
}
__device__ __forceinline__ void xcd_barrier(const XcdBarrier& b) {
    asm volatile("s_waitcnt vmcnt(0)" ::: "memory");
    __syncthreads();
    if (threadIdx.x == 0) {
        unsigned* bar = b.bar;
        __builtin_amdgcn_s_waitcnt(0);
        unsigned nloc = b.st[0], nx = b.st[1];
        if (nloc == 0u) { xcd_barrier_complete(bar, b.x, nloc, nx); b.st[0] = nloc; b.st[1] = nx; }
        const unsigned old = xb_add(&bar[XB_XSUB(b.x)], 1u);
        const unsigned gen = old / nloc;
        if (old + 1u == (gen + 1u) * nloc) {
            __builtin_amdgcn_fence(__ATOMIC_RELEASE, "agent");
            asm volatile("s_waitcnt vmcnt(0)" ::: "memory");
            const unsigned og = xb_add(&bar[XB_TOP], 1u);
            const unsigned tg = og / nx;
            if (og + 1u == (tg + 1u) * nx) xb_add(&bar[XB_TOPGEN], 1u);
            else XB_SPIN(xb_ld(&bar[XB_TOPGEN]) == tg, bar);
            __builtin_amdgcn_fence(__ATOMIC_ACQUIRE, "agent");
            xb_add(&bar[XB_XGEN(b.x)], 1u);
            asm volatile("s_waitcnt vmcnt(0)" ::: "memory");
        } else {
            XB_SPIN(xb_ld(&bar[XB_XGEN(b.x)]) == gen, bar);
            __builtin_amdgcn_fence(__ATOMIC_ACQUIRE, "agent");
            asm volatile("s_waitcnt vmcnt(0)" ::: "memory");
        }
    }
    __syncthreads();
}

constexpr int NWAVES = 8, NTHR = 512;
constexpr int LDS_BYTES = 147456, LDSCTL_OFF = LDS_BYTES - 1024, MISC_OFF = LDSCTL_OFF + 320;

struct Args { const float* in[21]; float* out; unsigned char* ws; int ph_lo, ph_hi, li, pad; };

struct Frame {
    LAS unsigned char* lds;
    unsigned char* ws;
    int tid, lane, wave, vcu, G;
};

template <int MODE = 0> struct EpiInProjT {
    static constexpr bool PERM = true; static constexpr bool RAW = true;
    unsigned char* ws; const u32x4* rope;
    __device__ __forceinline__ void operator()(const f32x4 (&acc)[2][2][4][2], const pg8::Unit& u, int wr, int wc, int fr, int fq) const {
        const int seg = MODE == 4 ? 5 : (u.pn >> 2);
        bf16_t* O = (bf16_t*)(MODE == 0 ? ws + WS_PROJ + (size_t)seg * SEG : ws + WS_OUTF + (size_t)(seg % 5) * SEG);
        const int colt = (u.pn & 3) * 256;
        const int row0 = (MODE == 3 ? (u.pm & 3) : u.pm) * 256 + wr * 64 + fr;
        const int d = wc * 32 + 8 * fq;
        auto emit = [&](int row, f32x4 v00, f32x4 v01, f32x4 v10, f32x4 v11) {
            if (seg <= 2) {
                u32x4 w0, w1; w0.x = cvtpk(v00[0], v00[1]); w0.y = cvtpk(v00[2], v00[3]); w0.z = cvtpk(v01[0], v01[1]); w0.w = cvtpk(v01[2], v01[3]);
                w1.x = cvtpk(v10[0], v10[1]); w1.y = cvtpk(v10[2], v10[3]); w1.z = cvtpk(v11[0], v11[1]); w1.w = cvtpk(v11[2], v11[3]);
                if (seg == 0) {
                    const int pos = row & (SEQ - 1), il = pos & 127;
                    bf16_t* blkp = O + ((((size_t)(row >> 12) * 4 + (u.pn & 3)) * 32 + (pos >> 7)) * 4 + (il >> 5)) * 8192 + (size_t)(((d >> 3) & 1) * 32 + (il & 31)) * 8;
                    if (MODE == 2 || MODE == 4) asm volatile("" :: "v"(w0), "v"(w1), "v"(blkp)); else { *(u32x4*)(blkp + (d >> 4) * 512) = w0; *(u32x4*)(blkp + ((d >> 4) + 8) * 512) = w1; }
                } else { bf16_t* rowp = O + (size_t)row * DM + colt + d; if (MODE == 2 || MODE == 4) asm volatile("" :: "v"(w0), "v"(w1), "v"(rowp)); else { *(u32x4*)rowp = w0; *(u32x4*)(rowp + 128) = w1; } }
            } else {
                unsigned char* rowp = (unsigned char*)O + (size_t)row * DM + colt + d;
                u32x2 f0, f1;
                if (seg >= 7) { f0.x = pk4_fp8_noclamp(v00[0], v00[1], v00[2], v00[3]); f0.y = pk4_fp8_noclamp(v01[0], v01[1], v01[2], v01[3]); f1.x = pk4_fp8_noclamp(v10[0], v10[1], v10[2], v10[3]); f1.y = pk4_fp8_noclamp(v11[0], v11[1], v11[2], v11[3]); }
                else { f0.x = pk4_fp8_clamped(v00[0], v00[1], v00[2], v00[3]); f0.y = pk4_fp8_clamped(v01[0], v01[1], v01[2], v01[3]); f1.x = pk4_fp8_clamped(v10[0], v10[1], v10[2], v10[3]); f1.y = pk4_fp8_clamped(v11[0], v11[1], v11[2], v11[3]); }
                if (MODE == 2 || MODE == 4) asm volatile("" :: "v"(f0), "v"(f1), "v"(rowp)); else { *(u32x2*)rowp = f0; *(u32x2*)(rowp + 128) = f1; }
            }
        };
        if (seg <= 1) {
            u32x4 cs[8][2];
#pragma unroll
            for (int it = 0; it < 8; ++it) { const int pos = (row0 + (it >> 2) * 128 + (it & 3) * 16) & (SEQ - 1); const u32x4* p = rope + ((size_t)pos * 16 + (d >> 3)) * 2; cs[it][0] = p[0]; cs[it][1] = p[1]; }
            const float sc = seg == 1 ? 0.0625f * FP8_UNSCALE : FP8_UNSCALE;
#pragma unroll
            for (int it = 0; it < 8; ++it) {
                const int ai = it >> 2, m = it & 3;
                const f32x4 v00 = acc[ai][0][m][0], v01 = acc[ai][0][m][1], v10 = acc[ai][1][m][0], v11 = acc[ai][1][m][1];
                const u32x4 c = cs[it][0], sn = cs[it][1];
                const f32x4 c0 = (f32x4){bflo(c.x), bfhi(c.x), bflo(c.y), bfhi(c.y)} * sc, c1 = (f32x4){bflo(c.z), bfhi(c.z), bflo(c.w), bfhi(c.w)} * sc;
                const f32x4 s0 = (f32x4){bflo(sn.x), bfhi(sn.x), bflo(sn.y), bfhi(sn.y)} * sc, s1 = (f32x4){bflo(sn.z), bfhi(sn.z), bflo(sn.w), bfhi(sn.w)} * sc;
                emit(row0 + ai * 128 + m * 16, v00 * c0 - v10 * s0, v01 * c1 - v11 * s1, v00 * s0 + v10 * c0, v01 * s1 + v11 * c1);
            }
            return;
        }
#pragma unroll
        for (int ai = 0; ai < 2; ++ai)
#pragma unroll
            for (int m = 0; m < 4; ++m) {
                f32x4 v00 = acc[ai][0][m][0], v01 = acc[ai][0][m][1], v10 = acc[ai][1][m][0], v11 = acc[ai][1][m][1];
                if (seg == 2) { v00 = v00 * FP8_UNSCALE; v01 = v01 * FP8_UNSCALE; v10 = v10 * FP8_UNSCALE; v11 = v11 * FP8_UNSCALE; }
                else if (seg == 3) {
                    constexpr float ce = -FP8_UNSCALE * 1.4426950408889634f, cm = YD_SCALE * FP8_UNSCALE;
#pragma unroll
                    for (int i = 0; i < 4; ++i) { v00[i] = (v00[i] * cm) * __builtin_amdgcn_rcpf(1.f + __builtin_amdgcn_exp2f(v00[i] * ce)); v01[i] = (v01[i] * cm) * __builtin_amdgcn_rcpf(1.f + __builtin_amdgcn_exp2f(v01[i] * ce));
                        v10[i] = (v10[i] * cm) * __builtin_amdgcn_rcpf(1.f + __builtin_amdgcn_exp2f(v10[i] * ce)); v11[i] = (v11[i] * cm) * __builtin_amdgcn_rcpf(1.f + __builtin_amdgcn_exp2f(v11[i] * ce)); }
                } else if (seg <= 6) { const float q = (seg == 4 ? 0.18033688011112042f : 1.0f) * (YD_SCALE * FP8_UNSCALE); v00 = v00 * q; v01 = v01 * q; v10 = v10 * q; v11 = v11 * q; }
                else {
                    constexpr float ce = -FP8_UNSCALE * 1.4426950408889634f;
#pragma unroll
                    for (int i = 0; i < 4; ++i) { v00[i] = __builtin_amdgcn_rcpf(__builtin_fmaf(__builtin_amdgcn_exp2f(v00[i] * ce), YD_INV, YD_INV)); v01[i] = __builtin_amdgcn_rcpf(__builtin_fmaf(__builtin_amdgcn_exp2f(v01[i] * ce), YD_INV, YD_INV));
                        v10[i] = __builtin_amdgcn_rcpf(__builtin_fmaf(__builtin_amdgcn_exp2f(v10[i] * ce), YD_INV, YD_INV)); v11[i] = __builtin_amdgcn_rcpf(__builtin_fmaf(__builtin_amdgcn_exp2f(v11[i] * ce), YD_INV, YD_INV)); }
                }
                emit(row0 + ai * 128 + m * 16, v00, v01, v10, v11);
            }
    }
};
using EpiInProj = EpiInProjT<0>;
template <bool ADD> struct EpiGateBf16 {
    static constexpr bool PERM = true; static constexpr bool RAW = false;
    bf16_t* O; const bf16_t* Gt; const bf16_t* P;
    __device__ __forceinline__ void operator()(const f32x4 (&acc)[2][2][4][2], const pg8::Unit& u, int wr, int wc, int fr, int fq) const {
        const int row0 = u.pm * 256 + wr * 64 + fr, col0 = u.pn * 256 + wc * 32 + 8 * fq;
#pragma unroll
        for (int ai = 0; ai < 2; ++ai)
#pragma unroll
            for (int m = 0; m < 4; ++m) {
                const size_t ro = (size_t)(row0 + ai * 128 + m * 16) * DM + col0;
#pragma unroll
                for (int bj = 0; bj < 2; ++bj) {
                    const u32x4 g = *(const u32x4*)(Gt + ro + bj * 128);
                    f32x4 v0 = acc[ai][bj][m][0], v1 = acc[ai][bj][m][1];
                    v0[0] *= bflo(g.x); v0[1] *= bfhi(g.x); v0[2] *= bflo(g.y); v0[3] *= bfhi(g.y);
                    v1[0] *= bflo(g.z); v1[1] *= bfhi(g.z); v1[2] *= bflo(g.w); v1[3] *= bfhi(g.w);
                    if (ADD) { const u32x4 p = *(const u32x4*)(P + ro + bj * 128);
                        v0[0] += bflo(p.x); v0[1] += bfhi(p.x); v0[2] += bflo(p.y); v0[3] += bfhi(p.y);
                        v1[0] += bflo(p.z); v1[1] += bfhi(p.z); v1[2] += bflo(p.w); v1[3] += bfhi(p.w); }
                    u32x4 w; w.x = cvtpk(v0[0], v0[1]); w.y = cvtpk(v0[2], v0[3]); w.z = cvtpk(v1[0], v1[1]); w.w = cvtpk(v1[2], v1[3]);
                    *(u32x4*)(O + ro + bj * 128) = w;
                }
            }
    }
};
struct EpiMerge {
    static constexpr bool PERM = true; static constexpr bool RAW = false;
    unsigned char* O; const unsigned char* Gr; const unsigned char* Ga;
    __device__ __forceinline__ void operator()(f32x4 (&acc)[2][2][4][2], const pg8::Unit& u, int wr, int wc, int fr, int fq) const {
        const int row0 = u.pm * 256 + wr * 64 + fr, col0 = u.pn * 256 + wc * 32 + 8 * fq;
        u32x2 ga[8][2], gr[8][2];
#pragma unroll
        for (int it = 0; it < 8; ++it)
#pragma unroll
            for (int bj = 0; bj < 2; ++bj) { const size_t ro = (size_t)(row0 + (it >> 2) * 128 + (it & 3) * 16) * DM + col0 + bj * 128;
                ga[it][bj] = *(const u32x2*)(Ga + ro); gr[it][bj] = *(const u32x2*)(Gr + (u.e == 0 ? ro : 0)); }
#pragma unroll
        for (int it = 0; it < 8; ++it) {
            const int ai = it >> 2, m = it & 3;
            const size_t ro = (size_t)(row0 + ai * 128 + m * 16) * DM + col0;
#pragma unroll
            for (int bj = 0; bj < 2; ++bj) {
                const u32x2 g = ga[it][bj];
                const f32x2 ga0 = __builtin_amdgcn_cvt_pk_f32_fp8((int)g.x, false), ga1 = __builtin_amdgcn_cvt_pk_f32_fp8((int)g.x, true), ga2 = __builtin_amdgcn_cvt_pk_f32_fp8((int)g.y, false), ga3 = __builtin_amdgcn_cvt_pk_f32_fp8((int)g.y, true);
                f32x4 a0 = (f32x4){ga0.x, ga0.y, ga1.x, ga1.y} * YD_INV, a1 = (f32x4){ga2.x, ga2.y, ga3.x, ga3.y} * YD_INV;
                if (u.e == 0) {
                    const u32x2 h = gr[it][bj];
                    const f32x2 gr0 = __builtin_amdgcn_cvt_pk_f32_fp8((int)h.x, false), gr1 = __builtin_amdgcn_cvt_pk_f32_fp8((int)h.x, true), gr2 = __builtin_amdgcn_cvt_pk_f32_fp8((int)h.y, false), gr3 = __builtin_amdgcn_cvt_pk_f32_fp8((int)h.y, true);
                    const f32x4 r0 = (f32x4){gr0.x, gr0.y, gr1.x, gr1.y} * YD_INV, r1 = (f32x4){gr2.x, gr2.y, gr3.x, gr3.y} * YD_INV;
#pragma unroll
                    for (int i = 0; i < 4; ++i) { acc[ai][bj][m][0][i] *= r0[i] * __builtin_amdgcn_rcpf(fmaxf(a0[i], 1e-30f)); acc[ai][bj][m][1][i] *= r1[i] * __builtin_amdgcn_rcpf(fmaxf(a1[i], 1e-30f)); }
                } else {
                    const f32x4 v0 = acc[ai][bj][m][0] * a0, v1 = acc[ai][bj][m][1] * a1;
                    u32x2 w; w.x = pk4_fp8(v0[0], v0[1], v0[2], v0[3]); w.y = pk4_fp8(v1[0], v1[1], v1[2], v1[3]);
                    *(u32x2*)(O + ro + bj * 128) = w;
                }
            }
        }
    }
};
struct EpiOProj {
    static constexpr bool PERM = true; static constexpr bool RAW = false;
    const float* x; bf16_t* x1; const float* mod; float* ss;
    __device__ __forceinline__ void operator()(const f32x4 (&acc)[2][2][4][2], const pg8::Unit& u, int wr, int wc, int fr, int fq) const {
        const int row0 = u.pm * 256 + wr * 64 + fr, col0 = u.pn * 256 + wc * 32 + 8 * fq;
        const int b = (u.pm * 256) / SEQ;
        f32x4 gm[2][2];
#pragma unroll
        for (int bj = 0; bj < 2; ++bj)
#pragma unroll
            for (int n = 0; n < 2; ++n) gm[bj][n] = *(const f32x4*)(mod + (size_t)b * 6144 + 2 * DM + col0 + bj * 128 + n * 4);
        f32x4 xv[4][2][2]; u32x4 wv[4][2]; float sqv[4];
#define OP_LOAD(ai) do { _Pragma("unroll") for (int m = 0; m < 4; ++m) _Pragma("unroll") for (int bj = 0; bj < 2; ++bj) { const float* p_ = x + (size_t)(row0 + (ai) * 128 + m * 16) * DM + col0 + bj * 128; \
            xv[m][bj][0] = *(const f32x4*)p_; xv[m][bj][1] = *(const f32x4*)(p_ + 4); } } while (0)
#define OP_CALC(ai) do { _Pragma("unroll") for (int m = 0; m < 4; ++m) { float sq = 0.f; _Pragma("unroll") for (int bj = 0; bj < 2; ++bj) { \
            const f32x4 o0 = xv[m][bj][0] + gm[bj][0] * acc[ai][bj][m][0], o1 = xv[m][bj][1] + gm[bj][1] * acc[ai][bj][m][1]; \
            u32x4 w; w.x = cvtpk(o0[0], o0[1]); w.y = cvtpk(o0[2], o0[3]); w.z = cvtpk(o1[0], o1[1]); w.w = cvtpk(o1[2], o1[3]); wv[m][bj] = w; \
            sq += (o0[0] * o0[0] + o0[1] * o0[1]) + (o0[2] * o0[2] + o0[3] * o0[3]) + (o1[0] * o1[0] + o1[1] * o1[1]) + (o1[2] * o1[2] + o1[3] * o1[3]); } \
            sq += __shfl_xor(sq, 16); sq += __shfl_xor(sq, 32); sqv[m] = sq; } } while (0)
#define OP_STORE(ai) do { _Pragma("unroll") for (int m = 0; m < 4; ++m) { const int row = row0 + (ai) * 128 + m * 16; const size_t ro = (size_t)row * DM + col0; \
            *(u32x4*)(x1 + ro) = wv[m][0]; *(u32x4*)(x1 + ro + 128) = wv[m][1]; if (fq == 0) ss[(size_t)row * 16 + u.pn * 4 + wc] = sqv[m]; } } while (0)
        OP_LOAD(0); OP_CALC(0); OP_LOAD(1); OP_STORE(0); OP_CALC(1); OP_STORE(1);
#undef OP_LOAD
#undef OP_CALC
#undef OP_STORE
    }
};
struct EpiF32 {
    static constexpr bool PERM = false; static constexpr bool RAW = false;
    float* C; int ldc;
    __device__ __forceinline__ void operator()(const f32x4 (&acc)[2][2][4][2], const pg8::Unit& u, int wr, int wc, int fr, int fq) const {
        const int row0 = u.pm * 256 + wr * 64 + fr, col0 = u.pn * 256 + wc * 32 + 4 * fq;
#pragma unroll
        for (int ai = 0; ai < 2; ++ai)
#pragma unroll
            for (int m = 0; m < 4; ++m) { float* rowp = C + (size_t)(row0 + ai * 128 + m * 16) * ldc + col0;
#pragma unroll
                for (int bj = 0; bj < 2; ++bj)
#pragma unroll
                    for (int n = 0; n < 2; ++n) *(f32x4*)(rowp + bj * 128 + n * 16) = acc[ai][bj][m][n]; }
    }
};
struct EpiPlainScratch {
    static constexpr bool PERM = true; static constexpr bool RAW = false;
    bf16_t* O;
    __device__ __forceinline__ void operator()(const f32x4 (&acc)[2][2][4][2], const pg8::Unit& u, int wr, int wc, int fr, int fq) const {
        const int row0 = u.pm * 256 + wr * 64 + fr, col0 = (u.pn & 3) * 256 + wc * 32 + 8 * fq;
#pragma unroll
        for (int ai = 0; ai < 2; ++ai)
#pragma unroll
            for (int m = 0; m < 4; ++m) { bf16_t* rowp = O + (size_t)(row0 + ai * 128 + m * 16) * DM + col0;
#pragma unroll
                for (int bj = 0; bj < 2; ++bj) { const f32x4 v0 = acc[ai][bj][m][0], v1 = acc[ai][bj][m][1];
                    u32x4 w; w.x = cvtpk(v0[0], v0[1]); w.y = cvtpk(v0[2], v0[3]); w.z = cvtpk(v1[0], v1[1]); w.w = cvtpk(v1[2], v1[3]); *(u32x4*)(rowp + bj * 128) = w; } }
    }
};
struct EpiNull {
    static constexpr bool PERM = false; static constexpr bool RAW = false;
    __device__ __forceinline__ void operator()(const f32x4 (&acc)[2][2][4][2], const pg8::Unit&, int, int, int, int) const {
#pragma unroll
        for (int ai = 0; ai < 2; ++ai)
#pragma unroll
            for (int bj = 0; bj < 2; ++bj)
#pragma unroll
                for (int m = 0; m < 4; ++m)
#pragma unroll
                    for (int n = 0; n < 2; ++n) asm volatile("" :: "v"(acc[ai][bj][m][n]));
    }
};
struct EpiGU {
    static constexpr bool PERM = true; static constexpr bool RAW = false;
    bf16_t* hid;
    __device__ __forceinline__ void operator()(const f32x4 (&acc)[2][2][4][2], const pg8::Unit& u, int wr, int wc, int fr, int fq) const {
        const int row0 = u.pm * 256 + wr * 64 + fr, col0 = u.pn * 128 + wc * 32 + 8 * fq;
#pragma unroll
        for (int ai = 0; ai < 2; ++ai)
#pragma unroll
            for (int m = 0; m < 4; ++m) { bf16_t* rowp = hid + (size_t)(row0 + ai * 128 + m * 16) * EH + col0;
                f32x4 h0, h1;
#pragma unroll
                for (int i = 0; i < 4; ++i) { h0[i] = siluf_(acc[ai][0][m][0][i]) * acc[ai][1][m][0][i]; h1[i] = siluf_(acc[ai][0][m][1][i]) * acc[ai][1][m][1][i]; }
                u32x4 w; w.x = cvtpk(h0[0], h0[1]); w.y = cvtpk(h0[2], h0[3]); w.z = cvtpk(h1[0], h1[1]); w.w = cvtpk(h1[2], h1[3]); *(u32x4*)rowp = w; }
    }
};
template <int MODE> struct EpiDownT {
    static constexpr bool PERM = true; static constexpr bool RAW = false;
    unsigned char* ws; const LAS int* exp_info;
    __device__ __forceinline__ void operator()(const f32x4 (&acc)[2][2][4][2], const pg8::Unit& u, int wr, int wc, int fr, int fq) const {
        const int shift = __builtin_amdgcn_readfirstlane(exp_info[u.e]), lim = __builtin_amdgcn_readfirstlane(exp_info[512 + u.e]);
        const int row0 = u.pm * 256 + wr * 64 + fr, col0 = u.pn * 256 + wc * 32 + 8 * fq;
#pragma unroll
        for (int ai = 0; ai < 2; ++ai)
#pragma unroll
            for (int m = 0; m < 4; ++m) {
                const int pos = row0 + ai * 128 + m * 16;
                if (pos < lim) {
                    unsigned char* rowp = (MODE == 1 ? ws + WS_SS + (size_t)blockIdx.x * 2048 : ydense_row(ws, pos - shift)) + col0;
#pragma unroll
                    for (int bj = 0; bj < 2; ++bj) { const f32x4 v0 = acc[ai][bj][m][0], v1 = acc[ai][bj][m][1];
                        u32x2 w; w.x = pk4_fp8(v0[0], v0[1], v0[2], v0[3]); w.y = pk4_fp8(v1[0], v1[1], v1[2], v1[3]);
                        *(u32x2*)(rowp + bj * 128) = w; }
                }
            }
    }
};
typedef EpiDownT<0> EpiDown;

template <bool F8 = false> __device__ __forceinline__ void transpose_item(const float* W, int N, int K, int k0, int n0, bf16_t* WT, int drow0, LAS float* scr, int lane) {
#pragma unroll 8
    for (int i = 0; i < 32; ++i) { const int kk = 2 * i + (lane >> 5); scr[kk * 33 + (lane & 31)] = W[(size_t)(k0 + kk) * N + n0 + (lane & 31)]; }
    asm volatile("s_waitcnt lgkmcnt(0)" ::: "memory");
    const int c = lane & 7;
#pragma unroll
    for (int j = 0; j < 4; ++j) { const int n = (lane >> 3) + 8 * j; const LAS float* s = scr + (8 * c) * 33 + n;
        if constexpr (F8) { u32x2 o; o.x = pk4_fp8w(s[0 * 33], s[1 * 33], s[2 * 33], s[3 * 33]); o.y = pk4_fp8w(s[4 * 33], s[5 * 33], s[6 * 33], s[7 * 33]);
            *(u32x2*)((unsigned char*)WT + (size_t)(drow0 + n) * K + k0 + 8 * c) = o; }
        else { u32x4 o; o.x = cvtpk(s[0 * 33], s[1 * 33]); o.y = cvtpk(s[2 * 33], s[3 * 33]); o.z = cvtpk(s[4 * 33], s[5 * 33]); o.w = cvtpk(s[6 * 33], s[7 * 33]);
            *(u32x4*)(WT + (size_t)(drow0 + n) * K + k0 + 8 * c) = o; } }
    asm volatile("s_waitcnt lgkmcnt(0)" ::: "memory");
}
template <bool F8 = false> __device__ __forceinline__ void transpose_plain(const float* W, int K, int N, bf16_t* WT, LAS float* scr, int item, int lane) {
    const int nblk = N / 32, kb = item / nblk, nb = item % nblk;
    transpose_item<F8>(W, N, K, 64 * kb, 32 * nb, WT, 32 * nb, scr, lane);
}

__device__ __forceinline__ int t5_bucket(int rel) {
    const int n = rel < 0 ? -rel : rel;
    int large = 8 + (int)(logf((float)(n > 1 ? n : 1) / 8.0f) / 4.852030263919617f * 8.0f);
    large = large < 15 ? large : 15;
    return (rel > 0 ? 16 : 0) + (n < 8 ? n : large);
}

__device__ __forceinline__ void phase0(Frame& F, const Args& a) {
    const float* c = a.in[1]; const float* w_ada = a.in[2]; const float* b_ada = a.in[3];
    {
        LAS float* cond = (LAS float*)F.lds;
        LAS float* red = (LAS float*)(F.lds + 32768);
        for (int i = F.tid; i < NB * DM; i += NTHR) cond[i] = siluf_(c[i]);
        __syncthreads();
        for (int cg = F.vcu; cg < 256; cg += F.G) {
            const int j = F.tid & 31, kg = F.tid >> 5;
            float s[NB];
#pragma unroll
            for (int b = 0; b < NB; ++b) s[b] = 0.f;
            if (j < 24) {
                for (int k = kg; k < DM; k += 16) { const float w = w_ada[(size_t)k * 6144 + cg * 24 + j];
#pragma unroll
                    for (int b = 0; b < NB; ++b) s[b] += cond[b * DM + k] * w; }
            }
#pragma unroll
            for (int b = 0; b < NB; ++b) red[(kg * NB + b) * 32 + j] = s[b];
            __syncthreads();
            if (F.tid < 192) { const int b = F.tid / 24, jj = F.tid % 24; float t = 0.f;
                for (int g = 0; g < 16; ++g) t += red[(g * NB + b) * 32 + jj];
                ((float*)(F.ws + WS_MOD))[b * 6144 + cg * 24 + jj] = t + b_ada[cg * 24 + jj]; }
            __syncthreads();
        }
    }
    const int gt = F.vcu * NTHR + F.tid, NGT = F.G * NTHR;
    {
        unsigned short* rt = (unsigned short*)(F.ws + WS_ROPE_C);
        for (int i = gt; i < SEQ * 128; i += NGT) { const int pos = i >> 7, d = i & 127;
            const float inv = (float)pow(10000.0, -(double)d / 128.0); const float ang = (float)pos * inv;
            const size_t o = ((size_t)pos * 16 + (d >> 3)) * 16 + (d & 7);
            rt[o] = (unsigned short)(cvtpk((float)cos((double)ang), 0.f) & 0xffffu); rt[o + 8] = (unsigned short)(cvtpk((float)sin((double)ang), 0.f) & 0xffffu); }
    }
    {
        const float* t5 = a.in[7]; float* bt = (float*)(F.ws + WS_BTAB);
        for (int i = gt; i < 3 * 16 * 160; i += NGT) { const int g = i / (16 * 160), h = (i / 160) % 16, j = i % 160;
            const int dil = g == 0 ? 1 : (g == 1 ? 4 : 16);
            bt[i] = j <= 128 ? t5[t5_bucket((j - 64) * dil) * 16 + h] * 1.4426950408889634f : 0.f; }
    }
    { unsigned* z = (unsigned*)(F.ws + WS_H + (size_t)NTOK * DM * 2); for (int i = gt; i < DM / 2; i += NGT) z[i] = 0u; }
    {
        LAS float* scr = (LAS float*)(F.lds + 49152 + F.wave * 8704);
        const int gw = F.vcu * NWAVES + F.wave, NGW = F.G * NWAVES;
        constexpr int I_IN = (DM / 64) * (PROJW / 32), I_SQ = (DM / 64) * (DM / 32), I_R = (DM / 64) * (NEXP / 32);
        constexpr int NITEMS = I_IN + 3 * I_SQ + I_R;
        for (int it = gw; it < NITEMS; it += NGW) {
            int r = it;
            if (r < I_IN) { transpose_plain<true>(a.in[5], DM, PROJW, (bf16_t*)(F.ws + WS_WIN), scr, r, F.lane); continue; } r -= I_IN;
            if (r < I_SQ) { transpose_plain<true>(a.in[8], DM, DM, (bf16_t*)(F.ws + WS_WRU), scr, r, F.lane); continue; } r -= I_SQ;
            if (r < I_SQ) { transpose_plain<true>(a.in[9], DM, DM, (bf16_t*)(F.ws + WS_WAU), scr, r, F.lane); continue; } r -= I_SQ;
            if (r < I_SQ) { transpose_plain<true>(a.in[10], DM, DM, (bf16_t*)(F.ws + WS_WO), scr, r, F.lane); continue; } r -= I_SQ;
            transpose_plain(a.in[12], DM, NEXP, (bf16_t*)(F.ws + WS_WR), scr, r, F.lane);
        }
    }
}

constexpr int CW_CONVQ = 16384 + 2048;
constexpr size_t WGU_E_BYTES = 512 * 1024, WGU_T_BYTES = 256 * 1024;
__device__ __forceinline__ void moe_weight_convert(Frame& F, const Args& a) {
    LAS unsigned char* img = F.lds + F.wave * 16384;
    const int total = 257 * 2 * 16, c = F.lane;
    unsigned* q = (unsigned*)(F.ws + WS_CTL) + CW_CONVQ;
    const int R0 = 32 * ((c >> 3) & 3) + 16 * (c & 1) + 4 * ((c & 7) >> 1);
    const int lbase = (c >> 5) * 8192 + (R0 >> 4) * 1024 + (R0 & 15) * 64;
    f32x4 va[16], vb[16];
#define CV_SRC(it) ((((it) >> 5) < 256 ? a.in[14 + (((it) >> 4) & 1)] + (size_t)((it) >> 5) * 1024 * 256 : a.in[17 + (((it) >> 4) & 1)]) + (size_t)((it) & 15) * 64 * 256 + 4 * c)
#define CV_LOAD(V, p, s) do { _Pragma("unroll") for (int r = 0; r < 16; ++r) V[r] = __builtin_nontemporal_load((const f32x4*)((p) + (size_t)(16 * (s) + r) * 256)); } while (0)
#define CV_PROC(V, s) do { _Pragma("unroll") for (int nn = 0; nn < 4; ++nn) { u32x4 pc; pc.x = pk4_fp8w(V[0][nn], V[1][nn], V[2][nn], V[3][nn]); pc.y = pk4_fp8w(V[4][nn], V[5][nn], V[6][nn], V[7][nn]); \
        pc.z = pk4_fp8w(V[8][nn], V[9][nn], V[10][nn], V[11][nn]); pc.w = pk4_fp8w(V[12][nn], V[13][nn], V[14][nn], V[15][nn]); \
        const int o_ = lbase + nn * 64 + 16 * (s); *(LAS u32x4*)(img + (o_ ^ (((o_ >> 9) & 1) << 5))) = pc; } } while (0)
    unsigned cur = 0;
    if (c == 0) cur = __hip_atomic_fetch_add(q, 1u, __ATOMIC_RELAXED, __HIP_MEMORY_SCOPE_AGENT);
    cur = __builtin_amdgcn_readfirstlane(cur);
    if ((int)cur >= total) return;
    const float* sp = CV_SRC(cur);
    CV_LOAD(va, sp, 0);
#pragma unroll 1
    for (;;) {
        unsigned nxt = 0;
        if (c == 0) nxt = __hip_atomic_fetch_add(q, 1u, __ATOMIC_RELAXED, __HIP_MEMORY_SCOPE_AGENT);
        nxt = __builtin_amdgcn_readfirstlane(nxt);
        const bool more = (int)nxt < total;
        const float* np = more ? CV_SRC(nxt) : sp;
        CV_LOAD(vb, sp, 1); CV_PROC(va, 0);
        CV_LOAD(va, sp, 2); CV_PROC(vb, 1);
        CV_LOAD(vb, sp, 3); CV_PROC(va, 2);
        CV_LOAD(va, np, 0); CV_PROC(vb, 3);
        asm volatile("s_waitcnt lgkmcnt(0)" ::: "memory");
        const int e = cur >> 5, kind = (cur >> 4) & 1, kb = cur & 15;
        unsigned char* dst = F.ws + WS_WGU + (size_t)e * WGU_E_BYTES + (size_t)(kb >> 1) * 32768 + (size_t)kind * 16384 + (size_t)(kb & 1) * 1024 + 16 * c;
#pragma unroll
        for (int j = 0; j < 16; ++j) *(u32x4*)(dst + (size_t)(j >> 3) * WGU_T_BYTES + (size_t)(j & 7) * 2048) = *(const LAS u32x4*)(img + j * 1024 + 16 * c);
        asm volatile("s_waitcnt lgkmcnt(0)" ::: "memory");
        if (!more) break;
        cur = nxt; sp = np;
    }
#undef CV_SRC
#undef CV_LOAD
#undef CV_PROC
}

template <bool BF16IN, int OUT8> __device__ __forceinline__ void norm_mod_rows(Frame& F, const void* xin, const float* norm, const float* mod, int shift_off, int scale_off, const float* ssp, bf16_t* out, unsigned char* out8) {
    const float* x = (const float*)xin; const bf16_t* xb = (const bf16_t*)xin;
    const int gw = F.vcu * NWAVES + F.wave, NGW = F.G * NWAVES;
    f32x4 g4[4];
#pragma unroll
    for (int j = 0; j < 4; ++j) g4[j] = *(const f32x4*)(norm + 4 * F.lane + 256 * j);
    f32x4 v[4], vn[4]; float p = 0.f, pn = 0.f;
    int row = gw;
#define NM_LOAD(V, ROW) do { if (BF16IN) { const u32x2* xr_ = (const u32x2*)(xb + (size_t)(ROW) * DM) + F.lane; _Pragma("unroll") for (int j = 0; j < 4; ++j) { const u32x2 t_ = xr_[64 * j]; V[j] = (f32x4){bflo(t_.x), bfhi(t_.x), bflo(t_.y), bfhi(t_.y)}; } } \
        else { const f32x4* xr_ = (const f32x4*)(x + (size_t)(ROW) * DM) + F.lane; _Pragma("unroll") for (int j = 0; j < 4; ++j) V[j] = xr_[64 * j]; } } while (0)
    if (row < NTOK) { NM_LOAD(v, row);
        if (ssp) p = F.lane < 16 ? ssp[(size_t)row * 16 + F.lane] : 0.f; }
#pragma unroll 1
    for (; row < NTOK; row += NGW) {
        const int nrow = row + NGW < NTOK ? row + NGW : row;
        { NM_LOAD(vn, nrow);
          if (ssp) pn = F.lane < 16 ? ssp[(size_t)nrow * 16 + F.lane] : 0.f; }
        const int b = row / SEQ;
        float s = 0.f;
#pragma unroll
        for (int j = 0; j < 4; ++j) s += (v[j][0] * v[j][0] + v[j][1] * v[j][1]) + (v[j][2] * v[j][2] + v[j][3] * v[j][3]);
        const float tot = wave_sum(ssp ? p : s);
        const float rstd = rsqrtf(tot * (1.f / DM) + NORM_EPS);
        u32x2* o8 = (u32x2*)(out + (size_t)row * DM) + F.lane;
#pragma unroll
        for (int j = 0; j < 4; ++j) {
            const int col = 4 * F.lane + 256 * j;
            const f32x4 sc = *(const f32x4*)(mod + (size_t)b * 6144 + scale_off + col), sh = *(const f32x4*)(mod + (size_t)b * 6144 + shift_off + col);
            const f32x4 y = (v[j] * rstd) * g4[j] * (sc + 1.0f) + sh;
            if (OUT8 != 1) { u32x2 w; w.x = cvtpk(y[0], y[1]); w.y = cvtpk(y[2], y[3]); o8[64 * j] = w; }
            if (OUT8 != 0) *(unsigned*)(out8 + (size_t)row * DM + col) = pk4_fp8(y[0], y[1], y[2], y[3]);
        }
#pragma unroll
        for (int j = 0; j < 4; ++j) v[j] = vn[j];
        p = pn;
    }
}

__device__ __forceinline__ unsigned off_b(unsigned row, unsigned ch) { return 256u * row + 16u * (ch ^ (((row & 3) << 2) | ((row >> 2) & 3))); }
__device__ __forceinline__ int crow(int reg, int h) { return (reg & 3) + 8 * (reg >> 2) + 4 * h; }
__device__ __forceinline__ s16x4 tr_read(LAS unsigned char* p) { return __builtin_bit_cast(s16x4, __builtin_amdgcn_ds_read_tr16_b64_v4i16((LAS s16x4*)p)); }
__device__ __forceinline__ bf16x8 pack8(const f32x16& x, int s) {
    u32x4 p; p.x = cvtpk(x[8 * s], x[8 * s + 1]); p.y = cvtpk(x[8 * s + 2], x[8 * s + 3]); p.z = cvtpk(x[8 * s + 4], x[8 * s + 5]); p.w = cvtpk(x[8 * s + 6], x[8 * s + 7]);
    return __builtin_bit_cast(bf16x8, p);
}
#define MFMA32(a, b, c) __builtin_amdgcn_mfma_f32_32x32x16_bf16((a), (b), (c), 0, 0, 0)

constexpr int RK_STR = 528, RV_STR = 192;
constexpr int RL_K = 0, RL_V = 128 * RK_STR, RL_S = RL_V + 128 * RV_STR, RL_P = RL_S + 64 * RK_STR, RL_END = RL_P + 10 * 2048;
__device__ __forceinline__ void retention_chain_rs(Frame& F, const Args& a, int chain) {
    const int b = chain >> 5, h = (chain >> 3) & 3, dir = (chain >> 2) & 1, es = chain & 3;
    const int lane = F.lane, r = lane & 31, hh = lane >> 5, w = F.wave;
    const bool outw = w < 4; const int ib = w & 3, sw = w & 3;
    const bf16_t* RQ = (const bf16_t*)(F.ws + WS_RQ); const bf16_t* RK = (const bf16_t*)(F.ws + WS_RK); const bf16_t* RV = (const bf16_t*)(F.ws + WS_RV);
    bf16_t* OUT = (bf16_t*)(F.ws + (dir ? WS_OUTB : WS_OUTF));
    const float lg = log1pf(-__expf(a.in[6][dir * 4 + h]));
    const float decayC = __expf(lg * 128.f);
    LAS unsigned char* lds = F.lds;
    f32x16 R[4];
#pragma unroll
    for (int k = 0; k < 4; ++k)
#pragma unroll
        for (int i = 0; i < 16; ++i) R[k][i] = 0.f;
#define QFRAG(s) __builtin_bit_cast(bf16x8, (f32x4){R[(s) >> 2][4 * ((s) & 3)], R[(s) >> 2][4 * ((s) & 3) + 1], R[(s) >> 2][4 * ((s) & 3) + 2], R[(s) >> 2][4 * ((s) & 3) + 3]})
#define QLOAD(s, P) do { const f32x4 t_ = *(const f32x4*)(P); R[(s) >> 2][4 * ((s) & 3)] = t_[0]; R[(s) >> 2][4 * ((s) & 3) + 1] = t_[1]; R[(s) >> 2][4 * ((s) & 3) + 2] = t_[2]; R[(s) >> 2][4 * ((s) & 3) + 3] = t_[3]; } while (0)
    for (int i = F.tid; i < (64 * RK_STR) / 16; i += NTHR) *(LAS u32x4*)(lds + RL_S + i * 16) = (u32x4){0u, 0u, 0u, 0u};
    const int vj = F.tid >> 2, ve0 = (F.tid & 3) * 16;
    const float vscale = __expf(lg * (dir == 0 ? (float)(127 - vj) : (float)vj));
    const int blk = (lane >> 4) & 1, q4 = (lane & 15) >> 2, p4 = lane & 3;
    LAS unsigned char* kbase = lds + RL_K + r * RK_STR + 16 * hh;
    LAS unsigned char* sbase = lds + RL_S + r * RK_STR + 16 * hh;
    LAS unsigned char* vtr = lds + RL_V + (4 * hh + q4) * RV_STR + (16 * blk + 4 * p4) * 2;
    LAS unsigned char* ktr = lds + RL_K + (4 * hh + q4) * RK_STR + (sw * 64 + 16 * blk + 4 * p4) * 2;
    LAS unsigned char* spub = lds + RL_S + r * RK_STR + (sw * 64 + 4 * hh) * 2;
    const float rsc = __expf(lg * (dir == 0 ? (float)(ib * 32 + r - 127) : (float)(-(ib * 32 + r))));
    const char* RKb = (const char*)RK + (size_t)h * 512; const char* RVb = (const char*)RV + (size_t)(h * 256 + es * 64) * 2; const char* RQb = (const char*)RQ + ((size_t)((b * 4 + h) * 32) * 4 + ib) * 16384;
    char* OUTb = (char*)OUT + (size_t)(ib * 32 * DM + h * 256 + es * 64) * 2;
    const unsigned klo = (unsigned)(((F.tid >> 5) * DM + (F.tid & 31) * 8) * 2), vlo = (unsigned)((vj * DM + ve0) * 2), qlo = (unsigned)(lane * 16), olo = (unsigned)((r * DM + 4 * hh) * 2);
    u32x4 kpre[8]; u32x4 vpre[2];
    {
        const size_t t0 = (size_t)b * SEQ + (size_t)(dir == 0 ? 0 : 31) * 128;
        const char* kc = RKb + t0 * (DM * 2); const char* vc = RVb + t0 * (DM * 2); const char* qc = RQb + (size_t)(dir == 0 ? 0 : 31) * 65536;
#pragma unroll
        for (int i = 0; i < 8; ++i) kpre[i] = *(const u32x4*)(kc + (size_t)i * (16 * DM * 2) + klo);
        vpre[0] = *(const u32x4*)(vc + vlo); vpre[1] = *(const u32x4*)(vc + vlo + 16);
        if (outw) {
#pragma unroll
            for (int s = 0; s < 16; ++s) QLOAD(s, qc + qlo + 1024 * s);
        }
    }
#pragma unroll 1
    for (int n = 0; n < 32; ++n) {
        const int cidx = dir == 0 ? n : 31 - n;
        const size_t t0 = (size_t)b * SEQ + (size_t)cidx * 128;
        {
            LAS unsigned char* kw = lds + RL_K + (F.tid >> 5) * RK_STR + (F.tid & 31) * 16;
#pragma unroll
            for (int i = 0; i < 8; ++i) *(LAS u32x4*)(kw + i * 16 * RK_STR) = kpre[i];
#pragma unroll
            for (int i = 0; i < 2; ++i) {
                u32x4 o; o.x = cvtpk(bflo(vpre[i].x) * vscale, bfhi(vpre[i].x) * vscale); o.y = cvtpk(bflo(vpre[i].y) * vscale, bfhi(vpre[i].y) * vscale);
                o.z = cvtpk(bflo(vpre[i].z) * vscale, bfhi(vpre[i].z) * vscale); o.w = cvtpk(bflo(vpre[i].w) * vscale, bfhi(vpre[i].w) * vscale);
                *(LAS u32x4*)(lds + RL_V + vj * RV_STR + ve0 * 2 + 16 * i) = o;
            }
        }
        __syncthreads();
        {
            const int nn = n + 1 < 32 ? n + 1 : n; const int cn = dir == 0 ? nn : 31 - nn;
            const size_t t1 = (size_t)b * SEQ + (size_t)cn * 128;
            const char* kc = RKb + t1 * (DM * 2); const char* vc = RVb + t1 * (DM * 2);
#pragma unroll
            for (int i = 0; i < 8; ++i) kpre[i] = *(const u32x4*)(kc + (size_t)i * (16 * DM * 2) + klo);
            vpre[0] = *(const u32x4*)(vc + vlo); vpre[1] = *(const u32x4*)(vc + vlo + 16);
        }
        if (outw) {
            f32x16 acc0, acc1;
#pragma unroll
            for (int i = 0; i < 16; ++i) { acc0[i] = 0.f; acc1[i] = 0.f; }
            const int jb_lo = dir == 0 ? 0 : ib, jb_hi = dir == 0 ? ib : 3;
#pragma unroll 1
            for (int jb = jb_lo; jb <= jb_hi; ++jb) {
                LAS unsigned char* kb = kbase + jb * (32 * RK_STR);
                f32x16 sT;
#pragma unroll
                for (int i = 0; i < 16; ++i) sT[i] = 0.f;
#pragma unroll
                for (int hb = 0; hb < 2; ++hb) {
                    bf16x8 kf[8];
#pragma unroll
                    for (int s = 0; s < 8; ++s) kf[s] = *(const LAS bf16x8*)(kb + (hb * 8 + s) * 32);
                    __builtin_amdgcn_sched_barrier(0);
#pragma unroll
                    for (int s = 0; s < 8; ++s) sT = MFMA32(kf[s], QFRAG(hb * 8 + s), sT);
                    __builtin_amdgcn_sched_barrier(0);
                }
                if (jb == ib) {
#pragma unroll
                    for (int i = 0; i < 16; ++i) { const int jl = crow(i, hh); const bool keep = dir == 0 ? (jl <= r) : (jl > r); sT[i] = keep ? sT[i] : 0.f; }
                }
                const bf16x8 p0 = pack8(sT, 0), p1 = pack8(sT, 1);
                LAS unsigned char* vb = vtr + jb * (32 * RV_STR);
#pragma unroll
                for (int s2 = 0; s2 < 2; ++s2) {
                    const s16x4 l0 = tr_read(vb + s2 * (16 * RV_STR)), h0 = tr_read(vb + s2 * (16 * RV_STR) + 8 * RV_STR);
                    const s16x4 l1 = tr_read(vb + s2 * (16 * RV_STR) + 64), h1 = tr_read(vb + s2 * (16 * RV_STR) + 8 * RV_STR + 64);
                    acc0 = MFMA32(__builtin_shufflevector(l0, h0, 0, 1, 2, 3, 4, 5, 6, 7), s2 == 0 ? p0 : p1, acc0);
                    acc1 = MFMA32(__builtin_shufflevector(l1, h1, 0, 1, 2, 3, 4, 5, 6, 7), s2 == 0 ? p0 : p1, acc1);
                }
            }
#pragma unroll
            for (int hb = 0; hb < 4; ++hb) {
                bf16x8 sf0[4], sf1[4];
#pragma unroll
                for (int s = 0; s < 4; ++s) { sf0[s] = *(const LAS bf16x8*)(sbase + (hb * 4 + s) * 32); sf1[s] = *(const LAS bf16x8*)(sbase + 32 * RK_STR + (hb * 4 + s) * 32); }
                __builtin_amdgcn_sched_barrier(0);
#pragma unroll
                for (int s = 0; s < 4; ++s) { acc0 = MFMA32(sf0[s], QFRAG(hb * 4 + s), acc0); acc1 = MFMA32(sf1[s], QFRAG(hb * 4 + s), acc1); }
                __builtin_amdgcn_sched_barrier(0);
            }
            u32x2 ow[8];
#pragma unroll
            for (int g = 0; g < 4; ++g) { ow[g].x = cvtpk(acc0[4 * g] * rsc, acc0[4 * g + 1] * rsc); ow[g].y = cvtpk(acc0[4 * g + 2] * rsc, acc0[4 * g + 3] * rsc);
                ow[4 + g].x = cvtpk(acc1[4 * g] * rsc, acc1[4 * g + 1] * rsc); ow[4 + g].y = cvtpk(acc1[4 * g + 2] * rsc, acc1[4 * g + 3] * rsc); }
            {
                const int nn = n + 1 < 32 ? n + 1 : n; const int cn = dir == 0 ? nn : 31 - nn;
                const char* qc = RQb + (size_t)cn * 65536;
#pragma unroll
                for (int s = 0; s < 16; ++s) QLOAD(s, qc + qlo + 1024 * s);
            }
            {
                char* oc = OUTb + t0 * (DM * 2) + olo;
#pragma unroll
                for (int g = 0; g < 4; ++g) { *(u32x2*)(oc + g * 16) = ow[g]; *(u32x2*)(oc + 64 + g * 16) = ow[4 + g]; }
            }
        } else {
#pragma unroll
            for (int ks = 0; ks < 8; ++ks) {
                const s16x4 vl0 = tr_read(vtr + ks * (16 * RV_STR)), vh0 = tr_read(vtr + ks * (16 * RV_STR) + 8 * RV_STR);
                const s16x4 vl1 = tr_read(vtr + ks * (16 * RV_STR) + 64), vh1 = tr_read(vtr + ks * (16 * RV_STR) + 8 * RV_STR + 64);
                const bf16x8 vf0 = __builtin_shufflevector(vl0, vh0, 0, 1, 2, 3, 4, 5, 6, 7), vf1 = __builtin_shufflevector(vl1, vh1, 0, 1, 2, 3, 4, 5, 6, 7);
#pragma unroll
                for (int dd = 0; dd < 2; ++dd) {
                    const s16x4 lo = tr_read(ktr + ks * (16 * RK_STR) + dd * 64), hi = tr_read(ktr + ks * (16 * RK_STR) + 8 * RK_STR + dd * 64);
                    const bf16x8 kt = __builtin_shufflevector(lo, hi, 0, 1, 2, 3, 4, 5, 6, 7);
                    R[2 * dd] = MFMA32(kt, vf0, R[2 * dd]); R[2 * dd + 1] = MFMA32(kt, vf1, R[2 * dd + 1]);
                }
            }
#pragma unroll
            for (int k = 0; k < 4; ++k)
#pragma unroll
                for (int i = 0; i < 16; ++i) R[k][i] *= decayC;
        }
        __syncthreads();
        if (!outw) {
#pragma unroll
            for (int dd = 0; dd < 2; ++dd)
#pragma unroll
                for (int e = 0; e < 2; ++e)
#pragma unroll
                    for (int g = 0; g < 4; ++g) { u32x2 wv; wv.x = cvtpk(R[2 * dd + e][4 * g], R[2 * dd + e][4 * g + 1]); wv.y = cvtpk(R[2 * dd + e][4 * g + 2], R[2 * dd + e][4 * g + 3]);
                        *(LAS u32x2*)(spub + e * (32 * RK_STR) + dd * 64 + g * 16) = wv; }
        }
    }
    __syncthreads();
#undef QFRAG
#undef QLOAD
}

__device__ __forceinline__ u32x4 fp8x8_to_bf16(unsigned w0, unsigned w1) {
    const f32x2 a = __builtin_amdgcn_cvt_pk_f32_fp8((int)w0, false), b = __builtin_amdgcn_cvt_pk_f32_fp8((int)w0, true), c = __builtin_amdgcn_cvt_pk_f32_fp8((int)w1, false), d = __builtin_amdgcn_cvt_pk_f32_fp8((int)w1, true);
    return (u32x4){cvtpk(a.x, a.y), cvtpk(b.x, b.y), cvtpk(c.x, c.y), cvtpk(d.x, d.y)};
}
constexpr int AK_STR = 144, AV_STR = 192;
constexpr int AL_K = 0, AL_V = 384 * AK_STR, AL_B = AL_V + 384 * AV_STR, AL_END = AL_B + 896;
struct AttUnit { int g, dil, length, res, run0, b, head; };
__device__ __forceinline__ AttUnit att_decode(int slot) {
    AttUnit u; const int bh = slot / 48, k = slot % 48, ru = k & 15; u.g = k >> 4;
    u.dil = u.g == 0 ? 1 : (u.g == 1 ? 4 : 16); u.length = SEQ / u.dil; u.res = ru % u.dil; u.run0 = (ru / u.dil) * 256; u.b = bh >> 4; u.head = bh & 15; return u;
}
__device__ __forceinline__ void attention_phase(Frame& F, int u0, int u1, int zero) {
    if (u0 >= u1) return;
    const int lane = F.lane, r = lane & 31, hh = lane >> 5, w = F.wave;
    const unsigned char* AQ = F.ws + WS_AQ; const unsigned char* AK = F.ws + WS_AK; const unsigned char* AV = F.ws + WS_AV;
    LAS unsigned char* lds = F.lds;
    const int blk = (lane >> 4) & 1, q4 = (lane & 15) >> 2, p4 = lane & 3;
    LAS unsigned char* kbase = lds + AL_K + (32 * w + r) * AK_STR + 16 * hh;
    LAS unsigned char* vbase = lds + AL_V + (32 * w + 4 * hh + q4) * AV_STR + (16 * blk + 4 * p4) * 2;
    const LAS float* bt = (const LAS float*)(lds + AL_B) + (4 * hh - r + 32);
    u32x4 kk[3], vv[3]; u32x2 qn[4]; float bnext = 0.f;
    u32x4 kk2[3], vv2[3]; u32x2 qn2[4]; float bnext2 = 0.f;
#define ATT_LOAD(U) do { const AttUnit un_ = att_decode(U); \
        if (F.tid < 224) { const int X_ = F.tid - 32; bnext = (X_ >= 0 && X_ <= 128) ? ((const float*)(F.ws + WS_BTAB))[(un_.g * 16 + un_.head) * 160 + X_] : -3.0e38f; } \
        _Pragma("unroll") for (int i = 0; i < 3; ++i) { const int id = F.tid + i * NTHR, row = id >> 2, ch = id & 3; int idx = un_.run0 - 64 + row; idx = idx < 0 ? 0 : (idx >= un_.length ? un_.length - 1 : idx); \
            const size_t off = ((size_t)un_.b * SEQ + (size_t)idx * un_.dil + un_.res) * DM + un_.head * 64 + ch * 16; kk[i] = *(const u32x4*)(AK + off); vv[i] = *(const u32x4*)(AV + off); } \
        const size_t qt_ = (size_t)un_.b * SEQ + (size_t)(un_.run0 + 32 * w + r) * un_.dil + un_.res; \
        _Pragma("unroll") for (int s = 0; s < 4; ++s) qn[s] = *(const u32x2*)(AQ + qt_ * DM + un_.head * 64 + 16 * s + 8 * hh); } while (0)
#define ATT_LOAD2(U) do { const AttUnit un_ = att_decode(U); \
        if (F.tid < 224) { const int X_ = F.tid - 32; bnext2 = (X_ >= 0 && X_ <= 128) ? ((const float*)(F.ws + WS_BTAB))[(un_.g * 16 + un_.head) * 160 + X_] : -3.0e38f; } \
        _Pragma("unroll") for (int i = 0; i < 3; ++i) { const int id = F.tid + i * NTHR, row = id >> 2, ch = id & 3; int idx = un_.run0 - 64 + row; idx = idx < 0 ? 0 : (idx >= un_.length ? un_.length - 1 : idx); \
            const size_t off = ((size_t)un_.b * SEQ + (size_t)idx * un_.dil + un_.res) * DM + un_.head * 64 + ch * 16; kk2[i] = *(const u32x4*)(AK + off); vv2[i] = *(const u32x4*)(AV + off); } \
        const size_t qt_ = (size_t)un_.b * SEQ + (size_t)(un_.run0 + 32 * w + r) * un_.dil + un_.res; \
        _Pragma("unroll") for (int s = 0; s < 4; ++s) qn2[s] = *(const u32x2*)(AQ + qt_ * DM + un_.head * 64 + 16 * s + 8 * hh); } while (0)
    const int nun = u1 - u0, nit = nun * (PROBE_PHASE == 31 ? 2 : 1);
#define ATT_SLOT(I) (u0 + ((I) >= nit ? nun - 1 : ((I) >= nun ? (I) - nun : (I))))
    ATT_LOAD(ATT_SLOT(0)); ATT_LOAD2(ATT_SLOT(1));
#pragma unroll 1
    for (int it = 0; it < nit; ++it) {
        const int unit = u0 + (it >= nun ? it - nun : it);
        const AttUnit un = att_decode(unit);
        unsigned char* OG = F.ws + WS_OG + (size_t)un.g * (SEG / 2); float* LSE = (float*)(F.ws + WS_LSE) + (size_t)un.g * NTOK * 16;
#pragma unroll
        for (int i = 0; i < 3; ++i) { const int id = F.tid + i * NTHR, row = id >> 2, ch = id & 3;
            *(LAS u32x4*)(lds + AL_K + row * AK_STR + 32 * ch) = fp8x8_to_bf16(kk[i].x, kk[i].y); *(LAS u32x4*)(lds + AL_K + row * AK_STR + 32 * ch + 16) = fp8x8_to_bf16(kk[i].z, kk[i].w);
            *(LAS u32x4*)(lds + AL_V + row * AV_STR + 32 * ch) = fp8x8_to_bf16(vv[i].x, vv[i].y); *(LAS u32x4*)(lds + AL_V + row * AV_STR + 32 * ch + 16) = fp8x8_to_bf16(vv[i].z, vv[i].w); }
        if (F.tid < 224) ((LAS float*)(lds + AL_B))[F.tid] = bnext;
        bf16x8 qf[4];
#pragma unroll
        for (int s = 0; s < 4; ++s) qf[s] = __builtin_bit_cast(bf16x8, fp8x8_to_bf16(qn[s].x, qn[s].y));
        __syncthreads();
#pragma unroll
        for (int i = 0; i < 3; ++i) { kk[i] = kk2[i]; vv[i] = vv2[i]; }
#pragma unroll
        for (int s = 0; s < 4; ++s) qn[s] = qn2[s];
        bnext = bnext2;
        ATT_LOAD2(ATT_SLOT(it + 2));
        const size_t qtok = (size_t)un.b * SEQ + (size_t)(un.run0 + 32 * w + r) * un.dil + un.res;
        const int lv = 4 * hh - r, kv = un.run0 - 64 + 32 * w + 4 * hh;
        const int clo = max(-lv, -kv), chi = min(128 - lv, un.length - 1 - kv);
        const bool edge = (un.run0 == 0) || (un.run0 + 256 == un.length);
        float m, lsum = 0.f;
        f32x16 o0, o1, sT[5];
#pragma unroll
        for (int i = 0; i < 16; ++i) { o0[i] = 0.f; o1[i] = 0.f; }
#pragma unroll
        for (int kb = 0; kb < 5; ++kb) {
#pragma unroll
            for (int i = 0; i < 16; ++i) sT[kb][i] = 0.f;
#pragma unroll
            for (int s = 0; s < 4; ++s) sT[kb] = MFMA32(*(const LAS bf16x8*)(kbase + kb * (32 * AK_STR) + s * 32), qf[s], sT[kb]);
        }
        float bm = -3.0e38f;
#pragma unroll
        for (int kb = 0; kb < 5; ++kb)
#pragma unroll
            for (int i = 0; i < 16; ++i) { sT[kb][i] = __builtin_fmaf(sT[kb][i], 1.0f / 256.0f, bt[32 * kb + (i & 3) + 8 * (i >> 2)]); }
        if (edge) {
            const int kv = un.run0 - 64 + 32 * w + 4 * hh;
#pragma unroll
            for (int kb = 0; kb < 5; ++kb)
#pragma unroll
                for (int i = 0; i < 16; ++i) { const int c = 32 * kb + (i & 3) + 8 * (i >> 2); sT[kb][i] = ((unsigned)(c + kv) < (unsigned)un.length) ? sT[kb][i] : -3.0e38f; }
        }
#pragma unroll
        for (int kb = 0; kb < 5; ++kb)
#pragma unroll
            for (int i = 0; i < 16; ++i) bm = fmaxf(bm, sT[kb][i]);
        m = fmaxf(bm, __shfl_xor(bm, 32));
#pragma unroll
        for (int kb = 0; kb < 5; ++kb) {
#pragma unroll
            for (int i = 0; i < 16; ++i) { const float p = __builtin_amdgcn_exp2f(sT[kb][i] - m); sT[kb][i] = p; lsum += p; }
#pragma unroll
            for (int s2 = 0; s2 < 2; ++s2) {
                const bf16x8 pb = pack8(sT[kb], s2);
#pragma unroll
                for (int e2 = 0; e2 < 2; ++e2) {
                    const s16x4 lo = tr_read(vbase + kb * (32 * AV_STR) + s2 * (16 * AV_STR) + e2 * 64);
                    const s16x4 hi = tr_read(vbase + kb * (32 * AV_STR) + s2 * (16 * AV_STR) + 8 * AV_STR + e2 * 64);
                    const bf16x8 vf = __builtin_shufflevector(lo, hi, 0, 1, 2, 3, 4, 5, 6, 7);
                    if (e2 == 0) o0 = MFMA32(vf, pb, o0); else o1 = MFMA32(vf, pb, o1);
                }
            }
        }
        lsum += __shfl_xor(lsum, 32);
        if (hh == 0) LSE[qtok * 16 + un.head] = (m + __log2f(lsum)) * 0.6931471805599453f;
        const float linv = YD_INV / lsum;
        __syncthreads();
#pragma unroll 1
        for (int rs_ = 0; rs_ < (PROBE_PHASE == 34 ? 2 + zero : 1); ++rs_)
        {
            LAS unsigned char* ost = lds + AL_K + w * (32 * AK_STR);
#pragma unroll
            for (int g = 0; g < 4; ++g) {
                u32x2 a0, a1; a0.x = cvtpk(o0[4 * g] * linv, o0[4 * g + 1] * linv); a0.y = cvtpk(o0[4 * g + 2] * linv, o0[4 * g + 3] * linv);
                a1.x = cvtpk(o1[4 * g] * linv, o1[4 * g + 1] * linv); a1.y = cvtpk(o1[4 * g + 2] * linv, o1[4 * g + 3] * linv);
                *(LAS u32x2*)(ost + r * AK_STR + 16 * g + 8 * hh) = a0; *(LAS u32x2*)(ost + r * AK_STR + 64 + 16 * g + 8 * hh) = a1;
            }
            asm volatile("s_waitcnt lgkmcnt(0)" ::: "memory");
#pragma unroll
            for (int it = 0; it < 4; ++it) {
                const int ql = 8 * it + (lane >> 3);
                const u32x4 v = *(const LAS u32x4*)(ost + ql * AK_STR + 16 * (lane & 7));
                const size_t tok = (size_t)un.b * SEQ + (size_t)(un.run0 + 32 * w + ql) * un.dil + un.res;
                u32x2 f8; f8.x = pk4_fp8(bflo(v.x), bfhi(v.x), bflo(v.y), bfhi(v.y)); f8.y = pk4_fp8(bflo(v.z), bfhi(v.z), bflo(v.w), bfhi(v.w));
                __builtin_nontemporal_store(f8, (u32x2*)(OG + tok * DM + un.head * 64 + 8 * (lane & 7)));
            }
        }
        __syncthreads();
    }
#undef ATT_LOAD
#undef ATT_LOAD2
#undef ATT_SLOT
}

__device__ __forceinline__ void mixer_post_rows(Frame& F) {
    const int gw = F.vcu * NWAVES + F.wave, NGW = F.G * NWAVES, lane = F.lane;
    const bf16_t* OF = (const bf16_t*)(F.ws + WS_OUTF); const bf16_t* OB = (const bf16_t*)(F.ws + WS_OUTB); const unsigned char* SG = (F.ws + WS_RG);
    const unsigned char* OG = F.ws + WS_OG; const float* LSE = (const float*)(F.ws + WS_LSE);
    unsigned char* RN = F.ws + WS_RETN; unsigned char* AC = F.ws + WS_ATTC;
    const int head = lane >> 2;
    u32x2 fa[4], fb[4], na[4], nb[4]; unsigned sg[4], nsg[4]; u32x4 og[3], nog[3]; float ls[3], nls[3];
#define MP_LOAD(A, B, S, O, L, ROW) do { _Pragma("unroll") for (int h = 0; h < 4; ++h) { const size_t off_ = (size_t)(ROW) * DM + h * 256 + 4 * lane; \
            A[h] = *(const u32x2*)(OF + off_); B[h] = *(const u32x2*)(OB + off_); S[h] = *(const unsigned*)(SG + off_); } \
        _Pragma("unroll") for (int g = 0; g < 3; ++g) { O[g] = *(const u32x4*)(OG + (size_t)g * NTOK * DM + (size_t)(ROW) * DM + 16 * lane); L[g] = LSE[((size_t)g * NTOK + (ROW)) * 16 + head]; } } while (0)
    if (gw >= NTOK) return;
    MP_LOAD(fa, fb, sg, og, ls, gw);
#pragma unroll 1
    for (int row = gw; row < NTOK; row += NGW) {
        const int rn = row + NGW < NTOK ? row + NGW : row;
        MP_LOAD(na, nb, nsg, nog, nls, rn);
        f32x4 v[4];
#pragma unroll
        for (int h = 0; h < 4; ++h) v[h] = (f32x4){bflo(fa[h].x) + bflo(fb[h].x), bfhi(fa[h].x) + bfhi(fb[h].x), bflo(fa[h].y) + bflo(fb[h].y), bfhi(fa[h].y) + bfhi(fb[h].y)};
#pragma unroll
        for (int h = 0; h < 4; ++h) {
            const float mu = wave_sum((v[h][0] + v[h][1]) + (v[h][2] + v[h][3])) * (1.f / 256.f);
            const f32x4 d = v[h] - mu;
            const float var = wave_sum((d[0] * d[0] + d[1] * d[1]) + (d[2] * d[2] + d[3] * d[3])) * (1.f / 256.f);
            const float rs = rsqrtf(var + NORM_EPS);
            const f32x2 g01 = __builtin_amdgcn_cvt_pk_f32_fp8((int)sg[h], false), g23 = __builtin_amdgcn_cvt_pk_f32_fp8((int)sg[h], true); const float rq = rs * YD_INV;
            *(unsigned*)(RN + (size_t)row * DM + h * 256 + 4 * lane) = pk4_fp8(d[0] * rq * g01.x, d[1] * rq * g01.y, d[2] * rq * g23.x, d[3] * rq * g23.y);
        }
        const float lm = fmaxf(ls[0], fmaxf(ls[1], ls[2]));
        float wg[3]; float wsum = 0.f;
#pragma unroll
        for (int g = 0; g < 3; ++g) { wg[g] = __expf(ls[g] - lm); wsum += wg[g]; }
        const float winv = 1.f / wsum;
        unsigned res[4];
#pragma unroll
        for (int wI = 0; wI < 4; ++wI) {
            float a0 = 0.f, a1 = 0.f, a2 = 0.f, a3 = 0.f;
#pragma unroll
            for (int g = 0; g < 3; ++g) { const int wd = (int)(wI == 0 ? og[g].x : (wI == 1 ? og[g].y : (wI == 2 ? og[g].z : og[g].w)));
                const f32x2 p0 = __builtin_amdgcn_cvt_pk_f32_fp8(wd, false), p1 = __builtin_amdgcn_cvt_pk_f32_fp8(wd, true);
                a0 += wg[g] * p0.x; a1 += wg[g] * p0.y; a2 += wg[g] * p1.x; a3 += wg[g] * p1.y; }
            const float sc = winv * YD_INV;
            res[wI] = pk4_fp8(a0 * sc, a1 * sc, a2 * sc, a3 * sc);
        }
        *(u32x4*)(AC + (size_t)row * DM + 16 * lane) = (u32x4){res[0], res[1], res[2], res[3]};
#pragma unroll
        for (int h = 0; h < 4; ++h) { fa[h] = na[h]; fb[h] = nb[h]; sg[h] = nsg[h]; }
#pragma unroll
        for (int g = 0; g < 3; ++g) { og[g] = nog[g]; ls[g] = nls[g]; }
    }
#undef MP_LOAD
}

__device__ __forceinline__ void routing_rows(Frame& F, const Args& a) {
    const int gw = F.vcu * NWAVES + F.wave, NGW = F.G * NWAVES, lane = F.lane;
    const float* LOG = (const float*)(F.ws + WS_LOGIT); const float* rb = a.in[13];
    int* EIDX = (int*)(F.ws + WS_EIDX); float* GATE = (float*)(F.ws + WS_GATE);
    LAS unsigned* hist = (LAS unsigned*)(F.lds);
    for (int i = F.tid; i < NEXP; i += NTHR) hist[i] = 0u;
    __syncthreads();
    const f32x4 bias = *(const f32x4*)(rb + 4 * lane);
    for (int row = gw; row < NTOK; row += NGW) {
        const f32x4 lg = *(const f32x4*)(LOG + (size_t)row * NEXP + 4 * lane);
        float sc[4], ch[4];
#pragma unroll
        for (int i = 0; i < 4; ++i) { sc[i] = 1.f / (1.f + expf(-lg[i])); ch[i] = sc[i] + bias[i]; }
        float m1 = fmaxf(ch[0], ch[1]), m2 = fminf(ch[0], ch[1]);
        { const float c2 = ch[2]; const float n1 = fmaxf(m1, c2); m2 = fmaxf(m2, fminf(m1, c2)); m1 = n1; }
        { const float c3 = ch[3]; const float n1 = fmaxf(m1, c3); m2 = fmaxf(m2, fminf(m1, c3)); m1 = n1; }
#pragma unroll
        for (int o = 1; o < 8; o <<= 1) { const float b1 = __shfl_xor(m1, o), b2 = __shfl_xor(m2, o);
            const float n1 = fmaxf(m1, b1); const float n2 = fmaxf(fminf(m1, b1), fmaxf(m2, b2)); m1 = n1; m2 = n2; }
        const float gs = m1 + m2; const int mygrp = lane >> 3;
        int rank = 0;
#pragma unroll
        for (int g = 0; g < 8; ++g) { const float og = __shfl(gs, g * 8); rank += (og > gs || (og == gs && g < mygrp)) ? 1 : 0; }
        const bool elig = rank < 4;
        float cv[4];
#pragma unroll
        for (int i = 0; i < 4; ++i) cv[i] = elig ? ch[i] : -3.0e38f;
        float gsel = 0.f; int esel = 0; float gsum = 0.f;
#pragma unroll
        for (int k = 0; k < TOPK; ++k) {
            float bv = cv[0]; int bi = 4 * lane;
#pragma unroll
            for (int i = 1; i < 4; ++i) if (cv[i] > bv) { bv = cv[i]; bi = 4 * lane + i; }
#pragma unroll
            for (int o = 1; o < 64; o <<= 1) { const float ov = __shfl_xor(bv, o); const int oi = __shfl_xor(bi, o); if (ov > bv || (ov == bv && oi < bi)) { bv = ov; bi = oi; } }
            const int own = bi >> 2, el = bi & 3;
            const float mine = el == 0 ? sc[0] : (el == 1 ? sc[1] : (el == 2 ? sc[2] : sc[3]));
            const float s = __shfl(mine, own);
            if (lane == own) { if (el == 0) cv[0] = -3.0e38f; else if (el == 1) cv[1] = -3.0e38f; else if (el == 2) cv[2] = -3.0e38f; else cv[3] = -3.0e38f; }
            gsum += s;
            if (lane == k) { gsel = s; esel = bi; }
        }
        if (lane < TOPK) { EIDX[row * TOPK + lane] = esel; GATE[row * TOPK + lane] = gsel / gsum * 2.5f; __hip_atomic_fetch_add(&hist[esel], 1u, __ATOMIC_RELAXED, __HIP_MEMORY_SCOPE_WORKGROUP); }
    }
    __syncthreads();
    for (int i = F.tid; i < NEXP; i += NTHR) if (hist[i]) atomicAdd((unsigned*)(F.ws + WS_CTL) + CW_CNT + i, hist[i]);
}

__device__ __forceinline__ void routing_lists(Frame& F) {
    LAS unsigned* cnt = (LAS unsigned*)(F.lds);
    LAS unsigned* pstart = cnt + 256;
    LAS unsigned* lh = pstart + 264;
    LAS unsigned* lbase = lh + 256;
    LAS unsigned* ustart = lbase + 256;
    int* DPOS = (int*)(F.ws + WS_DPOS);
    unsigned* ctl = (unsigned*)(F.ws + WS_CTL);
    const int* EIDX = (const int*)(F.ws + WS_EIDX); int* ROWL = (int*)(F.ws + WS_ROWL); int* TILE_E = (int*)(F.ws + WS_TILE_E);
    for (int i = F.tid; i < NEXP; i += NTHR) { cnt[i] = __hip_atomic_load(ctl + CW_CNT + i, RLX_AGENT); lh[i] = 0u; }
    __syncthreads();
    if (F.tid == 0) { unsigned s = 0, us = 0; for (int e = 0; e < NEXP; ++e) { pstart[e] = s; ustart[e] = us; s += (cnt[e] + 255u) & ~255u; us += cnt[e]; } pstart[NEXP] = s; }
    __syncthreads();
    const unsigned ptotal = pstart[NEXP];
    const int per = (NTOK + F.G - 1) / F.G, tk0 = F.vcu * per, tk1 = (tk0 + per) < NTOK ? (tk0 + per) : NTOK;
    for (int i = tk0 * TOPK + F.tid; i < tk1 * TOPK; i += NTHR) __hip_atomic_fetch_add(&lh[EIDX[i]], 1u, __ATOMIC_RELAXED, __HIP_MEMORY_SCOPE_WORKGROUP);
    __syncthreads();
    for (int e = F.tid; e < NEXP; e += NTHR) { const unsigned c = lh[e]; lbase[e] = c ? atomicAdd(ctl + CW_FILL + e, c) : 0u; lh[e] = 0u; }
    __syncthreads();
    for (int i = tk0 * TOPK + F.tid; i < tk1 * TOPK; i += NTHR) { const int e = EIDX[i]; const unsigned p = __hip_atomic_fetch_add(&lh[e], 1u, __ATOMIC_RELAXED, __HIP_MEMORY_SCOPE_WORKGROUP);
        ROWL[pstart[e] + lbase[e] + p] = (i >> 3) * 16 + (i & 7); DPOS[i] = (int)(ustart[e] + lbase[e] + p); }
    for (int t = tk0 + F.tid; t < tk1; t += NTHR) ROWL[ptotal + t] = t * 16 + 8;
    for (int e = F.vcu; e < NEXP; e += F.G) { const unsigned s = pstart[e] + cnt[e], en = pstart[e + 1]; for (unsigned p = s + F.tid; p < en; p += NTHR) ROWL[p] = -1; }
    if (F.vcu == 0) {
        const int nrt = (int)(ptotal >> 8);
        for (int e = F.tid; e < NEXP; e += NTHR) { for (unsigned t = pstart[e] >> 8; t < (pstart[e + 1] >> 8); ++t) TILE_E[t] = e; TILE_E[4096 + e] = (int)(pstart[e] - ustart[e]); TILE_E[8192 + e] = (int)(pstart[e] + cnt[e]); }
        for (int t = F.tid; t < NTOK / 256; t += NTHR) TILE_E[nrt + t] = NEXP;
        if (F.tid == 0) { TILE_E[4096 + NEXP] = (int)ptotal - YD_SHARED0; TILE_E[8192 + NEXP] = (int)ptotal + NTOK; }
        if (F.tid == 0) TILE_E[MAX_TILES] = nrt + NTOK / 256;
    }
}

__device__ __forceinline__ void final_rows(Frame& F, const Args& a) {
    const int gw = F.vcu * NWAVES + F.wave, NGW = F.G * NWAVES, lane = F.lane;
    const float* mod = (const float*)(F.ws + WS_MOD); const float* nf = a.in[20];
    const int* DPOS = (const int*)(F.ws + WS_DPOS); const float* GATE = (const float*)(F.ws + WS_GATE);
    f32x4 g4[4];
#pragma unroll
    for (int j = 0; j < 4; ++j) g4[j] = *(const f32x4*)(nf + 4 * lane + 256 * j);
    if (gw >= NTOK) return;
    auto clampr = [&](int r) { return r < NTOK ? r : gw; };
    int dcur = DPOS[clampr(gw) * 8 + (lane & 7)]; float gcur = GATE[clampr(gw) * 8 + (lane & 7)];
    int dnxt = DPOS[clampr(gw + NGW) * 8 + (lane & 7)]; float gnxt = GATE[clampr(gw + NGW) * 8 + (lane & 7)];
    f32x4 xw[4], xn[4]; int yw[9][4], yn[9][4];
#define FIN_LOAD(XW, YW, ROW, DV) do { const u32x2* xr_ = (const u32x2*)((const bf16_t*)(F.ws + WS_X1B) + (size_t)(ROW) * DM) + lane; \
        _Pragma("unroll") for (int j = 0; j < 4; ++j) { const u32x2 t_ = xr_[64 * j]; XW[j] = (f32x4){bflo(t_.x), bfhi(t_.x), bflo(t_.y), bfhi(t_.y)}; } \
        _Pragma("unroll") for (int k = 0; k < 9; ++k) { const unsigned char* yr_ = ydense_row(F.ws, k < 8 ? __builtin_amdgcn_readlane((DV), k) : YD_SHARED0 + (ROW)) + 4 * lane; \
            _Pragma("unroll") for (int j = 0; j < 4; ++j) YW[k][j] = *(const int*)(yr_ + 256 * j); } } while (0)
    FIN_LOAD(xw, yw, gw, dcur);
#pragma unroll 1
    for (int row = gw; row < NTOK; row += NGW) {
        const int rn = clampr(row + NGW), rn2 = clampr(row + 2 * NGW);
        FIN_LOAD(xn, yn, rn, dnxt);
        const int dn2 = DPOS[rn2 * 8 + (lane & 7)]; const float gn2 = GATE[rn2 * 8 + (lane & 7)];
        const int b = row / SEQ;
        f32x4 v[4]; float s = 0.f;
#pragma unroll
        for (int j = 0; j < 4; ++j) {
            const int col = 4 * lane + 256 * j;
            f32x4 y = (f32x4){0.f, 0.f, 0.f, 0.f};
#pragma unroll
            for (int k = 0; k < 9; ++k) { const int wv = yw[k][j]; const float gk = (k < 8 ? __uint_as_float(__builtin_amdgcn_readlane(__float_as_uint(gcur), k)) : 1.0f) * YD_INV;
                const f32x2 lo = __builtin_amdgcn_cvt_pk_f32_fp8(wv, false), hi = __builtin_amdgcn_cvt_pk_f32_fp8(wv, true);
                y[0] += gk * lo.x; y[1] += gk * lo.y; y[2] += gk * hi.x; y[3] += gk * hi.y; }
            const f32x4 gf = *(const f32x4*)(mod + (size_t)b * 6144 + 5 * DM + col);
            v[j] = xw[j] + gf * y;
            s += (v[j][0] * v[j][0] + v[j][1] * v[j][1]) + (v[j][2] * v[j][2] + v[j][3] * v[j][3]);
        }
        const float rstd = rsqrtf(wave_sum(s) * (1.f / DM) + NORM_EPS);
        f32x4* xo = (f32x4*)(a.out + (size_t)row * DM) + lane;
#pragma unroll
        for (int j = 0; j < 4; ++j) xo[64 * j] = (v[j] * rstd) * g4[j];
#pragma unroll
        for (int j = 0; j < 4; ++j) xw[j] = xn[j];
#pragma unroll
        for (int k = 0; k < 9; ++k)
#pragma unroll
            for (int j = 0; j < 4; ++j) yw[k][j] = yn[k][j];
        dcur = dnxt; gcur = gnxt; dnxt = dn2; gnxt = gn2;
    }
#undef FIN_LOAD
}

constexpr int MT_OFF = 131072, MT_INFO = MT_OFF + 4096;
__device__ __forceinline__ void moe_tables_to_lds(Frame& F, int ntiles) {
    const int* TILE_E = (const int*)(F.ws + WS_TILE_E);
    LAS unsigned short* te = (LAS unsigned short*)(F.lds + MT_OFF); LAS int* info = (LAS int*)(F.lds + MT_INFO);
    for (int t = F.tid; t < ntiles; t += NTHR) te[t] = (unsigned short)TILE_E[t];
    for (int e = F.tid; e <= NEXP; e += NTHR) { info[e] = TILE_E[4096 + e]; info[512 + e] = TILE_E[8192 + e]; }
    __syncthreads();
}
constexpr int DW_STR = 192;
constexpr int DW_BUF = 256 * DW_STR;
typedef float f32x4_t __attribute__((ext_vector_type(4)));
#define MFMA16(a, b, c) __builtin_amdgcn_mfma_f32_16x16x32_bf16((a), (b), (c), 0, 0, 0)
template <int MODE> __device__ __forceinline__ void down_phase(Frame& F, const Args& a) {
    const int* TILE_E = (const int*)(F.ws + WS_TILE_E); const int ntiles = __builtin_amdgcn_readfirstlane(TILE_E[MAX_TILES]);
    moe_tables_to_lds(F, ntiles);
    const LAS unsigned short* tile_e = (const LAS unsigned short*)(F.lds + MT_OFF); const LAS int* info = (const LAS int*)(F.lds + MT_INFO);
    const int lane = F.lane, w = F.wave, fr = lane & 15, g4 = lane >> 4;
    LAS unsigned char* lds = F.lds;
    const bf16_t* HID = (const bf16_t*)(F.ws + WS_HID);
    const int sk = F.tid >> 4, sn4 = F.tid & 15;
    const int spos = 16 * (sn4 & 3) + 4 * (sn4 >> 2);
    const int q4 = (lane & 15) >> 2, p4 = lane & 3;
    auto next_tile = [&](int i) -> int { const long L = (long)i * F.G + (int)blockIdx.x; return L < ntiles ? pg8::xcd_remap((int)L, ntiles) : -1; };
    int ui = 0, tile = next_tile(0);
    if (tile < 0) return;
    f32x4_t st[8], st2[8];
    auto wd_base = [&](int t) -> const float* { const int e = MODE == 1 ? 0 : (int)tile_e[t]; return e < NEXP ? a.in[16] + (size_t)e * (EH * DM) : a.in[19]; };
#define DW_LOAD(R, WB, C) do { const float* p_ = (WB) + (size_t)sk * DM + (C) * 64 + sn4 * 4; _Pragma("unroll") for (int i = 0; i < 8; ++i) R[i] = *(const f32x4_t*)(p_ + (size_t)i * 32 * DM); } while (0)
#define DW_WRITE(R, SLOT) do { _Pragma("unroll") for (int i = 0; i < 8; ++i) { const int k_ = sk + 32 * i; u32x2 w_; w_.x = cvtpk(R[i][0], R[i][1]); w_.y = cvtpk(R[i][2], R[i][3]); \
        *(LAS u32x2*)(lds + (SLOT) * DW_BUF + k_ * DW_STR + (((spos >> 4) ^ ((k_ >> 3) & 1)) << 5) + (spos & 15) * 2) = w_; } } while (0)
    const float* wb = wd_base(tile);
    int ntile = next_tile(1);
    const float* nwb = ntile >= 0 ? wd_base(ntile) : wb;
    DW_LOAD(st, wb, 0); DW_WRITE(st, 0);
    DW_LOAD(st, wb, 1); DW_LOAD(st2, wb, 2);
    __syncthreads();
    int cc = 0;
    for (;;) {
        const int e = (int)tile_e[tile]; const int shift = info[e], lim = info[512 + e];
        bf16x8 af[2][8];
        { const bf16_t* hp = HID + ((size_t)tile * 256 + 32 * w + fr) * EH + 8 * g4;
#pragma unroll
          for (int m = 0; m < 2; ++m)
#pragma unroll
              for (int ks = 0; ks < 8; ++ks) af[m][ks] = *(const bf16x8*)(hp + (size_t)m * 16 * EH + 32 * ks);
#pragma unroll
          for (int m = 0; m < 2; ++m)
#pragma unroll
              for (int ks = 0; ks < 8; ++ks) asm volatile("" : "+v"(af[m][ks])); }
        const int pos0 = tile * 256 + 32 * w + fr;
#pragma unroll 1
        for (int c = 0; c < 16; c += 2) {
#pragma unroll
            for (int hc = 0; hc < 2; ++hc, ++cc) {
                const int cq = c + hc;
                f32x4 acc[2][4];
                if (MODE == 3) {
#pragma unroll
                    for (int m = 0; m < 2; ++m)
#pragma unroll
                        for (int nf = 0; nf < 4; ++nf) acc[m][nf] = (f32x4){0.f, 0.f, 0.f, 0.f}; }
                LAS unsigned char* bb = lds + (cc & 1) * DW_BUF + (8 * g4 + q4) * DW_STR + 8 * p4;
#pragma unroll 1
                for (int rp_ = 0; rp_ < (MODE == 3 ? a.pad : (PROBE_PHASE == 40 ? 2 + a.pad : 1)); ++rp_) {
#pragma unroll
                for (int m = 0; m < 2; ++m)
#pragma unroll
                    for (int nf = 0; nf < 4; ++nf) acc[m][nf] = (f32x4){0.f, 0.f, 0.f, 0.f};
#pragma unroll
                for (int ks = 0; ks < 8; ++ks) {
#pragma unroll
                    for (int nf = 0; nf < 4; ++nf) {
                        LAS unsigned char* pp = bb + ks * (32 * DW_STR) + ((nf ^ (g4 & 1)) << 5);
                        const s16x4 lo = tr_read(pp), hi = tr_read(pp + 4 * DW_STR);
                        const bf16x8 bf = __builtin_shufflevector(lo, hi, 0, 1, 2, 3, 4, 5, 6, 7);
                        acc[0][nf] = MFMA16(bf, af[0][ks], acc[0][nf]); acc[1][nf] = MFMA16(bf, af[1][ks], acc[1][nf]);
                    }
                }
                }
                u32x4 ow[2];
#pragma unroll
                for (int m = 0; m < 2; ++m) { ow[m].x = pk4_fp8(acc[m][0][0], acc[m][0][1], acc[m][0][2], acc[m][0][3]); ow[m].y = pk4_fp8(acc[m][1][0], acc[m][1][1], acc[m][1][2], acc[m][1][3]);
                    ow[m].z = pk4_fp8(acc[m][2][0], acc[m][2][1], acc[m][2][2], acc[m][2][3]); ow[m].w = pk4_fp8(acc[m][3][0], acc[m][3][1], acc[m][3][2], acc[m][3][3]); }
                const int c3 = cq + 3; const float* b3 = c3 < 16 ? wb : nwb; const int k3 = c3 < 16 ? c3 : c3 - 16;
                if (hc == 0) { DW_WRITE(st, (cc + 1) & 1); DW_LOAD(st, b3, k3); } else { DW_WRITE(st2, (cc + 1) & 1); DW_LOAD(st2, b3, k3); }
#pragma unroll
                for (int m = 0; m < 2; ++m) {
                    const int pos = pos0 + 16 * m;
                    unsigned char* rowp = (pos < lim ? ydense_row(F.ws, pos - shift) : F.ws + WS_SS + (size_t)blockIdx.x * 2048) + 64 * cq + 16 * g4;
                    if (MODE >= 2) asm volatile("" :: "v"(ow[m])); else *(u32x4*)rowp = ow[m];
                }
                __syncthreads();
            }
        }
        if (ntile < 0) break;
        tile = ntile; wb = nwb; ++ui;
        ntile = next_tile(ui + 1); nwb = ntile >= 0 ? wd_base(ntile) : wb;
    }
#undef DW_LOAD
#undef DW_WRITE
}

constexpr int N_PHASES = 13;
__global__ void __launch_bounds__(NTHR, 2) fwd_kernel(Args args) {
    extern __shared__ __attribute__((aligned(16))) unsigned char lds_raw[];
    Frame F;
    F.lds = (LAS unsigned char*)lds_raw; F.ws = args.ws;
    F.tid = threadIdx.x; F.lane = F.tid & 63; F.wave = __builtin_amdgcn_readfirstlane(F.tid >> 6);
    F.G = gridDim.x; { const int bx = blockIdx.x; F.vcu = (F.G % 8 == 0) ? (bx % 8) * (F.G / 8) + bx / 8 : bx; }
    volatile LAS unsigned* MISC = (volatile LAS unsigned*)(F.lds + MISC_OFF);
    for (int u = F.tid; u < (LDS_BYTES - LDSCTL_OFF) / 4; u += NTHR) ((LAS unsigned*)(F.lds + LDSCTL_OFF))[u] = 0u;
    __syncthreads();
    unsigned* ctl = (unsigned*)(F.ws + WS_CTL);
    XcdBarrier bar; bar.bar = ctl + CW_BAR; bar.x = 0; bar.st = nullptr;
    const int lo = args.ph_lo, hi = args.ph_hi;
    if (hi - lo > 1) bar = xcd_barrier_post(ctl + CW_BAR, MISC + 8);
#ifdef ONLY_PHASE
#define IN(k) ((k) == ONLY_PHASE && lo <= (k) && (k) < hi)
#else
#define IN(k) (lo <= (k) && (k) < hi)
#endif
#define SEAM(k) do { if (IN(k) && IN((k) + 1)) xcd_barrier(bar); } while (0)
#ifndef PROBE_PHASE
#define PROBE_PHASE -1
#endif
#define REP(k) _Pragma("unroll 1") for (int rep_ = 0; rep_ < ((k) == PROBE_PHASE ? 2 + args.pad : 1); ++rep_)
    const float* mod = (const float*)(F.ws + WS_MOD);
    bf16_t* HB = (bf16_t*)(F.ws + WS_H);

    if (IN(0)) REP(0) { phase0(F, args); } SEAM(0);
    if (IN(1)) REP(1) { norm_mod_rows<false, 1>(F, args.in[0], args.in[4], mod, 0, DM, nullptr, HB, F.ws + WS_H8); } SEAM(1);
    if (IN(2)) REP(2) {
        EpiInProj E{F.ws, (const u32x4*)(F.ws + WS_ROPE_C)};
        { pg8::StaticOrder S; S.init((const bf16_t*)(F.ws + WS_H8), (const bf16_t*)(F.ws + WS_WIN), NTOK, PROJW - 3 * DM, DM / 2, F.G, (int)blockIdx.x, 12);
          pg8::gemm_phase<EpiInProj, pg8::StaticOrder, true, true>(F.lds, S, E); }
        { pg8::StaticOrder S; S.init((const bf16_t*)(F.ws + WS_H8), (const bf16_t*)(F.ws + WS_WIN), NTOK, 3 * DM, DM / 2, F.G, (int)blockIdx.x, 0);
          pg8::gemm_phase<EpiInProj, pg8::StaticOrder, true, true>(F.lds, S, E); }
    } SEAM(2);
    if (IN(3)) {
#ifndef NO_RET
        REP(30) for (int ch = F.vcu; ch < 256; ch += F.G) retention_chain_rs(F, args, ch);
#endif
#ifndef NO_ATT
        const int per = (6144 + F.G - 1) / F.G;
        attention_phase(F, F.vcu * per, (F.vcu + 1) * per < 6144 ? (F.vcu + 1) * per : 6144, args.pad);
#endif
    } SEAM(3);
    if (IN(4)) REP(4) { mixer_post_rows(F); } SEAM(4);
    if (IN(5)) REP(5) {
        pg8::DualOrder S; S.so.init((const bf16_t*)(F.ws + WS_RETN), (const bf16_t*)(F.ws + WS_WRU), NTOK, DM, DM / 2, F.G, (int)blockIdx.x);
        S.A1 = (const bf16_t*)(F.ws + WS_ATTC); S.Bt1 = (const bf16_t*)(F.ws + WS_WAU); S.K = DM / 2;
        EpiMerge E{F.ws + WS_MERGED, F.ws + WS_SGR, F.ws + WS_SGA};
        pg8::gemm_phase<EpiMerge, pg8::DualOrder, true, true>(F.lds, S, E);
    } SEAM(5);
    if (IN(6)) REP(6) {
        pg8::StaticOrder S; S.init((const bf16_t*)(F.ws + WS_MERGED), (const bf16_t*)(F.ws + WS_WO), NTOK, DM, DM / 2, F.G, (int)blockIdx.x);
        EpiOProj E{args.in[0], (bf16_t*)(F.ws + WS_X1B), mod, (float*)(F.ws + WS_SS)};
        pg8::gemm_phase<EpiOProj, pg8::StaticOrder, true, true>(F.lds, S, E);
    } SEAM(6);
    if (IN(7)) REP(7) {
        norm_mod_rows<true, 2>(F, F.ws + WS_X1B, args.in[11], mod, 3 * DM, 4 * DM, (const float*)(F.ws + WS_SS), HB, F.ws + WS_H8B);
        if (F.vcu == 0 && F.tid < 256) ((unsigned*)(F.ws + WS_H8B + (size_t)NTOK * DM))[F.tid] = 0u;
    } SEAM(7);
    if (IN(8)) {
        pg8::StaticOrder S; S.init(HB, (const bf16_t*)(F.ws + WS_WR), NTOK, NEXP, DM, F.G, (int)blockIdx.x);
        EpiF32 E{(float*)(F.ws + WS_LOGIT), NEXP};
        pg8::gemm_phase<EpiF32, pg8::StaticOrder, true>(F.lds, S, E);
        __syncthreads();
        moe_weight_convert(F, args);
    } SEAM(8);
    if (IN(9)) { routing_rows(F, args); } SEAM(9);
    if (IN(10)) { routing_lists(F); } SEAM(10);
    if (IN(11)) REP(11) {
        const int* TILE_E = (const int*)(F.ws + WS_TILE_E); const int ntiles = __builtin_amdgcn_readfirstlane(TILE_E[MAX_TILES]);
        pg8::MoeOrder<true, true> S; S.A = (const bf16_t*)(F.ws + WS_H8B); S.Bt = (const bf16_t*)(F.ws + WS_WGU); S.K = DM / 2; S.e_stride = WGU_E_BYTES; S.tile_e = (const LAS unsigned short*)(F.lds + MT_OFF); S.rowlist = (const int*)(F.ws + WS_ROWL); moe_tables_to_lds(F, ntiles);
        S.ntiles = ntiles; S.nN = 2; S.nwg = ntiles * 2; S.G = F.G; S.c = (int)blockIdx.x;
        EpiGU E{(bf16_t*)(F.ws + WS_HID)};
        pg8::gemm_phase<EpiGU, pg8::MoeOrder<true, true>, true, true>(F.lds, S, E);
    } SEAM(11);
    if (IN(12)) REP(12) {
        down_phase<0>(F, args);
    } SEAM(12);
    if (IN(13)) { final_rows(F, args); }
#if PROBE_LAUNCH == 14
    if (lo == 14) {
        pg8::StaticOrder S; S.init((const bf16_t*)(F.ws + WS_H8), (const bf16_t*)(F.ws + WS_WIN), NTOK, PROJW, DM / 2, F.G, (int)blockIdx.x);
        EpiNull E{};
        pg8::gemm_phase<EpiNull, pg8::StaticOrder, true, true>(F.lds, S, E);
    }
#endif
#if PROBE_LAUNCH == 16
    if (lo == 14) {
        const int* TILE_E = (const int*)(F.ws + WS_TILE_E); const int ntiles = __builtin_amdgcn_readfirstlane(TILE_E[MAX_TILES]);
        pg8::MoeOrder<false> S; S.A = (const bf16_t*)(F.ws + WS_HID); S.Bt = (const bf16_t*)(F.ws + WS_WD); S.K = EH; S.e_stride = (size_t)1024 * 256; S.tile_e = (const LAS unsigned short*)(F.lds + MT_OFF); S.rowlist = (const int*)(F.ws + WS_ROWL); moe_tables_to_lds(F, ntiles);
        S.ntiles = ntiles; S.nN = 4; S.nwg = ntiles * 4; S.G = F.G; S.c = (int)blockIdx.x;
        EpiNull E{};
        pg8::gemm_phase<EpiNull, pg8::MoeOrder<false>, true>(F.lds, S, E);
    }
#endif
#if PROBE_LAUNCH == 18
    if (lo == 14) { down_phase<1>(F, args); }
#endif
#if PROBE_LAUNCH == 19
    if (lo == 14) { down_phase<2>(F, args); }
#endif
#if PROBE_LAUNCH == 20
    if (lo == 14) { down_phase<3>(F, args); }
#endif
#if PROBE_LAUNCH == 17
    if (lo == 14) {
        const int* TILE_E = (const int*)(F.ws + WS_TILE_E); const int ntiles = __builtin_amdgcn_readfirstlane(TILE_E[MAX_TILES]);
        pg8::MoeOrder<false> S; S.A = (const bf16_t*)(F.ws + WS_HID); S.Bt = (const bf16_t*)(F.ws + WS_WD); S.K = EH; S.e_stride = (size_t)1024 * 256; S.tile_e = (const LAS unsigned short*)(F.lds + MT_OFF); S.rowlist = (const int*)(F.ws + WS_ROWL); moe_tables_to_lds(F, ntiles);
        S.ntiles = ntiles; S.nN = 4; S.nwg = ntiles * 4; S.G = F.G; S.c = (int)blockIdx.x;
        EpiDownT<1> E{F.ws, (const LAS int*)(F.lds + MT_INFO)};
        pg8::gemm_phase<EpiDownT<1>, pg8::MoeOrder<false>, true>(F.lds, S, E);
    }
#endif
#if PROBE_LAUNCH == 15
    if (lo == 14) {
        EpiInProjT<1> E{F.ws, (const u32x4*)(F.ws + WS_ROPE_C)};
        { pg8::StaticOrder S; S.init((const bf16_t*)(F.ws + WS_H8), (const bf16_t*)(F.ws + WS_WIN), NTOK, PROJW - 3 * DM, DM / 2, F.G, (int)blockIdx.x, 12);
          pg8::gemm_phase<EpiInProjT<1>, pg8::StaticOrder, true, true>(F.lds, S, E); }
        { pg8::StaticOrder S; S.init((const bf16_t*)(F.ws + WS_H8), (const bf16_t*)(F.ws + WS_WIN), NTOK, 3 * DM, DM / 2, F.G, (int)blockIdx.x, 0);
          pg8::gemm_phase<EpiInProjT<1>, pg8::StaticOrder, true, true>(F.lds, S, E); }
    }
#endif
#if PROBE_LAUNCH == 21 || PROBE_LAUNCH == 22 || PROBE_LAUNCH == 23
    if (lo == 14) {
        constexpr int PM_ = PROBE_LAUNCH == 21 ? 2 : (PROBE_LAUNCH == 22 ? 3 : 4);
        EpiInProjT<PM_> E{F.ws, (const u32x4*)(F.ws + WS_ROPE_C)};
        { pg8::StaticOrder S; S.init((const bf16_t*)(F.ws + WS_H8), (const bf16_t*)(F.ws + WS_WIN), NTOK, PROJW - 3 * DM, DM / 2, F.G, (int)blockIdx.x, 12);
          pg8::gemm_phase<EpiInProjT<PM_>, pg8::StaticOrder, true, true>(F.lds, S, E); }
        { pg8::StaticOrder S; S.init((const bf16_t*)(F.ws + WS_H8), (const bf16_t*)(F.ws + WS_WIN), NTOK, 3 * DM, DM / 2, F.G, (int)blockIdx.x, 0);
          pg8::gemm_phase<EpiInProjT<PM_>, pg8::StaticOrder, true, true>(F.lds, S, E); }
    }
#endif
#undef IN
#undef SEAM
}

extern "C" void kernel_launch(void* const* d_in, const int* in_sizes, int n_in, void* d_out, int out_size, void* d_ws, size_t ws_size, hipStream_t stream) {
    static int grid = 0;
    if (grid == 0) {
        if (n_in != 21 || out_size != NTOK * DM || ws_size < WS_END) { fprintf(stderr, "kernel_launch: unexpected shapes (n_in %d out %d ws %zu)\n", n_in, out_size, ws_size); grid = -1; return; }
        int dev = 0, cus = 0, per_cu = 0;
        if (hipGetDevice(&dev) != hipSuccess || hipDeviceGetAttribute(&cus, hipDeviceAttributeMultiprocessorCount, dev) != hipSuccess) { grid = -1; return; }
        if (hipFuncSetAttribute((const void*)fwd_kernel, hipFuncAttributeMaxDynamicSharedMemorySize, LDS_BYTES) != hipSuccess) { fprintf(stderr, "kernel_launch: hipFuncSetAttribute failed\n"); grid = -1; return; }
        if (hipOccupancyMaxActiveBlocksPerMultiprocessor(&per_cu, (const void*)fwd_kernel, NTHR, LDS_BYTES) != hipSuccess || per_cu < 1)
            fprintf(stderr, "kernel_launch: note: occupancy query reports %d\n", per_cu);
        (void)hipGetLastError();
        grid = cus;
    }
    if (grid < 0) return;
    (void)hipMemsetAsync((char*)d_ws + WS_CTL, 0, CTL_ZERO_BYTES, stream);
    Args a{};
    for (int i = 0; i < 21; ++i) a.in[i] = (const float*)d_in[i];
    a.out = (float*)d_out; a.ws = (unsigned char*)d_ws;
#if MK_N_LAUNCHES == 1
    a.ph_lo = 0; a.ph_hi = N_PHASES + 1; a.li = 0;
    hipLaunchKernelGGL(fwd_kernel, dim3(grid), dim3(NTHR), LDS_BYTES, stream, a);
#else
    for (int p = 0; p <= N_PHASES; ++p) {
        if ((PROBE_LAUNCH == 18 || PROBE_LAUNCH == 19 || PROBE_LAUNCH == 20) && p == 12) { a.ph_lo = 14; a.ph_hi = 15; hipLaunchKernelGGL(fwd_kernel, dim3(grid), dim3(NTHR), LDS_BYTES, stream, a); }
        a.ph_lo = p; a.ph_hi = p + 1; a.li = p; hipLaunchKernelGGL(fwd_kernel, dim3(grid), dim3(NTHR), LDS_BYTES, stream, a);
        if (p == PROBE_LAUNCH) { if (p == 8) (void)hipMemsetAsync((char*)d_ws + WS_CTL + (size_t)CW_CONVQ * 4, 0, 4, stream); hipLaunchKernelGGL(fwd_kernel, dim3(grid), dim3(NTHR), LDS_BYTES, stream, a); }
        if (((PROBE_LAUNCH == 14 || PROBE_LAUNCH == 15 || PROBE_LAUNCH == 21 || PROBE_LAUNCH == 22 || PROBE_LAUNCH == 23) && p == 2) || ((PROBE_LAUNCH == 16 || PROBE_LAUNCH == 17) && p == 12)) { a.ph_lo = 14; a.ph_hi = 15; hipLaunchKernelGGL(fwd_kernel, dim3(grid), dim3(NTHR), LDS_BYTES, stream, a); } }
#endif
}
```

```cpp
#include <hip/hip_runtime.h>
#include <cstdio>
#include <cstdint>

#ifndef MK_N_LAUNCHES
#define MK_N_LAUNCHES 1
#endif
#define PROBE_LAUNCH -1
#ifndef PROBE_PHASE
#define PROBE_PHASE -1
#endif

#define LAS __attribute__((address_space(3)))
#define GAS __attribute__((address_space(1)))
typedef unsigned short bf16_t;
typedef short bf16x8 __attribute__((ext_vector_type(8)));
typedef short s16x4 __attribute__((ext_vector_type(4)));
typedef float f32x2 __attribute__((ext_vector_type(2)));
typedef float f32x4 __attribute__((ext_vector_type(4)));
typedef float f32x16 __attribute__((ext_vector_type(16)));
typedef unsigned u32x2 __attribute__((ext_vector_type(2)));
typedef unsigned u32x4 __attribute__((ext_vector_type(4)));
typedef int i32x4 __attribute__((ext_vector_type(4)));
typedef int i32x8 __attribute__((ext_vector_type(8)));
typedef __bf16 bf16x2_t __attribute__((ext_vector_type(2)));

constexpr int NB = 8, SEQ = 4096, DM = 1024, NTOK = NB * SEQ;
constexpr int PROJW = 9216, NEXP = 256, TOPK = 8, EH = 256;
constexpr float NORM_EPS = 1e-6f;

constexpr size_t MiB = 1u << 20;
constexpr size_t WS_CTL = 0, CTL_ZERO_BYTES = 1 * MiB;
constexpr size_t WS_MOD = 1 * MiB;
constexpr size_t WS_BTAB = 1 * MiB + 256 * 1024;
constexpr size_t WS_ROPE_C = 2 * MiB;
constexpr size_t WS_SS = 6 * MiB;
constexpr size_t WS_EIDX = 8 * MiB, WS_GATE = 9 * MiB;
constexpr size_t WS_ROWL = 10 * MiB;
constexpr size_t WS_TILE_E = 12 * MiB;
constexpr size_t WS_WIN = 16 * MiB, WS_WRU = 34 * MiB, WS_WAU = 36 * MiB, WS_WO = 38 * MiB, WS_WR = 40 * MiB;
constexpr size_t WS_H = 48 * MiB;
constexpr size_t WS_PROJ = 120 * MiB;
constexpr size_t SEG = 64 * MiB;
constexpr size_t WS_RQ = WS_PROJ, WS_RK = WS_PROJ + SEG, WS_RV = WS_PROJ + 2 * SEG, WS_RG = WS_PROJ + 3 * SEG, WS_AQ = WS_PROJ + 4 * SEG,
                 WS_AK = WS_PROJ + 5 * SEG, WS_AV = WS_PROJ + 6 * SEG, WS_SGR = WS_PROJ + 7 * SEG, WS_SGA = WS_PROJ + 8 * SEG;
constexpr size_t WS_OUTF = 696 * MiB, WS_OUTB = 760 * MiB, WS_OG = 824 * MiB, WS_LSE = 1016 * MiB;
constexpr size_t WS_RETN = WS_RQ, WS_ATTC = WS_RK, WS_YR = WS_RV, WS_MERGED = WS_AQ;
constexpr size_t WS_WGU = 120 * MiB, WS_WD = 377 * MiB, WS_HID = 512 * MiB, WS_LOGIT = 696 * MiB;
constexpr size_t WS_H8 = 48 * MiB, WS_H8B = 384 * MiB;
constexpr size_t WS_WRB = 42 * MiB, WS_RBIAS = 46 * MiB, WS_RSTD = 46 * MiB + 65536;
constexpr size_t WS_X1B = 448 * MiB;
constexpr size_t WS_END = 1022 * MiB;
constexpr int YD_SPLIT = 262144, YD_SHARED0 = NTOK * TOPK;
constexpr float YD_SCALE = 16.0f, YD_INV = 0.0625f;
__device__ __forceinline__ unsigned char* ydense_row(unsigned char* ws, int row) { return ws + (row < YD_SPLIT ? 120 * MiB : 696 * MiB) + (size_t)(row < YD_SPLIT ? row : row - YD_SPLIT) * DM; }
__device__ __forceinline__ unsigned pk4_fp8(float a, float b, float c, float d) {
    a = __builtin_fminf(__builtin_fmaxf(a * YD_SCALE, -448.f), 448.f); b = __builtin_fminf(__builtin_fmaxf(b * YD_SCALE, -448.f), 448.f);
    c = __builtin_fminf(__builtin_fmaxf(c * YD_SCALE, -448.f), 448.f); d = __builtin_fminf(__builtin_fmaxf(d * YD_SCALE, -448.f), 448.f);
    int w = __builtin_amdgcn_cvt_pk_fp8_f32(a, b, 0, false); w = __builtin_amdgcn_cvt_pk_fp8_f32(c, d, w, true); return (unsigned)w;
}
constexpr float W8_SCALE = 256.0f, FP8_UNSCALE = 1.0f / 4096.0f;
__device__ __forceinline__ unsigned pk4_fp8w(float a, float b, float c, float d) {
    a = __builtin_fminf(__builtin_fmaxf(a * W8_SCALE, -448.f), 448.f); b = __builtin_fminf(__builtin_fmaxf(b * W8_SCALE, -448.f), 448.f);
    c = __builtin_fminf(__builtin_fmaxf(c * W8_SCALE, -448.f), 448.f); d = __builtin_fminf(__builtin_fmaxf(d * W8_SCALE, -448.f), 448.f);
    int w = __builtin_amdgcn_cvt_pk_fp8_f32(a, b, 0, false); w = __builtin_amdgcn_cvt_pk_fp8_f32(c, d, w, true); return (unsigned)w;
}
__device__ __forceinline__ unsigned pk4_fp8_clamped(float a, float b, float c, float d) {
    a = __builtin_amdgcn_fmed3f(a, -448.f, 448.f); b = __builtin_amdgcn_fmed3f(b, -448.f, 448.f); c = __builtin_amdgcn_fmed3f(c, -448.f, 448.f); d = __builtin_amdgcn_fmed3f(d, -448.f, 448.f);
    int w = __builtin_amdgcn_cvt_pk_fp8_f32(a, b, 0, false); w = __builtin_amdgcn_cvt_pk_fp8_f32(c, d, w, true); return (unsigned)w;
}
constexpr float HID_SCALE = 8.0f;
__device__ __forceinline__ unsigned pk4_fp8_scaled(float a, float b, float c, float d, float sc) {
    a = __builtin_amdgcn_fmed3f(a * sc, -448.f, 448.f); b = __builtin_amdgcn_fmed3f(b * sc, -448.f, 448.f); c = __builtin_amdgcn_fmed3f(c * sc, -448.f, 448.f); d = __builtin_amdgcn_fmed3f(d * sc, -448.f, 448.f);
    int w = __builtin_amdgcn_cvt_pk_fp8_f32(a, b, 0, false); w = __builtin_amdgcn_cvt_pk_fp8_f32(c, d, w, true); return (unsigned)w;
}
__device__ __forceinline__ unsigned pk4_fp8_noclamp(float a, float b, float c, float d) {
    int w = __builtin_amdgcn_cvt_pk_fp8_f32(a, b, 0, false); w = __builtin_amdgcn_cvt_pk_fp8_f32(c, d, w, true); return (unsigned)w;
}
constexpr size_t WS_DPOS = 13 * MiB;
constexpr int CW_TMO = 0, CW_BAR = 4096, CW_CNT = 16384, CW_FILL = 16384 + 1024;
constexpr int MAX_TILES = 2048;

__device__ __forceinline__ unsigned cvtpk(float lo, float hi) { f32x2 v = {lo, hi}; bf16x2_t b = __builtin_convertvector(v, bf16x2_t); return __builtin_bit_cast(unsigned, b); }
__device__ __forceinline__ float bf2f(unsigned short u) { return __uint_as_float((unsigned)u << 16); }
__device__ __forceinline__ float bflo(unsigned u) { return __uint_as_float(u << 16); }
__device__ __forceinline__ float bfhi(unsigned u) { return __uint_as_float(u & 0xffff0000u); }
__device__ __forceinline__ float wave_sum(float v) {
#define WS_DPP(ctrl, rm) v += __uint_as_float((unsigned)__builtin_amdgcn_update_dpp(0, (int)__float_as_uint(v), ctrl, rm, 0xf, false))
    WS_DPP(0x111, 0xf); WS_DPP(0x112, 0xf); WS_DPP(0x114, 0xf); WS_DPP(0x118, 0xf); WS_DPP(0x142, 0xa); WS_DPP(0x143, 0xc);
#undef WS_DPP
    return __uint_as_float((unsigned)__builtin_amdgcn_readlane((int)__float_as_uint(v), 63));
}
__device__ __forceinline__ float sigmoidf_(float x) { return __builtin_amdgcn_rcpf(1.f + __builtin_amdgcn_exp2f(x * -1.4426950408889634f)); }
__device__ __forceinline__ float siluf_(float x) { return x * __builtin_amdgcn_rcpf(1.f + __builtin_amdgcn_exp2f(x * -1.4426950408889634f)); }

namespace pg8 {
constexpr int BM = 256, BK = 64, HALF = 128, HTB = HALF * BK * 2, STAGE_BYTES = 8 * HTB, NXCD = 8, WGM = 8;
__host__ __device__ __forceinline__ int lds_byte(int r, int c) { const int st = (r >> 4) * 2 + (c >> 5), rr = r & 15, cc = c & 31, ob = rr * 64 + cc * 2; return st * 1024 + (ob ^ (((ob >> 9) & 1) << 5)); }
__host__ __device__ __forceinline__ void stage_rc(int b, int& R, int& C) { const int st = b / 1024, sb = b % 1024, swz = sb ^ (((sb >> 9) & 1) << 5); R = (st >> 1) * 16 + swz / 64; C = (st & 1) * 32 + (swz % 64) / 2; }
__host__ __device__ __forceinline__ int perm32(int rho) { const int n = rho >> 4, i = rho & 15; return 8 * (i >> 2) + 4 * n + (i & 3); }

struct Unit { int pm, pn, e, slot; };

__device__ __forceinline__ int xcd_remap(int L, int nwg) { const int q = nwg / NXCD, r = nwg % NXCD, xcd = L % NXCD, off = L / NXCD; return (xcd < r ? xcd * (q + 1) : r * (q + 1) + (xcd - r) * q) + off; }

struct StaticOrder {
    static constexpr bool GATHER = false, DUAL = false, B_IMG = false;
    const bf16_t* A; const bf16_t* Bt; int K;
    int nM, nN, nwg, G, c, pn_off;
    size_t b_batch_stride = 0;
    __device__ void init(const bf16_t* A_, const bf16_t* Bt_, int M, int N, int K_, int G_, int c_, int pn_off_ = 0) { A = A_; Bt = Bt_; K = K_; nM = M / BM; nN = N / BM; nwg = nM * nN; G = G_; c = c_; pn_off = pn_off_; }
    __device__ bool next(int i, Unit& u) const {
        const long L = (long)i * G + c; if (L >= nwg) return false;
        const int wgid = xcd_remap((int)L, nwg);
        const int nig = WGM * nN, gid = wgid / nig, fm = gid * WGM, gsz = (nM - fm) < WGM ? (nM - fm) : WGM;
        u.pm = fm + ((wgid % nig) % gsz); u.pn = (wgid % nig) / gsz + pn_off; u.e = 0; u.slot = 0; return true;
    }
    __device__ __forceinline__ const char* a_base(const Unit& u) const { return (const char*)A + (size_t)u.pm * (size_t)(BM * 2) * K; }
    __device__ __forceinline__ const char* b_base(const Unit& u) const { return (const char*)Bt + (size_t)u.pn * (size_t)(BM * 2) * K + (size_t)(u.pm >> 4) * b_batch_stride; }
    __device__ __forceinline__ unsigned a_row(const Unit&, int) const { return 0u; }
};

struct DualOrder {
    static constexpr bool GATHER = false, DUAL = true, B_IMG = false;
    StaticOrder so; const bf16_t* A1; const bf16_t* Bt1; int K;
    __device__ bool next(int i, Unit& u) const { if (!so.next(i >> 1, u)) return false; u.e = i & 1; return true; }
    __device__ __forceinline__ const char* a_base(const Unit& u) const { return (const char*)(u.e ? A1 : so.A) + (size_t)u.pm * (size_t)(BM * 2) * K; }
    __device__ __forceinline__ const char* b_base(const Unit& u) const { return (const char*)(u.e ? Bt1 : so.Bt) + (size_t)u.pn * (size_t)(BM * 2) * K; }
    __device__ __forceinline__ unsigned a_row(const Unit&, int) const { return 0u; }
};

template <bool GATHER_, bool B_IMG_ = false>
struct MoeOrder {
    static constexpr bool GATHER = GATHER_, DUAL = false, B_IMG = B_IMG_;
    const bf16_t* A; const bf16_t* Bt; int K; size_t e_stride;
    const LAS unsigned short* tile_e; const int* rowlist; const LAS unsigned short* rl_lds; int ntiles, nN, nwg, G, c;
    __device__ bool next(int i, Unit& u) const {
        const long L = (long)i * G + c; if (L >= nwg) return false;
        const int wgid = xcd_remap((int)L, nwg);
        u.pm = wgid / nN; u.pn = wgid % nN; u.e = __builtin_amdgcn_readfirstlane((int)tile_e[u.pm]); u.slot = i; return true;
    }
    __device__ __forceinline__ const char* a_base(const Unit& u) const { return GATHER ? (const char*)A : (const char*)A + (size_t)u.pm * (size_t)(BM * 2) * K; }
    __device__ __forceinline__ const char* b_base(const Unit& u) const { return B_IMG ? (const char*)Bt + (size_t)u.e * e_stride + (size_t)u.pn * (size_t)(BM * 2) * K : (const char*)Bt + ((size_t)u.e * e_stride + (size_t)u.pn * BM * K) * 2; }
    __device__ __forceinline__ unsigned a_row(const Unit& u, int r) const {
        const unsigned t = rl_lds[u.slot * BM + r]; return t == 0xFFFFu ? (unsigned)NTOK : t; }
};

template <class Epi, class Sched, bool ALIGN_EPI, bool FP8 = false>
__device__ __forceinline__ void gemm_phase(LAS unsigned char* lds, const Sched& S, const Epi& E) {
    const int tid = threadIdx.x, wid = __builtin_amdgcn_readfirstlane(tid >> 6), lane = tid & 63, wr = wid >> 2, wc = wid & 3, fr = lane & 15, fq = lane >> 4;
    const int K = S.K, nt = K / BK;
    unsigned voffA[2], voffB[2]; int RA[2]; unsigned CA2[2];
#pragma unroll
    for (int i = 0; i < 2; ++i) { int R, C; stage_rc(tid * 16 + i * 8192, R, C); const int Rb = Epi::PERM ? ((R & ~31) + perm32(R & 31)) : R;
        voffA[i] = (unsigned)(R * K + C) * 2u; voffB[i] = Sched::B_IMG ? (unsigned)(tid * 16 + i * 8192) : (unsigned)(Rb * K + C) * 2u; RA[i] = R; CA2[i] = (unsigned)C * 2u; }
    const size_t kstep = (size_t)(BK * 2);
    const size_t hstep = (size_t)HALF * K * 2;
    const size_t bk = Sched::B_IMG ? (size_t)32768 : kstep, bh = Sched::B_IMG ? (size_t)16384 : hstep;
    const unsigned ldsw = (unsigned)wid * 1024u;
    const int aoff = lds_byte(wr * 64 + fr, fq * 8), boff = lds_byte(wc * 32 + fr, fq * 8);
    unsigned gC[2][2], gN[2][2];
#define PG8_SA(b, h) (((b) * 2 + (h)) * HTB)
#define PG8_SB(b, h) ((4 + (b) * 2 + (h)) * HTB)
#define PG8_STAGE(bufoff, gbase, voff) do { _Pragma("unroll") for (int _i = 0; _i < 2; ++_i) \
        __builtin_amdgcn_global_load_lds((const unsigned*)((const char*)(gbase) + (voff)[_i]), (LAS unsigned*)(lds + (bufoff) + ldsw + _i * 8192), 16, 0, 0); } while (0)
#define PG8_STAGE_A(bufoff, p, h, NX) do { if constexpr (Sched::GATHER) { _Pragma("unroll") for (int _i = 0; _i < 2; ++_i) { const unsigned _v = (NX) ? gN[h][_i] : gC[h][_i]; \
        __builtin_amdgcn_global_load_lds((const unsigned*)((const char*)(p) + _v), (LAS unsigned*)(lds + (bufoff) + ldsw + _i * 8192), 16, 0, 0); } } \
        else { PG8_STAGE(bufoff, (p) + (h) * hstep, voffA); } } while (0)
#define PG8_GATHER_SET(g, u) do { _Pragma("unroll") for (int _h = 0; _h < 2; ++_h) _Pragma("unroll") for (int _i = 0; _i < 2; ++_i) \
        g[_h][_i] = S.a_row(u, _h * HALF + RA[_i]) * (unsigned)(K * 2) + CA2[_i]; } while (0)
#define PG8_LDA(dst, b, h) do { _Pragma("unroll") for (int m = 0; m < 4; ++m) _Pragma("unroll") for (int k = 0; k < 2; ++k) dst[m][k] = *(const LAS bf16x8*)(lds + PG8_SA(b, h) + aoff + m * 2048 + k * 1024); } while (0)
#define PG8_LDB(dst, b, h) do { _Pragma("unroll") for (int n = 0; n < 2; ++n) _Pragma("unroll") for (int k = 0; k < 2; ++k) dst[n][k] = *(const LAS bf16x8*)(lds + PG8_SB(b, h) + boff + n * 2048 + k * 1024); } while (0)
#define PG8_CAT(x0, x1) __builtin_shufflevector(__builtin_bit_cast(i32x4, x0), __builtin_bit_cast(i32x4, x1), 0, 1, 2, 3, 4, 5, 6, 7)
#define PG8_MMA(ai, bj, At, Bt) do { __builtin_amdgcn_s_setprio(1); if constexpr (FP8) { _Pragma("unroll") for (int m = 0; m < 4; ++m) _Pragma("unroll") for (int n = 0; n < 2; ++n) \
        asm volatile("v_mfma_f32_16x16x128_f8f6f4 %0, %1, %2, %0" : "+v"(acc[ai][bj][m][n]) : "v"(PG8_CAT(Bt[n][0], Bt[n][1])), "v"(PG8_CAT(At[m][0], At[m][1]))); } else { \
        _Pragma("unroll") for (int m = 0; m < 4; ++m) _Pragma("unroll") for (int n = 0; n < 2; ++n) _Pragma("unroll") for (int k = 0; k < 2; ++k) \
        acc[ai][bj][m][n] = __builtin_amdgcn_mfma_f32_16x16x32_bf16(Bt[n][k], At[m][k], acc[ai][bj][m][n], 0, 0, 0); } __builtin_amdgcn_s_setprio(0); } while (0)
#define PG8_WAIT_V(n) asm volatile("s_waitcnt vmcnt(" #n ")" ::: "memory")
#define PG8_WAIT_L(n) asm volatile("s_waitcnt lgkmcnt(" #n ")" ::: "memory")
#define PG8_BAR __builtin_amdgcn_s_barrier()
#define PG8_SCHED __builtin_amdgcn_sched_barrier(0)
    Unit cur, nxt; int ui = 0;
    if (!S.next(0, cur)) return;
    f32x4 acc[2][2][4][2];
#pragma unroll
    for (int a = 0; a < 2; ++a)
#pragma unroll
        for (int b = 0; b < 2; ++b)
#pragma unroll
            for (int m = 0; m < 4; ++m)
#pragma unroll
                for (int n = 0; n < 2; ++n) acc[a][b][m][n] = (f32x4){0.f, 0.f, 0.f, 0.f};
    bf16x8 At[4][2], B0[2][2], B1[2][2];
    const char* cA = S.a_base(cur); const char* cB = S.b_base(cur);
    if constexpr (Sched::GATHER) { PG8_GATHER_SET(gC, cur); PG8_GATHER_SET(gN, cur); }
    PG8_STAGE(PG8_SB(0, 0), cB, voffB); PG8_STAGE(PG8_SB(0, 1), cB + bh, voffB); PG8_STAGE_A(PG8_SA(0, 0), cA, 0, false); PG8_STAGE_A(PG8_SA(0, 1), cA, 1, false);
    if (wr == 1) PG8_BAR;
    PG8_WAIT_V(2); PG8_BAR;
    PG8_STAGE(PG8_SB(1, 0), cB + bk, voffB); PG8_STAGE_A(PG8_SA(1, 0), cA + kstep, 0, false); PG8_STAGE(PG8_SB(1, 1), cB + bh + bk, voffB);
    PG8_WAIT_V(6); PG8_BAR;
    for (;;) {
        const bool has_next = S.next(ui + 1, nxt);
        const char* nA = has_next ? S.a_base(nxt) : cA; const char* nB = has_next ? S.b_base(nxt) : cB;
        if constexpr (Sched::GATHER) { if (has_next) { PG8_GATHER_SET(gN, nxt); } }
        for (int t = 0; t < nt; t += 2) {
            const bool last = (t == nt - 2);
            const char* a1 = cA + (size_t)(t + 1) * kstep;
            const char* a2 = last ? nA : cA + (size_t)(t + 2) * kstep; const char* b2 = last ? nB : cB + (size_t)(t + 2) * bk;
            const char* a3 = a2 + kstep; const char* b3 = b2 + bk;
            PG8_LDB(B0, 0, 0); PG8_LDB(B1, 0, 1); PG8_SCHED; PG8_LDA(At, 0, 0); PG8_STAGE_A(PG8_SA(1, 1), a1, 1, false);
            PG8_WAIT_V(8); PG8_WAIT_L(0); PG8_BAR; PG8_MMA(0, 0, At, B0); PG8_MMA(0, 1, At, B1); PG8_BAR; PG8_SCHED;
            PG8_LDA(At, 0, 1); PG8_STAGE(PG8_SB(0, 0), b2, voffB); PG8_STAGE(PG8_SB(0, 1), b2 + bh, voffB); PG8_STAGE_A(PG8_SA(0, 0), a2, 0, last);
            PG8_WAIT_V(8); PG8_WAIT_L(0); PG8_BAR; PG8_MMA(1, 0, At, B0); PG8_MMA(1, 1, At, B1); PG8_BAR; PG8_SCHED;
            PG8_LDB(B0, 1, 0); PG8_LDB(B1, 1, 1); PG8_SCHED; PG8_LDA(At, 1, 0); PG8_STAGE_A(PG8_SA(0, 1), a2, 1, last);
            PG8_WAIT_V(8); PG8_WAIT_L(0); PG8_BAR; PG8_MMA(0, 0, At, B0); PG8_MMA(0, 1, At, B1); PG8_BAR; PG8_SCHED;
            PG8_LDA(At, 1, 1); PG8_STAGE(PG8_SB(1, 0), b3, voffB); PG8_STAGE(PG8_SB(1, 1), b3 + bh, voffB); PG8_STAGE_A(PG8_SA(1, 0), a3, 0, last);
            PG8_WAIT_V(8); PG8_WAIT_L(0); PG8_BAR; PG8_MMA(1, 0, At, B0); PG8_MMA(1, 1, At, B1); PG8_BAR; PG8_SCHED;
        }
        if constexpr (ALIGN_EPI) { if (wr == 0) PG8_BAR; }
        if constexpr (FP8) {
            asm volatile("s_nop 15\n\ts_nop 15" ::: "memory");
            if constexpr (!Epi::RAW)
#pragma unroll
            for (int a = 0; a < 2; ++a)
#pragma unroll
                for (int b = 0; b < 2; ++b)
#pragma unroll
                    for (int m = 0; m < 4; ++m)
#pragma unroll
                        for (int n = 0; n < 2; ++n) acc[a][b][m][n] *= (Sched::DUAL && cur.e == 0) ? 1.0f : FP8_UNSCALE;
        }
        { int ln_;
          asm volatile("v_mbcnt_lo_u32_b32 %0, -1, 0\n\tv_mbcnt_hi_u32_b32 %0, -1, %0" : "=v"(ln_));
          E(acc, cur, wr, wc, ln_ & 15, ln_ >> 4); }
        if (!has_next) break;
        if (!(Sched::DUAL && cur.e == 0))
#pragma unroll
        for (int a = 0; a < 2; ++a)
#pragma unroll
            for (int b = 0; b < 2; ++b)
#pragma unroll
                for (int m = 0; m < 4; ++m)
#pragma unroll
                    for (int n = 0; n < 2; ++n) acc[a][b][m][n] = (f32x4){0.f, 0.f, 0.f, 0.f};
        cur = nxt; cA = nA; cB = nB; ++ui;
        if constexpr (Sched::GATHER) {
#pragma unroll
            for (int h = 0; h < 2; ++h)
#pragma unroll
                for (int i = 0; i < 2; ++i) gC[h][i] = gN[h][i];
        }
        if constexpr (ALIGN_EPI) { if (wr == 1) PG8_BAR; }
    }
    PG8_WAIT_V(0);
    if constexpr (!ALIGN_EPI) { if (wr == 0) PG8_BAR; }
    PG8_BAR;
#undef PG8_SA
#undef PG8_SB
#undef PG8_STAGE
#undef PG8_STAGE_A
#undef PG8_GATHER_SET
#undef PG8_LDA
#undef PG8_LDB
#undef PG8_MMA
#undef PG8_CAT
#undef PG8_WAIT_V
#undef PG8_WAIT_L
#undef PG8_BAR
#undef PG8_SCHED
}
}

typedef GAS unsigned gu32;
#define RLX_AGENT __ATOMIC_RELAXED, __HIP_MEMORY_SCOPE_AGENT
#define XB_TMO      128
#define XB_XCNT(j)  (256  + 64 * (j))
#define XB_XSUB(j)  (1280 + 64 * (j))
#define XB_XGEN(j)  (2304 + 64 * (j))
#define XB_TOP      3328
#define XB_TOPGEN   3392
#define XCD_BAR_WORDS 3456
#define XB_SPIN_CAP (1u << 18)
__device__ __forceinline__ unsigned xb_ld(unsigned* p)              { return __hip_atomic_load(p, __ATOMIC_RELAXED, __HIP_MEMORY_SCOPE_AGENT); }
__device__ __forceinline__ unsigned xb_add(unsigned* p, unsigned v) { return __hip_atomic_fetch_add(p, v, __ATOMIC_RELAXED, __HIP_MEMORY_SCOPE_AGENT); }
__device__ __forceinline__ unsigned xb_xcc_id() { return (unsigned)__builtin_amdgcn_s_getreg((3 << 11) | 20) & 0xFu; }
#define XB_SPIN(cond, bar) do { unsigned _sp = 0; while (cond) { __builtin_amdgcn_s_sleep(1); \
    if ((++_sp & 255u) == 0u) { if (xb_ld(&(bar)[XB_TMO])) break; if (_sp > XB_SPIN_CAP) { atomicAdd(&(bar)[XB_TMO], 1u); break; } } } } while (0)
struct XcdBarrier { unsigned* bar; unsigned x; volatile LAS unsigned* st; };
__device__ __forceinline__ XcdBarrier xcd_barrier_post(unsigned* bar, volatile LAS unsigned* st) {
    XcdBarrier b; b.bar = bar; b.x = xb_xcc_id(); b.st = st;
    if (threadIdx.x == 0) (void)xb_add(&bar[XB_XCNT(b.x)], 1u);
    return b;
}
__device__ __forceinline__ void xcd_barrier_complete(unsigned* bar, unsigned x, unsigned& nloc, unsigned& nx) {
    const unsigned G = gridDim.x * gridDim.y * gridDim.z;
    unsigned sum, cnt, mine, sp = 0u;
    for (;;) {
        sum = 0u; cnt = 0u; mine = 0u;
#pragma unroll
        for (unsigned j = 0; j < 16; ++j) { const unsigned c = xb_ld(&bar[XB_XCNT(j)]); sum += c; cnt += (c > 0u) ? 1u : 0u; mine = (j == x) ? c : mine; }
        if (sum == G) break;
        __builtin_amdgcn_s_sleep(1);
        if ((++sp & 255u) == 0u) { if (xb_ld(&bar[XB_TMO])) break; if (sp > XB_SPIN_CAP) { atomicAdd(&bar[XB_TMO], 1u); break; } }
    }
    nloc = mine > 0u ? mine : 1u; nx = cnt > 0u ? cnt : 1u;
}
__device__ __forceinline__ void xcd_barrier(const XcdBarrier& b) {
    asm volatile("s_waitcnt vmcnt(0)" ::: "memory");
    __syncthreads();
    if (threadIdx.x == 0) {
        unsigned* bar = b.bar;
        __builtin_amdgcn_s_waitcnt(0);
        unsigned nloc = b.st[0], nx = b.st[1];
        if (nloc == 0u) { xcd_barrier_complete(bar, b.x, nloc, nx); b.st[0] = nloc; b.st[1] = nx; }
        const unsigned old = xb_add(&bar[XB_XSUB(b.x)], 1u);
        const unsigned gen = old / nloc;
        if (old + 1u == (gen + 1u) * nloc) {
            __builtin_amdgcn_fence(__ATOMIC_RELEASE, "agent");
            asm volatile("s_waitcnt vmcnt(0)" ::: "memory");
            const unsigned og = xb_add(&bar[XB_TOP], 1u);
            const unsigned tg = og / nx;
            if (og + 1u == (tg + 1u) * nx) xb_add(&bar[XB_TOPGEN], 1u);
            else XB_SPIN(xb_ld(&bar[XB_TOPGEN]) == tg, bar);
            __builtin_amdgcn_fence(__ATOMIC_ACQUIRE, "agent");
            xb_add(&bar[XB_XGEN(b.x)], 1u);
            asm volatile("s_waitcnt vmcnt(0)" ::: "memory");
        } else {
            XB_SPIN(xb_ld(&bar[XB_XGEN(b.x)]) == gen, bar);
            __builtin_amdgcn_fence(__ATOMIC_ACQUIRE, "agent");
            asm volatile("s_waitcnt vmcnt(0)" ::: "memory");
        }
    }
    __syncthreads();
}

constexpr int NWAVES = 8, NTHR = 512;
constexpr int LDS_BYTES = 147456, LDSCTL_OFF = LDS_BYTES - 1024, MISC_OFF = LDSCTL_OFF + 320;

struct Args { const float* in[21]; float* out; unsigned char* ws; int ph_lo, ph_hi, li, pad; };

struct Frame {
    LAS unsigned char* lds;
    unsigned char* ws;
    int tid, lane, wave, vcu, G;
};

template <int MODE = 0> struct EpiInProjT {
    static constexpr bool PERM = true; static constexpr bool RAW = true;
    unsigned char* ws; const u32x4* rope;
    __device__ __forceinline__ void operator()(const f32x4 (&acc)[2][2][4][2], const pg8::Unit& u, int wr, int wc, int fr, int fq) const {
        const int seg = MODE == 4 ? 5 : (u.pn >> 2);
        bf16_t* O = (bf16_t*)(MODE == 0 ? ws + WS_PROJ + (size_t)seg * SEG : ws + WS_OUTF + (size_t)(seg % 5) * SEG);
        const int colt = (u.pn & 3) * 256;
        const int row0 = (MODE == 3 ? (u.pm & 3) : u.pm) * 256 + wr * 64 + fr;
        const int d = wc * 32 + 8 * fq;
        auto store_bf16 = [&](int row, u32x4 w0, u32x4 w1) {
            if (seg == 0) {
                const int pos = row & (SEQ - 1), il = pos & 127;
                bf16_t* blkp = O + ((((size_t)(row >> 12) * 4 + (u.pn & 3)) * 32 + (pos >> 7)) * 4 + (il >> 5)) * 8192 + (size_t)(((d >> 3) & 1) * 32 + (il & 31)) * 8;
                unsigned char* b8 = (unsigned char*)O + (size_t)(blkp - O);
                if (MODE == 2 || MODE == 4) asm volatile("" :: "v"(w0), "v"(w1), "v"(b8)); else { *(u32x2*)(b8 + (d >> 4) * 512) = (u32x2){w0.x, w0.y}; *(u32x2*)(b8 + ((d >> 4) + 8) * 512) = (u32x2){w1.x, w1.y}; }
            } else if (MODE == 0 && seg == 1) {
                const int it_ = ((row - row0) >> 7) * 4 + (((row - row0) >> 4) & 3);
                unsigned char* tp = (unsigned char*)O + ((size_t)(u.pm * 4 + (u.pn & 3)) * 8 + (wr * 4 + wc)) * 8192 + (size_t)it_ * 1024 + (fq * 16 + fr) * 8;
                *(u32x2*)tp = (u32x2){w0.x, w0.y}; *(u32x2*)(tp + 512) = (u32x2){w1.x, w1.y};
            } else if (MODE == 0) {
                const int it_ = ((row - row0) >> 7) * 4 + (((row - row0) >> 4) & 3);
                unsigned char* tp = (unsigned char*)O + ((size_t)(u.pm * 4 + (u.pn & 3)) * 8 + (wr * 4 + wc)) * 16384 + (size_t)it_ * 2048 + (fq * 16 + fr) * 16;
                *(u32x4*)tp = w0; *(u32x4*)(tp + 1024) = w1;
            } else { bf16_t* rowp = O + (size_t)row * DM + colt + d; if (MODE == 2 || MODE == 4) asm volatile("" :: "v"(w0), "v"(w1), "v"(rowp)); else { *(u32x4*)rowp = w0; *(u32x4*)(rowp + 128) = w1; } }
        };
        auto emit = [&](int row, f32x4 v00, f32x4 v01, f32x4 v10, f32x4 v11) {
            if (MODE == 5) {
                const int it5 = ((row - row0) >> 7) * 4 + (((row - row0) >> 4) & 3);
                unsigned char* base5 = ws + WS_OUTF + ((size_t)((u.pm * 36 + u.pn) % 2048) * 8 + (wr * 4 + wc)) * 16384 + (size_t)it5 * 2048 + (fq * 16 + fr) * 16;
                if (seg <= 2) { u32x4 w0, w1; w0.x = cvtpk(v00[0], v00[1]); w0.y = cvtpk(v00[2], v00[3]); w0.z = cvtpk(v01[0], v01[1]); w0.w = cvtpk(v01[2], v01[3]);
                    w1.x = cvtpk(v10[0], v10[1]); w1.y = cvtpk(v10[2], v10[3]); w1.z = cvtpk(v11[0], v11[1]); w1.w = cvtpk(v11[2], v11[3]); *(u32x4*)base5 = w0; *(u32x4*)(base5 + 1024) = w1; }
                else { u32x4 f; f.x = pk4_fp8_clamped(v00[0], v00[1], v00[2], v00[3]); f.y = pk4_fp8_clamped(v01[0], v01[1], v01[2], v01[3]); f.z = pk4_fp8_clamped(v10[0], v10[1], v10[2], v10[3]); f.w = pk4_fp8_clamped(v11[0], v11[1], v11[2], v11[3]); *(u32x4*)base5 = f; }
                return;
            }
            if (seg <= 2) {
                u32x4 w0, w1; w0.x = cvtpk(v00[0], v00[1]); w0.y = cvtpk(v00[2], v00[3]); w0.z = cvtpk(v01[0], v01[1]); w0.w = cvtpk(v01[2], v01[3]);
                w1.x = cvtpk(v10[0], v10[1]); w1.y = cvtpk(v10[2], v10[3]); w1.z = cvtpk(v11[0], v11[1]); w1.w = cvtpk(v11[2], v11[3]);
                store_bf16(row, w0, w1);
            } else {
                unsigned char* rowp = (unsigned char*)O + (size_t)row * DM + colt + d;
                u32x2 f0, f1;
                if (seg >= 7 && MODE == 0) {
                    const int it_ = ((row - row0) >> 7) * 4 + (((row - row0) >> 4) & 3);
                    u32x4 f; f.x = pk4_fp8_noclamp(v00[0], v00[1], v00[2], v00[3]); f.y = pk4_fp8_noclamp(v01[0], v01[1], v01[2], v01[3]); f.z = pk4_fp8_noclamp(v10[0], v10[1], v10[2], v10[3]); f.w = pk4_fp8_noclamp(v11[0], v11[1], v11[2], v11[3]);
                    *(u32x4*)((unsigned char*)O + ((size_t)(u.pm * 4 + (u.pn & 3)) * 8 + (wr * 4 + wc)) * 8192 + (size_t)it_ * 1024 + (fq * 16 + fr) * 16) = f;
                    return;
                }
                if (seg >= 7) { f0.x = pk4_fp8_noclamp(v00[0], v00[1], v00[2], v00[3]); f0.y = pk4_fp8_noclamp(v01[0], v01[1], v01[2], v01[3]); f1.x = pk4_fp8_noclamp(v10[0], v10[1], v10[2], v10[3]); f1.y = pk4_fp8_noclamp(v11[0], v11[1], v11[2], v11[3]); }
                else { f0.x = pk4_fp8_clamped(v00[0], v00[1], v00[2], v00[3]); f0.y = pk4_fp8_clamped(v01[0], v01[1], v01[2], v01[3]); f1.x = pk4_fp8_clamped(v10[0], v10[1], v10[2], v10[3]); f1.y = pk4_fp8_clamped(v11[0], v11[1], v11[2], v11[3]); }
                if (MODE == 2 || MODE == 4) asm volatile("" :: "v"(f0), "v"(f1), "v"(rowp)); else { *(u32x2*)rowp = f0; *(u32x2*)(rowp + 128) = f1; }
            }
        };
        if (seg <= 1) {
            u32x4 cs[4][2], pw[4][2];
            const float sc = seg == 1 ? 0.0625f * FP8_UNSCALE : FP8_UNSCALE;
#define RP_LOAD(ai) do { _Pragma("unroll") for (int m = 0; m < 4; ++m) { const int pos = (row0 + (ai) * 128 + m * 16) & (SEQ - 1); const u32x4* p = rope + ((size_t)pos * 16 + (d >> 3)) * 2; cs[m][0] = p[0]; cs[m][1] = p[1]; } } while (0)
#define RP_CALC(ai) do { _Pragma("unroll") for (int m = 0; m < 4; ++m) { \
                const f32x4 v00 = acc[ai][0][m][0], v01 = acc[ai][0][m][1], v10 = acc[ai][1][m][0], v11 = acc[ai][1][m][1]; const u32x4 c = cs[m][0], sn = cs[m][1]; \
                const f32x4 c0 = (f32x4){bflo(c.x), bfhi(c.x), bflo(c.y), bfhi(c.y)} * sc, c1 = (f32x4){bflo(c.z), bfhi(c.z), bflo(c.w), bfhi(c.w)} * sc; \
                const f32x4 s0 = (f32x4){bflo(sn.x), bfhi(sn.x), bflo(sn.y), bfhi(sn.y)} * sc, s1 = (f32x4){bflo(sn.z), bfhi(sn.z), bflo(sn.w), bfhi(sn.w)} * sc; \
                const f32x4 a0 = v00 * c0 - v10 * s0, a1 = v01 * c1 - v11 * s1, b0 = v00 * s0 + v10 * c0, b1 = v01 * s1 + v11 * c1; \
                pw[m][0] = (u32x4){pk4_fp8(a0[0], a0[1], a0[2], a0[3]), pk4_fp8(a1[0], a1[1], a1[2], a1[3]), 0u, 0u}; pw[m][1] = (u32x4){pk4_fp8(b0[0], b0[1], b0[2], b0[3]), pk4_fp8(b1[0], b1[1], b1[2], b1[3]), 0u, 0u}; } } while (0)
#define RP_STORE(ai) do { _Pragma("unroll") for (int m = 0; m < 4; ++m) store_bf16(row0 + (ai) * 128 + m * 16, pw[m][0], pw[m][1]); } while (0)
            RP_LOAD(0); RP_CALC(0); RP_LOAD(1); RP_STORE(0); RP_CALC(1); RP_STORE(1);
#undef RP_LOAD
#undef RP_CALC
#undef RP_STORE
            return;
        }
#pragma unroll
        for (int ai = 0; ai < 2; ++ai)
#pragma unroll
            for (int m = 0; m < 4; ++m) {
                f32x4 v00 = acc[ai][0][m][0], v01 = acc[ai][0][m][1], v10 = acc[ai][1][m][0], v11 = acc[ai][1][m][1];
                if (seg == 2) { v00 = v00 * FP8_UNSCALE; v01 = v01 * FP8_UNSCALE; v10 = v10 * FP8_UNSCALE; v11 = v11 * FP8_UNSCALE; }
                else if (seg == 3) {
                    constexpr float ce = -FP8_UNSCALE * 1.4426950408889634f, cm = YD_SCALE * FP8_UNSCALE;
#pragma unroll
                    for (int i = 0; i < 4; ++i) { v00[i] = (v00[i] * cm) * __builtin_amdgcn_rcpf(1.f + __builtin_amdgcn_exp2f(v00[i] * ce)); v01[i] = (v01[i] * cm) * __builtin_amdgcn_rcpf(1.f + __builtin_amdgcn_exp2f(v01[i] * ce));
                        v10[i] = (v10[i] * cm) * __builtin_amdgcn_rcpf(1.f + __builtin_amdgcn_exp2f(v10[i] * ce)); v11[i] = (v11[i] * cm) * __builtin_amdgcn_rcpf(1.f + __builtin_amdgcn_exp2f(v11[i] * ce)); }
                } else if (seg <= 6) { const float q = (seg == 4 ? 0.18033688011112042f : 1.0f) * (YD_SCALE * FP8_UNSCALE); v00 = v00 * q; v01 = v01 * q; v10 = v10 * q; v11 = v11 * q; }
                else {
                    constexpr float ce = -FP8_UNSCALE * 1.4426950408889634f;
#pragma unroll
                    for (int i = 0; i < 4; ++i) { v00[i] = __builtin_amdgcn_rcpf(__builtin_fmaf(__builtin_amdgcn_exp2f(v00[i] * ce), YD_INV, YD_INV)); v01[i] = __builtin_amdgcn_rcpf(__builtin_fmaf(__builtin_amdgcn_exp2f(v01[i] * ce), YD_INV, YD_INV));
                        v10[i] = __builtin_amdgcn_rcpf(__builtin_fmaf(__builtin_amdgcn_exp2f(v10[i] * ce), YD_INV, YD_INV)); v11[i] = __builtin_amdgcn_rcpf(__builtin_fmaf(__builtin_amdgcn_exp2f(v11[i] * ce), YD_INV, YD_INV)); }
                }
                emit(row0 + ai * 128 + m * 16, v00, v01, v10, v11);
            }
    }
};
using EpiInProj = EpiInProjT<0>;
template <bool ADD> struct EpiGateBf16 {
    static constexpr bool PERM = true; static constexpr bool RAW = false;
    bf16_t* O; const bf16_t* Gt; const bf16_t* P;
    __device__ __forceinline__ void operator()(const f32x4 (&acc)[2][2][4][2], const pg8::Unit& u, int wr, int wc, int fr, int fq) const {
        const int row0 = u.pm * 256 + wr * 64 + fr, col0 = u.pn * 256 + wc * 32 + 8 * fq;
#pragma unroll
        for (int ai = 0; ai < 2; ++ai)
#pragma unroll
            for (int m = 0; m < 4; ++m) {
                const size_t ro = (size_t)(row0 + ai * 128 + m * 16) * DM + col0;
#pragma unroll
                for (int bj = 0; bj < 2; ++bj) {
                    const u32x4 g = *(const u32x4*)(Gt + ro + bj * 128);
                    f32x4 v0 = acc[ai][bj][m][0], v1 = acc[ai][bj][m][1];
                    v0[0] *= bflo(g.x); v0[1] *= bfhi(g.x); v0[2] *= bflo(g.y); v0[3] *= bfhi(g.y);
                    v1[0] *= bflo(g.z); v1[1] *= bfhi(g.z); v1[2] *= bflo(g.w); v1[3] *= bfhi(g.w);
                    if (ADD) { const u32x4 p = *(const u32x4*)(P + ro + bj * 128);
                        v0[0] += bflo(p.x); v0[1] += bfhi(p.x); v0[2] += bflo(p.y); v0[3] += bfhi(p.y);
                        v1[0] += bflo(p.z); v1[1] += bfhi(p.z); v1[2] += bflo(p.w); v1[3] += bfhi(p.w); }
                    u32x4 w; w.x = cvtpk(v0[0], v0[1]); w.y = cvtpk(v0[2], v0[3]); w.z = cvtpk(v1[0], v1[1]); w.w = cvtpk(v1[2], v1[3]);
                    *(u32x4*)(O + ro + bj * 128) = w;
                }
            }
    }
};
struct EpiMerge {
    static constexpr bool PERM = true; static constexpr bool RAW = false;
    unsigned char* O; const unsigned char* Gr; const unsigned char* Ga;
    __device__ __forceinline__ void operator()(f32x4 (&acc)[2][2][4][2], const pg8::Unit& u, int wr, int wc, int fr, int fq) const {
        const int row0 = u.pm * 256 + wr * 64 + fr, col0 = u.pn * 256 + wc * 32 + 8 * fq;
        u32x4 ga4[8], gr4[8];
        const size_t fo = ((size_t)(u.pm * 4 + u.pn) * 8 + (wr * 4 + wc)) * 8192 + (fq * 16 + fr) * 16;
#pragma unroll
        for (int it = 0; it < 8; ++it) { ga4[it] = *(const u32x4*)(Ga + fo + it * 1024); gr4[it] = *(const u32x4*)(Gr + (u.e == 0 ? fo + it * 1024 : 0)); }
#pragma unroll
        for (int it = 0; it < 8; ++it) {
            const int ai = it >> 2, m = it & 3;
            const size_t ro = (size_t)(row0 + ai * 128 + m * 16) * DM + col0;
#pragma unroll
            for (int bj = 0; bj < 2; ++bj) {
                u32x2 g; g.x = bj == 0 ? ga4[it].x : ga4[it].z; g.y = bj == 0 ? ga4[it].y : ga4[it].w;
                const f32x2 ga0 = __builtin_amdgcn_cvt_pk_f32_fp8((int)g.x, false), ga1 = __builtin_amdgcn_cvt_pk_f32_fp8((int)g.x, true), ga2 = __builtin_amdgcn_cvt_pk_f32_fp8((int)g.y, false), ga3 = __builtin_amdgcn_cvt_pk_f32_fp8((int)g.y, true);
                f32x4 a0 = (f32x4){ga0.x, ga0.y, ga1.x, ga1.y} * YD_INV, a1 = (f32x4){ga2.x, ga2.y, ga3.x, ga3.y} * YD_INV;
                if (u.e == 0) {
                    u32x2 h; h.x = bj == 0 ? gr4[it].x : gr4[it].z; h.y = bj == 0 ? gr4[it].y : gr4[it].w;
                    const f32x2 gr0 = __builtin_amdgcn_cvt_pk_f32_fp8((int)h.x, false), gr1 = __builtin_amdgcn_cvt_pk_f32_fp8((int)h.x, true), gr2 = __builtin_amdgcn_cvt_pk_f32_fp8((int)h.y, false), gr3 = __builtin_amdgcn_cvt_pk_f32_fp8((int)h.y, true);
                    const f32x4 r0 = (f32x4){gr0.x, gr0.y, gr1.x, gr1.y} * YD_INV, r1 = (f32x4){gr2.x, gr2.y, gr3.x, gr3.y} * YD_INV;
#pragma unroll
                    for (int i = 0; i < 4; ++i) { acc[ai][bj][m][0][i] *= r0[i] * __builtin_amdgcn_rcpf(fmaxf(a0[i], 1e-30f)); acc[ai][bj][m][1][i] *= r1[i] * __builtin_amdgcn_rcpf(fmaxf(a1[i], 1e-30f)); }
                } else {
                    const f32x4 v0 = acc[ai][bj][m][0] * a0, v1 = acc[ai][bj][m][1] * a1;
                    u32x2 w; w.x = pk4_fp8(v0[0], v0[1], v0[2], v0[3]); w.y = pk4_fp8(v1[0], v1[1], v1[2], v1[3]);
                    *(u32x2*)(O + ro + bj * 128) = w;
                }
            }
        }
    }
};
struct EpiOProj {
    static constexpr bool PERM = true; static constexpr bool RAW = false;
    const float* x; bf16_t* x1; const float* mod; float* ss;
    __device__ __forceinline__ void operator()(const f32x4 (&acc)[2][2][4][2], const pg8::Unit& u, int wr, int wc, int fr, int fq) const {
        const int row0 = u.pm * 256 + wr * 64 + fr, col0 = u.pn * 256 + wc * 32 + 8 * fq;
        const int b = (u.pm * 256) / SEQ;
        f32x4 gm[2][2];
#pragma unroll
        for (int bj = 0; bj < 2; ++bj)
#pragma unroll
            for (int n = 0; n < 2; ++n) gm[bj][n] = *(const f32x4*)(mod + (size_t)b * 6144 + 2 * DM + col0 + bj * 128 + n * 4);
        f32x4 xv[4][2][2]; u32x4 wv[4][2]; float sqv[4];
#define OP_LOAD(ai) do { _Pragma("unroll") for (int m = 0; m < 4; ++m) _Pragma("unroll") for (int bj = 0; bj < 2; ++bj) { const float* p_ = x + (size_t)(row0 + (ai) * 128 + m * 16) * DM + col0 + bj * 128; \
            xv[m][bj][0] = *(const f32x4*)p_; xv[m][bj][1] = *(const f32x4*)(p_ + 4); } } while (0)
#define OP_CALC(ai) do { _Pragma("unroll") for (int m = 0; m < 4; ++m) { float sq = 0.f; _Pragma("unroll") for (int bj = 0; bj < 2; ++bj) { \
            const f32x4 o0 = xv[m][bj][0] + gm[bj][0] * acc[ai][bj][m][0], o1 = xv[m][bj][1] + gm[bj][1] * acc[ai][bj][m][1]; \
            u32x4 w; w.x = cvtpk(o0[0], o0[1]); w.y = cvtpk(o0[2], o0[3]); w.z = cvtpk(o1[0], o1[1]); w.w = cvtpk(o1[2], o1[3]); wv[m][bj] = w; \
            sq += (o0[0] * o0[0] + o0[1] * o0[1]) + (o0[2] * o0[2] + o0[3] * o0[3]) + (o1[0] * o1[0] + o1[1] * o1[1]) + (o1[2] * o1[2] + o1[3] * o1[3]); } \
            sq += __shfl_xor(sq, 16); sq += __shfl_xor(sq, 32); sqv[m] = sq; } } while (0)
#define OP_STORE(ai) do { _Pragma("unroll") for (int m = 0; m < 4; ++m) { const int row = row0 + (ai) * 128 + m * 16; const size_t ro = (size_t)row * DM + col0; \
            *(u32x4*)(x1 + ro) = wv[m][0]; *(u32x4*)(x1 + ro + 128) = wv[m][1]; if (fq == 0) ss[(size_t)row * 16 + u.pn * 4 + wc] = sqv[m]; } } while (0)
        OP_LOAD(0); OP_CALC(0); OP_LOAD(1); OP_STORE(0); OP_CALC(1); OP_STORE(1);
#undef OP_LOAD
#undef OP_CALC
#undef OP_STORE
    }
};
struct EpiRouter {
    static constexpr bool PERM = false; static constexpr bool RAW = false; static constexpr bool PERM16 = false;
    float* C; const float* rstd; const float* bias;
    __device__ __forceinline__ void operator()(const f32x4 (&acc)[2][2][4][2], const pg8::Unit& u, int wr, int wc, int fr, int fq) const {
        const int row0 = u.pm * 256 + wr * 64 + fr, col0 = wc * 32 + 4 * fq;
        f32x4 bs[2][2]; float rs[8];
#pragma unroll
        for (int bj = 0; bj < 2; ++bj)
#pragma unroll
            for (int n = 0; n < 2; ++n) bs[bj][n] = *(const f32x4*)(bias + (size_t)(u.pm >> 4) * NEXP + col0 + bj * 128 + n * 16);
#pragma unroll
        for (int it = 0; it < 8; ++it) rs[it] = rstd[row0 + (it >> 2) * 128 + (it & 3) * 16];
#pragma unroll
        for (int ai = 0; ai < 2; ++ai)
#pragma unroll
            for (int m = 0; m < 4; ++m) { float* rowp = C + (size_t)(row0 + ai * 128 + m * 16) * NEXP + col0;
#pragma unroll
                for (int bj = 0; bj < 2; ++bj)
#pragma unroll
                    for (int n = 0; n < 2; ++n) *(f32x4*)(rowp + bj * 128 + n * 16) = acc[ai][bj][m][n] * rs[ai * 4 + m] + bs[bj][n]; }
    }
};
struct EpiF32 {
    static constexpr bool PERM = false; static constexpr bool RAW = false;
    float* C; int ldc;
    __device__ __forceinline__ void operator()(const f32x4 (&acc)[2][2][4][2], const pg8::Unit& u, int wr, int wc, int fr, int fq) const {
        const int row0 = u.pm * 256 + wr * 64 + fr, col0 = u.pn * 256 + wc * 32 + 4 * fq;
#pragma unroll
        for (int ai = 0; ai < 2; ++ai)
#pragma unroll
            for (int m = 0; m < 4; ++m) { float* rowp = C + (size_t)(row0 + ai * 128 + m * 16) * ldc + col0;
#pragma unroll
                for (int bj = 0; bj < 2; ++bj)
#pragma unroll
                    for (int n = 0; n < 2; ++n) *(f32x4*)(rowp + bj * 128 + n * 16) = acc[ai][bj][m][n]; }
    }
};
struct EpiPlainScratch {
    static constexpr bool PERM = true; static constexpr bool RAW = false;
    bf16_t* O;
    __device__ __forceinline__ void operator()(const f32x4 (&acc)[2][2][4][2], const pg8::Unit& u, int wr, int wc, int fr, int fq) const {
        const int row0 = u.pm * 256 + wr * 64 + fr, col0 = (u.pn & 3) * 256 + wc * 32 + 8 * fq;
#pragma unroll
        for (int ai = 0; ai < 2; ++ai)
#pragma unroll
            for (int m = 0; m < 4; ++m) { bf16_t* rowp = O + (size_t)(row0 + ai * 128 + m * 16) * DM + col0;
#pragma unroll
                for (int bj = 0; bj < 2; ++bj) { const f32x4 v0 = acc[ai][bj][m][0], v1 = acc[ai][bj][m][1];
                    u32x4 w; w.x = cvtpk(v0[0], v0[1]); w.y = cvtpk(v0[2], v0[3]); w.z = cvtpk(v1[0], v1[1]); w.w = cvtpk(v1[2], v1[3]); *(u32x4*)(rowp + bj * 128) = w; } }
    }
};
struct EpiNull {
    static constexpr bool PERM = false; static constexpr bool RAW = false;
    __device__ __forceinline__ void operator()(const f32x4 (&acc)[2][2][4][2], const pg8::Unit&, int, int, int, int) const {
#pragma unroll
        for (int ai = 0; ai < 2; ++ai)
#pragma unroll
            for (int bj = 0; bj < 2; ++bj)
#pragma unroll
                for (int m = 0; m < 4; ++m)
#pragma unroll
                    for (int n = 0; n < 2; ++n) asm volatile("" :: "v"(acc[ai][bj][m][n]));
    }
};
struct EpiGU {
    static constexpr bool PERM = true; static constexpr bool RAW = false;
    bf16_t* hid;
    __device__ __forceinline__ void operator()(const f32x4 (&acc)[2][2][4][2], const pg8::Unit& u, int wr, int wc, int fr, int fq) const {
        const int row0 = u.pm * 256 + wr * 64 + fr, col0 = u.pn * 128 + wc * 32 + 8 * fq;
#pragma unroll
        for (int ai = 0; ai < 2; ++ai)
#pragma unroll
            for (int m = 0; m < 4; ++m) {
                unsigned char* rowp = (unsigned char*)hid + (size_t)u.pm * 65536 + (size_t)u.pn * 32768 + (size_t)(wr * 4 + wc) * 4096 + (size_t)(ai * 4 + m) * 512 + (fq * 16 + fr) * 8;
                f32x4 h0, h1;
#pragma unroll
                for (int i = 0; i < 4; ++i) { h0[i] = siluf_(acc[ai][0][m][0][i]) * acc[ai][1][m][0][i]; h1[i] = siluf_(acc[ai][0][m][1][i]) * acc[ai][1][m][1][i]; }
                u32x2 w; w.x = pk4_fp8_scaled(h0[0], h0[1], h0[2], h0[3], HID_SCALE); w.y = pk4_fp8_scaled(h1[0], h1[1], h1[2], h1[3], HID_SCALE); *(u32x2*)rowp = w; }
    }
};
template <int MODE> struct EpiDownT {
    static constexpr bool PERM = true; static constexpr bool RAW = false;
    unsigned char* ws; const LAS int* exp_info;
    __device__ __forceinline__ void operator()(const f32x4 (&acc)[2][2][4][2], const pg8::Unit& u, int wr, int wc, int fr, int fq) const {
        const int shift = __builtin_amdgcn_readfirstlane(exp_info[u.e]), lim = __builtin_amdgcn_readfirstlane(exp_info[512 + u.e]);
        const int row0 = u.pm * 256 + wr * 64 + fr, col0 = u.pn * 256 + wc * 32 + 8 * fq;
#pragma unroll
        for (int ai = 0; ai < 2; ++ai)
#pragma unroll
            for (int m = 0; m < 4; ++m) {
                const int pos = row0 + ai * 128 + m * 16;
                if (pos < lim) {
                    unsigned char* rowp = (MODE == 1 ? ws + WS_SS + (size_t)blockIdx.x * 2048 : ydense_row(ws, pos - shift)) + col0;
#pragma unroll
                    for (int bj = 0; bj < 2; ++bj) { const f32x4 v0 = acc[ai][bj][m][0], v1 = acc[ai][bj][m][1];
                        u32x2 w; w.x = pk4_fp8(v0[0], v0[1], v0[2], v0[3]); w.y = pk4_fp8(v1[0], v1[1], v1[2], v1[3]);
                        *(u32x2*)(rowp + bj * 128) = w; }
                }
            }
    }
};
typedef EpiDownT<0> EpiDown;

template <bool F8 = false> __device__ __forceinline__ void transpose_item(const float* W, int N, int K, int k0, int n0, bf16_t* WT, int drow0, LAS float* scr, int lane) {
    float tv[32];
#pragma unroll
    for (int i = 0; i < 32; ++i) tv[i] = W[(size_t)(k0 + 2 * i + (lane >> 5)) * N + n0 + (lane & 31)];
#pragma unroll
    for (int i = 0; i < 32; ++i) scr[(2 * i + (lane >> 5)) * 33 + (lane & 31)] = tv[i];
    asm volatile("s_waitcnt lgkmcnt(0)" ::: "memory");
    const int c = lane & 7;
#pragma unroll
    for (int j = 0; j < 4; ++j) { const int n = (lane >> 3) + 8 * j; const LAS float* s = scr + (8 * c) * 33 + n;
        if constexpr (F8) { u32x2 o; o.x = pk4_fp8w(s[0 * 33], s[1 * 33], s[2 * 33], s[3 * 33]); o.y = pk4_fp8w(s[4 * 33], s[5 * 33], s[6 * 33], s[7 * 33]);
            *(u32x2*)((unsigned char*)WT + (size_t)(drow0 + n) * K + k0 + 8 * c) = o; }
        else { u32x4 o; o.x = cvtpk(s[0 * 33], s[1 * 33]); o.y = cvtpk(s[2 * 33], s[3 * 33]); o.z = cvtpk(s[4 * 33], s[5 * 33]); o.w = cvtpk(s[6 * 33], s[7 * 33]);
            *(u32x4*)(WT + (size_t)(drow0 + n) * K + k0 + 8 * c) = o; } }
    asm volatile("s_waitcnt lgkmcnt(0)" ::: "memory");
}
template <bool F8 = false> __device__ __forceinline__ void transpose_plain(const float* W, int K, int N, bf16_t* WT, LAS float* scr, int item, int lane) {
    const int nblk = N / 32, kb = item / nblk, nb = item % nblk;
    transpose_item<F8>(W, N, K, 64 * kb, 32 * nb, WT, 32 * nb, scr, lane);
}

__device__ __forceinline__ int t5_bucket(int rel) {
    const int n = rel < 0 ? -rel : rel;
    int large = 8 + (int)(logf((float)(n > 1 ? n : 1) / 8.0f) / 4.852030263919617f * 8.0f);
    large = large < 15 ? large : 15;
    return (rel > 0 ? 16 : 0) + (n < 8 ? n : large);
}

__device__ __forceinline__ void phase0(Frame& F, const Args& a) {
    const float* c = a.in[1]; const float* w_ada = a.in[2]; const float* b_ada = a.in[3];
    {
        LAS float* cond = (LAS float*)F.lds;
        LAS float* red = (LAS float*)(F.lds + 32768);
        for (int i = F.tid; i < NB * DM; i += NTHR) cond[i] = siluf_(c[i]);
        __syncthreads();
        for (int cg = F.vcu; cg < 256; cg += F.G) {
            const int j = F.tid & 31, kg = F.tid >> 5;
            float s[NB];
#pragma unroll
            for (int b = 0; b < NB; ++b) s[b] = 0.f;
            if (j < 24) {
                float wv[64];
#pragma unroll
                for (int i = 0; i < 64; ++i) wv[i] = w_ada[(size_t)(kg + 16 * i) * 6144 + cg * 24 + j];
#pragma unroll
                for (int i = 0; i < 64; ++i) {
#pragma unroll
                    for (int b = 0; b < NB; ++b) s[b] += cond[b * DM + kg + 16 * i] * wv[i]; }
            }
#pragma unroll
            for (int b = 0; b < NB; ++b) red[(kg * NB + b) * 32 + j] = s[b];
            __syncthreads();
            if (F.tid < 192) { const int b = F.tid / 24, jj = F.tid % 24; float t = 0.f;
                for (int g = 0; g < 16; ++g) t += red[(g * NB + b) * 32 + jj];
                ((float*)(F.ws + WS_MOD))[b * 6144 + cg * 24 + jj] = t + b_ada[cg * 24 + jj]; }
            __syncthreads();
        }
    }
    const int gt = F.vcu * NTHR + F.tid, NGT = F.G * NTHR;
    {
        unsigned short* rt = (unsigned short*)(F.ws + WS_ROPE_C);
        for (int i = gt; i < SEQ * 128; i += NGT) { const int pos = i >> 7, d = i & 127;
            const float inv = exp2f((float)d * (-13.287712379549449f / 128.0f)); const float ang = (float)pos * inv;
            const size_t o = ((size_t)pos * 16 + (d >> 3)) * 16 + (d & 7);
            rt[o] = (unsigned short)(cvtpk(cosf(ang), 0.f) & 0xffffu); rt[o + 8] = (unsigned short)(cvtpk(sinf(ang), 0.f) & 0xffffu); }
    }
    {
        const float* t5 = a.in[7]; float* bt = (float*)(F.ws + WS_BTAB);
        for (int i = gt; i < 3 * 16 * 160; i += NGT) { const int g = i / (16 * 160), h = (i / 160) % 16, j = i % 160;
            const int dil = g == 0 ? 1 : (g == 1 ? 4 : 16);
            bt[i] = j <= 128 ? t5[t5_bucket((j - 64) * dil) * 16 + h] * 1.4426950408889634f : 0.f; }
    }
    { unsigned* z = (unsigned*)(F.ws + WS_H + (size_t)NTOK * DM * 2); for (int i = gt; i < DM / 2; i += NGT) z[i] = 0u; }
    {
        LAS float* scr = (LAS float*)(F.lds + 49152 + F.wave * 8704);
        const int gw = F.vcu * NWAVES + F.wave, NGW = F.G * NWAVES;
        constexpr int I_IN = (DM / 64) * (PROJW / 32), I_SQ = (DM / 64) * (DM / 32), I_R = (DM / 64) * (NEXP / 32);
        constexpr int NITEMS = I_IN + 3 * I_SQ + I_R;
        for (int it = gw; it < NITEMS; it += NGW) {
            int r = it;
            if (r < I_IN) { transpose_plain<true>(a.in[5], DM, PROJW, (bf16_t*)(F.ws + WS_WIN), scr, r, F.lane); continue; } r -= I_IN;
            if (r < I_SQ) { transpose_plain<true>(a.in[8], DM, DM, (bf16_t*)(F.ws + WS_WRU), scr, r, F.lane); continue; } r -= I_SQ;
            if (r < I_SQ) { transpose_plain<true>(a.in[9], DM, DM, (bf16_t*)(F.ws + WS_WAU), scr, r, F.lane); continue; } r -= I_SQ;
            if (r < I_SQ) { transpose_plain<true>(a.in[10], DM, DM, (bf16_t*)(F.ws + WS_WO), scr, r, F.lane); continue; } r -= I_SQ;
            transpose_plain(a.in[12], DM, NEXP, (bf16_t*)(F.ws + WS_WR), scr, r, F.lane);
        }
    }
}

constexpr int CW_CONVQ = 16384 + 2048;
constexpr size_t WGU_E_BYTES = 512 * 1024, WGU_T_BYTES = 256 * 1024;
__device__ __forceinline__ void moe_weight_convert(Frame& F, const Args& a) {
    LAS unsigned char* img = F.lds + F.wave * 16384;
    const int total = 257 * 2 * 16, c = F.lane;
    unsigned* q = (unsigned*)(F.ws + WS_CTL) + CW_CONVQ;
    const int R0 = 32 * ((c >> 3) & 3) + 16 * (c & 1) + 4 * ((c & 7) >> 1);
    const int lbase = (c >> 5) * 8192 + (R0 >> 4) * 1024 + (R0 & 15) * 64;
    f32x4 va[16], vb[16];
#define CV_SRC(it) ((((it) >> 5) < 256 ? a.in[14 + (((it) >> 4) & 1)] + (size_t)((it) >> 5) * 1024 * 256 : a.in[17 + (((it) >> 4) & 1)]) + (size_t)((it) & 15) * 64 * 256 + 4 * c)
#define CV_LOAD(V, p, s) do { _Pragma("unroll") for (int r = 0; r < 16; ++r) V[r] = *(const f32x4*)((p) + (size_t)(16 * (s) + r) * 256); } while (0)
#define CV_PROC(V, s) do { _Pragma("unroll") for (int nn = 0; nn < 4; ++nn) { u32x4 pc; pc.x = pk4_fp8w(V[0][nn], V[1][nn], V[2][nn], V[3][nn]); pc.y = pk4_fp8w(V[4][nn], V[5][nn], V[6][nn], V[7][nn]); \
        pc.z = pk4_fp8w(V[8][nn], V[9][nn], V[10][nn], V[11][nn]); pc.w = pk4_fp8w(V[12][nn], V[13][nn], V[14][nn], V[15][nn]); \
        const int o_ = lbase + nn * 64 + 16 * (s); *(LAS u32x4*)(img + (o_ ^ (((o_ >> 9) & 1) << 5))) = pc; } } while (0)
    unsigned cur = 0;
    if (c == 0) cur = __hip_atomic_fetch_add(q, 1u, __ATOMIC_RELAXED, __HIP_MEMORY_SCOPE_AGENT);
    cur = __builtin_amdgcn_readfirstlane(cur);
    if ((int)cur >= total) return;
    const float* sp = CV_SRC(cur);
    CV_LOAD(va, sp, 0);
#pragma unroll 1
    for (;;) {
        unsigned nxt = 0;
        if (c == 0) nxt = __hip_atomic_fetch_add(q, 1u, __ATOMIC_RELAXED, __HIP_MEMORY_SCOPE_AGENT);
        nxt = __builtin_amdgcn_readfirstlane(nxt);
        const bool more = (int)nxt < total;
        const float* np = more ? CV_SRC(nxt) : sp;
        CV_LOAD(vb, sp, 1); CV_PROC(va, 0);
        CV_LOAD(va, sp, 2); CV_PROC(vb, 1);
        CV_LOAD(vb, sp, 3); CV_PROC(va, 2);
        CV_LOAD(va, np, 0); CV_PROC(vb, 3);
        asm volatile("s_waitcnt lgkmcnt(0)" ::: "memory");
        const int e = cur >> 5, kind = (cur >> 4) & 1, kb = cur & 15;
        unsigned char* dst = F.ws + WS_WGU + (size_t)e * WGU_E_BYTES + (size_t)(kb >> 1) * 32768 + (size_t)kind * 16384 + (size_t)(kb & 1) * 1024 + 16 * c;
#pragma unroll
        for (int j = 0; j < 16; ++j) *(u32x4*)(dst + (size_t)(j >> 3) * WGU_T_BYTES + (size_t)(j & 7) * 2048) = *(const LAS u32x4*)(img + j * 1024 + 16 * c);
        asm volatile("s_waitcnt lgkmcnt(0)" ::: "memory");
        if (!more) break;
        cur = nxt; sp = np;
    }
#undef CV_SRC
#undef CV_LOAD
#undef CV_PROC
}

template <bool BF16IN, int OUT8> __device__ __forceinline__ void norm_mod_rows(Frame& F, const void* xin, const float* norm, const float* mod, int shift_off, int scale_off, const float* ssp, bf16_t* out, unsigned char* out8, float* rs_out = nullptr) {
    const float* x = (const float*)xin; const bf16_t* xb = (const bf16_t*)xin;
    const int gw = F.vcu * NWAVES + F.wave, NGW = F.G * NWAVES;
    f32x4 g4[4];
#pragma unroll
    for (int j = 0; j < 4; ++j) g4[j] = *(const f32x4*)(norm + 4 * F.lane + 256 * j);
    const int per = (NTOK + NGW - 1) / NGW, r0 = gw * per, r1 = (r0 + per) < NTOK ? (r0 + per) : NTOK;
    if (r0 >= r1) return;
    int bcur = r0 / SEQ;
    f32x4 sc[4], sh[4];
#define NM_MOD(B) do { _Pragma("unroll") for (int j = 0; j < 4; ++j) { const int col = 4 * F.lane + 256 * j; sc[j] = *(const f32x4*)(mod + (size_t)(B) * 6144 + scale_off + col) + 1.0f; sh[j] = *(const f32x4*)(mod + (size_t)(B) * 6144 + shift_off + col); } } while (0)
    NM_MOD(bcur);
    f32x4 vA[4], vB[4], vC[4], vD[4]; u32x2 wA[4], wB[4], wC[4], wD[4]; float pA = 0.f, pB = 0.f, pC = 0.f, pD = 0.f;
#define NM_LOAD(VF, VW, P, ROW) do { if (BF16IN) { const u32x2* xr_ = (const u32x2*)(xb + (size_t)(ROW) * DM) + F.lane; _Pragma("unroll") for (int j = 0; j < 4; ++j) VW[j] = xr_[64 * j]; } \
        else { const f32x4* xr_ = (const f32x4*)(x + (size_t)(ROW) * DM) + F.lane; _Pragma("unroll") for (int j = 0; j < 4; ++j) VF[j] = xr_[64 * j]; } \
        if (ssp) P = F.lane < 16 ? ssp[(size_t)(ROW) * 16 + F.lane] : 0.f; } while (0)
#define NM_BODY(VF, VW, P, ROW) do { f32x4 v_[4]; float s_ = 0.f; \
        _Pragma("unroll") for (int j = 0; j < 4; ++j) { v_[j] = BF16IN ? (f32x4){bflo(VW[j].x), bfhi(VW[j].x), bflo(VW[j].y), bfhi(VW[j].y)} : VF[j]; \
            s_ += (v_[j][0] * v_[j][0] + v_[j][1] * v_[j][1]) + (v_[j][2] * v_[j][2] + v_[j][3] * v_[j][3]); } \
        const float tot_ = wave_sum(ssp ? P : s_); const float rstd_ = rsqrtf(tot_ * (1.f / DM) + NORM_EPS); \
        if (rs_out && F.lane == 0) rs_out[(ROW)] = rstd_; \
        u32x2* o8_ = (u32x2*)(out + (size_t)(ROW) * DM) + F.lane; \
        _Pragma("unroll") for (int j = 0; j < 4; ++j) { const int col_ = 4 * F.lane + 256 * j; const f32x4 y_ = (v_[j] * rstd_) * g4[j] * sc[j] + sh[j]; \
            if (OUT8 != 1) { u32x2 w_; w_.x = cvtpk(y_[0], y_[1]); w_.y = cvtpk(y_[2], y_[3]); o8_[64 * j] = w_; } \
            if (OUT8 != 0) *(unsigned*)(out8 + (size_t)(ROW) * DM + col_) = pk4_fp8(y_[0], y_[1], y_[2], y_[3]); } } while (0)
    auto clampr = [&](int r) { return r < r1 ? r : r1 - 1; };
    NM_LOAD(vA, wA, pA, r0); NM_LOAD(vB, wB, pB, clampr(r0 + 1)); NM_LOAD(vC, wC, pC, clampr(r0 + 2));
#pragma unroll 1
    for (int row = r0; row < r1; row += 4) {
        const int b = row / SEQ;
        if (b != bcur) { NM_MOD(b); bcur = b; }
        NM_LOAD(vD, wD, pD, clampr(row + 3)); __builtin_amdgcn_sched_barrier(0);
        NM_BODY(vA, wA, pA, row);             __builtin_amdgcn_sched_barrier(0);
        NM_LOAD(vA, wA, pA, clampr(row + 4)); __builtin_amdgcn_sched_barrier(0);
        NM_BODY(vB, wB, pB, clampr(row + 1)); __builtin_amdgcn_sched_barrier(0);
        NM_LOAD(vB, wB, pB, clampr(row + 5)); __builtin_amdgcn_sched_barrier(0);
        NM_BODY(vC, wC, pC, clampr(row + 2)); __builtin_amdgcn_sched_barrier(0);
        NM_LOAD(vC, wC, pC, clampr(row + 6)); __builtin_amdgcn_sched_barrier(0);
        NM_BODY(vD, wD, pD, clampr(row + 3)); __builtin_amdgcn_sched_barrier(0);
    }
#undef NM_BODY
#undef NM_LOAD
#undef NM_MOD
}

__device__ __forceinline__ u32x4 fp8x8_to_bf16(unsigned w0, unsigned w1) {
    const f32x2 a = __builtin_amdgcn_cvt_pk_f32_fp8((int)w0, false), b = __builtin_amdgcn_cvt_pk_f32_fp8((int)w0, true), c = __builtin_amdgcn_cvt_pk_f32_fp8((int)w1, false), d = __builtin_amdgcn_cvt_pk_f32_fp8((int)w1, true);
    return (u32x4){cvtpk(a.x, a.y), cvtpk(b.x, b.y), cvtpk(c.x, c.y), cvtpk(d.x, d.y)};
}
__device__ __forceinline__ unsigned off_b(unsigned row, unsigned ch) { return 256u * row + 16u * (ch ^ (((row & 3) << 2) | ((row >> 2) & 3))); }
__device__ __forceinline__ int crow(int reg, int h) { return (reg & 3) + 8 * (reg >> 2) + 4 * h; }
__device__ __forceinline__ s16x4 tr_read(LAS unsigned char* p) { return __builtin_bit_cast(s16x4, __builtin_amdgcn_ds_read_tr16_b64_v4i16((LAS s16x4*)p)); }
__device__ __forceinline__ bf16x8 pack8(const f32x16& x, int s) {
    u32x4 p; p.x = cvtpk(x[8 * s], x[8 * s + 1]); p.y = cvtpk(x[8 * s + 2], x[8 * s + 3]); p.z = cvtpk(x[8 * s + 4], x[8 * s + 5]); p.w = cvtpk(x[8 * s + 6], x[8 * s + 7]);
    return __builtin_bit_cast(bf16x8, p);
}
#define MFMA32(a, b, c) __builtin_amdgcn_mfma_f32_32x32x16_bf16((a), (b), (c), 0, 0, 0)

constexpr int RK_STR = 528, RV_STR = 192;
constexpr int RL_K = 0, RL_V = 128 * RK_STR, RL_S = RL_V + 128 * RV_STR, RL_P = RL_S + 64 * RK_STR, RL_END = RL_P + 10 * 2048;
__device__ __forceinline__ void retention_chain_rs(Frame& F, const Args& a, int chain) {
    const int b = chain >> 5, h = (chain >> 3) & 3, dir = (chain >> 2) & 1, es = chain & 3;
    const int lane = F.lane, r = lane & 31, hh = lane >> 5, w = F.wave;
    const bool outw = w < 4; const int ib = w & 3, sw = w & 3;
    const bf16_t* RQ = (const bf16_t*)(F.ws + WS_RQ); const bf16_t* RK = (const bf16_t*)(F.ws + WS_RK); const bf16_t* RV = (const bf16_t*)(F.ws + WS_RV);
    bf16_t* OUT = (bf16_t*)(F.ws + (dir ? WS_OUTB : WS_OUTF));
    const float lg = log1pf(-__expf(a.in[6][dir * 4 + h]));
    const float decayC = __expf(lg * 128.f);
    LAS unsigned char* lds = F.lds;
    f32x16 R[4];
#pragma unroll
    for (int k = 0; k < 4; ++k)
#pragma unroll
        for (int i = 0; i < 16; ++i) R[k][i] = 0.f;
#define QFRAG(s) __builtin_bit_cast(bf16x8, (f32x4){R[(s) >> 2][4 * ((s) & 3)], R[(s) >> 2][4 * ((s) & 3) + 1], R[(s) >> 2][4 * ((s) & 3) + 2], R[(s) >> 2][4 * ((s) & 3) + 3]})
#define QLOAD(s, P) do { const u32x2 q8_ = *(const u32x2*)(P); R[(s) >> 3][(2 * (s)) & 15] = __uint_as_float(q8_.x); R[(s) >> 3][((2 * (s)) & 15) + 1] = __uint_as_float(q8_.y); } while (0)
#define QEXPAND() do { _Pragma("unroll") for (int s_ = 15; s_ >= 0; --s_) { const u32x4 t_ = fp8x8_to_bf16(__float_as_uint(R[s_ >> 3][(2 * s_) & 15]), __float_as_uint(R[s_ >> 3][((2 * s_) & 15) + 1])); \
        R[s_ >> 2][4 * (s_ & 3)] = __uint_as_float(t_.x); R[s_ >> 2][4 * (s_ & 3) + 1] = __uint_as_float(t_.y); R[s_ >> 2][4 * (s_ & 3) + 2] = __uint_as_float(t_.z); R[s_ >> 2][4 * (s_ & 3) + 3] = __uint_as_float(t_.w); } } while (0)
    for (int i = F.tid; i < (64 * RK_STR) / 16; i += NTHR) *(LAS u32x4*)(lds + RL_S + i * 16) = (u32x4){0u, 0u, 0u, 0u};
    const int kfr = F.tid & 15, kfq = (F.tid >> 4) & 3;
    const int k8it = (F.tid & 255) >> 6, k8bj = (F.tid >> 5) & 1, k8fq = (F.tid & 31) >> 3, k8fr = 2 * (F.tid & 7), k8wc = F.tid >> 8;
    const int vj = 16 * ((F.tid >> 6) & 3) + kfr, ve0 = 32 * ((F.tid >> 8) & 1) + 8 * kfq;
    const float vscale = __expf(lg * (dir == 0 ? (float)(127 - vj) : (float)vj)), vscale1 = vscale * __expf(lg * (dir == 0 ? -64.f : 64.f));
    const int blk = (lane >> 4) & 1, q4 = (lane & 15) >> 2, p4 = lane & 3;
    LAS unsigned char* kbase = lds + RL_K + r * RK_STR + 16 * hh;
    LAS unsigned char* sbase = lds + RL_S + r * RK_STR + 16 * hh;
    LAS unsigned char* vtr = lds + RL_V + (4 * hh + q4) * RV_STR + (16 * blk + 4 * p4) * 2;
    LAS unsigned char* ktr = lds + RL_K + (4 * hh + q4) * RK_STR + (sw * 64 + 16 * blk + 4 * p4) * 2;
    LAS unsigned char* spub = lds + RL_S + r * RK_STR + (sw * 64 + 4 * hh) * 2;
    const float rsc = __expf(lg * (dir == 0 ? (float)(ib * 32 + r - 127) : (float)(-(ib * 32 + r)))) * (YD_INV * YD_INV);
    const char* RKb = (const char*)RK + (size_t)h * 65536 + (size_t)(F.tid >> 8) * 8192 + (size_t)(F.tid & 255) * 16;
    const char* RQb = (const char*)RQ + ((size_t)((b * 4 + h) * 32) * 4 + ib) * 8192;
    const char* RVb = (const char*)RV + (size_t)h * 131072 + (size_t)(2 * (es & 1) + ((F.tid >> 8) & 1)) * 16384 + (size_t)((F.tid >> 6) & 3) * 2048 + (size_t)(es >> 1) * 1024 + (size_t)(F.tid & 63) * 16;
    char* OUTb = (char*)OUT + (size_t)(ib * 32 * DM + h * 256 + es * 64);
    const unsigned qlo = (unsigned)(lane * 8), olo = (unsigned)((r * DM + 4 * hh) * 2);
    u32x4 kpre[4]; u32x4 vpre[2];
    {
        const size_t t0 = (size_t)b * SEQ + (size_t)(dir == 0 ? 0 : 31) * 128;
        const size_t tb = (t0 >> 8) * 524288 + ((t0 >> 7) & 1) * 8192;
        const char* kc = RKb + (tb >> 1); const char* vc = RVb + tb; const char* qc = RQb + (size_t)(dir == 0 ? 0 : 31) * 32768;
#pragma unroll
        for (int i = 0; i < 4; ++i) kpre[i] = *(const u32x4*)(kc + (size_t)i * 16384);
        vpre[0] = *(const u32x4*)vc; vpre[1] = *(const u32x4*)(vc + 65536);
        if (outw) {
#pragma unroll
            for (int s = 0; s < 16; ++s) QLOAD(s, qc + qlo + 512 * s);
        }
    }
#pragma unroll 1
    for (int n = 0; n < 32; ++n) {
        const int cidx = dir == 0 ? n : 31 - n;
        const size_t t0 = (size_t)b * SEQ + (size_t)cidx * 128;
        {
            LAS unsigned char* kw = lds + RL_K + (16 * k8it + k8fr) * RK_STR + (128 * k8bj + 32 * k8wc + 8 * k8fq) * 2;
#pragma unroll
            for (int i = 0; i < 4; ++i) { LAS unsigned char* kd = kw + (i >> 1) * (64 * RK_STR) + (i & 1) * 128;
                *(LAS u32x4*)kd = fp8x8_to_bf16(kpre[i].x, kpre[i].y); *(LAS u32x4*)(kd + RK_STR) = fp8x8_to_bf16(kpre[i].z, kpre[i].w); }
#pragma unroll
            for (int i = 0; i < 2; ++i) {
                const float vs = i == 0 ? vscale : vscale1;
                u32x4 o; o.x = cvtpk(bflo(vpre[i].x) * vs, bfhi(vpre[i].x) * vs); o.y = cvtpk(bflo(vpre[i].y) * vs, bfhi(vpre[i].y) * vs);
                o.z = cvtpk(bflo(vpre[i].z) * vs, bfhi(vpre[i].z) * vs); o.w = cvtpk(bflo(vpre[i].w) * vs, bfhi(vpre[i].w) * vs);
                *(LAS u32x4*)(lds + RL_V + (vj + 64 * i) * RV_STR + ve0 * 2) = o;
            }
        }
        __syncthreads();
        {
            const int nn = n + 1 < 32 ? n + 1 : n; const int cn = dir == 0 ? nn : 31 - nn;
            const size_t t1 = (size_t)b * SEQ + (size_t)cn * 128;
            const size_t tb = (t1 >> 8) * 524288 + ((t1 >> 7) & 1) * 8192;
            const char* kc = RKb + (tb >> 1); const char* vc = RVb + tb;
#pragma unroll
            for (int i = 0; i < 4; ++i) kpre[i] = *(const u32x4*)(kc + (size_t)i * 16384);
            vpre[0] = *(const u32x4*)vc; vpre[1] = *(const u32x4*)(vc + 65536);
        }
        if (outw) {
            QEXPAND();
            f32x16 acc0, acc1;
#pragma unroll
            for (int i = 0; i < 16; ++i) { acc0[i] = 0.f; acc1[i] = 0.f; }
            const int jb_lo = dir == 0 ? 0 : ib, jb_hi = dir == 0 ? ib : 3;
#pragma unroll 1
            for (int jb = jb_lo; jb <= jb_hi; ++jb) {
                LAS unsigned char* kb = kbase + jb * (32 * RK_STR);
                f32x16 sT;
#pragma unroll
                for (int i = 0; i < 16; ++i) sT[i] = 0.f;
#pragma unroll
                for (int hb = 0; hb < 2; ++hb) {
                    bf16x8 kf[8];
#pragma unroll
                    for (int s = 0; s < 8; ++s) kf[s] = *(const LAS bf16x8*)(kb + (hb * 8 + s) * 32);
                    __builtin_amdgcn_sched_barrier(0);
#pragma unroll
                    for (int s = 0; s < 8; ++s) sT = MFMA32(kf[s], QFRAG(hb * 8 + s), sT);
                    __builtin_amdgcn_sched_barrier(0);
                }
                if (jb == ib) {
#pragma unroll
                    for (int i = 0; i < 16; ++i) { const int jl = crow(i, hh); const bool keep = dir == 0 ? (jl <= r) : (jl > r); sT[i] = keep ? sT[i] : 0.f; }
                }
                const bf16x8 p0 = pack8(sT, 0), p1 = pack8(sT, 1);
                LAS unsigned char* vb = vtr + jb * (32 * RV_STR);
#pragma unroll
                for (int s2 = 0; s2 < 2; ++s2) {
                    const s16x4 l0 = tr_read(vb + s2 * (16 * RV_STR)), h0 = tr_read(vb + s2 * (16 * RV_STR) + 8 * RV_STR);
                    const s16x4 l1 = tr_read(vb + s2 * (16 * RV_STR) + 64), h1 = tr_read(vb + s2 * (16 * RV_STR) + 8 * RV_STR + 64);
                    acc0 = MFMA32(__builtin_shufflevector(l0, h0, 0, 1, 2, 3, 4, 5, 6, 7), s2 == 0 ? p0 : p1, acc0);
                    acc1 = MFMA32(__builtin_shufflevector(l1, h1, 0, 1, 2, 3, 4, 5, 6, 7), s2 == 0 ? p0 : p1, acc1);
                }
            }
#pragma unroll
            for (int hb = 0; hb < 4; ++hb) {
                bf16x8 sf0[4], sf1[4];
#pragma unroll
                for (int s = 0; s < 4; ++s) { sf0[s] = *(const LAS bf16x8*)(sbase + (hb * 4 + s) * 32); sf1[s] = *(const LAS bf16x8*)(sbase + 32 * RK_STR + (hb * 4 + s) * 32); }
                __builtin_amdgcn_sched_barrier(0);
#pragma unroll
                for (int s = 0; s < 4; ++s) { acc0 = MFMA32(sf0[s], QFRAG(hb * 4 + s), acc0); acc1 = MFMA32(sf1[s], QFRAG(hb * 4 + s), acc1); }
                __builtin_amdgcn_sched_barrier(0);
            }
            LAS unsigned char* ost = lds + RL_P + ib * (32 * 80);
#pragma unroll
            for (int g = 0; g < 4; ++g) {
                *(LAS unsigned*)(ost + r * 80 + 8 * g + 4 * hh) = pk4_fp8_clamped(acc0[4 * g] * rsc, acc0[4 * g + 1] * rsc, acc0[4 * g + 2] * rsc, acc0[4 * g + 3] * rsc);
                *(LAS unsigned*)(ost + r * 80 + 32 + 8 * g + 4 * hh) = pk4_fp8_clamped(acc1[4 * g] * rsc, acc1[4 * g + 1] * rsc, acc1[4 * g + 2] * rsc, acc1[4 * g + 3] * rsc); }
            {
                const int nn = n + 1 < 32 ? n + 1 : n; const int cn = dir == 0 ? nn : 31 - nn;
                const char* qc = RQb + (size_t)cn * 32768;
#pragma unroll
                for (int s = 0; s < 16; ++s) QLOAD(s, qc + qlo + 512 * s);
            }
            {
                asm volatile("s_waitcnt lgkmcnt(0)" ::: "memory");
                char* oc = OUTb + t0 * DM + (size_t)(lane >> 2) * DM + 16 * (lane & 3);
#pragma unroll
                for (int it = 0; it < 2; ++it) { const u32x4 v_ = *(const LAS u32x4*)(ost + (16 * it + (lane >> 2)) * 80 + 16 * (lane & 3)); *(u32x4*)(oc + (size_t)it * 16 * DM) = v_; }
            }
        } else {
#pragma unroll
            for (int ks = 0; ks < 8; ++ks) {
                const s16x4 vl0 = tr_read(vtr + ks * (16 * RV_STR)), vh0 = tr_read(vtr + ks * (16 * RV_STR) + 8 * RV_STR);
                const s16x4 vl1 = tr_read(vtr + ks * (16 * RV_STR) + 64), vh1 = tr_read(vtr + ks * (16 * RV_STR) + 8 * RV_STR + 64);
                const bf16x8 vf0 = __builtin_shufflevector(vl0, vh0, 0, 1, 2, 3, 4, 5, 6, 7), vf1 = __builtin_shufflevector(vl1, vh1, 0, 1, 2, 3, 4, 5, 6, 7);
#pragma unroll
                for (int dd = 0; dd < 2; ++dd) {
                    const s16x4 lo = tr_read(ktr + ks * (16 * RK_STR) + dd * 64), hi = tr_read(ktr + ks * (16 * RK_STR) + 8 * RK_STR + dd * 64);
                    const bf16x8 kt = __builtin_shufflevector(lo, hi, 0, 1, 2, 3, 4, 5, 6, 7);
                    R[2 * dd] = MFMA32(kt, vf0, R[2 * dd]); R[2 * dd + 1] = MFMA32(kt, vf1, R[2 * dd + 1]);
                }
            }
#pragma unroll
            for (int k = 0; k < 4; ++k)
#pragma unroll
                for (int i = 0; i < 16; ++i) R[k][i] *= decayC;
        }
        __syncthreads();
        if (!outw) {
#pragma unroll
            for (int dd = 0; dd < 2; ++dd)
#pragma unroll
                for (int e = 0; e < 2; ++e)
#pragma unroll
                    for (int g = 0; g < 4; ++g) { u32x2 wv; wv.x = cvtpk(R[2 * dd + e][4 * g], R[2 * dd + e][4 * g + 1]); wv.y = cvtpk(R[2 * dd + e][4 * g + 2], R[2 * dd + e][4 * g + 3]);
                        *(LAS u32x2*)(spub + e * (32 * RK_STR) + dd * 64 + g * 16) = wv; }
        }
    }
    __syncthreads();
#undef QFRAG
#undef QLOAD
#undef QEXPAND
}

constexpr int AK8_STR = 80;
constexpr int AK_STR = 144, AV_STR = 192;
constexpr int AL_K = 0, AL_V = 384 * AK8_STR, AL_B = AL_V + 384 * AV_STR, AL_O = AL_B + 1024, AL_END = AL_O + 8 * 32 * AK_STR;
static_assert(AL_END <= 146432, "attention LDS");
struct AttUnit { int g, dil, length, res, run0, b, head; };
__device__ __forceinline__ AttUnit att_decode(int slot) {
    AttUnit u; const int bh = slot / 48, k = slot % 48, ru = k & 15; u.g = k >> 4;
    u.dil = u.g == 0 ? 1 : (u.g == 1 ? 4 : 16); u.length = SEQ / u.dil; u.res = ru % u.dil; u.run0 = (ru / u.dil) * 256; u.b = bh >> 4; u.head = bh & 15; return u;
}
__device__ __forceinline__ void attention_phase(Frame& F, int u0, int u1, int zero) {
    if (u0 >= u1) return;
    const int lane = F.lane, r = lane & 31, hh = lane >> 5, w = F.wave;
    const unsigned char* AQ = F.ws + WS_AQ; const unsigned char* AK = F.ws + WS_AK; const unsigned char* AV = F.ws + WS_AV;
    LAS unsigned char* lds = F.lds;
    const int blk = (lane >> 4) & 1, q4 = (lane & 15) >> 2, p4 = lane & 3;
    LAS unsigned char* kbase = lds + AL_K + (32 * w + r) * AK8_STR + 32 * hh;
    LAS unsigned char* vbase = lds + AL_V + (32 * w + 4 * hh + q4) * AV_STR + (16 * blk + 4 * p4) * 2;
    const LAS float* bt = (const LAS float*)(lds + AL_B) + (4 * hh - r + 32);
    u32x4 kk[3], vv[3]; u32x4 qn[2]; float bnext = 0.f;
    u32x4 kk2[3], vv2[3]; u32x4 qn2[2]; float bnext2 = 0.f;
#define ATT_LOAD(U) do { const AttUnit un_ = att_decode(U); \
        if (F.tid < 224) { const int X_ = F.tid - 32; bnext = (X_ >= 0 && X_ <= 128) ? ((const float*)(F.ws + WS_BTAB))[(un_.g * 16 + un_.head) * 160 + X_] : -3.0e38f; } \
        _Pragma("unroll") for (int i = 0; i < 3; ++i) { const int id = F.tid + i * NTHR, row = id >> 2, ch = id & 3; int idx = un_.run0 - 64 + row; idx = idx < 0 ? 0 : (idx >= un_.length ? un_.length - 1 : idx); \
            const size_t off = ((size_t)un_.b * SEQ + (size_t)idx * un_.dil + un_.res) * DM + un_.head * 64 + ch * 16; kk[i] = *(const u32x4*)(AK + off); vv[i] = *(const u32x4*)(AV + off); } \
        const size_t qt_ = (size_t)un_.b * SEQ + (size_t)(un_.run0 + 32 * w + r) * un_.dil + un_.res; \
        _Pragma("unroll") for (int s = 0; s < 2; ++s) qn[s] = *(const u32x4*)(AQ + qt_ * DM + un_.head * 64 + 32 * hh + 16 * s); } while (0)
#define ATT_LOAD2(U) do { const AttUnit un_ = att_decode(U); \
        if (F.tid < 224) { const int X_ = F.tid - 32; bnext2 = (X_ >= 0 && X_ <= 128) ? ((const float*)(F.ws + WS_BTAB))[(un_.g * 16 + un_.head) * 160 + X_] : -3.0e38f; } \
        _Pragma("unroll") for (int i = 0; i < 3; ++i) { const int id = F.tid + i * NTHR, row = id >> 2, ch = id & 3; int idx = un_.run0 - 64 + row; idx = idx < 0 ? 0 : (idx >= un_.length ? un_.length - 1 : idx); \
            const size_t off = ((size_t)un_.b * SEQ + (size_t)idx * un_.dil + un_.res) * DM + un_.head * 64 + ch * 16; kk2[i] = *(const u32x4*)(AK + off); vv2[i] = *(const u32x4*)(AV + off); } \
        const size_t qt_ = (size_t)un_.b * SEQ + (size_t)(un_.run0 + 32 * w + r) * un_.dil + un_.res; \
        _Pragma("unroll") for (int s = 0; s < 2; ++s) qn2[s] = *(const u32x4*)(AQ + qt_ * DM + un_.head * 64 + 32 * hh + 16 * s); } while (0)
    const int nun = u1 - u0, nit = nun * (PROBE_PHASE == 31 ? 2 : 1);
#define ATT_SLOT(I) (u0 + ((I) >= nit ? nun - 1 : ((I) >= nun ? (I) - nun : (I))))
    ATT_LOAD(ATT_SLOT(0)); ATT_LOAD2(ATT_SLOT(1));
#pragma unroll 1
    for (int it = 0; it < nit; ++it) {
        const int unit = u0 + (it >= nun ? it - nun : it);
        const AttUnit un = att_decode(unit);
        unsigned char* OG = F.ws + WS_OG + (size_t)un.g * (SEG / 2); float* LSE = (float*)(F.ws + WS_LSE) + (size_t)un.g * NTOK * 16;
#pragma unroll
        for (int i = 0; i < 3; ++i) { const int id = F.tid + i * NTHR, row = id >> 2, ch = id & 3;
            *(LAS u32x4*)(lds + AL_K + row * AK8_STR + 16 * ch) = kk[i];
            *(LAS u32x4*)(lds + AL_V + row * AV_STR + 32 * ch) = fp8x8_to_bf16(vv[i].x, vv[i].y); *(LAS u32x4*)(lds + AL_V + row * AV_STR + 32 * ch + 16) = fp8x8_to_bf16(vv[i].z, vv[i].w); }
        if (F.tid < 224) ((LAS float*)(lds + AL_B))[F.tid] = bnext;
        const i32x8 qf8 = __builtin_shufflevector(__builtin_bit_cast(i32x4, qn[0]), __builtin_bit_cast(i32x4, qn[1]), 0, 1, 2, 3, 4, 5, 6, 7);
        __syncthreads();
#pragma unroll
        for (int i = 0; i < 3; ++i) { kk[i] = kk2[i]; vv[i] = vv2[i]; }
#pragma unroll
        for (int s = 0; s < 2; ++s) qn[s] = qn2[s];
        bnext = bnext2;
        ATT_LOAD2(ATT_SLOT(it + 2));
        const size_t qtok = (size_t)un.b * SEQ + (size_t)(un.run0 + 32 * w + r) * un.dil + un.res;
        const int lv = 4 * hh - r, kv = un.run0 - 64 + 32 * w + 4 * hh;
        const int clo = max(-lv, -kv), chi = min(128 - lv, un.length - 1 - kv);
        const int kv0 = un.run0 - 64 + 32 * w;
        const bool edge = (kv0 < 0) || (kv0 + 4 + 155 >= un.length);
        float m, lsum = 0.f;
        f32x16 o0, o1, sT[5];
#pragma unroll
        for (int i = 0; i < 16; ++i) { o0[i] = 0.f; o1[i] = 0.f; }
#pragma unroll
        for (int kb = 0; kb < 5; ++kb) {
            const i32x4 ka = *(const LAS i32x4*)(kbase + kb * (32 * AK8_STR)), kb2 = *(const LAS i32x4*)(kbase + kb * (32 * AK8_STR) + 16);
            sT[kb] = __builtin_amdgcn_mfma_scale_f32_32x32x64_f8f6f4(__builtin_shufflevector(ka, kb2, 0, 1, 2, 3, 4, 5, 6, 7), qf8, (f32x16){0.f, 0.f, 0.f, 0.f, 0.f, 0.f, 0.f, 0.f, 0.f, 0.f, 0.f, 0.f, 0.f, 0.f, 0.f, 0.f}, 0, 0, 0, 0, 0, 0);
        }
        float bm = -3.0e38f;
#pragma unroll
        for (int kb = 0; kb < 5; ++kb)
#pragma unroll
            for (int i = 0; i < 16; ++i) { sT[kb][i] = __builtin_fmaf(sT[kb][i], 1.0f / 256.0f, bt[32 * kb + (i & 3) + 8 * (i >> 2)]); }
        if (edge) {
            const int kv = un.run0 - 64 + 32 * w + 4 * hh;
#pragma unroll
            for (int kb = 0; kb < 5; ++kb)
#pragma unroll
                for (int i = 0; i < 16; ++i) { const int c = 32 * kb + (i & 3) + 8 * (i >> 2); sT[kb][i] = ((unsigned)(c + kv) < (unsigned)un.length) ? sT[kb][i] : -3.0e38f; }
        }
#pragma unroll
        for (int kb = 0; kb < 5; ++kb)
#pragma unroll
            for (int i = 0; i < 16; ++i) bm = fmaxf(bm, sT[kb][i]);
        m = fmaxf(bm, __shfl_xor(bm, 32));
#pragma unroll
        for (int kb = 0; kb < 5; ++kb) {
#pragma unroll
            for (int i = 0; i < 16; ++i) { const float p = __builtin_amdgcn_exp2f(sT[kb][i] - m); sT[kb][i] = p; lsum += p; }
#pragma unroll
            for (int s2 = 0; s2 < 2; ++s2) {
                const bf16x8 pb = pack8(sT[kb], s2);
#pragma unroll
                for (int e2 = 0; e2 < 2; ++e2) {
                    const s16x4 lo = tr_read(vbase + kb * (32 * AV_STR) + s2 * (16 * AV_STR) + e2 * 64);
                    const s16x4 hi = tr_read(vbase + kb * (32 * AV_STR) + s2 * (16 * AV_STR) + 8 * AV_STR + e2 * 64);
                    const bf16x8 vf = __builtin_shufflevector(lo, hi, 0, 1, 2, 3, 4, 5, 6, 7);
                    if (e2 == 0) o0 = MFMA32(vf, pb, o0); else o1 = MFMA32(vf, pb, o1);
                }
            }
        }
        lsum += __shfl_xor(lsum, 32);
        if (hh == 0) LSE[qtok * 16 + un.head] = (m + __log2f(lsum)) * 0.6931471805599453f;
        {
            LAS unsigned char* ost = lds + AL_O + w * (32 * 80);
            const float lsc = __builtin_amdgcn_rcpf(lsum);
#pragma unroll
            for (int g = 0; g < 4; ++g) {
                *(LAS unsigned*)(ost + r * 80 + 8 * g + 4 * hh) = pk4_fp8_noclamp(o0[4 * g] * lsc, o0[4 * g + 1] * lsc, o0[4 * g + 2] * lsc, o0[4 * g + 3] * lsc);
                *(LAS unsigned*)(ost + r * 80 + 32 + 8 * g + 4 * hh) = pk4_fp8_noclamp(o1[4 * g] * lsc, o1[4 * g + 1] * lsc, o1[4 * g + 2] * lsc, o1[4 * g + 3] * lsc);
            }
            asm volatile("s_waitcnt lgkmcnt(0)" ::: "memory");
#pragma unroll
            for (int it = 0; it < 2; ++it) {
                const int ql = 16 * it + (lane >> 2);
                const u32x4 v = *(const LAS u32x4*)(ost + ql * 80 + 16 * (lane & 3));
                const size_t tok = (size_t)un.b * SEQ + (size_t)(un.run0 + 32 * w + ql) * un.dil + un.res;
                *(u32x4*)(OG + tok * DM + un.head * 64 + 16 * (lane & 3)) = v;
            }
        }
        __syncthreads();
    }
#undef ATT_LOAD
#undef ATT_LOAD2
#undef ATT_SLOT
}

__device__ __forceinline__ void mixer_post_rows(Frame& F) {
    const int gw = F.vcu * NWAVES + F.wave, NGW = F.G * NWAVES, lane = F.lane;
    const bf16_t* OF = (const bf16_t*)(F.ws + WS_OUTF); const bf16_t* OB = (const bf16_t*)(F.ws + WS_OUTB); const unsigned char* SG = (F.ws + WS_RG);
    const unsigned char* OG = F.ws + WS_OG; const float* LSE = (const float*)(F.ws + WS_LSE);
    unsigned char* RN = F.ws + WS_RETN; unsigned char* AC = F.ws + WS_ATTC;
    const int head = lane >> 2;
    unsigned fa[4], fb[4], na[4], nb[4]; unsigned sg[4], nsg[4]; u32x4 og[3], nog[3]; float ls[3], nls[3];
#define MP_LOAD(A, B, S, O, L, ROW) do { _Pragma("unroll") for (int h = 0; h < 4; ++h) { const size_t off_ = (size_t)(ROW) * DM + h * 256 + 4 * lane; \
            A[h] = *(const unsigned*)((const unsigned char*)OF + off_); B[h] = *(const unsigned*)((const unsigned char*)OB + off_); S[h] = *(const unsigned*)(SG + off_); } \
        _Pragma("unroll") for (int g = 0; g < 3; ++g) { O[g] = *(const u32x4*)(OG + (size_t)g * NTOK * DM + (size_t)(ROW) * DM + 16 * lane); L[g] = LSE[((size_t)g * NTOK + (ROW)) * 16 + head]; } } while (0)
    if (gw >= NTOK) return;
    MP_LOAD(fa, fb, sg, og, ls, gw);
#pragma unroll 1
    for (int row = gw; row < NTOK; row += NGW) {
        const int rn = row + NGW < NTOK ? row + NGW : row;
        MP_LOAD(na, nb, nsg, nog, nls, rn);
        f32x4 v[4];
#pragma unroll
        for (int h = 0; h < 4; ++h) { const f32x2 a0_ = __builtin_amdgcn_cvt_pk_f32_fp8((int)fa[h], false), a1_ = __builtin_amdgcn_cvt_pk_f32_fp8((int)fa[h], true), b0_ = __builtin_amdgcn_cvt_pk_f32_fp8((int)fb[h], false), b1_ = __builtin_amdgcn_cvt_pk_f32_fp8((int)fb[h], true);
            v[h] = (f32x4){a0_.x + b0_.x, a0_.y + b0_.y, a1_.x + b1_.x, a1_.y + b1_.y}; }
#pragma unroll
        for (int h = 0; h < 4; ++h) {
            const float mu = wave_sum((v[h][0] + v[h][1]) + (v[h][2] + v[h][3])) * (1.f / 256.f);
            const f32x4 d = v[h] - mu;
            const float var = wave_sum((d[0] * d[0] + d[1] * d[1]) + (d[2] * d[2] + d[3] * d[3])) * (1.f / 256.f);
            const float rs = rsqrtf(var + NORM_EPS);
            const f32x2 g01 = __builtin_amdgcn_cvt_pk_f32_fp8((int)sg[h], false), g23 = __builtin_amdgcn_cvt_pk_f32_fp8((int)sg[h], true); const float rq = rs * YD_INV;
            *(unsigned*)(RN + (size_t)row * DM + h * 256 + 4 * lane) = pk4_fp8(d[0] * rq * g01.x, d[1] * rq * g01.y, d[2] * rq * g23.x, d[3] * rq * g23.y);
        }
        const float lm = fmaxf(ls[0], fmaxf(ls[1], ls[2]));
        float wg[3]; float wsum = 0.f;
#pragma unroll
        for (int g = 0; g < 3; ++g) { wg[g] = __expf(ls[g] - lm); wsum += wg[g]; }
        const float winv = 1.f / wsum;
        unsigned res[4];
#pragma unroll
        for (int wI = 0; wI < 4; ++wI) {
            float a0 = 0.f, a1 = 0.f, a2 = 0.f, a3 = 0.f;
#pragma unroll
            for (int g = 0; g < 3; ++g) { const int wd = (int)(wI == 0 ? og[g].x : (wI == 1 ? og[g].y : (wI == 2 ? og[g].z : og[g].w)));
                const f32x2 p0 = __builtin_amdgcn_cvt_pk_f32_fp8(wd, false), p1 = __builtin_amdgcn_cvt_pk_f32_fp8(wd, true);
                a0 += wg[g] * p0.x; a1 += wg[g] * p0.y; a2 += wg[g] * p1.x; a3 += wg[g] * p1.y; }
            const float sc = winv * YD_INV;
            res[wI] = pk4_fp8(a0 * sc, a1 * sc, a2 * sc, a3 * sc);
        }
        *(u32x4*)(AC + (size_t)row * DM + 16 * lane) = (u32x4){res[0], res[1], res[2], res[3]};
#pragma unroll
        for (int h = 0; h < 4; ++h) { fa[h] = na[h]; fb[h] = nb[h]; sg[h] = nsg[h]; }
#pragma unroll
        for (int g = 0; g < 3; ++g) { og[g] = nog[g]; ls[g] = nls[g]; }
    }
#undef MP_LOAD
}

template <int CTRL, int ROWMASK> __device__ __forceinline__ unsigned dpp_u(unsigned src) { return (unsigned)__builtin_amdgcn_update_dpp(0, (int)src, CTRL, ROWMASK, 0xf, false); }
template <int CTRL> __device__ __forceinline__ float dpp_f(float src) { return __uint_as_float((unsigned)__builtin_amdgcn_update_dpp(0, (int)__float_as_uint(src), CTRL, 0xf, 0xf, false)); }
__device__ __forceinline__ unsigned wave_max_u32(unsigned v) {
    v = max(v, dpp_u<0x111, 0xf>(v)); v = max(v, dpp_u<0x112, 0xf>(v)); v = max(v, dpp_u<0x114, 0xf>(v)); v = max(v, dpp_u<0x118, 0xf>(v));
    v = max(v, dpp_u<0x142, 0xa>(v)); v = max(v, dpp_u<0x143, 0xc>(v));
    return (unsigned)__builtin_amdgcn_readlane((int)v, 63);
}
constexpr int RT_HIST_OFF = 135168;
__device__ __forceinline__ void routing_rows(Frame& F, const Args& a, int rbeg, int nrows) {
    const int gw = rbeg + F.wave, NGW = NWAVES, rend = rbeg + nrows, lane = F.lane;
    const float* LOG = (const float*)(F.ws + WS_LOGIT); const float* rb = a.in[13];
    int* EIDX = (int*)(F.ws + WS_EIDX); float* GATE = (float*)(F.ws + WS_GATE);
    LAS unsigned* hist = (LAS unsigned*)(F.lds + RT_HIST_OFF);
    for (int i = F.tid; i < NEXP; i += NTHR) hist[i] = 0u;
    __syncthreads();
    const f32x4 bias = *(const f32x4*)(rb + 4 * lane);
    f32x4 lg = *(const f32x4*)(LOG + (size_t)(gw < rend ? gw : rbeg) * NEXP + 4 * lane);
#pragma unroll 1
    for (int row = gw; row < rend; row += NGW) {
        const f32x4 lgn = *(const f32x4*)(LOG + (size_t)(row + NGW < rend ? row + NGW : row) * NEXP + 4 * lane);
        float sc[4], ch[4];
#pragma unroll
        for (int i = 0; i < 4; ++i) { sc[i] = 1.f / (1.f + expf(-lg[i])); ch[i] = sc[i] + bias[i]; }
        float m1 = fmaxf(ch[0], ch[1]), m2 = fminf(ch[0], ch[1]);
        { const float c2 = ch[2]; const float n1 = fmaxf(m1, c2); m2 = fmaxf(m2, fminf(m1, c2)); m1 = n1; }
        { const float c3 = ch[3]; const float n1 = fmaxf(m1, c3); m2 = fmaxf(m2, fminf(m1, c3)); m1 = n1; }
        { const float b1 = dpp_f<0xB1>(m1), b2 = dpp_f<0xB1>(m2); const float n1 = fmaxf(m1, b1), n2 = fmaxf(fminf(m1, b1), fmaxf(m2, b2)); m1 = n1; m2 = n2; }
        { const float b1 = dpp_f<0x4E>(m1), b2 = dpp_f<0x4E>(m2); const float n1 = fmaxf(m1, b1), n2 = fmaxf(fminf(m1, b1), fmaxf(m2, b2)); m1 = n1; m2 = n2; }
        { const float b1 = dpp_f<0x141>(m1), b2 = dpp_f<0x141>(m2); const float n1 = fmaxf(m1, b1), n2 = fmaxf(fminf(m1, b1), fmaxf(m2, b2)); m1 = n1; m2 = n2; }
        const float gs = m1 + m2; const int mygrp = lane >> 3;
        int rank = 0;
#pragma unroll
        for (int g = 0; g < 8; ++g) { const float og = __uint_as_float((unsigned)__builtin_amdgcn_readlane((int)__float_as_uint(gs), g * 8)); rank += (og > gs || (og == gs && g < mygrp)) ? 1 : 0; }
        const bool elig = rank < 4;
        unsigned key[4];
#pragma unroll
        for (int i = 0; i < 4; ++i) { const unsigned qv = (unsigned)(fminf(fmaxf(ch[i] + 1.0f, 0.f), 3.99f) * 4194304.0f); key[i] = elig ? ((qv << 8) | (unsigned)(255 - (4 * lane + i))) : 0u; }
        float gsel = 0.f; int esel = 0; float gsum = 0.f;
#pragma unroll
        for (int k = 0; k < TOPK; ++k) {
            const unsigned best = wave_max_u32(max(max(key[0], key[1]), max(key[2], key[3])));
            const int idx = 255 - (int)(best & 255u), own = idx >> 2, el = idx & 3;
            const float mine = el == 0 ? sc[0] : (el == 1 ? sc[1] : (el == 2 ? sc[2] : sc[3]));
            const float sv = __uint_as_float((unsigned)__builtin_amdgcn_readlane((int)__float_as_uint(mine), own));
#pragma unroll
            for (int i = 0; i < 4; ++i) key[i] = key[i] == best ? 0u : key[i];
            gsum += sv;
            if (lane == k) { gsel = sv; esel = idx; }
        }
        if (lane < TOPK) { EIDX[row * TOPK + lane] = esel; GATE[row * TOPK + lane] = gsel / gsum * 2.5f; __hip_atomic_fetch_add(&hist[esel], 1u, __ATOMIC_RELAXED, __HIP_MEMORY_SCOPE_WORKGROUP); }
        lg = lgn;
    }
    __syncthreads();
    for (int i = F.tid; i < NEXP; i += NTHR) if (hist[i]) atomicAdd((unsigned*)(F.ws + WS_CTL) + CW_CNT + i, hist[i]);
}

__device__ __forceinline__ void routing_lists(Frame& F) {
    LAS unsigned* cnt = (LAS unsigned*)(F.lds);
    LAS unsigned* pstart = cnt + 256;
    LAS unsigned* lh = pstart + 264;
    LAS unsigned* lbase = lh + 256;
    LAS unsigned* ustart = lbase + 256;
    int* DPOS = (int*)(F.ws + WS_DPOS);
    unsigned* ctl = (unsigned*)(F.ws + WS_CTL);
    const int* EIDX = (const int*)(F.ws + WS_EIDX); int* ROWL = (int*)(F.ws + WS_ROWL); int* TILE_E = (int*)(F.ws + WS_TILE_E);
    for (int i = F.tid; i < NEXP; i += NTHR) { cnt[i] = __hip_atomic_load(ctl + CW_CNT + i, RLX_AGENT); lh[i] = 0u; }
    __syncthreads();
    {
        LAS unsigned* wtot = ustart + 256;
        unsigned pv = 0, uv = 0;
        if (F.tid < NEXP) { uv = cnt[F.tid]; pv = (uv + 255u) & ~255u; }
        unsigned pi = pv, ui = uv;
#pragma unroll
        for (int o = 1; o < 64; o <<= 1) { const unsigned a = __shfl_up(pi, o), b = __shfl_up(ui, o); if (F.lane >= o) { pi += a; ui += b; } }
        if (F.tid < NEXP && F.lane == 63) { wtot[F.wave] = pi; wtot[4 + F.wave] = ui; }
        __syncthreads();
        if (F.tid < NEXP) { unsigned po = 0, uo = 0;
#pragma unroll
            for (int w = 0; w < 4; ++w) if (w < F.wave) { po += wtot[w]; uo += wtot[4 + w]; }
            pstart[F.tid] = po + pi - pv; ustart[F.tid] = uo + ui - uv;
            if (F.tid == NEXP - 1) pstart[NEXP] = po + pi; }
    }
    __syncthreads();
    const unsigned ptotal = pstart[NEXP];
    const int per = (NTOK + F.G - 1) / F.G, tk0 = F.vcu * per, tk1 = (tk0 + per) < NTOK ? (tk0 + per) : NTOK;
    const int i0 = tk0 * TOPK + F.tid, i1 = i0 + NTHR, iend = tk1 * TOPK;
    const int e0 = i0 < iend ? EIDX[i0] : -1, e1 = i1 < iend ? EIDX[i1] : -1;
    if (e0 >= 0) __hip_atomic_fetch_add(&lh[e0], 1u, __ATOMIC_RELAXED, __HIP_MEMORY_SCOPE_WORKGROUP);
    if (e1 >= 0) __hip_atomic_fetch_add(&lh[e1], 1u, __ATOMIC_RELAXED, __HIP_MEMORY_SCOPE_WORKGROUP);
    for (int i = i0 + 2 * NTHR; i < iend; i += NTHR) __hip_atomic_fetch_add(&lh[EIDX[i]], 1u, __ATOMIC_RELAXED, __HIP_MEMORY_SCOPE_WORKGROUP);
    __syncthreads();
    for (int e = F.tid; e < NEXP; e += NTHR) { const unsigned c = lh[e]; lbase[e] = c ? atomicAdd(ctl + CW_FILL + e, c) : 0u; lh[e] = 0u; }
    __syncthreads();
    auto place = [&](int i, int e) { const unsigned p = __hip_atomic_fetch_add(&lh[e], 1u, __ATOMIC_RELAXED, __HIP_MEMORY_SCOPE_WORKGROUP);
        ROWL[pstart[e] + lbase[e] + p] = (i >> 3) * 16 + (i & 7); DPOS[i] = (int)(ustart[e] + lbase[e] + p); };
    if (e0 >= 0) place(i0, e0);
    if (e1 >= 0) place(i1, e1);
    for (int i = i0 + 2 * NTHR; i < iend; i += NTHR) place(i, EIDX[i]);
    for (int t = tk0 + F.tid; t < tk1; t += NTHR) ROWL[ptotal + t] = t * 16 + 8;
    for (int e = F.vcu; e < NEXP; e += F.G) { const unsigned s = pstart[e] + cnt[e], en = pstart[e + 1]; for (unsigned p = s + F.tid; p < en; p += NTHR) ROWL[p] = -1;
        for (unsigned t = (pstart[e] >> 8) + F.tid; t < (pstart[e + 1] >> 8); t += NTHR) TILE_E[t] = e;
        if (F.tid == 0) { TILE_E[4096 + e] = (int)(pstart[e] - ustart[e]); TILE_E[8192 + e] = (int)(pstart[e] + cnt[e]); } }
    if (F.vcu == 0) {
        const int nrt = (int)(ptotal >> 8);
        for (int t = F.tid; t < NTOK / 256; t += NTHR) TILE_E[nrt + t] = NEXP;
        if (F.tid == 0) { TILE_E[4096 + NEXP] = (int)ptotal - YD_SHARED0; TILE_E[8192 + NEXP] = (int)ptotal + NTOK; }
        if (F.tid == 0) TILE_E[MAX_TILES] = nrt + NTOK / 256;
    }
}

__device__ __forceinline__ void final_rows(Frame& F, const Args& a) {
    const int gw = F.vcu * NWAVES + F.wave, NGW = F.G * NWAVES, lane = F.lane;
    const float* mod = (const float*)(F.ws + WS_MOD); const float* nf = a.in[20];
    const int* DPOS = (const int*)(F.ws + WS_DPOS); const float* GATE = (const float*)(F.ws + WS_GATE);
    f32x4 g4[4];
#pragma unroll
    for (int j = 0; j < 4; ++j) g4[j] = *(const f32x4*)(nf + 4 * lane + 256 * j);
    const int per = (NTOK + NGW - 1) / NGW, r0 = gw * per, r1 = (r0 + per) < NTOK ? (r0 + per) : NTOK;
    if (r0 >= r1) return;
    auto clampr = [&](int r) { return r < r1 ? r : r1 - 1; };
    int bcur = r0 / SEQ;
    f32x4 gf[4];
#pragma unroll
    for (int j = 0; j < 4; ++j) gf[j] = *(const f32x4*)(mod + (size_t)bcur * 6144 + 5 * DM + 4 * lane + 256 * j);
    int dcur = DPOS[r0 * 8 + (lane & 7)]; float gcur = GATE[r0 * 8 + (lane & 7)];
    int dnxt = DPOS[clampr(r0 + 1) * 8 + (lane & 7)]; float gnxt = GATE[clampr(r0 + 1) * 8 + (lane & 7)];
    f32x4 xw[4], xn[4]; int yw[9][4], yn[9][4];
#define FIN_LOAD(XW, YW, ROW, DV) do { const u32x2* xr_ = (const u32x2*)((const bf16_t*)(F.ws + WS_X1B) + (size_t)(ROW) * DM) + lane; \
        _Pragma("unroll") for (int j = 0; j < 4; ++j) { const u32x2 t_ = xr_[64 * j]; XW[j] = (f32x4){bflo(t_.x), bfhi(t_.x), bflo(t_.y), bfhi(t_.y)}; } \
        _Pragma("unroll") for (int k = 0; k < 9; ++k) { const unsigned char* yr_ = ydense_row(F.ws, k < 8 ? __builtin_amdgcn_readlane((DV), k) : YD_SHARED0 + (ROW)) + 4 * lane; \
            _Pragma("unroll") for (int j = 0; j < 4; ++j) YW[k][j] = *(const int*)(yr_ + 256 * j); } } while (0)
    FIN_LOAD(xw, yw, r0, dcur);
#pragma unroll 1
    for (int row = r0; row < r1; ++row) {
        const int b = row / SEQ;
        if (b != bcur) { bcur = b;
#pragma unroll
            for (int j = 0; j < 4; ++j) gf[j] = *(const f32x4*)(mod + (size_t)bcur * 6144 + 5 * DM + 4 * lane + 256 * j); }
        const int rn = clampr(row + 1), rn2 = clampr(row + 2);
        FIN_LOAD(xn, yn, rn, dnxt);
        const int dn2 = DPOS[rn2 * 8 + (lane & 7)]; const float gn2 = GATE[rn2 * 8 + (lane & 7)];
        f32x4 v[4]; float s = 0.f;
#pragma unroll
        for (int j = 0; j < 4; ++j) {
            f32x4 y = (f32x4){0.f, 0.f, 0.f, 0.f};
#pragma unroll
            for (int k = 0; k < 9; ++k) { const int wv = yw[k][j]; const float gk = (k < 8 ? __uint_as_float(__builtin_amdgcn_readlane(__float_as_uint(gcur), k)) : 1.0f) * YD_INV;
                const f32x2 lo = __builtin_amdgcn_cvt_pk_f32_fp8(wv, false), hi = __builtin_amdgcn_cvt_pk_f32_fp8(wv, true);
                y[0] += gk * lo.x; y[1] += gk * lo.y; y[2] += gk * hi.x; y[3] += gk * hi.y; }
            v[j] = xw[j] + gf[j] * y;
            s += (v[j][0] * v[j][0] + v[j][1] * v[j][1]) + (v[j][2] * v[j][2] + v[j][3] * v[j][3]);
        }
        const float rstd = rsqrtf(wave_sum(s) * (1.f / DM) + NORM_EPS);
        f32x4* xo = (f32x4*)(a.out + (size_t)row * DM) + lane;
#pragma unroll
        for (int j = 0; j < 4; ++j) xo[64 * j] = (v[j] * rstd) * g4[j];
#pragma unroll
        for (int j = 0; j < 4; ++j) xw[j] = xn[j];
#pragma unroll
        for (int k = 0; k < 9; ++k)
#pragma unroll
            for (int j = 0; j < 4; ++j) yw[k][j] = yn[k][j];
        dcur = dnxt; gcur = gnxt; dnxt = dn2; gnxt = gn2;
    }
#undef FIN_LOAD
}

constexpr int RL_LDS_OFF = 139264, RL_LDS_UNITS = 14;
constexpr int MT_OFF = 131072, MT_INFO = MT_OFF + 4096;
__device__ __forceinline__ void moe_tables_to_lds(Frame& F, int ntiles) {
    const int* TILE_E = (const int*)(F.ws + WS_TILE_E);
    LAS unsigned short* te = (LAS unsigned short*)(F.lds + MT_OFF); LAS int* info = (LAS int*)(F.lds + MT_INFO);
    for (int t = F.tid; t < ntiles; t += NTHR) te[t] = (unsigned short)TILE_E[t];
    for (int e = F.tid; e <= NEXP; e += NTHR) { info[e] = TILE_E[4096 + e]; info[512 + e] = TILE_E[8192 + e]; }
    __syncthreads();
}
constexpr int DW_STR = 192;
constexpr int DW_BUF = 256 * DW_STR;
typedef float f32x4_t __attribute__((ext_vector_type(4)));
#define MFMA16(a, b, c) __builtin_amdgcn_mfma_f32_16x16x32_bf16((a), (b), (c), 0, 0, 0)
template <int MODE> __device__ __forceinline__ void down_phase(Frame& F, const Args& a) {
    const int* TILE_E = (const int*)(F.ws + WS_TILE_E); const int ntiles = __builtin_amdgcn_readfirstlane(TILE_E[MAX_TILES]);
    if (!(a.ph_lo <= 11 && a.ph_hi > 11)) moe_tables_to_lds(F, ntiles);
    const LAS unsigned short* tile_e = (const LAS unsigned short*)(F.lds + MT_OFF); const LAS int* info = (const LAS int*)(F.lds + MT_INFO);
    const int lane = F.lane, w = F.wave, fr = lane & 15, g4 = lane >> 4;
    LAS unsigned char* lds = F.lds;
    const bf16_t* HID = (const bf16_t*)(F.ws + WS_HID);
    const int sk = F.tid >> 4, sn4 = F.tid & 15;
    const int spos = 16 * (sn4 & 3) + 4 * (sn4 >> 2);
    const int q4 = (lane & 15) >> 2, p4 = lane & 3;
    auto next_tile = [&](int i) -> int { const long L = (long)i * F.G + (int)blockIdx.x; return L < ntiles ? pg8::xcd_remap((int)L, ntiles) : -1; };
    int ui = 0, tile = next_tile(0);
    if (tile < 0) return;
    f32x4_t st[8], st2[8];
    auto wd_base = [&](int t) -> const float* { const int e = MODE == 1 ? 0 : (int)tile_e[t]; return e < NEXP ? a.in[16] + (size_t)e * (EH * DM) : a.in[19]; };
#define DW_LOAD(R, WB, C) do { const float* p_ = (WB) + (size_t)sk * DM + (C) * 64 + sn4 * 4; _Pragma("unroll") for (int i = 0; i < 8; ++i) R[i] = *(const f32x4_t*)(p_ + (size_t)i * 32 * DM); } while (0)
#define DW_WRITE(R, SLOT) do { _Pragma("unroll") for (int i = 0; i < 8; ++i) { const int k_ = sk + 32 * i; u32x2 w_; w_.x = cvtpk(R[i][0], R[i][1]); w_.y = cvtpk(R[i][2], R[i][3]); \
        *(LAS u32x2*)(lds + (SLOT) * DW_BUF + k_ * DW_STR + (((spos >> 4) ^ ((k_ >> 3) & 1)) << 5) + (spos & 15) * 2) = w_; } } while (0)
    const float* wb = wd_base(tile);
    int ntile = next_tile(1);
    const float* nwb = ntile >= 0 ? wd_base(ntile) : wb;
    DW_LOAD(st, wb, 0); DW_WRITE(st, 0);
    DW_LOAD(st, wb, 1); DW_LOAD(st2, wb, 2);
    __syncthreads();
    int cc = 0;
    for (;;) {
        const int e = (int)tile_e[tile]; const int shift = info[e], lim = info[512 + e];
        bf16x8 af[2][8];
        {
          const unsigned char* hp = (const unsigned char*)HID + (size_t)tile * 65536 + (size_t)((w >> 1) & 1) * 16384 + (size_t)(4 * (w >> 2) + 2 * (w & 1)) * 512 + (g4 * 16 + fr) * 8;
          u32x2 hraw[2][8];
#pragma unroll
          for (int m = 0; m < 2; ++m)
#pragma unroll
              for (int ks = 0; ks < 8; ++ks) hraw[m][ks] = *(const u32x2*)(hp + (size_t)(ks >> 2) * 32768 + (size_t)(ks & 3) * 4096 + (size_t)m * 512);
#pragma unroll
          for (int m = 0; m < 2; ++m)
#pragma unroll
              for (int ks = 0; ks < 8; ++ks) af[m][ks] = __builtin_bit_cast(bf16x8, fp8x8_to_bf16(hraw[m][ks].x, hraw[m][ks].y));
#pragma unroll
          for (int m = 0; m < 2; ++m)
#pragma unroll
              for (int ks = 0; ks < 8; ++ks) asm volatile("" : "+v"(af[m][ks])); }
        const int pos0 = tile * 256 + 32 * w + fr;
#pragma unroll 1
        for (int c = 0; c < 16; c += 2) {
#pragma unroll
            for (int hc = 0; hc < 2; ++hc, ++cc) {
                const int cq = c + hc;
                f32x4 acc[2][4];
                if (MODE == 3) {
#pragma unroll
                    for (int m = 0; m < 2; ++m)
#pragma unroll
                        for (int nf = 0; nf < 4; ++nf) acc[m][nf] = (f32x4){0.f, 0.f, 0.f, 0.f}; }
                LAS unsigned char* bb = lds + (cc & 1) * DW_BUF + (8 * g4 + q4) * DW_STR + 8 * p4;
                { const int c3 = cq + 3; const float* b3 = c3 < 16 ? wb : nwb; const int k3 = c3 < 16 ? c3 : c3 - 16;
                  if (hc == 0) { DW_WRITE(st, (cc + 1) & 1); DW_LOAD(st, b3, k3); } else { DW_WRITE(st2, (cc + 1) & 1); DW_LOAD(st2, b3, k3); } }
                __builtin_amdgcn_sched_barrier(0);
#pragma unroll 1
                for (int rp_ = 0; rp_ < (MODE == 3 ? a.pad : (PROBE_PHASE == 40 ? 2 + a.pad : 1)); ++rp_) {
#pragma unroll
                for (int m = 0; m < 2; ++m)
#pragma unroll
                    for (int nf = 0; nf < 4; ++nf) acc[m][nf] = (f32x4){0.f, 0.f, 0.f, 0.f};
#pragma unroll
                for (int ks = 0; ks < 8; ++ks) {
#pragma unroll
                    for (int nf = 0; nf < 4; ++nf) {
                        LAS unsigned char* pp = bb + ks * (32 * DW_STR) + ((nf ^ (g4 & 1)) << 5);
                        const s16x4 lo = tr_read(pp), hi = tr_read(pp + 4 * DW_STR);
                        const bf16x8 bf = __builtin_shufflevector(lo, hi, 0, 1, 2, 3, 4, 5, 6, 7);
                        acc[0][nf] = MFMA16(bf, af[0][ks], acc[0][nf]); acc[1][nf] = MFMA16(bf, af[1][ks], acc[1][nf]);
                    }
                }
                }
                u32x4 ow[2];
#pragma unroll
                for (int m = 0; m < 2; ++m) { constexpr float osc = YD_SCALE / HID_SCALE;
                    ow[m].x = pk4_fp8_scaled(acc[m][0][0], acc[m][0][1], acc[m][0][2], acc[m][0][3], osc); ow[m].y = pk4_fp8_scaled(acc[m][1][0], acc[m][1][1], acc[m][1][2], acc[m][1][3], osc);
                    ow[m].z = pk4_fp8_scaled(acc[m][2][0], acc[m][2][1], acc[m][2][2], acc[m][2][3], osc); ow[m].w = pk4_fp8_scaled(acc[m][3][0], acc[m][3][1], acc[m][3][2], acc[m][3][3], osc); }
#pragma unroll
                for (int m = 0; m < 2; ++m) {
                    const int pos = pos0 + 16 * m;
                    unsigned char* rowp = (pos < lim ? ydense_row(F.ws, pos - shift) : F.ws + WS_SS + (size_t)blockIdx.x * 2048) + 64 * cq + 16 * g4;
                    if (MODE >= 2) asm volatile("" :: "v"(ow[m])); else *(u32x4*)rowp = ow[m];
                }
                __syncthreads();
            }
        }
        if (ntile < 0) break;
        tile = ntile; wb = nwb; ++ui;
        ntile = next_tile(ui + 1); nwb = ntile >= 0 ? wd_base(ntile) : wb;
    }
#undef DW_LOAD
#undef DW_WRITE
}

constexpr int N_PHASES = 13;
__global__ void __launch_bounds__(NTHR, 2) fwd_kernel(Args args) {
    extern __shared__ __attribute__((aligned(16))) unsigned char lds_raw[];
    Frame F;
    F.lds = (LAS unsigned char*)lds_raw; F.ws = args.ws;
    F.tid = threadIdx.x; F.lane = F.tid & 63; F.wave = __builtin_amdgcn_readfirstlane(F.tid >> 6);
    F.G = gridDim.x; { const int bx = blockIdx.x; F.vcu = (F.G % 8 == 0) ? (bx % 8) * (F.G / 8) + bx / 8 : bx; }
    volatile LAS unsigned* MISC = (volatile LAS unsigned*)(F.lds + MISC_OFF);
    for (int u = F.tid; u < (LDS_BYTES - LDSCTL_OFF) / 4; u += NTHR) ((LAS unsigned*)(F.lds + LDSCTL_OFF))[u] = 0u;
    __syncthreads();
    unsigned* ctl = (unsigned*)(F.ws + WS_CTL);
    XcdBarrier bar; bar.bar = ctl + CW_BAR; bar.x = 0; bar.st = nullptr;
    const int lo = args.ph_lo, hi = args.ph_hi;
    if (hi - lo > 1) bar = xcd_barrier_post(ctl + CW_BAR, MISC + 8);
#ifdef ONLY_PHASE
#define IN(k) ((k) == ONLY_PHASE && lo <= (k) && (k) < hi)
#else
#define IN(k) (lo <= (k) && (k) < hi)
#endif
#define SEAM(k) do { if (IN(k) && IN((k) + 1)) xcd_barrier(bar); } while (0)
#define FRESH() do { int t_ = (int)threadIdx.x; asm volatile("" : "+v"(t_)); F.tid = t_; F.lane = t_ & 63; } while (0)
#ifndef PROBE_PHASE
#define PROBE_PHASE -1
#endif
#define REP(k) _Pragma("unroll 1") for (int rep_ = 0; rep_ < ((k) == PROBE_PHASE ? 2 + args.pad : 1); ++rep_)
    const float* mod = (const float*)(F.ws + WS_MOD);
    bf16_t* HB = (bf16_t*)(F.ws + WS_H);

    if (IN(0)) REP(0) { FRESH(); phase0(F, args); } SEAM(0);
    if (IN(1)) REP(1) { FRESH(); norm_mod_rows<false, 1>(F, args.in[0], args.in[4], mod, 0, DM, nullptr, HB, F.ws + WS_H8); } SEAM(1);
    if (IN(2)) REP(2) { FRESH();
        EpiInProj E{F.ws, (const u32x4*)(F.ws + WS_ROPE_C)};
        { pg8::StaticOrder S; S.init((const bf16_t*)(F.ws + WS_H8), (const bf16_t*)(F.ws + WS_WIN), NTOK, PROJW - 3 * DM, DM / 2, F.G, (int)blockIdx.x, 12);
          pg8::gemm_phase<EpiInProj, pg8::StaticOrder, true, true>(F.lds, S, E); }
        { pg8::StaticOrder S; S.init((const bf16_t*)(F.ws + WS_H8), (const bf16_t*)(F.ws + WS_WIN), NTOK, 3 * DM, DM / 2, F.G, (int)blockIdx.x, 0);
          pg8::gemm_phase<EpiInProj, pg8::StaticOrder, true, true>(F.lds, S, E); }
    } SEAM(2);
    if (IN(3)) { FRESH();
#ifndef NO_RET
        if (!(PROBE_LAUNCH == 31 && args.li == 99))
        REP(30) for (int ch = F.vcu; ch < 256; ch += F.G) retention_chain_rs(F, args, ch);
#endif
#ifndef NO_ATT
        if (!(PROBE_LAUNCH == 30 && args.li == 99)) {
        const int per = (6144 + F.G - 1) / F.G;
        attention_phase(F, F.vcu * per, (F.vcu + 1) * per < 6144 ? (F.vcu + 1) * per : 6144, args.pad); }
#endif
    } SEAM(3);
    if (IN(4)) REP(4) { FRESH(); mixer_post_rows(F); } SEAM(4);
    if (IN(5)) REP(5) { FRESH();
        pg8::DualOrder S; S.so.init((const bf16_t*)(F.ws + WS_RETN), (const bf16_t*)(F.ws + WS_WRU), NTOK, DM, DM / 2, F.G, (int)blockIdx.x);
        S.A1 = (const bf16_t*)(F.ws + WS_ATTC); S.Bt1 = (const bf16_t*)(F.ws + WS_WAU); S.K = DM / 2;
        EpiMerge E{F.ws + WS_MERGED, F.ws + WS_SGR, F.ws + WS_SGA};
        pg8::gemm_phase<EpiMerge, pg8::DualOrder, true, true>(F.lds, S, E);
    } SEAM(5);
    if (IN(6)) REP(6) { FRESH();
        pg8::StaticOrder S; S.init((const bf16_t*)(F.ws + WS_MERGED), (const bf16_t*)(F.ws + WS_WO), NTOK, DM, DM / 2, F.G, (int)blockIdx.x);
        EpiOProj E{args.in[0], (bf16_t*)(F.ws + WS_X1B), mod, (float*)(F.ws + WS_SS)};
        pg8::gemm_phase<EpiOProj, pg8::StaticOrder, true, true>(F.lds, S, E);
    } SEAM(6);
    if (IN(7)) REP(7) { FRESH();
        {
            const unsigned* wr2 = (const unsigned*)(F.ws + WS_WR); unsigned* wrb2 = (unsigned*)(F.ws + WS_WRB); const float* nf = args.in[11];
            for (int rem = F.vcu * NTHR + F.tid; rem < NEXP * (DM / 2); rem += F.G * NTHR) {
                const int k = 2 * (rem % (DM / 2)); const unsigned wv = wr2[rem]; const float n0 = nf[k], n1 = nf[k + 1];
                float s0[NB], s1[NB];
#pragma unroll
                for (int b = 0; b < NB; ++b) { s0[b] = mod[(size_t)b * 6144 + 4 * DM + k]; s1[b] = mod[(size_t)b * 6144 + 4 * DM + k + 1]; }
#pragma unroll
                for (int b = 0; b < NB; ++b) wrb2[(size_t)b * (NEXP * (DM / 2)) + rem] = cvtpk(bflo(wv) * n0 * (1.f + s0[b]), bfhi(wv) * n1 * (1.f + s1[b]));
            }
            const int gw_ = F.vcu * NWAVES + F.wave;
            for (int o = gw_; o < NB * NEXP; o += F.G * NWAVES) { const int b = o >> 8, n = o & 255; float acc_ = 0.f;
#pragma unroll
                for (int j = 0; j < 8; ++j) { const int k = 2 * (F.lane + 64 * j); const unsigned wv = wr2[(size_t)n * (DM / 2) + F.lane + 64 * j];
                    acc_ += bflo(wv) * mod[(size_t)b * 6144 + 3 * DM + k] + bfhi(wv) * mod[(size_t)b * 6144 + 3 * DM + k + 1]; }
                acc_ = wave_sum(acc_); if (F.lane == 0) ((float*)(F.ws + WS_RBIAS))[o] = acc_; }
        }
        norm_mod_rows<true, 1>(F, F.ws + WS_X1B, args.in[11], mod, 3 * DM, 4 * DM, (const float*)(F.ws + WS_SS), HB, F.ws + WS_H8B, (float*)(F.ws + WS_RSTD));
        if (F.vcu == 0 && F.tid < 256) ((unsigned*)(F.ws + WS_H8B + (size_t)NTOK * DM))[F.tid] = 0u;
    } SEAM(7);
    if (IN(8)) { FRESH();
        pg8::StaticOrder S; S.init((const bf16_t*)(F.ws + WS_X1B), (const bf16_t*)(F.ws + WS_WRB), NTOK, NEXP, DM, F.G, (int)blockIdx.x); S.b_batch_stride = (size_t)NEXP * DM * 2;
        EpiRouter E{(float*)(F.ws + WS_LOGIT), (const float*)(F.ws + WS_RSTD), (const float*)(F.ws + WS_RBIAS)};
        pg8::gemm_phase<EpiRouter, pg8::StaticOrder, true>(F.lds, S, E);
        __syncthreads();
        {
            for (int L = (int)blockIdx.x; L < NTOK / 256; L += F.G) {
                __builtin_amdgcn_fence(__ATOMIC_ACQUIRE, "agent"); routing_rows(F, args, pg8::xcd_remap(L, NTOK / 256) * 256, 256); __syncthreads(); }
        }
        moe_weight_convert(F, args);
    } SEAM(8);
    if (IN(10)) { FRESH(); routing_lists(F); } SEAM(10);
    if (IN(11)) REP(11) { FRESH();
        const int* TILE_E = (const int*)(F.ws + WS_TILE_E); const int ntiles = __builtin_amdgcn_readfirstlane(TILE_E[MAX_TILES]);
        pg8::MoeOrder<true, true> S; S.A = (const bf16_t*)(F.ws + WS_H8B); S.Bt = (const bf16_t*)(F.ws + WS_WGU); S.K = DM / 2; S.e_stride = WGU_E_BYTES; S.tile_e = (const LAS unsigned short*)(F.lds + MT_OFF); S.rowlist = (const int*)(F.ws + WS_ROWL); moe_tables_to_lds(F, ntiles);
        S.ntiles = ntiles; S.nN = 2; S.nwg = ntiles * 2; S.G = F.G; S.c = (int)blockIdx.x;
        {
            LAS unsigned short* rl = (LAS unsigned short*)(F.lds + RL_LDS_OFF);
            const int nun = (S.nwg - S.c + S.G - 1) / S.G;
            S.rl_lds = rl;
            {
                int ent[7];
#pragma unroll
                for (int j = 0; j < 7; ++j) { const int en = F.tid + NTHR * j, sl = en >> 8; const long L = (long)sl * F.G + (int)blockIdx.x;
                    ent[j] = (sl < nun && L < 2 * ntiles) ? ((const int*)(F.ws + WS_ROWL))[(size_t)(pg8::xcd_remap((int)L, 2 * ntiles) / 2) * 256 + (en & 255)] : -1; }
#pragma unroll
                for (int j = 0; j < 7; ++j) rl[F.tid + NTHR * j] = ent[j] < 0 ? (unsigned short)0xFFFFu : (unsigned short)(ent[j] >> 4);
            }
            __syncthreads();
        }
        EpiGU E{(bf16_t*)(F.ws + WS_HID)};
        pg8::gemm_phase<EpiGU, pg8::MoeOrder<true, true>, true, true>(F.lds, S, E);
    } SEAM(11);
    if (IN(12)) REP(12) { FRESH();
        down_phase<0>(F, args);
    } SEAM(12);
    if (IN(13)) { FRESH(); final_rows(F, args); }
#if PROBE_LAUNCH == 14
    if (lo == 14) {
        pg8::StaticOrder S; S.init((const bf16_t*)(F.ws + WS_H8), (const bf16_t*)(F.ws + WS_WIN), NTOK, PROJW, DM / 2, F.G, (int)blockIdx.x);
        EpiNull E{};
        pg8::gemm_phase<EpiNull, pg8::StaticOrder, true, true>(F.lds, S, E);
    }
#endif
#if PROBE_LAUNCH == 16
    if (lo == 14) {
        const int* TILE_E = (const int*)(F.ws + WS_TILE_E); const int ntiles = __builtin_amdgcn_readfirstlane(TILE_E[MAX_TILES]);
        pg8::MoeOrder<false> S; S.A = (const bf16_t*)(F.ws + WS_HID); S.Bt = (const bf16_t*)(F.ws + WS_WD); S.K = EH; S.e_stride = (size_t)1024 * 256; S.tile_e = (const LAS unsigned short*)(F.lds + MT_OFF); S.rowlist = (const int*)(F.ws + WS_ROWL); moe_tables_to_lds(F, ntiles);
        S.ntiles = ntiles; S.nN = 4; S.nwg = ntiles * 4; S.G = F.G; S.c = (int)blockIdx.x;
        EpiNull E{};
        pg8::gemm_phase<EpiNull, pg8::MoeOrder<false>, true>(F.lds, S, E);
    }
#endif
#if PROBE_LAUNCH == 18
    if (lo == 14) { down_phase<1>(F, args); }
#endif
#if PROBE_LAUNCH == 19
    if (lo == 14) { down_phase<2>(F, args); }
#endif
#if PROBE_LAUNCH == 20
    if (lo == 14) { down_phase<3>(F, args); }
#endif
#if PROBE_LAUNCH == 17
    if (lo == 14) {
        const int* TILE_E = (const int*)(F.ws + WS_TILE_E); const int ntiles = __builtin_amdgcn_readfirstlane(TILE_E[MAX_TILES]);
        pg8::MoeOrder<false> S; S.A = (const bf16_t*)(F.ws + WS_HID); S.Bt = (const bf16_t*)(F.ws + WS_WD); S.K = EH; S.e_stride = (size_t)1024 * 256; S.tile_e = (const LAS unsigned short*)(F.lds + MT_OFF); S.rowlist = (const int*)(F.ws + WS_ROWL); moe_tables_to_lds(F, ntiles);
        S.ntiles = ntiles; S.nN = 4; S.nwg = ntiles * 4; S.G = F.G; S.c = (int)blockIdx.x;
        EpiDownT<1> E{F.ws, (const LAS int*)(F.lds + MT_INFO)};
        pg8::gemm_phase<EpiDownT<1>, pg8::MoeOrder<false>, true>(F.lds, S, E);
    }
#endif
#if PROBE_LAUNCH == 15
    if (lo == 14) {
        EpiInProjT<1> E{F.ws, (const u32x4*)(F.ws + WS_ROPE_C)};
        { pg8::StaticOrder S; S.init((const bf16_t*)(F.ws + WS_H8), (const bf16_t*)(F.ws + WS_WIN), NTOK, PROJW - 3 * DM, DM / 2, F.G, (int)blockIdx.x, 12);
          pg8::gemm_phase<EpiInProjT<1>, pg8::StaticOrder, true, true>(F.lds, S, E); }
        { pg8::StaticOrder S; S.init((const bf16_t*)(F.ws + WS_H8), (const bf16_t*)(F.ws + WS_WIN), NTOK, 3 * DM, DM / 2, F.G, (int)blockIdx.x, 0);
          pg8::gemm_phase<EpiInProjT<1>, pg8::StaticOrder, true, true>(F.lds, S, E); }
    }
#endif
#if PROBE_LAUNCH == 21 || PROBE_LAUNCH == 22 || PROBE_LAUNCH == 23 || PROBE_LAUNCH == 24
    if (lo == 14) {
        constexpr int PM_ = PROBE_LAUNCH == 21 ? 2 : (PROBE_LAUNCH == 22 ? 3 : (PROBE_LAUNCH == 23 ? 4 : 5));
        EpiInProjT<PM_> E{F.ws, (const u32x4*)(F.ws + WS_ROPE_C)};
        { pg8::StaticOrder S; S.init((const bf16_t*)(F.ws + WS_H8), (const bf16_t*)(F.ws + WS_WIN), NTOK, PROJW - 3 * DM, DM / 2, F.G, (int)blockIdx.x, 12);
          pg8::gemm_phase<EpiInProjT<PM_>, pg8::StaticOrder, true, true>(F.lds, S, E); }
        { pg8::StaticOrder S; S.init((const bf16_t*)(F.ws + WS_H8), (const bf16_t*)(F.ws + WS_WIN), NTOK, 3 * DM, DM / 2, F.G, (int)blockIdx.x, 0);
          pg8::gemm_phase<EpiInProjT<PM_>, pg8::StaticOrder, true, true>(F.lds, S, E); }
    }
#endif
#undef IN
#undef SEAM
}

extern "C" void kernel_launch(void* const* d_in, const int* in_sizes, int n_in, void* d_out, int out_size, void* d_ws, size_t ws_size, hipStream_t stream) {
    static int grid = 0;
    if (grid == 0) {
        if (n_in != 21 || out_size != NTOK * DM || ws_size < WS_END) { fprintf(stderr, "kernel_launch: unexpected shapes (n_in %d out %d ws %zu)\n", n_in, out_size, ws_size); grid = -1; return; }
        int dev = 0, cus = 0, per_cu = 0;
        if (hipGetDevice(&dev) != hipSuccess || hipDeviceGetAttribute(&cus, hipDeviceAttributeMultiprocessorCount, dev) != hipSuccess) { grid = -1; return; }
        if (hipFuncSetAttribute((const void*)fwd_kernel, hipFuncAttributeMaxDynamicSharedMemorySize, LDS_BYTES) != hipSuccess) { fprintf(stderr, "kernel_launch: hipFuncSetAttribute failed\n"); grid = -1; return; }
        if (hipOccupancyMaxActiveBlocksPerMultiprocessor(&per_cu, (const void*)fwd_kernel, NTHR, LDS_BYTES) != hipSuccess || per_cu < 1)
            fprintf(stderr, "kernel_launch: note: occupancy query reports %d\n", per_cu);
        (void)hipGetLastError();
        grid = cus;
    }
    if (grid < 0) return;
    (void)hipMemsetAsync((char*)d_ws + WS_CTL, 0, CTL_ZERO_BYTES, stream);
    Args a{};
    for (int i = 0; i < 21; ++i) a.in[i] = (const float*)d_in[i];
    a.out = (float*)d_out; a.ws = (unsigned char*)d_ws;
#if MK_N_LAUNCHES == 1
    a.ph_lo = 0; a.ph_hi = N_PHASES + 1; a.li = 0;
    hipLaunchKernelGGL(fwd_kernel, dim3(grid), dim3(NTHR), LDS_BYTES, stream, a);
#else
    for (int p = 0; p <= N_PHASES; ++p) {
        if ((PROBE_LAUNCH == 18 || PROBE_LAUNCH == 19 || PROBE_LAUNCH == 20) && p == 12) { a.ph_lo = 14; a.ph_hi = 15; hipLaunchKernelGGL(fwd_kernel, dim3(grid), dim3(NTHR), LDS_BYTES, stream, a); }
        a.ph_lo = p; a.ph_hi = p + 1; a.li = p; hipLaunchKernelGGL(fwd_kernel, dim3(grid), dim3(NTHR), LDS_BYTES, stream, a);
        if ((PROBE_LAUNCH == 30 || PROBE_LAUNCH == 31) && p == 3) { a.li = 99; hipLaunchKernelGGL(fwd_kernel, dim3(grid), dim3(NTHR), LDS_BYTES, stream, a); }
        if (p == PROBE_LAUNCH) { if (p == 8) (void)hipMemsetAsync((char*)d_ws + WS_CTL + (size_t)CW_CONVQ * 4, 0, 4, stream); hipLaunchKernelGGL(fwd_kernel, dim3(grid), dim3(NTHR), LDS_BYTES, stream, a); }
        if (((PROBE_LAUNCH == 14 || PROBE_LAUNCH == 15 || PROBE_LAUNCH == 21 || PROBE_LAUNCH == 22 || PROBE_LAUNCH == 23 || PROBE_LAUNCH == 24) && p == 2) || ((PROBE_LAUNCH == 16 || PROBE_LAUNCH == 17) && p == 12)) { a.ph_lo = 14; a.ph_hi = 15; hipLaunchKernelGGL(fwd_kernel, dim3(grid), dim3(NTHR), LDS_BYTES, stream, a); } }
#endif
}
```
